# Optimizing an MI355X kernel written in HIP

```python
import math
import jax, jax.numpy as jnp
from jax import lax
import numpy as np

D_MODEL = 2048
BATCH = 2
SEQ = 8192
DEPTH = 4
DEC_BATCH = 8
DEC_SEQ = 4096
PAST_LEN = 128

HEAD_DIM = 128
SCALE = HEAD_DIM ** -0.5
A_HEADS = 6
A_KV_HEADS = 2
B_HEADS = 4
B_KV_HEADS = 2
B_WINDOW = 128
C_PATTERNS = ((128, 1), (512, 4), (2048, 16))
C_GROUPS = len(C_PATTERNS)
C_HEADS_PER_GROUP = 2
C_HEADS = C_GROUPS * C_HEADS_PER_GROUP
C_KV_HEADS = C_GROUPS
MIX_WIDTH = (A_HEADS + B_HEADS + C_HEADS) * HEAD_DIM
Q_BLOCK = 128
GRID_W = 64
ROPE_THETA = 10000.0
ROPE_AXIS_DIM = HEAD_DIM // 2
REL_BUCKETS = 32
REL_MAX_DIST = 1024
REL_HEADS = B_HEADS + C_HEADS
MEM_LEN = 256
X_HEADS = 4
X_WIDTH = X_HEADS * HEAD_DIM
D_FF = ((8 * D_MODEL + 3 * 256 - 1) // (3 * 256)) * 256
RMS_EPS = 1e-6
NEG_INF = -1e30
PROJ_SIZES = (A_HEADS * HEAD_DIM, A_KV_HEADS * HEAD_DIM, A_KV_HEADS * HEAD_DIM,
              B_HEADS * HEAD_DIM, B_KV_HEADS * HEAD_DIM, B_KV_HEADS * HEAD_DIM,
              C_HEADS * HEAD_DIM, C_KV_HEADS * HEAD_DIM, C_KV_HEADS * HEAD_DIM)
PROJ_WIDTH = sum(PROJ_SIZES)

kernel_name = 'hybrid_parallel_encoder'


def rmsnorm(x, g):
    xf = x.astype(jnp.float32)
    y = xf * lax.rsqrt(jnp.mean(xf * xf, axis=-1, keepdims=True) + RMS_EPS)
    return (y * g.astype(jnp.float32)).astype(x.dtype)


def axial_rope_tables(seq_len):
    rows = seq_len // GRID_W
    row = jnp.repeat(jnp.arange(rows), GRID_W).astype(jnp.float32)
    col = jnp.tile(jnp.arange(GRID_W), rows).astype(jnp.float32)
    inv = ROPE_THETA ** (-jnp.arange(0, ROPE_AXIS_DIM, 2, dtype=jnp.float32) / ROPE_AXIS_DIM)
    ang_r = row[:, None] * inv
    ang_c = col[:, None] * inv
    return (jnp.cos(ang_r), jnp.sin(ang_r), jnp.cos(ang_c), jnp.sin(ang_c))


def _rotate(u, c, s):
    u1, u2 = jnp.split(u, 2, axis=-1)
    c = c[:, None]
    s = s[:, None]
    return jnp.concatenate([u1 * c - u2 * s, u1 * s + u2 * c], axis=-1)


def apply_axial_rope(x, cos_r, sin_r, cos_c, sin_c):
    xf = x.astype(jnp.float32)
    xr, xc = jnp.split(xf, 2, axis=-1)
    out = jnp.concatenate([_rotate(xr, cos_r, sin_r), _rotate(xc, cos_c, sin_c)], axis=-1)
    return out.astype(x.dtype)


def t5_bucket(rel):
    nb = REL_BUCKETS // 2
    max_exact = nb // 2
    ret = jnp.where(rel > 0, nb, 0)
    n = jnp.abs(rel)
    large = max_exact + (jnp.log(jnp.maximum(n, 1).astype(jnp.float32) / max_exact)
                         / math.log(REL_MAX_DIST / max_exact) * (nb - max_exact)).astype(jnp.int32)
    large = jnp.minimum(large, nb - 1)
    return ret + jnp.where(n < max_exact, n, large)


def position_bias(rel_bias, rel, col0, n_heads):
    table = rel_bias[:, col0:col0 + n_heads].astype(jnp.float32)
    return jnp.moveaxis(table[t5_bucket(rel)], -1, 0)


def band_offsets(blk):
    return (jnp.arange(3 * blk) - blk)[None, :] - jnp.arange(blk)[:, None]


def to_residue(t, d):
    bt, s = t.shape[0], t.shape[1]
    rest = t.shape[2:]
    return jnp.moveaxis(t.reshape(bt, s // d, d, *rest), 2, 1).reshape(bt * d, s // d, *rest)


def from_residue(t, d, bt):
    l = t.shape[1]
    rest = t.shape[2:]
    return jnp.moveaxis(t.reshape(bt, d, l, *rest), 1, 2).reshape(bt, l * d, *rest)


def dense_attention_blocks(q, k, v):
    bt, s, h, d = q.shape
    hkv = k.shape[2]
    g = h // hkv
    nb = s // Q_BLOCK
    qb = jnp.moveaxis(q.reshape(bt, nb, Q_BLOCK, hkv, g, d), 1, 0)

    def attend(qi):
        sc = jnp.einsum('bqkgd,bskd->bkgqs', qi, k, preferred_element_type=jnp.float32)
        p = jax.nn.softmax(sc, axis=-1).astype(v.dtype)
        return jnp.einsum('bkgqs,bskd->bqkgd', p, v, preferred_element_type=jnp.float32).astype(q.dtype)

    o = lax.map(attend, qb)
    return jnp.moveaxis(o, 0, 1).reshape(bt, s, h, d)


def banded_attention(q, k, v, half_window, bias, sink):
    bt, l, h, d = q.shape
    hkv = k.shape[2]
    g = h // hkv
    blk = half_window
    nb = -(-l // blk)
    pad = nb * blk - l
    qb = jnp.pad(q, ((0, 0), (0, pad), (0, 0), (0, 0))).reshape(bt, nb, blk, hkv, g, d)

    def windows(t):
        tp = jnp.pad(t, ((0, 0), (blk, blk + pad), (0, 0), (0, 0))).reshape(bt, nb + 2, blk, hkv, d)
        return jnp.concatenate([tp[:, :-2], tp[:, 1:-1], tp[:, 2:]], axis=2)

    kw = windows(k)
    vw = windows(v)
    sc = jnp.einsum('bnqkgd,bnskd->bnkgqs', qb, kw, preferred_element_type=jnp.float32)
    off = band_offsets(blk)
    key_pos = jnp.arange(nb)[:, None, None] * blk + (jnp.arange(3 * blk) - blk)[None, None, :]
    valid = (jnp.abs(off) <= half_window)[None] & (key_pos >= 0) & (key_pos < l)
    sc = sc + bias.astype(jnp.float32).reshape(hkv, g, blk, 3 * blk)
    sc = jnp.where(valid[None, :, None, None], sc, NEG_INF)
    m = jnp.max(sc, axis=-1, keepdims=True)
    if sink is not None:
        sk = sink.astype(jnp.float32).reshape(hkv, g, 1, 1)
        m = jnp.maximum(m, sk)
    e = jnp.exp(sc - m)
    den = jnp.sum(e, axis=-1, keepdims=True)
    if sink is not None:
        den = den + jnp.exp(sk - m)
    o = jnp.einsum('bnkgqs,bnskd->bnqkgd', (e / den).astype(v.dtype), vw,
                   preferred_element_type=jnp.float32)
    lse = (m + jnp.log(den))[..., 0]
    o = o.reshape(bt, nb * blk, h, d)[:, :l].astype(q.dtype)
    lse = jnp.moveaxis(lse, -1, 2).reshape(bt, nb * blk, h)[:, :l]
    return o, lse


def hybrid_mixer(h, w_in, q_gain, k_gain, sink, w_out, rope, bias_b, bias_c):
    bt, s, _ = h.shape
    splits = np.cumsum(PROJ_SIZES)[:-1]
    qa, ka, va, qb, kb, vb, qc, kc, vc = jnp.split(h @ w_in, splits, axis=-1)

    def heads(t, n):
        return t.reshape(bt, s, n, HEAD_DIM)

    qa = apply_axial_rope(rmsnorm(heads(qa, A_HEADS), q_gain), *rope) * SCALE
    ka = apply_axial_rope(rmsnorm(heads(ka, A_KV_HEADS), k_gain), *rope)
    out_a = dense_attention_blocks(qa, ka, heads(va, A_KV_HEADS))

    out_b, _ = banded_attention(heads(qb, B_HEADS) * SCALE, heads(kb, B_KV_HEADS), heads(vb, B_KV_HEADS),
                                B_WINDOW, bias_b, sink)

    qc = heads(qc, C_HEADS) * SCALE
    kc = heads(kc, C_KV_HEADS)
    vc = heads(vc, C_KV_HEADS)
    outs = []
    lses = []
    for gi, (window, dil) in enumerate(C_PATTERNS):
        hs = slice(gi * C_HEADS_PER_GROUP, (gi + 1) * C_HEADS_PER_GROUP)
        o_g, lse_g = banded_attention(to_residue(qc[:, :, hs], dil), to_residue(kc[:, :, gi:gi + 1], dil),
                                      to_residue(vc[:, :, gi:gi + 1], dil), window // (2 * dil),
                                      bias_c[gi], None)
        outs.append(from_residue(o_g, dil, bt))
        lses.append(from_residue(lse_g, dil, bt))
    alpha = jax.nn.softmax(jnp.stack(lses, axis=2), axis=2)
    out_c = (jnp.stack(outs, axis=2).astype(jnp.float32) * alpha[..., None]).astype(h.dtype)

    mixed = jnp.concatenate([out_a.reshape(bt, s, -1), out_b.reshape(bt, s, -1),
                             out_c.reshape(bt, s, -1)], axis=-1)
    return mixed @ w_out


def memory_cross_attention(h, mem_h, w_cq, w_ckv, w_co):
    bt, s, _ = h.shape
    m = mem_h.shape[1]
    q = (h @ w_cq).reshape(bt, s, X_HEADS, HEAD_DIM) * SCALE
    kv = (mem_h @ w_ckv).reshape(bt, m, 2, X_HEADS, HEAD_DIM)
    sc = jnp.einsum('bshd,bmhd->bhsm', q, kv[:, :, 0], preferred_element_type=jnp.float32)
    p = jax.nn.softmax(sc, axis=-1).astype(kv.dtype)
    o = jnp.einsum('bhsm,bmhd->bshd', p, kv[:, :, 1], preferred_element_type=jnp.float32).astype(h.dtype)
    return o.reshape(bt, s, X_WIDTH) @ w_co


def swiglu(h, w_ffn_in, w_ffn_out):
    gate, up = jnp.split(h @ w_ffn_in, 2, axis=-1)
    return (jax.nn.silu(gate) * up) @ w_ffn_out


def encode(x, mem, ln_mix, w_in, q_norm_a, k_norm_a, sink_b, rel_bias, w_out, ln_cross, ln_mem,
           w_cq, w_ckv, w_co, ln_ffn, w_ffn_in, w_ffn_out, ln_final):
    s = x.shape[1]
    rope = axial_rope_tables(s)
    bias_b = position_bias(rel_bias, band_offsets(B_WINDOW), 0, B_HEADS)
    bias_c = [position_bias(rel_bias, band_offsets(w // (2 * d)) * d, B_HEADS + gi * C_HEADS_PER_GROUP,
                            C_HEADS_PER_GROUP) for gi, (w, d) in enumerate(C_PATTERNS)]
    for l in range(DEPTH):
        x = x + hybrid_mixer(rmsnorm(x, ln_mix[l]), w_in[l], q_norm_a[l], k_norm_a[l], sink_b[l], w_out[l],
                             rope, bias_b, bias_c)
        x = x + memory_cross_attention(rmsnorm(x, ln_cross[l]), rmsnorm(mem, ln_mem[l]),
                                       w_cq[l], w_ckv[l], w_co[l])
        x = x + swiglu(rmsnorm(x, ln_ffn[l]), w_ffn_in[l], w_ffn_out[l])
    return rmsnorm(x, ln_final)


def setup_inputs(seed: int = 0) -> dict:
    key = jax.random.key(seed)
    ks = jax.random.split(key, 24)

    def normal(k, shape, scale):
        return jax.random.normal(k, shape, jnp.float32) * scale

    def gain(k, shape):
        return 1.0 + normal(k, shape, 0.02)

    return {
        'x_prompt': normal(ks[0], (BATCH, SEQ, D_MODEL), 1.0),
        'x_sample': normal(ks[1], (DEC_BATCH, DEC_SEQ, D_MODEL), 1.0),
        'mem_prompt': normal(ks[2], (BATCH, MEM_LEN, D_MODEL), 1.0),
        'mem_sample': normal(ks[3], (DEC_BATCH, MEM_LEN, D_MODEL), 1.0),
        'ln_mix': gain(ks[4], (DEPTH, D_MODEL)),
        'w_in': normal(ks[5], (DEPTH, D_MODEL, PROJ_WIDTH), D_MODEL ** -0.5),
        'q_norm_a': gain(ks[6], (DEPTH, HEAD_DIM)),
        'k_norm_a': gain(ks[7], (DEPTH, HEAD_DIM)),
        'sink_b': normal(ks[8], (DEPTH, B_HEADS), 0.5),
        'rel_bias': normal(ks[9], (REL_BUCKETS, REL_HEADS), 0.5),
        'w_out': normal(ks[10], (DEPTH, MIX_WIDTH, D_MODEL), MIX_WIDTH ** -0.5),
        'ln_cross': gain(ks[11], (DEPTH, D_MODEL)),
        'ln_mem': gain(ks[12], (DEPTH, D_MODEL)),
        'w_cq': normal(ks[13], (DEPTH, D_MODEL, X_WIDTH), D_MODEL ** -0.5),
        'w_ckv': normal(ks[14], (DEPTH, D_MODEL, 2 * X_WIDTH), D_MODEL ** -0.5),
        'w_co': normal(ks[15], (DEPTH, X_WIDTH, D_MODEL), X_WIDTH ** -0.5),
        'ln_ffn': gain(ks[16], (DEPTH, D_MODEL)),
        'w_ffn_in': normal(ks[17], (DEPTH, D_MODEL, 2 * D_FF), D_MODEL ** -0.5),
        'w_ffn_out': normal(ks[18], (DEPTH, D_FF, D_MODEL), D_FF ** -0.5),
        'ln_final': gain(ks[19], (D_MODEL,)),
    }


def reference(x_prompt, x_sample, mem_prompt, mem_sample, ln_mix, w_in, q_norm_a, k_norm_a, sink_b, rel_bias,
              w_out, ln_cross, ln_mem, w_cq, w_ckv, w_co, ln_ffn, w_ffn_in, w_ffn_out, ln_final):
    y_prompt = encode(x_prompt, mem_prompt, ln_mix, w_in, q_norm_a, k_norm_a, sink_b, rel_bias, w_out,
                      ln_cross, ln_mem, w_cq, w_ckv, w_co, ln_ffn, w_ffn_in, w_ffn_out, ln_final)
    y_sample = encode(x_sample, mem_sample, ln_mix, w_in, q_norm_a, k_norm_a, sink_b, rel_bias, w_out,
                      ln_cross, ln_mem, w_cq, w_ckv, w_co, ln_ffn, w_ffn_in, w_ffn_out, ln_final)
    return (y_prompt, y_sample)
```

```cpp
#include <hip/hip_runtime.h>
#include <cstdio>
#include <cstdint>

#ifndef ONE_LAUNCH
#define ONE_LAUNCH 1
#endif

constexpr int DM = 2048, NTOK = 49152, NPROMPT = 16384, SEQ_P = 8192, SEQ_S = 4096, DEPTH = 4;
constexpr int PROJ = 3840, MIXW = 2048, XW = 512, DFF = 5632, MEMLEN = 256, MEMROWS = 2560, HD = 128;
constexpr int COL_QA = 0, COL_KA = 768, COL_VA = 1024, COL_QB = 1280, COL_KB = 1792, COL_VB = 2048, COL_QC = 2304, COL_KC = 3072, COL_VC = 3456;
constexpr float RMS_EPS = 1e-6f;
constexpr int PPL = 9;
constexpr int NPHASE = 2 + PPL * DEPTH;
constexpr int NNORM = 3 * DEPTH + 1;

constexpr size_t MiB = 1u << 20;
constexpr size_t WS_CTL = 0;
constexpr size_t WS_SS = 1 * MiB;
constexpr size_t CTL_ZERO_BYTES = 6 * MiB + 512 * 1024;
static_assert(WS_SS + (size_t)(NNORM + 1) * NTOK * 8 <= CTL_ZERO_BYTES, "ss inside the memset region");
constexpr size_t WS_TAB = 6 * MiB + 512 * 1024;
constexpr size_t WS_RSM = 7 * MiB;
constexpr size_t WS_LSE = 618 * MiB;
constexpr size_t WS_WIN = 8 * MiB, WS_WOUT = 68 * MiB, WS_WCQ = 100 * MiB, WS_WCKV = 108 * MiB, WS_WCO = 124 * MiB, WS_WFI = 132 * MiB, WS_WFO = 308 * MiB;
constexpr size_t WS_XB = 396 * MiB;
constexpr size_t WS_MB = 588 * MiB;
constexpr size_t WS_KVX = 598 * MiB;
constexpr size_t WS_QKV = 620 * MiB;
constexpr size_t WS_MIX = 980 * MiB;
constexpr size_t WS_HID = 620 * MiB;
constexpr size_t WS_QX = 620 * MiB, WS_OX = 668 * MiB;
constexpr size_t WS_END = 1172 * MiB;
constexpr int CW_BAR = 4096;
constexpr int CW_XRANK = 12288;
constexpr int CW_QUEUE = 16384;

#define GAS __attribute__((address_space(1)))
#define LAS __attribute__((address_space(3)))
typedef unsigned short bf16_t;
typedef short bf16x8 __attribute__((ext_vector_type(8)));
typedef short s16x4 __attribute__((ext_vector_type(4)));
typedef float f32x4 __attribute__((ext_vector_type(4)));
typedef float f32x16 __attribute__((ext_vector_type(16)));
typedef unsigned u32x4 __attribute__((ext_vector_type(4)));
typedef unsigned u32x2 __attribute__((ext_vector_type(2)));
typedef GAS unsigned gu32;

__device__ __forceinline__ int opaque_tid() { int t = threadIdx.x; asm volatile("" : "+v"(t)); return t; }
__device__ __forceinline__ unsigned cvt_pk_bf16(float lo, float hi) { unsigned r; asm volatile("v_cvt_pk_bf16_f32 %0, %1, %2" : "=v"(r) : "v"(lo), "v"(hi)); return r; }
__device__ __forceinline__ float bf2f(unsigned short b) { return __builtin_bit_cast(float, (unsigned)b << 16); }
__device__ __forceinline__ float bflo(unsigned w) { return __builtin_bit_cast(float, w << 16); }
__device__ __forceinline__ float bfhi(unsigned w) { return __builtin_bit_cast(float, w & 0xffff0000u); }

namespace pg8 {
#define PG8_LAS __attribute__((address_space(3)))
constexpr int BM = 256, BK = 64, HALF = 128, HTB = HALF * BK * 2, STAGE_BYTES = 8 * HTB, NXCD = 8, WGM = 4;
__host__ __device__ __forceinline__ int lds_byte(int r, int c) { const int st = (r >> 4) * 2 + (c >> 5), rr = r & 15, cc = c & 31, ob = rr * 64 + cc * 2; return st * 1024 + (ob ^ (((ob >> 9) & 1) << 5)); }
__host__ __device__ __forceinline__ void stage_rc(int b, int& R, int& C) { const int st = b / 1024, sb = b % 1024, swz = sb ^ (((sb >> 9) & 1) << 5); R = (st >> 1) * 16 + swz / 64; C = (st & 1) * 32 + (swz % 64) / 2; }
__host__ __device__ __forceinline__ int perm32(int rho) { const int n = rho >> 4, i = rho & 15; return 8 * (i >> 2) + 4 * n + (i & 3); }

struct Unit { int pm, pn; };
struct Gemm { const bf16_t* A; const bf16_t* Bt; int M, N, K; };

struct StaticOrder {
    int nM, nN, nwg, G, c, i_lo, i_hi, wgm = WGM;
    __host__ __device__ void init(int M, int N, int G_, int c_, int lo_ = 0, int hi_ = 1 << 30) { nM = M / BM; nN = N / BM; nwg = nM * nN; G = G_; c = c_; i_lo = lo_; i_hi = hi_; }
    __host__ __device__ bool next(int i, Unit& u) const {
        i += i_lo; if (i >= i_hi) return false;
        const long L = (long)i * G + c; if (L >= nwg) return false;
        int wgid = (int)L; { const int q = nwg / NXCD, r = nwg % NXCD, xcd = wgid % NXCD, off = wgid / NXCD; wgid = (xcd < r ? xcd * (q + 1) : r * (q + 1) + (xcd - r) * q) + off; }
        const int nig = wgm * nN, gid = wgid / nig, fm = gid * wgm, gsz = (nM - fm) < wgm ? (nM - fm) : wgm;
        u.pm = fm + ((wgid % nig) % gsz); u.pn = (wgid % nig) / gsz; return true;
    }
    __device__ __forceinline__ void a_ready(const Unit&) const {}
    __device__ __forceinline__ void done(const Unit&) const {}
};

typedef unsigned long long ss_t;
constexpr float SS_SCALE = 16777216.0f, SS_INV_MEAN = 1.0f / (16777216.0f * 2048.0f);
struct PreSS { ss_t v[2][4]; };
struct PreNone {};
__device__ __forceinline__ void ss_prefetch(PreSS& p, const ss_t* ss, int row0) {
#pragma unroll
    for (int ai = 0; ai < 2; ++ai)
#pragma unroll
        for (int m = 0; m < 4; ++m) p.v[ai][m] = ss[row0 + ai * HALF + m * 16];
}
__device__ __forceinline__ void row_rstd(const PreSS& p, float (&rs)[2][4]) {
#pragma unroll
    for (int ai = 0; ai < 2; ++ai)
#pragma unroll
        for (int m = 0; m < 4; ++m) rs[ai][m] = 1.0f / sqrtf((float)p.v[ai][m] * SS_INV_MEAN + 1e-6f);
}
struct EpiBf16 {
    static constexpr bool PERM = true, AFTER_DRAIN = false;
    bf16_t* O; int ldc; const ss_t* ss;
    typedef PreSS Pre;
    __device__ __forceinline__ void prefetch(Pre& p, const Unit& u, int wr, int fr) const { ss_prefetch(p, ss, u.pm * BM + wr * 64 + fr); }
    __device__ __forceinline__ void operator()(const f32x4 (&acc)[2][2][4][2], const Unit& u, int wr, int wc, int fr, int fq, const Pre& pre) const {
        const int row0 = u.pm * BM + wr * 64 + fr; const int col0 = u.pn * BM + wc * 32 + 8 * fq;
        float rs[2][4]; row_rstd(pre, rs);
#pragma unroll
        for (int ai = 0; ai < 2; ++ai)
#pragma unroll
            for (int m = 0; m < 4; ++m) { bf16_t* rowp = O + (size_t)(row0 + ai * HALF + m * 16) * ldc + col0; const float r = rs[ai][m];
#pragma unroll
                for (int bj = 0; bj < 2; ++bj) { const f32x4 v0 = acc[ai][bj][m][0] * r, v1 = acc[ai][bj][m][1] * r;
                    u32x4 w; w.x = cvt_pk_bf16(v0[0], v0[1]); w.y = cvt_pk_bf16(v0[2], v0[3]); w.z = cvt_pk_bf16(v1[0], v1[1]); w.w = cvt_pk_bf16(v1[2], v1[3]);
                    *(u32x4*)(rowp + bj * HALF) = w; } }
    }
};
struct EpiRes {
    static constexpr bool PERM = true, AFTER_DRAIN = false;
    bf16_t* xb; ss_t* ssout; float scale;
    typedef PreNone Pre;
    __device__ __forceinline__ void prefetch(Pre&, const Unit&, int, int) const {}
    __device__ __forceinline__ void operator()(const f32x4 (&acc)[2][2][4][2], const Unit& u, int wr, int wc, int fr, int fq, const Pre&) const {
        const int row0 = u.pm * BM + wr * 64 + fr; const int col0 = u.pn * BM + wc * 32 + 8 * fq;
        bf16_t* xbase = xb + (size_t)row0 * DM + col0;
#pragma unroll
        for (int ai = 0; ai < 2; ++ai) { float sq[4];
            u32x4 xv[4][2];
#pragma unroll
            for (int m = 0; m < 4; ++m)
#pragma unroll
                for (int bj = 0; bj < 2; ++bj) xv[m][bj] = *(const u32x4*)(xbase + (size_t)(ai * HALF + m * 16) * DM + bj * HALF);
#pragma unroll
            for (int m = 0; m < 4; ++m) { bf16_t* bp = xbase + (size_t)(ai * HALF + m * 16) * DM;
                float q = 0.f;
#pragma unroll
                for (int bj = 0; bj < 2; ++bj) { const u32x4 xw = xv[m][bj]; const f32x4 d0 = acc[ai][bj][m][0] * scale, d1 = acc[ai][bj][m][1] * scale;
                    u32x4 w; w.x = cvt_pk_bf16(bflo(xw.x) + d0[0], bfhi(xw.x) + d0[1]); w.y = cvt_pk_bf16(bflo(xw.y) + d0[2], bfhi(xw.y) + d0[3]);
                    w.z = cvt_pk_bf16(bflo(xw.z) + d1[0], bfhi(xw.z) + d1[1]); w.w = cvt_pk_bf16(bflo(xw.w) + d1[2], bfhi(xw.w) + d1[3]);
                    *(u32x4*)(bp + bj * HALF) = w;
                    const float e0 = bflo(w.x), e1 = bfhi(w.x), e2 = bflo(w.y), e3 = bfhi(w.y), e4 = bflo(w.z), e5 = bfhi(w.z), e6 = bflo(w.w), e7 = bfhi(w.w);
                    q += (e0 * e0 + e1 * e1) + (e2 * e2 + e3 * e3) + (e4 * e4 + e5 * e5) + (e6 * e6 + e7 * e7); }
                sq[m] = q; }
            asm volatile("" ::: "memory");
            const bool b0 = fq & 1, b1 = fq & 2;
            const float w0 = (b0 ? sq[1] : sq[0]) + __shfl_xor(b0 ? sq[0] : sq[1], 16), w1 = (b0 ? sq[3] : sq[2]) + __shfl_xor(b0 ? sq[2] : sq[3], 16);
            const float tot = (b1 ? w1 : w0) + __shfl_xor(b1 ? w0 : w1, 32);
            __hip_atomic_fetch_add(ssout + u.pm * BM + ai * HALF + wr * 64 + fq * 16 + fr, (ss_t)(tot * SS_SCALE), __ATOMIC_RELAXED, __HIP_MEMORY_SCOPE_AGENT); }
    }
};
struct EpiSwiglu {
    static constexpr bool PERM = true, AFTER_DRAIN = false;
    bf16_t* O; int ldc; const ss_t* ss;
    typedef PreSS Pre;
    __device__ __forceinline__ void prefetch(Pre& p, const Unit& u, int wr, int fr) const { ss_prefetch(p, ss, u.pm * BM + wr * 64 + fr); }
    __device__ __forceinline__ void operator()(const f32x4 (&acc)[2][2][4][2], const Unit& u, int wr, int wc, int fr, int fq, const Pre& pre) const {
        const int row0 = u.pm * BM + wr * 64 + fr; const int col0 = u.pn * HALF + wc * 32 + 8 * fq;
        float rs[2][4]; row_rstd(pre, rs);
#pragma unroll
        for (int ai = 0; ai < 2; ++ai)
#pragma unroll
            for (int m = 0; m < 4; ++m) { float h[8]; const float r = rs[ai][m];
#pragma unroll
                for (int n = 0; n < 2; ++n)
#pragma unroll
                    for (int i = 0; i < 4; ++i) { const float g = acc[ai][0][m][n][i] * r, up = acc[ai][1][m][n][i] * r;
                        const float e = __builtin_amdgcn_exp2f(-g * 1.4426950408889634f); h[n * 4 + i] = g * __builtin_amdgcn_rcpf(1.0f + e) * up; }
                u32x4 w; w.x = cvt_pk_bf16(h[0], h[1]); w.y = cvt_pk_bf16(h[2], h[3]); w.z = cvt_pk_bf16(h[4], h[5]); w.w = cvt_pk_bf16(h[6], h[7]);
                *(u32x4*)(O + (size_t)(row0 + ai * HALF + m * 16) * ldc + col0) = w; }
    }
};

template <class Epi, class Sched, bool ALIGN_EPI = false, bool SP2 = false>
__device__ __forceinline__ void gemm_phase(PG8_LAS unsigned char* lds, const Gemm g, const Sched& S, const Epi& E) {
    const int tid = opaque_tid(), wid = __builtin_amdgcn_readfirstlane(tid >> 6), lane = tid & 63, wr = wid >> 2, wc = wid & 3, fr = lane & 15, fq = lane >> 4;
    const int K = g.K, nt = K / BK;
    unsigned voffA[2], voffB[2];
#pragma unroll
    for (int i = 0; i < 2; ++i) { int R, C; stage_rc(tid * 16 + i * 8192, R, C); const int Rb = Epi::PERM ? ((R & ~31) + perm32(R & 31)) : R;
        voffA[i] = (unsigned)(R * K + C) * 2u; voffB[i] = (unsigned)(Rb * K + C) * 2u; }
    const size_t kstep = (size_t)(BK * 2);
    const size_t hstep = (size_t)HALF * K * 2;
    const size_t tstep = 2 * hstep;
    const unsigned ldsw = (unsigned)wid * 1024u;
    const int aoff = lds_byte(wr * 64 + fr, fq * 8), boff = lds_byte(wc * 32 + fr, fq * 8);
#define PG8_SA(b, h) (((b) * 2 + (h)) * HTB)
#define PG8_SB(b, h) ((4 + (b) * 2 + (h)) * HTB)
#define PG8_STAGE(bufoff, gbase, voff) do { _Pragma("unroll") for (int _i = 0; _i < 2; ++_i) \
        __builtin_amdgcn_global_load_lds((const unsigned*)((const char*)(gbase) + (voff)[_i]), (PG8_LAS unsigned*)(lds + (bufoff) + ldsw + _i * 8192), 16, 0, 0); } while (0)
#define PG8_LDA(dst, b, h) do { _Pragma("unroll") for (int m = 0; m < 4; ++m) _Pragma("unroll") for (int k = 0; k < 2; ++k) dst[m][k] = *(const PG8_LAS bf16x8*)(lds + PG8_SA(b, h) + aoff + m * 2048 + k * 1024); } while (0)
#define PG8_LDB(dst, b, h) do { _Pragma("unroll") for (int n = 0; n < 2; ++n) _Pragma("unroll") for (int k = 0; k < 2; ++k) dst[n][k] = *(const PG8_LAS bf16x8*)(lds + PG8_SB(b, h) + boff + n * 2048 + k * 1024); } while (0)
#define PG8_MMA(ai, bj, At, Bt) do { __builtin_amdgcn_s_setprio(1); _Pragma("unroll") for (int m = 0; m < 4; ++m) _Pragma("unroll") for (int n = 0; n < 2; ++n) _Pragma("unroll") for (int k = 0; k < 2; ++k) \
        acc[ai][bj][m][n] = __builtin_amdgcn_mfma_f32_16x16x32_bf16(Bt[n][k], At[m][k], acc[ai][bj][m][n], 0, 0, 0); __builtin_amdgcn_s_setprio(0); } while (0)
#define PG8_WAIT_V(n) asm volatile("s_waitcnt vmcnt(" #n ")" ::: "memory")
#define PG8_WAIT_L(n) asm volatile("s_waitcnt lgkmcnt(" #n ")" ::: "memory")
#define PG8_BAR __builtin_amdgcn_s_barrier()
#define PG8_SCHED __builtin_amdgcn_sched_barrier(0)
    Unit cur, nxt; int ui = 0;
    if (!S.next(0, cur)) return;
    f32x4 acc[2][2][4][2];
#pragma unroll
    for (int a = 0; a < 2; ++a)
#pragma unroll
        for (int b = 0; b < 2; ++b)
#pragma unroll
            for (int m = 0; m < 4; ++m)
#pragma unroll
                for (int n = 0; n < 2; ++n) acc[a][b][m][n] = (f32x4){0.f, 0.f, 0.f, 0.f};
    bf16x8 At[4][2], B0[2][2], B1[2][2];
    typename Epi::Pre pre;
    const char* cA = (const char*)g.A + (size_t)cur.pm * tstep; const char* cB = (const char*)g.Bt + (size_t)cur.pn * tstep;
    S.a_ready(cur);
    if constexpr (SP2) {
        PG8_STAGE(PG8_SB(0, 0), cB, voffB); PG8_STAGE(PG8_SB(0, 1), cB + hstep, voffB); PG8_STAGE(PG8_SA(0, 0), cA, voffA); PG8_STAGE(PG8_SA(0, 1), cA + hstep, voffA);
        if (wr == 1) PG8_BAR;
        PG8_WAIT_V(2); PG8_BAR;
        PG8_STAGE(PG8_SB(1, 0), cB + kstep, voffB); PG8_STAGE(PG8_SA(1, 0), cA + kstep, voffA); PG8_STAGE(PG8_SB(1, 1), cB + hstep + kstep, voffB);
        PG8_WAIT_V(6); PG8_BAR;
    } else {
        PG8_STAGE(PG8_SB(0, 0), cB, voffB); PG8_STAGE(PG8_SA(0, 0), cA, voffA); PG8_STAGE(PG8_SB(0, 1), cB + hstep, voffB); PG8_STAGE(PG8_SA(0, 1), cA + hstep, voffA);
        if (wr == 1) PG8_BAR;
        PG8_WAIT_V(4); PG8_BAR;
        PG8_STAGE(PG8_SB(1, 0), cB + kstep, voffB); PG8_STAGE(PG8_SA(1, 0), cA + kstep, voffA); PG8_STAGE(PG8_SB(1, 1), cB + hstep + kstep, voffB);
        PG8_WAIT_V(6); PG8_BAR;
    }
    for (;;) {
        const bool has_next = S.next(ui + 1, nxt);
        const char* nA = has_next ? (const char*)g.A + (size_t)nxt.pm * tstep : cA; const char* nB = has_next ? (const char*)g.Bt + (size_t)nxt.pn * tstep : cB;
        for (int t = 0; t < nt; t += 2) {
            const bool last = (t == nt - 2);
            const char* a1 = cA + (size_t)(t + 1) * kstep;
            const char* a2 = last ? nA : cA + (size_t)(t + 2) * kstep; const char* b2 = last ? nB : cB + (size_t)(t + 2) * kstep;
            const char* a3 = a2 + kstep; const char* b3 = b2 + kstep;
            if (last && has_next) S.a_ready(nxt);
            if (last) E.prefetch(pre, cur, wr, fr);
            if constexpr (SP2) {
            PG8_LDB(B0, 0, 0); PG8_LDB(B1, 0, 1); PG8_SCHED; PG8_LDA(At, 0, 0); PG8_STAGE(PG8_SA(1, 1), a1 + hstep, voffA);
            PG8_WAIT_V(8); PG8_WAIT_L(0); PG8_BAR; PG8_MMA(0, 0, At, B0); PG8_MMA(0, 1, At, B1); PG8_BAR; PG8_SCHED;
            PG8_LDA(At, 0, 1); PG8_STAGE(PG8_SB(0, 0), b2, voffB); PG8_STAGE(PG8_SB(0, 1), b2 + hstep, voffB); PG8_STAGE(PG8_SA(0, 0), a2, voffA);
            PG8_WAIT_V(8); PG8_WAIT_L(0); PG8_BAR; PG8_MMA(1, 0, At, B0); PG8_MMA(1, 1, At, B1); PG8_BAR; PG8_SCHED;
            PG8_LDB(B0, 1, 0); PG8_LDB(B1, 1, 1); PG8_SCHED; PG8_LDA(At, 1, 0); PG8_STAGE(PG8_SA(0, 1), a2 + hstep, voffA);
            PG8_WAIT_V(8); PG8_WAIT_L(0); PG8_BAR; PG8_MMA(0, 0, At, B0); PG8_MMA(0, 1, At, B1); PG8_BAR; PG8_SCHED;
            PG8_LDA(At, 1, 1); PG8_STAGE(PG8_SB(1, 0), b3, voffB); PG8_STAGE(PG8_SB(1, 1), b3 + hstep, voffB); PG8_STAGE(PG8_SA(1, 0), a3, voffA);
            PG8_WAIT_V(8); PG8_WAIT_L(0); PG8_BAR; PG8_MMA(1, 0, At, B0); PG8_MMA(1, 1, At, B1); PG8_BAR; PG8_SCHED;
            } else {
            PG8_LDB(B0, 0, 0); PG8_SCHED; PG8_LDA(At, 0, 0); PG8_STAGE(PG8_SA(1, 1), a1 + hstep, voffA);
            PG8_WAIT_L(8); PG8_BAR; PG8_WAIT_L(0); PG8_MMA(0, 0, At, B0); PG8_BAR; PG8_SCHED;
            PG8_LDB(B1, 0, 1); PG8_STAGE(PG8_SB(0, 0), b2, voffB);
            PG8_BAR; PG8_WAIT_L(0); PG8_MMA(0, 1, At, B1); PG8_BAR;
            PG8_LDA(At, 0, 1); PG8_STAGE(PG8_SA(0, 0), a2, voffA);
            PG8_BAR; PG8_WAIT_L(0); PG8_MMA(1, 0, At, B0); PG8_BAR; PG8_SCHED;
            PG8_STAGE(PG8_SB(0, 1), b2 + hstep, voffB);
            PG8_WAIT_V(6); PG8_BAR; PG8_MMA(1, 1, At, B1); PG8_BAR;
            PG8_LDB(B0, 1, 0); PG8_SCHED; PG8_LDA(At, 1, 0); PG8_STAGE(PG8_SA(0, 1), a2 + hstep, voffA);
            PG8_WAIT_L(8); PG8_BAR; PG8_WAIT_L(0); PG8_MMA(0, 0, At, B0); PG8_BAR; PG8_SCHED;
            PG8_LDB(B1, 1, 1); PG8_STAGE(PG8_SB(1, 0), b3, voffB);
            PG8_BAR; PG8_WAIT_L(0); PG8_MMA(0, 1, At, B1); PG8_BAR;
            PG8_LDA(At, 1, 1); PG8_STAGE(PG8_SA(1, 0), a3, voffA);
            PG8_BAR; PG8_WAIT_L(0); PG8_MMA(1, 0, At, B0); PG8_BAR; PG8_SCHED;
            PG8_STAGE(PG8_SB(1, 1), b3 + hstep, voffB);
            PG8_WAIT_V(6); PG8_BAR; PG8_MMA(1, 1, At, B1); PG8_BAR;
            }
        }
        if constexpr (ALIGN_EPI) { if (wr == 0) PG8_BAR; }
        if constexpr (!Epi::AFTER_DRAIN) { E(acc, cur, wr, wc, fr, fq, pre); S.done(cur); }
        if (!has_next) break;
#pragma unroll
        for (int a = 0; a < 2; ++a)
#pragma unroll
            for (int b = 0; b < 2; ++b)
#pragma unroll
                for (int m = 0; m < 4; ++m)
#pragma unroll
                    for (int n = 0; n < 2; ++n) acc[a][b][m][n] = (f32x4){0.f, 0.f, 0.f, 0.f};
        cur = nxt; cA = nA; cB = nB; ++ui;
        if constexpr (ALIGN_EPI) { if (wr == 1) PG8_BAR; }
    }
    PG8_WAIT_V(0);
    if constexpr (!ALIGN_EPI) { if (wr == 0) PG8_BAR; }
    PG8_BAR;
#undef PG8_SA
#undef PG8_SB
#undef PG8_STAGE
#undef PG8_LDA
#undef PG8_LDB
#undef PG8_MMA
#undef PG8_WAIT_V
#undef PG8_WAIT_L
#undef PG8_BAR
#undef PG8_SCHED
}
}

namespace att {
constexpr int D = 128, NW = 8, QBLK = 32, KVBLK = 64;
constexpr float SCALE = 0.088388347648318440f, LOG2E = 1.4426950408889634f, LN2 = 0.6931471805599453f;
constexpr float C = SCALE * LOG2E;
constexpr float THR2 = 8.f * LOG2E;
constexpr int SHM_V = KVBLK * D * 2, SHM_K = KVBLK * D * 2;
constexpr int OFF_V = 0, OFF_K = 2 * SHM_V, BUF3 = SHM_V + SHM_K  , OFF_WS = 3 * BUF3, OFF_TAB = OFF_WS + NW * 64 * 4, TAB_FLOATS = 1024, OFF_UID = OFF_TAB + TAB_FLOATS * 4, LDS_BYTES = OFF_UID + 64;
#define KSWZ(row, colB) ((row) * 256 + ((colB) ^ (((row) & 7) << 4)))
#define SBAR() __builtin_amdgcn_sched_barrier(0)
__device__ __forceinline__ int crow(int r, int hi) { return (r & 3) + 8 * (r >> 2) + 4 * hi; }
__device__ __forceinline__ void qkt(f32x16& p0, f32x16& p1, const char* Ks, const bf16x8* qr, int r32, int hi) {
  p0 = f32x16{}; p1 = f32x16{};
#pragma unroll
  for (int d0 = 0; d0 < 8; ++d0) { const int cb = (d0 * 16 + hi * 8) * 2;
    const bf16x8 b0 = *reinterpret_cast<const bf16x8*>(Ks + KSWZ(r32, cb));
    const bf16x8 b1 = *reinterpret_cast<const bf16x8*>(Ks + KSWZ(32 + r32, cb));
    p0 = __builtin_amdgcn_mfma_f32_32x32x16_bf16(b0, qr[d0], p0, 0, 0, 0);
    p1 = __builtin_amdgcn_mfma_f32_32x32x16_bf16(b1, qr[d0], p1, 0, 0, 0); }
}
__device__ __forceinline__ int v_st(int k, int c) { const int kk = (k & ~0xC) | ((k & 4) << 1) | ((k & 8) >> 1); return ((kk >> 3) * 4 + (c >> 5)) * 512 + ((kk & 7) * 32 + (c & 31)) * 2; }
__device__ __forceinline__ int v_rd_base(int lane) { return ((lane & 3) << 3) | (((lane >> 2) & 3) << 6) | (((lane >> 4) & 1) << 5) | (((lane >> 5) & 1) << 8); }
constexpr int v_rd_off(int d0, int ks, int half) { return d0 * 512 + ks * 4096 + half * 2048; }
template <int OFF> __device__ __forceinline__ s16x4 tr_read(int vb) {
  s16x4 r; asm volatile("ds_read_b64_tr_b16 %0, %1 offset:%2" : "=&v"(r) : "v"(vb), "i"(OFF) : "memory"); return r;
}
template <int D0> __device__ __forceinline__ void pv_one(f32x16& od, int vb, bf16x8 pa0, bf16x8 pa1, bf16x8 pa2, bf16x8 pa3) {
  const s16x4 l0 = tr_read<v_rd_off(D0, 0, 0)>(vb), h0 = tr_read<v_rd_off(D0, 0, 1)>(vb), l1 = tr_read<v_rd_off(D0, 1, 0)>(vb), h1 = tr_read<v_rd_off(D0, 1, 1)>(vb);
  const s16x4 l2 = tr_read<v_rd_off(D0, 2, 0)>(vb), h2 = tr_read<v_rd_off(D0, 2, 1)>(vb), l3 = tr_read<v_rd_off(D0, 3, 0)>(vb), h3 = tr_read<v_rd_off(D0, 3, 1)>(vb);
  asm volatile("s_waitcnt lgkmcnt(0)" ::: "memory"); SBAR();
#define PK(L, H) (bf16x8){L[0], L[1], L[2], L[3], H[0], H[1], H[2], H[3]}
  od = __builtin_amdgcn_mfma_f32_32x32x16_bf16(pa0, PK(l0, h0), od, 0, 0, 0);
  od = __builtin_amdgcn_mfma_f32_32x32x16_bf16(pa1, PK(l1, h1), od, 0, 0, 0);
  od = __builtin_amdgcn_mfma_f32_32x32x16_bf16(pa2, PK(l2, h2), od, 0, 0, 0);
  od = __builtin_amdgcn_mfma_f32_32x32x16_bf16(pa3, PK(l3, h3), od, 0, 0, 0);
#undef PK
}
__device__ __forceinline__ void pv_d0(f32x16* o, int vb, bf16x8 pa0, bf16x8 pa1, bf16x8 pa2, bf16x8 pa3) {
  pv_one<0>(o[0], vb, pa0, pa1, pa2, pa3); pv_one<1>(o[1], vb, pa0, pa1, pa2, pa3); pv_one<2>(o[2], vb, pa0, pa1, pa2, pa3); pv_one<3>(o[3], vb, pa0, pa1, pa2, pa3);
}

template <bool TAB>
__device__ __forceinline__ void attn_unit(const bf16_t* __restrict__ Qb, long ldq, const bf16_t* __restrict__ Kh, const bf16_t* __restrict__ Vh, long ldk,
                                          bf16_t* __restrict__ Ob, long ldo, int t_lo, int t_hi, int qpos0, int W, const float* __restrict__ tabg, int tablen,
                                          float m_init0, float m_init1, float l_init, float* __restrict__ lse, long ldlse, char* lds) {
  const int tid = opaque_tid(), lane = tid & 63, r32 = lane & 31, hi = lane >> 5; const int wid = __builtin_amdgcn_readfirstlane(tid >> 6);
  const int hw = wid >> 2, wq = wid & 3;
  char* V_lds = lds + OFF_V; char* K_lds = lds + OFF_K;
  float* ws = (float*)(lds + OFF_WS) + wid * 64; float* li_l = ws; float* al_l = ws + 32;
  float* tab = (float*)(lds + OFF_TAB);
  bf16x8 qr[8];
  { const bf16_t* Qw = Qb + hw * D + (long)(wq * QBLK + r32) * ldq + hi * 8;
#pragma unroll
    for (int d0 = 0; d0 < 8; ++d0) qr[d0] = *reinterpret_cast<const bf16x8*>(Qw + d0 * 16); }
  if (TAB) { for (int i = tid; i < 2 * 512; i += NW * 64) tab[i] = ((i & 511) < tablen) ? tabg[i] : 0.f; }
  const int sr = tid >> 4, sc = (tid & 15) * 8, vst0 = v_st(sr, sc), vst1 = v_st(32 + sr, sc);
  const int vb0 = (int)(uintptr_t)V_lds + v_rd_base(lane);
  bf16x8 vs0, vs1, ks0, ks1;
#define SLOAD(k0) do { vs0 = *reinterpret_cast<const bf16x8*>(&Vh[(long)((k0) + sr) * ldk + sc]); vs1 = *reinterpret_cast<const bf16x8*>(&Vh[(long)((k0) + 32 + sr) * ldk + sc]); \
    ks0 = *reinterpret_cast<const bf16x8*>(&Kh[(long)((k0) + sr) * ldk + sc]); ks1 = *reinterpret_cast<const bf16x8*>(&Kh[(long)((k0) + 32 + sr) * ldk + sc]); } while (0)
#define SWRITE(b) do { *(bf16x8*)(V_lds + (b) * SHM_V + vst0) = vs0; *(bf16x8*)(V_lds + (b) * SHM_V + vst1) = vs1; const int kc = sc * 2; \
    *(bf16x8*)(K_lds + (b) * SHM_K + KSWZ(sr, kc)) = ks0; *(bf16x8*)(K_lds + (b) * SHM_K + KSWZ(32 + sr, kc)) = ks1; } while (0)
  float m_reg = hw ? m_init1 : m_init0, l_reg = l_init; f32x16 o[4] = {};
  const int qw0 = qpos0 + wq * QBLK;
  SLOAD(t_lo * KVBLK); SWRITE(0); __syncthreads();
  for (int t = t_lo; t < t_hi; ++t) {
    const int b = (t - t_lo) & 1; const bool more = (t + 1 < t_hi);
    if (more) SLOAD((t + 1) * KVBLK);
    const bool active = !TAB || (KVBLK * t + KVBLK - 1 >= qw0 - W && KVBLK * t <= qw0 + QBLK - 1 + W);
    if (active) {
      f32x16 p0, p1; qkt(p0, p1, K_lds + b * SHM_K, qr, r32, hi);
      if (TAB) { const float* tl = tab + hw * 512 + (KVBLK * t - qw0 - r32 + 4 * hi + W + 96);
#pragma unroll
        for (int r = 0; r < 16; ++r) { const int ix = (r & 3) + 8 * (r >> 2); p0[r] = fmaf(p0[r], C, tl[ix]); p1[r] = fmaf(p1[r], C, tl[ix + 32]); } }
      else {
#pragma unroll
        for (int r = 0; r < 16; ++r) { p0[r] *= C; p1[r] *= C; } }
      float pmax = p0[0];
#pragma unroll
      for (int r = 1; r < 16; ++r) pmax = fmaxf(pmax, p0[r]);
#pragma unroll
      for (int r = 0; r < 16; ++r) pmax = fmaxf(pmax, p1[r]);
      { auto rr = __builtin_amdgcn_permlane32_swap(__float_as_uint(pmax), __float_as_uint(pmax), false, false);
        pmax = fmaxf(__uint_as_float(rr[0]), __uint_as_float(rr[1])); }
      if (!__all(pmax - m_reg <= THR2)) {
        const float mn = fmaxf(m_reg, pmax); const float alpha = __builtin_amdgcn_exp2f(m_reg - mn); m_reg = mn; l_reg *= alpha;
        if (hi == 0) al_l[r32] = alpha; asm volatile("s_waitcnt lgkmcnt(0)" ::: "memory");
#pragma unroll
        for (int d = 0; d < 4; ++d)
#pragma unroll
          for (int r = 0; r < 16; ++r) o[d][r] *= al_l[crow(r, hi)];
      }
#pragma unroll
      for (int r = 0; r < 16; ++r) { p0[r] = __builtin_amdgcn_exp2f(p0[r] - m_reg); p1[r] = __builtin_amdgcn_exp2f(p1[r] - m_reg); }
      float ps = 0.f;
#pragma unroll
      for (int r = 0; r < 16; ++r) ps += p0[r];
#pragma unroll
      for (int r = 0; r < 16; ++r) ps += p1[r];
      { auto rr = __builtin_amdgcn_permlane32_swap(__float_as_uint(ps), __float_as_uint(ps), false, false);
        ps = __uint_as_float(rr[0]) + __uint_as_float(rr[1]); }
      l_reg += ps;
      bf16x8 pa0, pa1, pa2, pa3;
#define PK4(P, BASE, OUT) do { unsigned a0 = cvt_pk_bf16(P[BASE + 0], P[BASE + 1]), a1 = cvt_pk_bf16(P[BASE + 2], P[BASE + 3]);   \
    unsigned b0 = cvt_pk_bf16(P[BASE + 4], P[BASE + 5]), b1 = cvt_pk_bf16(P[BASE + 6], P[BASE + 7]);                              \
    auto r0 = __builtin_amdgcn_permlane32_swap(a0, b0, false, false); auto r1 = __builtin_amdgcn_permlane32_swap(a1, b1, false, false); \
    u32x4 w = {r0[0], r1[0], r0[1], r1[1]}; OUT = *reinterpret_cast<bf16x8*>(&w); } while (0)
      PK4(p0, 0, pa0); PK4(p0, 8, pa1); PK4(p1, 0, pa2); PK4(p1, 8, pa3);
#undef PK4
      SBAR();
      pv_d0(o, vb0 + b * SHM_V, pa0, pa1, pa2, pa3);
    }
    if (more) SWRITE(b ^ 1);
    __syncthreads();
  }
  if (hi == 0) li_l[r32] = l_reg; asm volatile("s_waitcnt lgkmcnt(0)" ::: "memory");
  float rli[16];
#pragma unroll
  for (int r = 0; r < 16; ++r) rli[r] = __builtin_amdgcn_rcpf(li_l[crow(r, hi)]);
  bf16_t* stg = (bf16_t*)(lds + wid * 8192);
#pragma unroll
  for (int r = 0; r < 16; ++r) { const int orow = crow(r, hi);
#pragma unroll
    for (int d0 = 0; d0 < 4; ++d0) { const unsigned w = cvt_pk_bf16(o[d0][r] * rli[r], 0.f); stg[orow * 128 + d0 * 32 + r32] = (bf16_t)(w & 0xffffu); } }
  asm volatile("s_waitcnt lgkmcnt(0)" ::: "memory");
#pragma unroll
  for (int i = 0; i < 8; ++i) { const int row = i * 4 + (lane >> 4), ch = lane & 15; const u32x4 v = *(const u32x4*)(stg + row * 128 + ch * 8);
    *(u32x4*)(Ob + hw * D + (long)(wq * QBLK + row) * ldo + ch * 8) = v; }
  if (lse != nullptr && hi == 0) lse[hw + (long)(wq * QBLK + r32) * ldlse] = (m_reg + __builtin_amdgcn_logf(l_reg)) * LN2;
  __syncthreads();
#undef SLOAD
#undef SWRITE
}
template <bool PRE>
__device__ __forceinline__ void partialSM(f32x16& p0, f32x16& p1, float& m_reg, float& mn, float& alpha) {
  constexpr float cs = PRE ? 1.0f : C;
  float pmax = p0[0];
#pragma unroll
  for (int r = 1; r < 16; ++r) pmax = fmaxf(pmax, p0[r]);
#pragma unroll
  for (int r = 0; r < 16; ++r) pmax = fmaxf(pmax, p1[r]);
  { auto rr = __builtin_amdgcn_permlane32_swap(__float_as_uint(pmax), __float_as_uint(pmax), false, false);
    pmax = fmaxf(__uint_as_float(rr[0]), __uint_as_float(rr[1])); }
  if (__builtin_expect(__all((pmax - m_reg) * cs <= THR2), 1)) { mn = m_reg; alpha = 1.f; }
  else { mn = fmaxf(m_reg, pmax); alpha = __builtin_amdgcn_exp2f((m_reg - mn) * cs); m_reg = mn; }
  const float mnC = -mn * cs;
#pragma unroll
  for (int r = 0; r < 16; ++r) p0[r] = fmaf(p0[r], cs, mnC);
#pragma unroll
  for (int r = 0; r < 16; ++r) p1[r] = fmaf(p1[r], cs, mnC);
#pragma unroll
  for (int r = 0; r < 16; ++r) p0[r] = __builtin_amdgcn_exp2f(p0[r]);
}
__device__ __forceinline__ void partialSM_fixed(f32x16& p0) {
#pragma unroll
  for (int r = 0; r < 16; ++r) p0[r] = __builtin_amdgcn_exp2f(p0[r]);
}
__device__ __forceinline__ void finishSM(f32x16& p0, f32x16& p1, float alpha, float& l_reg, bf16x8& pa0, bf16x8& pa1, bf16x8& pa2, bf16x8& pa3) {
#pragma unroll
  for (int r = 0; r < 16; ++r) p1[r] = __builtin_amdgcn_exp2f(p1[r]);
  float ps = 0;
#pragma unroll
  for (int r = 0; r < 16; ++r) ps += p0[r];
#pragma unroll
  for (int r = 0; r < 16; ++r) ps += p1[r];
  { auto rr = __builtin_amdgcn_permlane32_swap(__float_as_uint(ps), __float_as_uint(ps), false, false);
    ps = __uint_as_float(rr[0]) + __uint_as_float(rr[1]); }
  l_reg = l_reg * alpha + ps;
#define PK4(P, BASE, OUT) do { unsigned a0 = cvt_pk_bf16(P[BASE + 0], P[BASE + 1]), a1 = cvt_pk_bf16(P[BASE + 2], P[BASE + 3]);   \
    unsigned b0 = cvt_pk_bf16(P[BASE + 4], P[BASE + 5]), b1 = cvt_pk_bf16(P[BASE + 6], P[BASE + 7]);                              \
    auto r0 = __builtin_amdgcn_permlane32_swap(a0, b0, false, false); auto r1 = __builtin_amdgcn_permlane32_swap(a1, b1, false, false); \
    u32x4 w = {r0[0], r1[0], r0[1], r1[1]}; OUT = *reinterpret_cast<bf16x8*>(&w); } while (0)
  PK4(p0, 0, pa0); PK4(p0, 8, pa1); PK4(p1, 0, pa2); PK4(p1, 8, pa3);
#undef PK4
}
template <bool PRE>
__device__ __forceinline__ void attn_unit_dense(const bf16_t* __restrict__ Qb, long ldq, const bf16_t* __restrict__ Kh, const bf16_t* __restrict__ Vh, long ldk,
                                                bf16_t* __restrict__ Ob, long ldo, int ntile, float mfix2, char* lds) {
  const int tid = opaque_tid(), lane = tid & 63, r32 = lane & 31, hi = lane >> 5; const int wid = __builtin_amdgcn_readfirstlane(tid >> 6);
  float* ws = (float*)(lds + OFF_WS) + wid * 64; float* li_l = ws; float* al_l = ws + 32;
  const bool fixm = PRE && mfix2 >= 0.f;
  float m_reg = -1e30f, l_reg = 0; f32x16 o[4] = {}; bf16x8 qr[8];
  { const bf16_t* Qw = Qb + (long)(wid * QBLK + r32) * ldq + hi * 8;
#pragma unroll
    for (int d0 = 0; d0 < 8; ++d0) qr[d0] = *reinterpret_cast<const bf16x8*>(Qw + d0 * 16); }
  const int sr = tid >> 4, sc = (tid & 15) * 8, vst0 = v_st(sr, sc), vst1 = v_st(32 + sr, sc);
  const int vb0 = (int)(uintptr_t)lds + v_rd_base(lane);
  bf16x8 vsE0, vsE1, ksE0, ksE1, vsO0, vsO1, ksO0, ksO1;
#define SLOAD_E(k0) do { vsE0 = *reinterpret_cast<const bf16x8*>(&Vh[(long)((k0) + sr) * ldk + sc]); vsE1 = *reinterpret_cast<const bf16x8*>(&Vh[(long)((k0) + 32 + sr) * ldk + sc]); \
    ksE0 = *reinterpret_cast<const bf16x8*>(&Kh[(long)((k0) + sr) * ldk + sc]); ksE1 = *reinterpret_cast<const bf16x8*>(&Kh[(long)((k0) + 32 + sr) * ldk + sc]); } while (0)
#define SLOAD_O(k0) do { vsO0 = *reinterpret_cast<const bf16x8*>(&Vh[(long)((k0) + sr) * ldk + sc]); vsO1 = *reinterpret_cast<const bf16x8*>(&Vh[(long)((k0) + 32 + sr) * ldk + sc]); \
    ksO0 = *reinterpret_cast<const bf16x8*>(&Kh[(long)((k0) + sr) * ldk + sc]); ksO1 = *reinterpret_cast<const bf16x8*>(&Kh[(long)((k0) + 32 + sr) * ldk + sc]); } while (0)
#define SWRITE_E(bo) do { char* B_ = lds + (bo); *(bf16x8*)(B_ + vst0) = vsE0; *(bf16x8*)(B_ + vst1) = vsE1; const int kc = sc * 2; \
    *(bf16x8*)(B_ + SHM_V + KSWZ(sr, kc)) = ksE0; *(bf16x8*)(B_ + SHM_V + KSWZ(32 + sr, kc)) = ksE1; } while (0)
#define SWRITE_O(bo) do { char* B_ = lds + (bo); *(bf16x8*)(B_ + vst0) = vsO0; *(bf16x8*)(B_ + vst1) = vsO1; const int kc = sc * 2; \
    *(bf16x8*)(B_ + SHM_V + KSWZ(sr, kc)) = ksO0; *(bf16x8*)(B_ + SHM_V + KSWZ(32 + sr, kc)) = ksO1; } while (0)
#define SWAIT() asm volatile("s_waitcnt vmcnt(4)" ::: "memory")
#define PSM(P0, P1, MN, AL) do { if (fixm) { partialSM_fixed(P0); AL = 1.f; MN = 0.f; } else partialSM<PRE>(P0, P1, m_reg, MN, AL); } while (0)
#define RESC(a) do { if (!fixm) if (__any((a) < 1.f)) { if (hi == 0) al_l[r32] = (a); asm volatile("s_waitcnt lgkmcnt(0)" ::: "memory"); \
    _Pragma("unroll") for (int d = 0; d < 4; ++d) _Pragma("unroll") for (int r = 0; r < 16; ++r) o[d][r] *= al_l[crow(r, hi)]; } } while (0)
#define ROT3() do { const int t_ = bV; bV = bK; bK = bW; bW = t_; } while (0)
  f32x16 pA0, pA1, pB0, pB1; float mnA, mnB, alA, alB; bf16x8 pa0, pa1, pa2, pa3; const int NT = ntile;
  int bV = 0, bK = 0, bW = BUF3;
  SLOAD_E(0); SLOAD_O(KVBLK); asm volatile("s_waitcnt vmcnt(4)" ::: "memory"); SWRITE_E(0); SLOAD_E(2 * KVBLK);
  __syncthreads();
  SWAIT(); SWRITE_O(bW);
  qkt(pA0, pA1, lds + bK + SHM_V, qr, r32, hi); PSM(pA0, pA1, mnA, alA);
  if (3 < NT) SLOAD_O(3 * KVBLK);
  bV = 0; bK = BUF3; bW = 2 * BUF3;
  for (int j = 1; j + 1 < NT; j += 2) {
    __syncthreads(); SWAIT(); SWRITE_E(bW);
    SBAR(); qkt(pB0, pB1, lds + bK + SHM_V, qr, r32, hi);
    finishSM(pA0, pA1, alA, l_reg, pa0, pa1, pa2, pa3); SBAR();
    if (j + 3 < NT) SLOAD_E((j + 3) * KVBLK); SBAR();
    pv_d0(o, vb0 + bV, pa0, pa1, pa2, pa3); PSM(pB0, pB1, mnB, alB);
    RESC(alB); ROT3();
    __syncthreads(); SWAIT(); SWRITE_O(bW);
    SBAR(); qkt(pA0, pA1, lds + bK + SHM_V, qr, r32, hi);
    finishSM(pB0, pB1, alB, l_reg, pa0, pa1, pa2, pa3); SBAR();
    if (j + 4 < NT) SLOAD_O((j + 4) * KVBLK); SBAR();
    pv_d0(o, vb0 + bV, pa0, pa1, pa2, pa3); PSM(pA0, pA1, mnA, alA);
    RESC(alA); ROT3();
  }
  __syncthreads();
  SBAR(); qkt(pB0, pB1, lds + bK + SHM_V, qr, r32, hi);
  finishSM(pA0, pA1, alA, l_reg, pa0, pa1, pa2, pa3); SBAR();
  pv_d0(o, vb0 + bV, pa0, pa1, pa2, pa3); PSM(pB0, pB1, mnB, alB);
  RESC(alB); ROT3();
  finishSM(pB0, pB1, alB, l_reg, pa0, pa1, pa2, pa3); SBAR();
  pv_d0(o, vb0 + bV, pa0, pa1, pa2, pa3);
#undef ROT3
  if (hi == 0) li_l[r32] = l_reg; asm volatile("s_waitcnt lgkmcnt(0)" ::: "memory");
  float rli[16];
#pragma unroll
  for (int r = 0; r < 16; ++r) rli[r] = __builtin_amdgcn_rcpf(li_l[crow(r, hi)]);
  __syncthreads();
  bf16_t* stg = (bf16_t*)(lds + wid * 8192);
#pragma unroll
  for (int r = 0; r < 16; ++r) { const int orow = crow(r, hi);
#pragma unroll
    for (int d0 = 0; d0 < 4; ++d0) { const unsigned w = cvt_pk_bf16(o[d0][r] * rli[r], 0.f); stg[orow * 128 + d0 * 32 + r32] = (bf16_t)(w & 0xffffu); } }
  asm volatile("s_waitcnt lgkmcnt(0)" ::: "memory");
#pragma unroll
  for (int i = 0; i < 8; ++i) { const int row = i * 4 + (lane >> 4), ch = lane & 15; const u32x4 v = *(const u32x4*)(stg + row * 128 + ch * 8);
    *(u32x4*)(Ob + (long)(wid * QBLK + row) * ldo + ch * 8) = v; }
  __syncthreads();
#undef PSM
#undef SLOAD_E
#undef SLOAD_O
#undef SWRITE_E
#undef SWRITE_O
#undef SWAIT
#undef RESC
}
#undef SBAR
}

#define XB_TMO      128
#define XB_XCNT(j)  (256  + 64 * (j))
#define XB_XSUB(j)  (1280 + 64 * (j))
#define XB_XGEN(j)  (2304 + 64 * (j))
#define XB_TOP      3328
#define XB_TOPGEN   3392
#define XCD_BAR_WORDS 3456
#define XB_SPIN_CAP (1u << 18)
__device__ __forceinline__ unsigned xb_ld(unsigned* p)              { return __hip_atomic_load(p, __ATOMIC_RELAXED, __HIP_MEMORY_SCOPE_AGENT); }
__device__ __forceinline__ unsigned xb_add(unsigned* p, unsigned v) { return __hip_atomic_fetch_add(p, v, __ATOMIC_RELAXED, __HIP_MEMORY_SCOPE_AGENT); }
__device__ __forceinline__ unsigned xb_xcc_id() { return (unsigned)__builtin_amdgcn_s_getreg((3 << 11) | 20) & 0xFu; }
#define XB_SPIN(cond, bar) do { unsigned _sp = 0; while (cond) { __builtin_amdgcn_s_sleep(1); \
    if ((++_sp & 255u) == 0u) { if (xb_ld(&(bar)[XB_TMO])) break; if (_sp > XB_SPIN_CAP) { atomicAdd(&(bar)[XB_TMO], 1u); break; } } } } while (0)
struct XcdBarrier { unsigned* bar; unsigned x; volatile LAS unsigned* st; };
__device__ __forceinline__ XcdBarrier xcd_barrier_post(unsigned* bar, volatile LAS unsigned* st) {
    XcdBarrier b; b.bar = bar; b.x = xb_xcc_id(); b.st = st;
    if (threadIdx.x == 0) (void)xb_add(&bar[XB_XCNT(b.x)], 1u);
    return b;
}
__device__ __forceinline__ void xcd_barrier_complete(unsigned* bar, unsigned x, unsigned& nloc, unsigned& nx) {
    const unsigned G = gridDim.x * gridDim.y * gridDim.z;
    unsigned sum, cnt, mine, sp = 0u;
    for (;;) {
        sum = 0u; cnt = 0u; mine = 0u;
#pragma unroll
        for (unsigned j = 0; j < 16; ++j) { const unsigned c = xb_ld(&bar[XB_XCNT(j)]); sum += c; cnt += (c > 0u) ? 1u : 0u; mine = (j == x) ? c : mine; }
        if (sum == G) break;
        __builtin_amdgcn_s_sleep(1);
        if ((++sp & 255u) == 0u) { if (xb_ld(&bar[XB_TMO])) break; if (sp > XB_SPIN_CAP) { atomicAdd(&bar[XB_TMO], 1u); break; } }
    }
    nloc = mine > 0u ? mine : 1u; nx = cnt > 0u ? cnt : 1u;
}
__device__ __forceinline__ void xcd_barrier(const XcdBarrier& b) {
    asm volatile("s_waitcnt vmcnt(0)" ::: "memory");
    __syncthreads();
    if (threadIdx.x == 0) {
        unsigned* bar = b.bar;
        __builtin_amdgcn_s_waitcnt(0);
        unsigned nloc = b.st[0], nx = b.st[1];
        if (nloc == 0u) { xcd_barrier_complete(bar, b.x, nloc, nx); b.st[0] = nloc; b.st[1] = nx; }
        const unsigned old = xb_add(&bar[XB_XSUB(b.x)], 1u);
        const unsigned gen = old / nloc;
        if (old + 1u == (gen + 1u) * nloc) {
            __builtin_amdgcn_fence(__ATOMIC_RELEASE, "agent");
            asm volatile("s_waitcnt vmcnt(0)" ::: "memory");
            const unsigned og = xb_add(&bar[XB_TOP], 1u);
            const unsigned tg = og / nx;
            if (og + 1u == (tg + 1u) * nx) xb_add(&bar[XB_TOPGEN], 1u);
            else XB_SPIN(xb_ld(&bar[XB_TOPGEN]) == tg, bar);
            __builtin_amdgcn_fence(__ATOMIC_ACQUIRE, "agent");
            xb_add(&bar[XB_XGEN(b.x)], 1u);
            asm volatile("s_waitcnt vmcnt(0)" ::: "memory");
        } else {
            XB_SPIN(xb_ld(&bar[XB_XGEN(b.x)]) == gen, bar);
            __builtin_amdgcn_fence(__ATOMIC_ACQUIRE, "agent");
            asm volatile("s_waitcnt vmcnt(0)" ::: "memory");
        }
    }
    __syncthreads();
}

constexpr int NWAVES = 8;
constexpr int RING_BYTES = 131072, LDSCTL_OFF = RING_BYTES, MISC_OFF = LDSCTL_OFF + 320, LDS_BYTES = 147456;
static_assert(att::LDS_BYTES <= RING_BYTES, "attention scratch inside the ring region");

struct Args {
    const float* in[20]; float* out; unsigned char* ws; int ph_lo, ph_hi;
};

__device__ __forceinline__ float wave_sum(float v) {
#pragma unroll
    for (int o = 1; o < 64; o <<= 1) v += __shfl_xor(v, o);
    return v;
}
__device__ __forceinline__ unsigned f2bf(float f) { unsigned u = __builtin_bit_cast(unsigned, f); return (u + 0x7fffu + ((u >> 16) & 1u)) >> 16; }
__device__ __forceinline__ unsigned pk2(float lo, float hi) { return f2bf(lo) | (f2bf(hi) << 16); }

__device__ __forceinline__ void transpose_item(const float* W, const float* gain, int K, int N, bf16_t* WT, int k0, int n0, int drow0, LAS float* scr, int lane) {
    const int kr = lane >> 3, nq = lane & 7;
    f32x4 v[8]; float gk[8];
#pragma unroll
    for (int i = 0; i < 8; ++i) { v[i] = *(const GAS f32x4*)(W + (size_t)(k0 + kr + 8 * i) * N + n0 + 4 * nq); gk[i] = gain ? gain[k0 + kr + 8 * i] : 1.0f; }
#pragma unroll
    for (int i = 0; i < 8; ++i) { LAS float* d = scr + (kr + 8 * i) * 33 + 4 * nq; d[0] = v[i].x * gk[i]; d[1] = v[i].y * gk[i]; d[2] = v[i].z * gk[i]; d[3] = v[i].w * gk[i]; }
    asm volatile("s_waitcnt lgkmcnt(0)" ::: "memory");
    const int c = lane & 7;
#pragma unroll
    for (int j = 0; j < 4; ++j) { const int n = (lane >> 3) + 8 * j; const LAS float* s = scr + (8 * c) * 33 + n;
        u32x4 o; o.x = pk2(s[0 * 33], s[1 * 33]); o.y = pk2(s[2 * 33], s[3 * 33]); o.z = pk2(s[4 * 33], s[5 * 33]); o.w = pk2(s[6 * 33], s[7 * 33]);
        *(GAS u32x4*)(WT + (size_t)(drow0 + n) * K + k0 + 8 * c) = o; }
    asm volatile("s_waitcnt lgkmcnt(0)" ::: "memory");
}

__device__ __forceinline__ int t5_bucket(int rel) {
    const int n = rel < 0 ? -rel : rel; int b;
    if (n < 8) b = n; else { b = 8 + (n >= 15) + (n >= 27) + (n >= 50) + (n >= 91) + (n >= 166) + (n >= 305) + (n >= 559); if (b > 15) b = 15; }
    return b + (rel > 0 ? 16 : 0);
}
__device__ __forceinline__ void sincos_d(double a, double& s, double& c) {
    const double k = __builtin_rint(a * 0.63661977236758134308);
    const double r = (a - k * 1.57079632679489655800) - k * 6.12323399573676603587e-17;
    const double r2 = r * r;
    double ps = 1.0 / 6227020800.0;
    ps = ps * r2 - 1.0 / 39916800.0; ps = ps * r2 + 1.0 / 362880.0; ps = ps * r2 - 1.0 / 5040.0; ps = ps * r2 + 1.0 / 120.0; ps = ps * r2 - 1.0 / 6.0; ps = ps * r2 + 1.0;
    const double sr = r * ps;
    double pc = -1.0 / 87178291200.0;
    pc = pc * r2 + 1.0 / 479001600.0; pc = pc * r2 - 1.0 / 3628800.0; pc = pc * r2 + 1.0 / 40320.0; pc = pc * r2 - 1.0 / 720.0; pc = pc * r2 + 1.0 / 24.0; pc = pc * r2 - 0.5; pc = pc * r2 + 1.0;
    const int q = ((int)k) & 3;
    s = (q == 0) ? sr : (q == 1) ? pc : (q == 2) ? -sr : -pc;
    c = (q == 0) ? pc : (q == 1) ? -sr : (q == 2) ? -pc : sr;
}

__device__ __forceinline__ float row_to_bf16(const float* xrow, bf16_t* orow, int lane) {
    const GAS f32x4* xr = (const GAS f32x4*)xrow + lane;
    f32x4 v[8]; float s = 0.f;
#pragma unroll
    for (int j = 0; j < 8; ++j) { v[j] = xr[64 * j]; s += (v[j].x * v[j].x + v[j].y * v[j].y) + (v[j].z * v[j].z + v[j].w * v[j].w); }
    GAS u32x2* o8 = (GAS u32x2*)orow + lane;
#pragma unroll
    for (int j = 0; j < 8; ++j) { u32x2 w; w.x = cvt_pk_bf16(v[j].x, v[j].y); w.y = cvt_pk_bf16(v[j].z, v[j].w); o8[64 * j] = w; }
    return wave_sum(s);
}
__device__ __forceinline__ void rms_row_out(const bf16_t* xrow, float* orow, const float* g, float rstd, int lane) {
    const GAS u32x2* xr = (const GAS u32x2*)xrow + lane; GAS f32x4* o = (GAS f32x4*)orow + lane; const GAS f32x4* gr = (const GAS f32x4*)g + lane;
#pragma unroll
    for (int j = 0; j < 8; ++j) { const u32x2 w = xr[64 * j]; const f32x4 gg = gr[64 * j]; f32x4 v = {bflo(w.x), bfhi(w.x), bflo(w.y), bfhi(w.y)}; o[64 * j] = v * rstd * gg; }
}

__device__ __forceinline__ void qknorm_rows(bf16_t* qkv, const float* ropec, const float* ropes, const float* qg, const float* kg, int row_base, int tid) {
    const int lane = tid & 63, wave = tid >> 6;
    const int head = lane >> 3, q8 = lane & 7, hf = q8 >> 2, a = q8 & 3;
    const float* gp = (head < 6) ? qg : kg;
    const float osc = (head < 6) ? 0.088388347648318440f * 1.4426950408889634f : 1.0f;
    float g1[8], g2[8];
#pragma unroll
    for (int e = 0; e < 8; ++e) { g1[e] = gp[hf * 64 + 8 * a + e]; g2[e] = gp[hf * 64 + 32 + 8 * a + e]; }
    for (int t0 = 0; t0 < 32; t0 += 4) {
        u32x4 w1[4], w2[4]; f32x4 cs[4][4];
#pragma unroll
        for (int i = 0; i < 4; ++i) { const int m = row_base + wave + 8 * (t0 + i);
            const int s = (m < NPROMPT) ? (m & (SEQ_P - 1)) : ((m - NPROMPT) & (SEQ_S - 1)); const int n = hf ? (s & 63) : (s >> 6);
            const bf16_t* p1 = qkv + (size_t)m * PROJ + head * HD + hf * 64 + 8 * a;
            w1[i] = *(const GAS u32x4*)p1; w2[i] = *(const GAS u32x4*)(p1 + 32);
            cs[i][0] = *(const GAS f32x4*)(ropec + n * 32 + 8 * a); cs[i][1] = *(const GAS f32x4*)(ropec + n * 32 + 8 * a + 4);
            cs[i][2] = *(const GAS f32x4*)(ropes + n * 32 + 8 * a); cs[i][3] = *(const GAS f32x4*)(ropes + n * 32 + 8 * a + 4); }
#pragma unroll
        for (int i = 0; i < 4; ++i) { const int m = row_base + wave + 8 * (t0 + i);
            bf16_t* p1 = qkv + (size_t)m * PROJ + head * HD + hf * 64 + 8 * a;
            float x1[8], x2[8];
#pragma unroll
            for (int e = 0; e < 4; ++e) { x1[2 * e] = bflo(w1[i][e]); x1[2 * e + 1] = bfhi(w1[i][e]); x2[2 * e] = bflo(w2[i][e]); x2[2 * e + 1] = bfhi(w2[i][e]); }
            float ss = 0.f;
#pragma unroll
            for (int e = 0; e < 8; ++e) ss += x1[e] * x1[e] + x2[e] * x2[e];
            ss += __shfl_xor(ss, 1); ss += __shfl_xor(ss, 2); ss += __shfl_xor(ss, 4);
            const float rstd = 1.0f / sqrtf(ss * (1.f / HD) + RMS_EPS);
            float o1[8], o2[8];
#pragma unroll
            for (int e = 0; e < 8; ++e) { const float cc = e < 4 ? cs[i][0][e & 3] : cs[i][1][e & 3], sn = e < 4 ? cs[i][2][e & 3] : cs[i][3][e & 3];
                const float y1 = x1[e] * rstd * g1[e], y2 = x2[e] * rstd * g2[e]; o1[e] = (y1 * cc - y2 * sn) * osc; o2[e] = (y1 * sn + y2 * cc) * osc; }
            u32x4 r1, r2;
#pragma unroll
            for (int e = 0; e < 4; ++e) { r1[e] = cvt_pk_bf16(o1[2 * e], o1[2 * e + 1]); r2[e] = cvt_pk_bf16(o2[2 * e], o2[2 * e + 1]); }
            *(GAS u32x4*)p1 = r1; *(GAS u32x4*)(p1 + 32) = r2; }
    }
}
__device__ __forceinline__ void crescale_rows(bf16_t* mix, const float* lsebuf, int row_base, int tid) {
    const int lane = tid & 63, wave = tid >> 6;
    for (int t0 = 0; t0 < 32; t0 += 4) {
        float ls[4][6]; u32x2 w[4][3];
#pragma unroll
        for (int i = 0; i < 4; ++i) { const int m = row_base + wave + 8 * (t0 + i);
#pragma unroll
            for (int k = 0; k < 6; ++k) ls[i][k] = lsebuf[(size_t)m * 6 + k];
            const GAS u32x2* p = (const GAS u32x2*)(mix + (size_t)m * MIXW + 1280) + lane;
#pragma unroll
            for (int j = 0; j < 3; ++j) w[i][j] = p[64 * j]; }
#pragma unroll
        for (int i = 0; i < 4; ++i) { const int m = row_base + wave + 8 * (t0 + i);
            float al[6];
#pragma unroll
            for (int j = 0; j < 2; ++j) { const float mx = fmaxf(fmaxf(ls[i][j], ls[i][2 + j]), ls[i][4 + j]);
                const float e0 = __expf(ls[i][j] - mx), e1 = __expf(ls[i][2 + j] - mx), e2 = __expf(ls[i][4 + j] - mx); const float inv = 1.0f / (e0 + e1 + e2);
                al[j] = e0 * inv; al[2 + j] = e1 * inv; al[4 + j] = e2 * inv; }
            GAS u32x2* p = (GAS u32x2*)(mix + (size_t)m * MIXW + 1280) + lane;
#pragma unroll
            for (int j = 0; j < 3; ++j) { const int hc = (4 * lane + 256 * j) >> 7; const float a = (hc == 0) ? al[0] : (hc == 1) ? al[1] : (hc == 2) ? al[2] : (hc == 3) ? al[3] : (hc == 4) ? al[4] : al[5];
                u32x2 v = w[i][j]; v.x = cvt_pk_bf16(bflo(v.x) * a, bfhi(v.x) * a); v.y = cvt_pk_bf16(bflo(v.y) * a, bfhi(v.y) * a); p[64 * j] = v; } }
    }
}

__global__ void __launch_bounds__(NWAVES * 64, 2) fwd(Args args) {
    extern __shared__ __attribute__((aligned(16))) unsigned char lds[];
    LAS unsigned char* ldsl = (LAS unsigned char*)lds;
    volatile LAS unsigned* MISC = (volatile LAS unsigned*)(ldsl + MISC_OFF);
    const int G = gridDim.x;
    unsigned char* ws = args.ws;
    gu32* ctl = (gu32*)(ws + WS_CTL);
    { const int tid0 = threadIdx.x; for (int u = tid0; u < (LDS_BYTES - LDSCTL_OFF) / 4; u += NWAVES * 64) ((LAS unsigned*)(ldsl + LDSCTL_OFF))[u] = 0u; }
    __syncthreads();
    XcdBarrier bar; bar.bar = (unsigned*)ctl + CW_BAR; bar.x = 0; bar.st = nullptr;
    if (ONE_LAUNCH) bar = xcd_barrier_post((unsigned*)ctl + CW_BAR, MISC + 8);
    int bx = blockIdx.x;
    if (ONE_LAUNCH) {
        if (threadIdx.x == 0) { const unsigned xcc = xb_xcc_id(); const unsigned rk = __hip_atomic_fetch_add(ctl + CW_XRANK + 64 * (xcc & 15u), 1u, __ATOMIC_RELAXED, __HIP_MEMORY_SCOPE_AGENT); MISC[12] = rk * 8u + xcc; }
        xcd_barrier(bar);
        if (threadIdx.x == 0) { bool ok = (G % 8 == 0);
            for (unsigned j = 0; j < 16; ++j) { const unsigned cnt = __hip_atomic_load(ctl + CW_XRANK + 64 * j, __ATOMIC_RELAXED, __HIP_MEMORY_SCOPE_AGENT); ok = ok && (cnt == (j < 8 ? (unsigned)G / 8u : 0u)); }
            if (!ok) MISC[12] = blockIdx.x; }
        __syncthreads();
        bx = __builtin_amdgcn_readfirstlane((int)MISC[12]);
    }
    const int lo = args.ph_lo, hi = args.ph_hi;
#ifndef PHMASK
#define PHMASK 0xffff
#endif
#define IN(k) (lo <= (k) && (k) < hi)
#define EN(b) ((PHMASK >> (b)) & 1)
#ifndef PROBE_DUP
#define PROBE_DUP 0
#endif
#define NREP(b) (1 + ((PROBE_DUP >> (b)) & 1))
#define REPSEAM(b) do { if (ONE_LAUNCH && NREP(b) > 1 && rep == 0) xcd_barrier(bar); } while (0)
#define SEAM(k) do { if (ONE_LAUNCH && IN(k) && IN((k) + 1)) xcd_barrier(bar); } while (0)
#define LANE_ID() const int tid = opaque_tid(), lane = tid & 63, wave = __builtin_amdgcn_readfirstlane(tid >> 6); const int vcu = (G % 8 == 0) ? (bx % 8) * (G / 8) + bx / 8 : bx; const int gw = vcu * NWAVES + wave, NGW = G * NWAVES; (void)lane; (void)gw; (void)NGW
#define ROPEC ((float*)(ws + WS_TAB))
#define ROPES (ROPEC + 128 * 32)
#define TABB (ROPES + 128 * 32)
#define TABC (TABB + 4 * 512)
#define LSEBUF ((float*)(ws + WS_LSE))
#define XB ((bf16_t*)(ws + WS_XB))
#define MB ((bf16_t*)(ws + WS_MB))
#define SSBUF ((pg8::ss_t*)(ws + WS_SS))
#define RSM ((pg8::ss_t*)(ws + WS_RSM))
#define QKV ((bf16_t*)(ws + WS_QKV))
#define MIX ((bf16_t*)(ws + WS_MIX))
#define HID ((bf16_t*)(ws + WS_HID))
#define QX ((bf16_t*)(ws + WS_QX))
#define OX ((bf16_t*)(ws + WS_OX))
#define KVX ((bf16_t*)(ws + WS_KVX))
    float* out = args.out;

    if (EN(13) && IN(0)) {
        LANE_ID();
        float* ropec = ROPEC; float* ropes = ROPES; float* tabB = TABB; float* tabC = TABC;
        LAS float* scr = (LAS float*)(ldsl + wave * 16384);
        constexpr int I_IN = 32 * 120, I_OUT = 32 * 64, I_CQ = 32 * 16, I_CKV = 32 * 32, I_CO = 8 * 64, I_FI = 32 * 352, I_FO = 88 * 64;
        constexpr int I_LAYER = I_IN + I_OUT + I_CQ + I_CKV + I_CO + I_FI + I_FO;
        for (int it = gw; it < DEPTH * I_LAYER; it += NGW) {
            const int l = it / I_LAYER; int r = it % I_LAYER;
            const float* W; bf16_t* WT; int K, N; const float* gain = nullptr;
            if (r < I_IN) { gain = args.in[4] + (size_t)l * DM; W = args.in[5] + (size_t)l * DM * PROJ; WT = (bf16_t*)(ws + WS_WIN) + (size_t)l * PROJ * DM; K = DM; N = PROJ; }
            else if ((r -= I_IN) < I_OUT) { W = args.in[10] + (size_t)l * MIXW * DM; WT = (bf16_t*)(ws + WS_WOUT) + (size_t)l * DM * MIXW; K = MIXW; N = DM; }
            else if ((r -= I_OUT) < I_CQ) { gain = args.in[11] + (size_t)l * DM; W = args.in[13] + (size_t)l * DM * XW; WT = (bf16_t*)(ws + WS_WCQ) + (size_t)l * XW * DM; K = DM; N = XW; }
            else if ((r -= I_CQ) < I_CKV) { gain = args.in[12] + (size_t)l * DM; W = args.in[14] + (size_t)l * DM * 2 * XW; WT = (bf16_t*)(ws + WS_WCKV) + (size_t)l * 2 * XW * DM; K = DM; N = 2 * XW; }
            else if ((r -= I_CKV) < I_CO) { W = args.in[15] + (size_t)l * XW * DM; WT = (bf16_t*)(ws + WS_WCO) + (size_t)l * DM * XW; K = XW; N = DM; }
            else if ((r -= I_CO) < I_FI) { gain = args.in[16] + (size_t)l * DM; W = args.in[17] + (size_t)l * DM * 2 * DFF; WT = (bf16_t*)(ws + WS_WFI) + (size_t)l * 2 * DFF * DM; K = DM; N = 2 * DFF; }
            else { r -= I_FI; W = args.in[18] + (size_t)l * DFF * DM; WT = (bf16_t*)(ws + WS_WFO) + (size_t)l * DM * DFF; K = DFF; N = DM; }
            const int nblk = N / 32, kb = r / nblk, nb = r % nblk, n0 = 32 * nb;
            int drow0 = n0;
            if (N == 2 * DFF) drow0 = (n0 < DFF) ? 256 * (n0 / 128) + (n0 % 128) : 256 * ((n0 - DFF) / 128) + 128 + ((n0 - DFF) % 128);
            transpose_item(W, gain, K, N, WT, 64 * kb, n0, drow0, scr, lane);
        }
        { bf16_t* xb = XB; pg8::ss_t* ss0 = SSBUF; bf16_t* mb = MB; pg8::ss_t* rsm = RSM;
          for (int m = gw; m < NTOK; m += NGW) { const float* xr = (m < NPROMPT) ? args.in[0] + (size_t)m * DM : args.in[1] + (size_t)(m - NPROMPT) * DM;
              const float q = row_to_bf16(xr, xb + (size_t)m * DM, lane); if (lane == 0) ss0[m] = (pg8::ss_t)(q * pg8::SS_SCALE); }
          for (int m = gw; m < MEMROWS; m += NGW) { const float* mr = (m < 2 * MEMLEN) ? args.in[2] + (size_t)m * DM : args.in[3] + (size_t)(m - 2 * MEMLEN) * DM;
              const float q = row_to_bf16(mr, mb + (size_t)m * DM, lane); if (lane == 0) rsm[m] = (pg8::ss_t)(q * pg8::SS_SCALE); } }
        const int gt = vcu * (NWAVES * 64) + tid, NGT = G * NWAVES * 64;
        const float* rel_bias = args.in[9];
        for (int e = gt; e < 4096 + 2048 + 3072; e += NGT) {
            if (e < 4096) { const int n = e >> 5, i = e & 31;
                double invd = 1.0; for (int q = 0; q < i; ++q) invd *= 0.7498942093324559;
                const float inv = (float)invd;
                const float ang = (float)n * inv; double s, c; sincos_d((double)ang, s, c); ropec[e] = (float)c; ropes[e] = (float)s; }
            else if (e < 4096 + 2048) { const int t = e - 4096, h = t >> 9, i = t & 511; const int rel = i - 96 - 128;
                float v = -INFINITY; if (rel >= -128 && rel <= 128) v = rel_bias[t5_bucket(rel) * 10 + h] * att::LOG2E;
                tabB[t] = v; }
            else { const int t = e - 6144, hc = t >> 9, i = t & 511; const int off = i - 96 - 64; const int d = (hc < 2) ? 1 : (hc < 4) ? 4 : 16;
                float v = -INFINITY; if (off >= -64 && off <= 64) v = rel_bias[t5_bucket(off * d) * 10 + 4 + hc] * att::LOG2E;
                tabC[t] = v; }
        }
    }
    SEAM(0);

    for (int l = 0; l < DEPTH; ++l) {
        const int pb = 1 + PPL * l;
#define XS0 ((l == 0) ? args.in[0] : (const float*)out)
#define XS1 ((l == 0) ? args.in[1] : (const float*)out + (size_t)NPROMPT * DM)
        if (EN(0) && IN(pb + 0)) for (int rep = 0; rep < NREP(0); ++rep) {
            { const bf16_t* Win = (const bf16_t*)(ws + WS_WIN) + (size_t)l * PROJ * DM;
              pg8::Gemm g{XB, Win, NTOK, PROJ, DM}; pg8::StaticOrder S; S.init(NTOK, PROJ, G, bx);
              pg8::EpiBf16 E{QKV, PROJ, SSBUF + (size_t)(3 * l) * NTOK};
              pg8::gemm_phase<pg8::EpiBf16, pg8::StaticOrder, true, true>(ldsl, g, S, E); }
            if (l == 0) {
              pg8::Gemm g{MB, (const bf16_t*)(ws + WS_WCKV), MEMROWS, 4 * 2 * XW, DM}; pg8::StaticOrder S; S.init(MEMROWS, 4 * 2 * XW, G, (bx + G - 64) % G);
              pg8::EpiBf16 E{KVX, 4 * 2 * XW, RSM};
              pg8::gemm_phase<pg8::EpiBf16, pg8::StaticOrder, true, true>(ldsl, g, S, E); }
            REPSEAM(0);
        }
        SEAM(pb + 0);
        if (EN(1) && IN(pb + 1)) {
            const int tid = opaque_tid(); const float* tabC = TABC; float* lsebuf = LSEBUF;
            gu32* qhead = ctl + CW_QUEUE + 64 * (2 * l);
            volatile LAS unsigned* uidw = (volatile LAS unsigned*)(ldsl + att::OFF_UID);
            for (;;) {
                if (tid == 0) uidw[0] = __hip_atomic_fetch_add(qhead, 1u, __ATOMIC_RELAXED, __HIP_MEMORY_SCOPE_AGENT);
                __syncthreads();
                const int u = (int)uidw[0];
                __syncthreads();
                if (u >= 1344) break;
                if (u % 7 == 6) {
                    qknorm_rows(QKV, ROPEC, ROPES, args.in[6] + (size_t)l * HD, args.in[7] + (size_t)l * HD, (u / 7) * 256, tid);
                } else { const int v0 = u - u / 7;
                {
                    const int v = v0, gi = v % 3, idx = v / 3; const int d = (gi == 0) ? 1 : (gi == 1) ? 4 : 16;
                    long row0; int j, L;
                    if (idx < 128) { row0 = (long)(idx / 64) * SEQ_P; j = idx % 64; L = SEQ_P; } else { const int i2 = idx - 128; row0 = NPROMPT + (long)(i2 / 32) * SEQ_S; j = i2 % 32; L = SEQ_S; }
                    const int res = j % d, qbr = j / d, p0 = qbr * 128, Lr = L / d;
                    int tlo = p0 / 64 - 1, thi = p0 / 64 + 3; if (tlo < 0) tlo = 0; if (thi > Lr / 64) thi = Lr / 64;
                    const long rq = row0 + (long)p0 * d + res, rk = row0 + res; const int hc = 2 * gi;
                    att::attn_unit<true>(QKV + rq * PROJ + COL_QC + hc * HD, (long)d * PROJ, QKV + rk * PROJ + COL_KC + gi * HD, QKV + rk * PROJ + COL_VC + gi * HD, (long)d * PROJ,
                                         MIX + rq * MIXW + 1280 + hc * HD, (long)d * MIXW, tlo, thi, p0, 64, tabC + hc * 512, 321, -1e30f, -1e30f, 0.f, lsebuf + rq * 6 + hc, (long)d * 6, (char*)lds);
                } }
            }
        }
        SEAM(pb + 1);
        if (EN(2) && IN(pb + 2)) for (int rep = 0; rep < NREP(2); ++rep) {
            const int tid = opaque_tid(); const float* tabB = TABB;
            float mfix2;
            { const float* qg = args.in[6] + (size_t)l * HD; const float* kg = args.in[7] + (size_t)l * HD; const int ln = tid & 63;
              float a = fmaxf(fabsf(qg[ln]), fabsf(qg[ln + 64])), b = fmaxf(fabsf(kg[ln]), fabsf(kg[ln + 64]));
#pragma unroll
              for (int o = 1; o < 64; o <<= 1) { a = fmaxf(a, __shfl_xor(a, o)); b = fmaxf(b, __shfl_xor(b, o)); }
              mfix2 = __builtin_amdgcn_readfirstlane(128.f * a * b * 1.02f * att::C); if (!(mfix2 <= 40.f)) mfix2 = -1.f; }
            gu32* qhead = ctl + CW_QUEUE + 64 * (2 * l + 1 + 8 * rep);
            volatile LAS unsigned* uidw = (volatile LAS unsigned*)(ldsl + att::OFF_UID);
            const float* sink = args.in[8] + (size_t)l * 4;
            for (;;) {
                if (tid == 0) uidw[0] = __hip_atomic_fetch_add(qhead, 1u, __ATOMIC_RELAXED, __HIP_MEMORY_SCOPE_AGENT);
                __syncthreads();
                const int u = (int)uidw[0];
                __syncthreads();
                if (u >= 1152 + 192 + 768) break;
                if (u < 1152) {
                    int seq, kvh, qb, gi, L;
                    if (u < 384) { seq = u / 192; const int r = u % 192; kvh = r / 96; const int r2 = r % 96; qb = r2 / 3; gi = r2 % 3; L = SEQ_P; }
                    else { const int v = u - 384; seq = 2 + v / 96; const int r = v % 96; kvh = r / 48; const int r2 = r % 48; qb = r2 / 3; gi = r2 % 3; L = SEQ_S; }
                    const long row0 = (seq < 2) ? (long)seq * SEQ_P : (long)NPROMPT + (long)(seq - 2) * SEQ_S;
                    const int h = kvh * 3 + gi;
                    att::attn_unit_dense<true>(QKV + (row0 + qb * 256) * PROJ + COL_QA + h * HD, PROJ, QKV + row0 * PROJ + COL_KA + kvh * HD, QKV + row0 * PROJ + COL_VA + kvh * HD, PROJ,
                                         MIX + (row0 + qb * 256) * MIXW + h * HD, MIXW, L / 64, mfix2, (char*)lds);
                } else if (u < 1344) { if (rep == 0) crescale_rows(MIX, LSEBUF, (u - 1152) * 256, tid); }
                else {
                    const int v = u - 1344, qbg = v >> 1, kvh = v & 1; const long rowq = (long)qbg * 128;
                    long row0; int pos0, L;
                    if (rowq < NPROMPT) { row0 = (rowq / SEQ_P) * SEQ_P; pos0 = (int)(rowq % SEQ_P); L = SEQ_P; } else { const long rr = rowq - NPROMPT; row0 = NPROMPT + (rr / SEQ_S) * SEQ_S; pos0 = (int)(rr % SEQ_S); L = SEQ_S; }
                    int tlo = pos0 / 64 - 2, thi = pos0 / 64 + 4; if (tlo < 0) tlo = 0; if (thi > L / 64) thi = L / 64;
                    const int h = 2 * kvh;
                    att::attn_unit<true>(QKV + rowq * PROJ + COL_QB + h * HD, PROJ, QKV + row0 * PROJ + COL_KB + kvh * HD, QKV + row0 * PROJ + COL_VB + kvh * HD, PROJ,
                                         MIX + rowq * MIXW + 768 + h * HD, MIXW, tlo, thi, pos0, 128, tabB + h * 512, 449, sink[h] * att::LOG2E, sink[h + 1] * att::LOG2E, 1.0f, nullptr, 0, (char*)lds);
                }
            }
            REPSEAM(2);
        }
        SEAM(pb + 2);
        if (EN(3) && IN(pb + 3)) for (int rep = 0; rep < NREP(3); ++rep) {
            const bf16_t* Wout = (const bf16_t*)(ws + WS_WOUT) + (size_t)l * DM * MIXW;
            pg8::Gemm g{MIX, Wout, NTOK, DM, MIXW}; pg8::StaticOrder S; S.init(NTOK, DM, G, bx);
            pg8::EpiRes E{XB, SSBUF + (size_t)(rep ? NNORM : 3 * l + 1) * NTOK, rep ? 0.f : 1.f};
            pg8::gemm_phase<pg8::EpiRes, pg8::StaticOrder, true, true>(ldsl, g, S, E);
            REPSEAM(3);
        }
        SEAM(pb + 3);
        if (EN(4) && IN(pb + 4)) for (int rep = 0; rep < NREP(4); ++rep) {
            const bf16_t* Wcq = (const bf16_t*)(ws + WS_WCQ) + (size_t)l * XW * DM;
            pg8::Gemm g{XB, Wcq, NTOK, XW, DM}; pg8::StaticOrder S; S.init(NTOK, XW, G, bx); pg8::EpiBf16 E{QX, XW, SSBUF + (size_t)(3 * l + 1) * NTOK};
            pg8::gemm_phase<pg8::EpiBf16, pg8::StaticOrder, true, true>(ldsl, g, S, E);
            REPSEAM(4);
        }
        SEAM(pb + 4);
        if (EN(5) && IN(pb + 5)) for (int rep = 0; rep < NREP(5); ++rep) {
            for (int u = bx; u < 768; u += G) {
                const int qbg = u >> 2, h = u & 3; const long rowq = (long)qbg * 256;
                const int seq = (rowq < NPROMPT) ? (int)(rowq / SEQ_P) : 2 + (int)((rowq - NPROMPT) / SEQ_S);
                const bf16_t* kb = KVX + (size_t)seq * MEMLEN * (4 * 2 * XW) + l * (2 * XW) + h * HD;
                att::attn_unit_dense<false>(QX + rowq * XW + h * HD, XW, kb, kb + XW, 4 * 2 * XW, OX + rowq * XW + h * HD, XW, MEMLEN / 64, -1.f, (char*)lds);
            }
            REPSEAM(5);
        }
        SEAM(pb + 5);
        if (EN(6) && IN(pb + 6)) for (int rep = 0; rep < NREP(6); ++rep) {
            const bf16_t* Wco = (const bf16_t*)(ws + WS_WCO) + (size_t)l * DM * XW;
            pg8::Gemm g{OX, Wco, NTOK, DM, XW}; pg8::StaticOrder S; S.init(NTOK, DM, G, bx);
            pg8::EpiRes E{XB, SSBUF + (size_t)(rep ? NNORM : 3 * l + 2) * NTOK, rep ? 0.f : 1.f};
            pg8::gemm_phase<pg8::EpiRes, pg8::StaticOrder, true, true>(ldsl, g, S, E);
            REPSEAM(6);
        }
        SEAM(pb + 6);
        if (EN(7) && IN(pb + 7)) for (int rep = 0; rep < NREP(7); ++rep) {
            const bf16_t* Wfi = (const bf16_t*)(ws + WS_WFI) + (size_t)l * 2 * DFF * DM;
            pg8::Gemm g{XB, Wfi, NTOK, 2 * DFF, DM}; pg8::StaticOrder S; S.init(NTOK, 2 * DFF, G, bx);
            pg8::EpiSwiglu E{HID, DFF, SSBUF + (size_t)(3 * l + 2) * NTOK};
            pg8::gemm_phase<pg8::EpiSwiglu, pg8::StaticOrder, true, true>(ldsl, g, S, E);
            REPSEAM(7);
        }
        SEAM(pb + 7);
        if (EN(8) && IN(pb + 8)) for (int rep = 0; rep < NREP(8); ++rep) {
            const bf16_t* Wfo = (const bf16_t*)(ws + WS_WFO) + (size_t)l * DM * DFF;
            pg8::Gemm g{HID, Wfo, NTOK, DM, DFF}; pg8::StaticOrder S; S.init(NTOK, DM, G, bx);
            pg8::EpiRes E{XB, SSBUF + (size_t)(rep ? NNORM : 3 * l + 3) * NTOK, rep ? 0.f : 1.f};
            pg8::gemm_phase<pg8::EpiRes, pg8::StaticOrder, true, true>(ldsl, g, S, E);
            REPSEAM(8);
        }
        SEAM(pb + 8);
    }
    if (EN(14) && IN(NPHASE - 1)) {
        LANE_ID();
        const float* g = args.in[19]; const pg8::ss_t* ssl = SSBUF + (size_t)(NNORM - 1) * NTOK;
        for (int m = gw; m < NTOK; m += NGW) { const float rstd = 1.0f / sqrtf((float)ssl[m] * pg8::SS_INV_MEAN + RMS_EPS); rms_row_out(XB + (size_t)m * DM, out + (size_t)m * DM, g, rstd, lane); }
    }
#undef IN
#undef SEAM
}

extern "C" void kernel_launch(void* const* d_in, const int* in_sizes, int n_in, void* d_out, int out_size, void* d_ws, size_t ws_size, hipStream_t stream) {
    static int grid = 0;
    if (grid == 0) {
        if (n_in != 20 || out_size != NTOK * DM || ws_size < WS_END) { fprintf(stderr, "kernel_launch: unexpected shapes: n_in %d out %d ws %zu (need %zu)\n", n_in, out_size, ws_size, (size_t)WS_END); grid = -1; return; }
        int dev = 0, cus = 0, per_cu = 0;
        if (hipGetDevice(&dev) != hipSuccess || hipDeviceGetAttribute(&cus, hipDeviceAttributeMultiprocessorCount, dev) != hipSuccess) { grid = -1; return; }
        if (hipFuncSetAttribute((const void*)fwd, hipFuncAttributeMaxDynamicSharedMemorySize, LDS_BYTES) != hipSuccess) { fprintf(stderr, "kernel_launch: hipFuncSetAttribute failed\n"); grid = -1; return; }
        if (hipOccupancyMaxActiveBlocksPerMultiprocessor(&per_cu, (const void*)fwd, NWAVES * 64, LDS_BYTES) != hipSuccess || per_cu < 1) { fprintf(stderr, "kernel_launch: occupancy query says %d\n", per_cu); }
        (void)hipGetLastError();
        grid = cus;
    }
    if (grid < 0) return;
    (void)hipMemsetAsync((char*)d_ws + WS_CTL, 0, CTL_ZERO_BYTES, stream);
    Args a{};
    for (int i = 0; i < 20; ++i) a.in[i] = (const float*)d_in[i];
    a.out = (float*)d_out; a.ws = (unsigned char*)d_ws;
#if ONE_LAUNCH
    a.ph_lo = 0; a.ph_hi = NPHASE;
    hipLaunchKernelGGL(fwd, dim3(grid), dim3(NWAVES * 64), LDS_BYTES, stream, a);
#else
    for (int p = 0; p < NPHASE; ++p) { a.ph_lo = p; a.ph_hi = p + 1; hipLaunchKernelGGL(fwd, dim3(grid), dim3(NWAVES * 64), LDS_BYTES, stream, a); }
#endif
    const hipError_t le = hipPeekAtLastError();
    if (le != hipSuccess) fprintf(stderr, "kernel_launch: launch failed: %s\n", hipGetErrorName(le));
}
```

```cpp
#include <hip/hip_runtime.h>
#include <cstdio>
#include <cstdint>

#ifndef ONE_LAUNCH
#define ONE_LAUNCH 1
#endif

constexpr int DM = 2048, NTOK = 49152, NPROMPT = 16384, SEQ_P = 8192, SEQ_S = 4096, DEPTH = 4;
constexpr int PROJ = 3840, MIXW = 2048, XW = 512, DFF = 5632, MEMLEN = 256, MEMROWS = 2560, HD = 128;
constexpr int COL_QA = 0, COL_KA = 768, COL_VA = 1024, COL_QB = 1280, COL_KB = 1792, COL_VB = 2048, COL_QC = 2304, COL_KC = 3072, COL_VC = 3456;
constexpr float RMS_EPS = 1e-6f;
constexpr int PPL = 9;
constexpr int NPHASE = 2 + PPL * DEPTH;
constexpr int NNORM = 3 * DEPTH + 1;

constexpr size_t MiB = 1u << 20;
constexpr size_t WS_CTL = 0;
constexpr size_t WS_SS = 1 * MiB;
constexpr size_t CTL_ZERO_BYTES = 6 * MiB + 512 * 1024;
static_assert(WS_SS + (size_t)(NNORM + 1) * NTOK * 8 <= CTL_ZERO_BYTES, "ss inside the memset region");
constexpr size_t WS_TAB = 6 * MiB + 512 * 1024;
constexpr size_t WS_RSM = 7 * MiB;
constexpr size_t WS_LSE = 618 * MiB;
constexpr size_t WS_WIN = 8 * MiB, WS_WOUT = 68 * MiB, WS_WCQ = 100 * MiB, WS_WCKV = 108 * MiB, WS_WCO = 124 * MiB, WS_WFI = 132 * MiB, WS_WFO = 308 * MiB;
constexpr size_t WS_XB = 396 * MiB;
constexpr size_t WS_MB = 588 * MiB;
constexpr size_t WS_KVX = 598 * MiB;
constexpr size_t WS_QKV = 620 * MiB;
constexpr size_t WS_MIX = 980 * MiB;
constexpr size_t WS_HID = 620 * MiB;
constexpr size_t WS_QX = 620 * MiB, WS_OX = 668 * MiB;
constexpr size_t WS_END = 1172 * MiB;
constexpr int CW_BAR = 4096;
constexpr int CW_XRANK = 12288;
constexpr int CW_QUEUE = 16384;

#define GAS __attribute__((address_space(1)))
#define LAS __attribute__((address_space(3)))
typedef unsigned short bf16_t;
typedef short bf16x8 __attribute__((ext_vector_type(8)));
typedef short s16x4 __attribute__((ext_vector_type(4)));
typedef float f32x4 __attribute__((ext_vector_type(4)));
typedef float f32x16 __attribute__((ext_vector_type(16)));
typedef unsigned u32x4 __attribute__((ext_vector_type(4)));
typedef unsigned u32x2 __attribute__((ext_vector_type(2)));
typedef GAS unsigned gu32;

__device__ __forceinline__ int opaque_tid() { int t = threadIdx.x; asm volatile("" : "+v"(t)); return t; }
__device__ __forceinline__ unsigned cvt_pk_bf16(float lo, float hi) { unsigned r; asm volatile("v_cvt_pk_bf16_f32 %0, %1, %2" : "=v"(r) : "v"(lo), "v"(hi)); return r; }
__device__ __forceinline__ float bf2f(unsigned short b) { return __builtin_bit_cast(float, (unsigned)b << 16); }
__device__ __forceinline__ float bflo(unsigned w) { return __builtin_bit_cast(float, w << 16); }
__device__ __forceinline__ float bfhi(unsigned w) { return __builtin_bit_cast(float, w & 0xffff0000u); }

namespace pg8 {
#define PG8_LAS __attribute__((address_space(3)))
constexpr int BM = 256, BK = 64, HALF = 128, HTB = HALF * BK * 2, STAGE_BYTES = 8 * HTB, NXCD = 8, WGM = 4;
__host__ __device__ __forceinline__ int lds_byte(int r, int c) { const int st = (r >> 4) * 2 + (c >> 5), rr = r & 15, cc = c & 31, ob = rr * 64 + cc * 2; return st * 1024 + (ob ^ (((ob >> 9) & 1) << 5)); }
__host__ __device__ __forceinline__ void stage_rc(int b, int& R, int& C) { const int st = b / 1024, sb = b % 1024, swz = sb ^ (((sb >> 9) & 1) << 5); R = (st >> 1) * 16 + swz / 64; C = (st & 1) * 32 + (swz % 64) / 2; }
__host__ __device__ __forceinline__ int perm32(int rho) { const int n = rho >> 4, i = rho & 15; return 8 * (i >> 2) + 4 * n + (i & 3); }

struct Unit { int pm, pn; };
struct Gemm { const bf16_t* A; const bf16_t* Bt; int M, N, K; };

struct StaticOrder {
    int nM, nN, nwg, G, c, i_lo, i_hi, wgm = WGM;
    __host__ __device__ void init(int M, int N, int G_, int c_, int lo_ = 0, int hi_ = 1 << 30) { nM = M / BM; nN = N / BM; nwg = nM * nN; G = G_; c = c_; i_lo = lo_; i_hi = hi_; }
    __host__ __device__ bool next(int i, Unit& u) const {
        i += i_lo; if (i >= i_hi) return false;
        const long L = (long)i * G + c; if (L >= nwg) return false;
        int wgid = (int)L; { const int q = nwg / NXCD, r = nwg % NXCD, xcd = wgid % NXCD, off = wgid / NXCD; wgid = (xcd < r ? xcd * (q + 1) : r * (q + 1) + (xcd - r) * q) + off; }
        const int nig = wgm * nN, gid = wgid / nig, fm = gid * wgm, gsz = (nM - fm) < wgm ? (nM - fm) : wgm;
        u.pm = fm + ((wgid % nig) % gsz); u.pn = (wgid % nig) / gsz; return true;
    }
    __device__ __forceinline__ void a_ready(const Unit&) const {}
    __device__ __forceinline__ void done(const Unit&) const {}
};

typedef unsigned long long ss_t;
constexpr float SS_SCALE = 16777216.0f, SS_INV_MEAN = 1.0f / (16777216.0f * 2048.0f);
struct PreSS { ss_t v[2][4]; };
struct PreNone {};
__device__ __forceinline__ void ss_prefetch(PreSS& p, const ss_t* ss, int row0) {
#pragma unroll
    for (int ai = 0; ai < 2; ++ai)
#pragma unroll
        for (int m = 0; m < 4; ++m) p.v[ai][m] = ss[row0 + ai * HALF + m * 16];
}
__device__ __forceinline__ void row_rstd(const PreSS& p, float (&rs)[2][4]) {
#pragma unroll
    for (int ai = 0; ai < 2; ++ai)
#pragma unroll
        for (int m = 0; m < 4; ++m) rs[ai][m] = 1.0f / sqrtf((float)p.v[ai][m] * SS_INV_MEAN + 1e-6f);
}
struct EpiBf16 {
    static constexpr bool PERM = true, AFTER_DRAIN = false;
    bf16_t* O; int ldc; const ss_t* ss;
    typedef PreSS Pre;
    __device__ __forceinline__ void prefetch(Pre& p, const Unit& u, int wr, int fr) const { ss_prefetch(p, ss, u.pm * BM + wr * 64 + fr); }
    __device__ __forceinline__ void operator()(const f32x4 (&acc)[2][2][4][2], const Unit& u, int wr, int wc, int fr, int fq, const Pre& pre) const {
        const int row0 = u.pm * BM + wr * 64 + fr; const int col0 = u.pn * BM + wc * 32 + 8 * fq;
        float rs[2][4]; row_rstd(pre, rs);
#pragma unroll
        for (int ai = 0; ai < 2; ++ai)
#pragma unroll
            for (int m = 0; m < 4; ++m) { bf16_t* rowp = O + (size_t)(row0 + ai * HALF + m * 16) * ldc + col0; const float r = rs[ai][m];
#pragma unroll
                for (int bj = 0; bj < 2; ++bj) { const f32x4 v0 = acc[ai][bj][m][0] * r, v1 = acc[ai][bj][m][1] * r;
                    u32x4 w; w.x = cvt_pk_bf16(v0[0], v0[1]); w.y = cvt_pk_bf16(v0[2], v0[3]); w.z = cvt_pk_bf16(v1[0], v1[1]); w.w = cvt_pk_bf16(v1[2], v1[3]);
                    *(u32x4*)(rowp + bj * HALF) = w; } }
    }
};
struct EpiRes {
    static constexpr bool PERM = true, AFTER_DRAIN = false;
    bf16_t* xb; ss_t* ssout; float scale;
    typedef PreNone Pre;
    __device__ __forceinline__ void prefetch(Pre&, const Unit&, int, int) const {}
    __device__ __forceinline__ void operator()(const f32x4 (&acc)[2][2][4][2], const Unit& u, int wr, int wc, int fr, int fq, const Pre&) const {
        const int row0 = u.pm * BM + wr * 64 + fr; const int col0 = u.pn * BM + wc * 32 + 8 * fq;
        bf16_t* xbase = xb + (size_t)row0 * DM + col0;
#pragma unroll
        for (int ai = 0; ai < 2; ++ai) { float sq[4];
            u32x4 xv[4][2];
#pragma unroll
            for (int m = 0; m < 4; ++m)
#pragma unroll
                for (int bj = 0; bj < 2; ++bj) xv[m][bj] = *(const u32x4*)(xbase + (size_t)(ai * HALF + m * 16) * DM + bj * HALF);
#pragma unroll
            for (int m = 0; m < 4; ++m) { bf16_t* bp = xbase + (size_t)(ai * HALF + m * 16) * DM;
                float q = 0.f;
#pragma unroll
                for (int bj = 0; bj < 2; ++bj) { const u32x4 xw = xv[m][bj]; const f32x4 d0 = acc[ai][bj][m][0] * scale, d1 = acc[ai][bj][m][1] * scale;
                    u32x4 w; w.x = cvt_pk_bf16(bflo(xw.x) + d0[0], bfhi(xw.x) + d0[1]); w.y = cvt_pk_bf16(bflo(xw.y) + d0[2], bfhi(xw.y) + d0[3]);
                    w.z = cvt_pk_bf16(bflo(xw.z) + d1[0], bfhi(xw.z) + d1[1]); w.w = cvt_pk_bf16(bflo(xw.w) + d1[2], bfhi(xw.w) + d1[3]);
                    *(u32x4*)(bp + bj * HALF) = w;
                    const float e0 = bflo(w.x), e1 = bfhi(w.x), e2 = bflo(w.y), e3 = bfhi(w.y), e4 = bflo(w.z), e5 = bfhi(w.z), e6 = bflo(w.w), e7 = bfhi(w.w);
                    q += (e0 * e0 + e1 * e1) + (e2 * e2 + e3 * e3) + (e4 * e4 + e5 * e5) + (e6 * e6 + e7 * e7); }
                sq[m] = q; }
            asm volatile("" ::: "memory");
            const bool b0 = fq & 1, b1 = fq & 2;
            const float w0 = (b0 ? sq[1] : sq[0]) + __shfl_xor(b0 ? sq[0] : sq[1], 16), w1 = (b0 ? sq[3] : sq[2]) + __shfl_xor(b0 ? sq[2] : sq[3], 16);
            const float tot = (b1 ? w1 : w0) + __shfl_xor(b1 ? w0 : w1, 32);
            __hip_atomic_fetch_add(ssout + u.pm * BM + ai * HALF + wr * 64 + fq * 16 + fr, (ss_t)(tot * SS_SCALE), __ATOMIC_RELAXED, __HIP_MEMORY_SCOPE_AGENT); }
    }
};
struct EpiSwiglu {
    static constexpr bool PERM = true, AFTER_DRAIN = false;
    bf16_t* O; int ldc; const ss_t* ss;
    typedef PreSS Pre;
    __device__ __forceinline__ void prefetch(Pre& p, const Unit& u, int wr, int fr) const { ss_prefetch(p, ss, u.pm * BM + wr * 64 + fr); }
    __device__ __forceinline__ void operator()(const f32x4 (&acc)[2][2][4][2], const Unit& u, int wr, int wc, int fr, int fq, const Pre& pre) const {
        const int row0 = u.pm * BM + wr * 64 + fr; const int col0 = u.pn * HALF + wc * 32 + 8 * fq;
        float rs[2][4]; row_rstd(pre, rs);
#pragma unroll
        for (int ai = 0; ai < 2; ++ai)
#pragma unroll
            for (int m = 0; m < 4; ++m) { float h[8]; const float r = rs[ai][m];
#pragma unroll
                for (int n = 0; n < 2; ++n)
#pragma unroll
                    for (int i = 0; i < 4; ++i) { const float g = acc[ai][0][m][n][i] * r, up = acc[ai][1][m][n][i] * r;
                        const float e = __builtin_amdgcn_exp2f(-g * 1.4426950408889634f); h[n * 4 + i] = g * __builtin_amdgcn_rcpf(1.0f + e) * up; }
                u32x4 w; w.x = cvt_pk_bf16(h[0], h[1]); w.y = cvt_pk_bf16(h[2], h[3]); w.z = cvt_pk_bf16(h[4], h[5]); w.w = cvt_pk_bf16(h[6], h[7]);
                *(u32x4*)(O + (size_t)(row0 + ai * HALF + m * 16) * ldc + col0) = w; }
    }
};

template <class Epi, class Sched, bool ALIGN_EPI = false, bool SP2 = false>
__device__ __forceinline__ void gemm_phase(PG8_LAS unsigned char* lds, const Gemm g, const Sched& S, const Epi& E) {
    const int tid = opaque_tid(), wid = __builtin_amdgcn_readfirstlane(tid >> 6), lane = tid & 63, wr = wid >> 2, wc = wid & 3, fr = lane & 15, fq = lane >> 4;
    const int K = g.K, nt = K / BK;
    unsigned voffA[2], voffB[2];
#pragma unroll
    for (int i = 0; i < 2; ++i) { int R, C; stage_rc(tid * 16 + i * 8192, R, C); const int Rb = Epi::PERM ? ((R & ~31) + perm32(R & 31)) : R;
        voffA[i] = (unsigned)(R * K + C) * 2u; voffB[i] = (unsigned)(Rb * K + C) * 2u; }
    const size_t kstep = (size_t)(BK * 2);
    const size_t hstep = (size_t)HALF * K * 2;
    const size_t tstep = 2 * hstep;
    const unsigned ldsw = (unsigned)wid * 1024u;
    const int aoff = lds_byte(wr * 64 + fr, fq * 8), boff = lds_byte(wc * 32 + fr, fq * 8);
#define PG8_SA(b, h) (((b) * 2 + (h)) * HTB)
#define PG8_SB(b, h) ((4 + (b) * 2 + (h)) * HTB)
#define PG8_STAGE(bufoff, gbase, voff) do { _Pragma("unroll") for (int _i = 0; _i < 2; ++_i) \
        __builtin_amdgcn_global_load_lds((const unsigned*)((const char*)(gbase) + (voff)[_i]), (PG8_LAS unsigned*)(lds + (bufoff) + ldsw + _i * 8192), 16, 0, 0); } while (0)
#define PG8_LDA(dst, b, h) do { _Pragma("unroll") for (int m = 0; m < 4; ++m) _Pragma("unroll") for (int k = 0; k < 2; ++k) dst[m][k] = *(const PG8_LAS bf16x8*)(lds + PG8_SA(b, h) + aoff + m * 2048 + k * 1024); } while (0)
#define PG8_LDB(dst, b, h) do { _Pragma("unroll") for (int n = 0; n < 2; ++n) _Pragma("unroll") for (int k = 0; k < 2; ++k) dst[n][k] = *(const PG8_LAS bf16x8*)(lds + PG8_SB(b, h) + boff + n * 2048 + k * 1024); } while (0)
#define PG8_MMA(ai, bj, At, Bt) do { __builtin_amdgcn_s_setprio(1); _Pragma("unroll") for (int m = 0; m < 4; ++m) _Pragma("unroll") for (int n = 0; n < 2; ++n) _Pragma("unroll") for (int k = 0; k < 2; ++k) \
        acc[ai][bj][m][n] = __builtin_amdgcn_mfma_f32_16x16x32_bf16(Bt[n][k], At[m][k], acc[ai][bj][m][n], 0, 0, 0); __builtin_amdgcn_s_setprio(0); } while (0)
#define PG8_WAIT_V(n) asm volatile("s_waitcnt vmcnt(" #n ")" ::: "memory")
#define PG8_WAIT_L(n) asm volatile("s_waitcnt lgkmcnt(" #n ")" ::: "memory")
#define PG8_BAR __builtin_amdgcn_s_barrier()
#define PG8_SCHED __builtin_amdgcn_sched_barrier(0)
    Unit cur, nxt; int ui = 0;
    if (!S.next(0, cur)) return;
    f32x4 acc[2][2][4][2];
#pragma unroll
    for (int a = 0; a < 2; ++a)
#pragma unroll
        for (int b = 0; b < 2; ++b)
#pragma unroll
            for (int m = 0; m < 4; ++m)
#pragma unroll
                for (int n = 0; n < 2; ++n) acc[a][b][m][n] = (f32x4){0.f, 0.f, 0.f, 0.f};
    bf16x8 At[4][2], B0[2][2], B1[2][2];
    typename Epi::Pre pre;
    const char* cA = (const char*)g.A + (size_t)cur.pm * tstep; const char* cB = (const char*)g.Bt + (size_t)cur.pn * tstep;
    S.a_ready(cur);
    if constexpr (SP2) {
        PG8_STAGE(PG8_SB(0, 0), cB, voffB); PG8_STAGE(PG8_SB(0, 1), cB + hstep, voffB); PG8_STAGE(PG8_SA(0, 0), cA, voffA); PG8_STAGE(PG8_SA(0, 1), cA + hstep, voffA);
        if (wr == 1) PG8_BAR;
        PG8_WAIT_V(2); PG8_BAR;
        PG8_STAGE(PG8_SB(1, 0), cB + kstep, voffB); PG8_STAGE(PG8_SA(1, 0), cA + kstep, voffA); PG8_STAGE(PG8_SB(1, 1), cB + hstep + kstep, voffB);
        PG8_WAIT_V(6); PG8_BAR;
    } else {
        PG8_STAGE(PG8_SB(0, 0), cB, voffB); PG8_STAGE(PG8_SA(0, 0), cA, voffA); PG8_STAGE(PG8_SB(0, 1), cB + hstep, voffB); PG8_STAGE(PG8_SA(0, 1), cA + hstep, voffA);
        if (wr == 1) PG8_BAR;
        PG8_WAIT_V(4); PG8_BAR;
        PG8_STAGE(PG8_SB(1, 0), cB + kstep, voffB); PG8_STAGE(PG8_SA(1, 0), cA + kstep, voffA); PG8_STAGE(PG8_SB(1, 1), cB + hstep + kstep, voffB);
        PG8_WAIT_V(6); PG8_BAR;
    }
    for (;;) {
        const bool has_next = S.next(ui + 1, nxt);
        const char* nA = has_next ? (const char*)g.A + (size_t)nxt.pm * tstep : cA; const char* nB = has_next ? (const char*)g.Bt + (size_t)nxt.pn * tstep : cB;
        for (int t = 0; t < nt; t += 2) {
            const bool last = (t == nt - 2);
            const char* a1 = cA + (size_t)(t + 1) * kstep;
            const char* a2 = last ? nA : cA + (size_t)(t + 2) * kstep; const char* b2 = last ? nB : cB + (size_t)(t + 2) * kstep;
            const char* a3 = a2 + kstep; const char* b3 = b2 + kstep;
            if (last && has_next) S.a_ready(nxt);
            if (last) E.prefetch(pre, cur, wr, fr);
            if constexpr (SP2) {
            PG8_LDB(B0, 0, 0); PG8_LDB(B1, 0, 1); PG8_SCHED; PG8_LDA(At, 0, 0); PG8_STAGE(PG8_SA(1, 1), a1 + hstep, voffA);
            PG8_WAIT_V(8); PG8_WAIT_L(0); PG8_BAR; PG8_MMA(0, 0, At, B0); PG8_MMA(0, 1, At, B1); PG8_BAR; PG8_SCHED;
            PG8_LDA(At, 0, 1); PG8_STAGE(PG8_SB(0, 0), b2, voffB); PG8_STAGE(PG8_SB(0, 1), b2 + hstep, voffB); PG8_STAGE(PG8_SA(0, 0), a2, voffA);
            PG8_WAIT_V(8); PG8_WAIT_L(0); PG8_BAR; PG8_MMA(1, 0, At, B0); PG8_MMA(1, 1, At, B1); PG8_BAR; PG8_SCHED;
            PG8_LDB(B0, 1, 0); PG8_LDB(B1, 1, 1); PG8_SCHED; PG8_LDA(At, 1, 0); PG8_STAGE(PG8_SA(0, 1), a2 + hstep, voffA);
            PG8_WAIT_V(8); PG8_WAIT_L(0); PG8_BAR; PG8_MMA(0, 0, At, B0); PG8_MMA(0, 1, At, B1); PG8_BAR; PG8_SCHED;
            PG8_LDA(At, 1, 1); PG8_STAGE(PG8_SB(1, 0), b3, voffB); PG8_STAGE(PG8_SB(1, 1), b3 + hstep, voffB); PG8_STAGE(PG8_SA(1, 0), a3, voffA);
            PG8_WAIT_V(8); PG8_WAIT_L(0); PG8_BAR; PG8_MMA(1, 0, At, B0); PG8_MMA(1, 1, At, B1); PG8_BAR; PG8_SCHED;
            } else {
            PG8_LDB(B0, 0, 0); PG8_SCHED; PG8_LDA(At, 0, 0); PG8_STAGE(PG8_SA(1, 1), a1 + hstep, voffA);
            PG8_WAIT_L(8); PG8_BAR; PG8_WAIT_L(0); PG8_MMA(0, 0, At, B0); PG8_BAR; PG8_SCHED;
            PG8_LDB(B1, 0, 1); PG8_STAGE(PG8_SB(0, 0), b2, voffB);
            PG8_BAR; PG8_WAIT_L(0); PG8_MMA(0, 1, At, B1); PG8_BAR;
            PG8_LDA(At, 0, 1); PG8_STAGE(PG8_SA(0, 0), a2, voffA);
            PG8_BAR; PG8_WAIT_L(0); PG8_MMA(1, 0, At, B0); PG8_BAR; PG8_SCHED;
            PG8_STAGE(PG8_SB(0, 1), b2 + hstep, voffB);
            PG8_WAIT_V(6); PG8_BAR; PG8_MMA(1, 1, At, B1); PG8_BAR;
            PG8_LDB(B0, 1, 0); PG8_SCHED; PG8_LDA(At, 1, 0); PG8_STAGE(PG8_SA(0, 1), a2 + hstep, voffA);
            PG8_WAIT_L(8); PG8_BAR; PG8_WAIT_L(0); PG8_MMA(0, 0, At, B0); PG8_BAR; PG8_SCHED;
            PG8_LDB(B1, 1, 1); PG8_STAGE(PG8_SB(1, 0), b3, voffB);
            PG8_BAR; PG8_WAIT_L(0); PG8_MMA(0, 1, At, B1); PG8_BAR;
            PG8_LDA(At, 1, 1); PG8_STAGE(PG8_SA(1, 0), a3, voffA);
            PG8_BAR; PG8_WAIT_L(0); PG8_MMA(1, 0, At, B0); PG8_BAR; PG8_SCHED;
            PG8_STAGE(PG8_SB(1, 1), b3 + hstep, voffB);
            PG8_WAIT_V(6); PG8_BAR; PG8_MMA(1, 1, At, B1); PG8_BAR;
            }
        }
        if constexpr (ALIGN_EPI) { if (wr == 0) PG8_BAR; }
        if constexpr (!Epi::AFTER_DRAIN) { E(acc, cur, wr, wc, fr, fq, pre); S.done(cur); }
        if (!has_next) break;
#pragma unroll
        for (int a = 0; a < 2; ++a)
#pragma unroll
            for (int b = 0; b < 2; ++b)
#pragma unroll
                for (int m = 0; m < 4; ++m)
#pragma unroll
                    for (int n = 0; n < 2; ++n) acc[a][b][m][n] = (f32x4){0.f, 0.f, 0.f, 0.f};
        cur = nxt; cA = nA; cB = nB; ++ui;
        if constexpr (ALIGN_EPI) { if (wr == 1) PG8_BAR; }
    }
    PG8_WAIT_V(0);
    if constexpr (!ALIGN_EPI) { if (wr == 0) PG8_BAR; }
    PG8_BAR;
#undef PG8_SA
#undef PG8_SB
#undef PG8_STAGE
#undef PG8_LDA
#undef PG8_LDB
#undef PG8_MMA
#undef PG8_WAIT_V
#undef PG8_WAIT_L
#undef PG8_BAR
#undef PG8_SCHED
}
}

namespace att {
constexpr int D = 128, NW = 8, QBLK = 32, KVBLK = 64;
constexpr float SCALE = 0.088388347648318440f, LOG2E = 1.4426950408889634f, LN2 = 0.6931471805599453f;
constexpr float C = SCALE * LOG2E;
constexpr float THR2 = 8.f * LOG2E;
constexpr int SHM_V = KVBLK * D * 2, SHM_K = KVBLK * D * 2;
constexpr int OFF_V = 0, OFF_K = 2 * SHM_V, BUF3 = SHM_V + SHM_K  , OFF_WS = 3 * BUF3, OFF_TAB = OFF_WS + NW * 64 * 4, TAB_FLOATS = 1024, OFF_UID = OFF_TAB + TAB_FLOATS * 4, LDS_BYTES = OFF_UID + 64;
#define KSWZ(row, colB) ((row) * 256 + ((colB) ^ (((row) & 7) << 4)))
#define SBAR() __builtin_amdgcn_sched_barrier(0)
__device__ __forceinline__ int crow(int r, int hi) { return (r & 3) + 8 * (r >> 2) + 4 * hi; }
__device__ __forceinline__ void qkt(f32x16& p0, f32x16& p1, const char* Ks, const bf16x8* qr, int r32, int hi) {
  p0 = f32x16{}; p1 = f32x16{};
#pragma unroll
  for (int d0 = 0; d0 < 8; ++d0) { const int cb = (d0 * 16 + hi * 8) * 2;
    const bf16x8 b0 = *reinterpret_cast<const bf16x8*>(Ks + KSWZ(r32, cb));
    const bf16x8 b1 = *reinterpret_cast<const bf16x8*>(Ks + KSWZ(32 + r32, cb));
    p0 = __builtin_amdgcn_mfma_f32_32x32x16_bf16(b0, qr[d0], p0, 0, 0, 0);
    p1 = __builtin_amdgcn_mfma_f32_32x32x16_bf16(b1, qr[d0], p1, 0, 0, 0); }
}
__device__ __forceinline__ int v_st(int k, int c) { const int kk = (k & ~0xC) | ((k & 4) << 1) | ((k & 8) >> 1); return ((kk >> 3) * 4 + (c >> 5)) * 512 + ((kk & 7) * 32 + (c & 31)) * 2; }
__device__ __forceinline__ int v_rd_base(int lane) { return ((lane & 3) << 3) | (((lane >> 2) & 3) << 6) | (((lane >> 4) & 1) << 5) | (((lane >> 5) & 1) << 8); }
constexpr int v_rd_off(int d0, int ks, int half) { return d0 * 512 + ks * 4096 + half * 2048; }
template <int OFF> __device__ __forceinline__ s16x4 tr_read(int vb) {
  s16x4 r; asm volatile("ds_read_b64_tr_b16 %0, %1 offset:%2" : "=&v"(r) : "v"(vb), "i"(OFF) : "memory"); return r;
}
template <int D0> __device__ __forceinline__ void pv_one(f32x16& od, int vb, bf16x8 pa0, bf16x8 pa1, bf16x8 pa2, bf16x8 pa3) {
  const s16x4 l0 = tr_read<v_rd_off(D0, 0, 0)>(vb), h0 = tr_read<v_rd_off(D0, 0, 1)>(vb), l1 = tr_read<v_rd_off(D0, 1, 0)>(vb), h1 = tr_read<v_rd_off(D0, 1, 1)>(vb);
  const s16x4 l2 = tr_read<v_rd_off(D0, 2, 0)>(vb), h2 = tr_read<v_rd_off(D0, 2, 1)>(vb), l3 = tr_read<v_rd_off(D0, 3, 0)>(vb), h3 = tr_read<v_rd_off(D0, 3, 1)>(vb);
  asm volatile("s_waitcnt lgkmcnt(0)" ::: "memory"); SBAR();
#define PK(L, H) (bf16x8){L[0], L[1], L[2], L[3], H[0], H[1], H[2], H[3]}
  od = __builtin_amdgcn_mfma_f32_32x32x16_bf16(pa0, PK(l0, h0), od, 0, 0, 0);
  od = __builtin_amdgcn_mfma_f32_32x32x16_bf16(pa1, PK(l1, h1), od, 0, 0, 0);
  od = __builtin_amdgcn_mfma_f32_32x32x16_bf16(pa2, PK(l2, h2), od, 0, 0, 0);
  od = __builtin_amdgcn_mfma_f32_32x32x16_bf16(pa3, PK(l3, h3), od, 0, 0, 0);
#undef PK
}
__device__ __forceinline__ void pv_d0(f32x16* o, int vb, bf16x8 pa0, bf16x8 pa1, bf16x8 pa2, bf16x8 pa3) {
  pv_one<0>(o[0], vb, pa0, pa1, pa2, pa3); pv_one<1>(o[1], vb, pa0, pa1, pa2, pa3); pv_one<2>(o[2], vb, pa0, pa1, pa2, pa3); pv_one<3>(o[3], vb, pa0, pa1, pa2, pa3);
}

template <bool TAB>
__device__ __forceinline__ void attn_unit(const bf16_t* __restrict__ Qb, long ldq, const bf16_t* __restrict__ Kh, const bf16_t* __restrict__ Vh, long ldk,
                                          bf16_t* __restrict__ Ob, long ldo, int t_lo, int t_hi, int qpos0, int W, const float* __restrict__ tabg, int tablen,
                                          float m_init0, float m_init1, float l_init, float* __restrict__ lse, long ldlse, char* lds) {
  const int tid = opaque_tid(), lane = tid & 63, r32 = lane & 31, hi = lane >> 5; const int wid = __builtin_amdgcn_readfirstlane(tid >> 6);
  const int hw = wid >> 2, wq = wid & 3;
  char* V_lds = lds + OFF_V; char* K_lds = lds + OFF_K;
  float* ws = (float*)(lds + OFF_WS) + wid * 64; float* li_l = ws; float* al_l = ws + 32;
  float* tab = (float*)(lds + OFF_TAB);
  bf16x8 qr[8];
  { const bf16_t* Qw = Qb + hw * D + (long)(wq * QBLK + r32) * ldq + hi * 8;
#pragma unroll
    for (int d0 = 0; d0 < 8; ++d0) qr[d0] = *reinterpret_cast<const bf16x8*>(Qw + d0 * 16); }
  if (TAB) { for (int i = tid; i < 2 * 512; i += NW * 64) tab[i] = ((i & 511) < tablen) ? tabg[i] : 0.f; }
  const int sr = tid >> 4, sc = (tid & 15) * 8, vst0 = v_st(sr, sc), vst1 = v_st(32 + sr, sc);
  const int vb0 = (int)(uintptr_t)V_lds + v_rd_base(lane);
  bf16x8 vs0, vs1, ks0, ks1;
#define SLOAD(k0) do { vs0 = *reinterpret_cast<const bf16x8*>(&Vh[(long)((k0) + sr) * ldk + sc]); vs1 = *reinterpret_cast<const bf16x8*>(&Vh[(long)((k0) + 32 + sr) * ldk + sc]); \
    ks0 = *reinterpret_cast<const bf16x8*>(&Kh[(long)((k0) + sr) * ldk + sc]); ks1 = *reinterpret_cast<const bf16x8*>(&Kh[(long)((k0) + 32 + sr) * ldk + sc]); } while (0)
#define SWRITE(b) do { *(bf16x8*)(V_lds + (b) * SHM_V + vst0) = vs0; *(bf16x8*)(V_lds + (b) * SHM_V + vst1) = vs1; const int kc = sc * 2; \
    *(bf16x8*)(K_lds + (b) * SHM_K + KSWZ(sr, kc)) = ks0; *(bf16x8*)(K_lds + (b) * SHM_K + KSWZ(32 + sr, kc)) = ks1; } while (0)
  float m_reg = hw ? m_init1 : m_init0, l_reg = l_init; f32x16 o[4] = {};
  const int qw0 = qpos0 + wq * QBLK;
  SLOAD(t_lo * KVBLK); SWRITE(0); __syncthreads();
  for (int t = t_lo; t < t_hi; ++t) {
    const int b = (t - t_lo) & 1; const bool more = (t + 1 < t_hi);
    if (more) SLOAD((t + 1) * KVBLK);
    const bool active = !TAB || (KVBLK * t + KVBLK - 1 >= qw0 - W && KVBLK * t <= qw0 + QBLK - 1 + W);
    if (active) {
      f32x16 p0, p1; qkt(p0, p1, K_lds + b * SHM_K, qr, r32, hi);
      if (TAB) { const float* tl = tab + hw * 512 + (KVBLK * t - qw0 - r32 + 4 * hi + W + 96);
#pragma unroll
        for (int r = 0; r < 16; ++r) { const int ix = (r & 3) + 8 * (r >> 2); p0[r] = fmaf(p0[r], C, tl[ix]); p1[r] = fmaf(p1[r], C, tl[ix + 32]); } }
      else {
#pragma unroll
        for (int r = 0; r < 16; ++r) { p0[r] *= C; p1[r] *= C; } }
      float pmax = p0[0];
#pragma unroll
      for (int r = 1; r < 16; ++r) pmax = fmaxf(pmax, p0[r]);
#pragma unroll
      for (int r = 0; r < 16; ++r) pmax = fmaxf(pmax, p1[r]);
      { auto rr = __builtin_amdgcn_permlane32_swap(__float_as_uint(pmax), __float_as_uint(pmax), false, false);
        pmax = fmaxf(__uint_as_float(rr[0]), __uint_as_float(rr[1])); }
      if (!__all(pmax - m_reg <= THR2)) {
        const float mn = fmaxf(m_reg, pmax); const float alpha = __builtin_amdgcn_exp2f(m_reg - mn); m_reg = mn; l_reg *= alpha;
        if (hi == 0) al_l[r32] = alpha; asm volatile("s_waitcnt lgkmcnt(0)" ::: "memory");
#pragma unroll
        for (int d = 0; d < 4; ++d)
#pragma unroll
          for (int r = 0; r < 16; ++r) o[d][r] *= al_l[crow(r, hi)];
      }
#pragma unroll
      for (int r = 0; r < 16; ++r) { p0[r] = __builtin_amdgcn_exp2f(p0[r] - m_reg); p1[r] = __builtin_amdgcn_exp2f(p1[r] - m_reg); }
      float ps = 0.f;
#pragma unroll
      for (int r = 0; r < 16; ++r) ps += p0[r];
#pragma unroll
      for (int r = 0; r < 16; ++r) ps += p1[r];
      { auto rr = __builtin_amdgcn_permlane32_swap(__float_as_uint(ps), __float_as_uint(ps), false, false);
        ps = __uint_as_float(rr[0]) + __uint_as_float(rr[1]); }
      l_reg += ps;
      bf16x8 pa0, pa1, pa2, pa3;
#define PK4(P, BASE, OUT) do { unsigned a0 = cvt_pk_bf16(P[BASE + 0], P[BASE + 1]), a1 = cvt_pk_bf16(P[BASE + 2], P[BASE + 3]);   \
    unsigned b0 = cvt_pk_bf16(P[BASE + 4], P[BASE + 5]), b1 = cvt_pk_bf16(P[BASE + 6], P[BASE + 7]);                              \
    auto r0 = __builtin_amdgcn_permlane32_swap(a0, b0, false, false); auto r1 = __builtin_amdgcn_permlane32_swap(a1, b1, false, false); \
    u32x4 w = {r0[0], r1[0], r0[1], r1[1]}; OUT = *reinterpret_cast<bf16x8*>(&w); } while (0)
      PK4(p0, 0, pa0); PK4(p0, 8, pa1); PK4(p1, 0, pa2); PK4(p1, 8, pa3);
#undef PK4
      SBAR();
      pv_d0(o, vb0 + b * SHM_V, pa0, pa1, pa2, pa3);
    }
    if (more) SWRITE(b ^ 1);
    __syncthreads();
  }
  if (hi == 0) li_l[r32] = l_reg; asm volatile("s_waitcnt lgkmcnt(0)" ::: "memory");
  float rli[16];
#pragma unroll
  for (int r = 0; r < 16; ++r) rli[r] = __builtin_amdgcn_rcpf(li_l[crow(r, hi)]);
  bf16_t* stg = (bf16_t*)(lds + wid * 8192);
#pragma unroll
  for (int r = 0; r < 16; ++r) { const int orow = crow(r, hi);
#pragma unroll
    for (int d0 = 0; d0 < 4; ++d0) { const unsigned w = cvt_pk_bf16(o[d0][r] * rli[r], 0.f); stg[orow * 128 + d0 * 32 + r32] = (bf16_t)(w & 0xffffu); } }
  asm volatile("s_waitcnt lgkmcnt(0)" ::: "memory");
#pragma unroll
  for (int i = 0; i < 8; ++i) { const int row = i * 4 + (lane >> 4), ch = lane & 15; const u32x4 v = *(const u32x4*)(stg + row * 128 + ch * 8);
    *(u32x4*)(Ob + hw * D + (long)(wq * QBLK + row) * ldo + ch * 8) = v; }
  if (lse != nullptr && hi == 0) lse[hw + (long)(wq * QBLK + r32) * ldlse] = (m_reg + __builtin_amdgcn_logf(l_reg)) * LN2;
  __syncthreads();
#undef SLOAD
#undef SWRITE
}
template <bool PRE>
__device__ __forceinline__ void partialSM(f32x16& p0, f32x16& p1, float& m_reg, float& mn, float& alpha) {
  constexpr float cs = PRE ? 1.0f : C;
  float pmax = p0[0];
#pragma unroll
  for (int r = 1; r < 16; ++r) pmax = fmaxf(pmax, p0[r]);
#pragma unroll
  for (int r = 0; r < 16; ++r) pmax = fmaxf(pmax, p1[r]);
  { auto rr = __builtin_amdgcn_permlane32_swap(__float_as_uint(pmax), __float_as_uint(pmax), false, false);
    pmax = fmaxf(__uint_as_float(rr[0]), __uint_as_float(rr[1])); }
  if (__builtin_expect(__all((pmax - m_reg) * cs <= THR2), 1)) { mn = m_reg; alpha = 1.f; }
  else { mn = fmaxf(m_reg, pmax); alpha = __builtin_amdgcn_exp2f((m_reg - mn) * cs); m_reg = mn; }
  const float mnC = -mn * cs;
#pragma unroll
  for (int r = 0; r < 16; ++r) p0[r] = fmaf(p0[r], cs, mnC);
#pragma unroll
  for (int r = 0; r < 16; ++r) p1[r] = fmaf(p1[r], cs, mnC);
#pragma unroll
  for (int r = 0; r < 16; ++r) p0[r] = __builtin_amdgcn_exp2f(p0[r]);
}
__device__ __forceinline__ void partialSM_fixed(f32x16& p0) {
#pragma unroll
  for (int r = 0; r < 16; ++r) p0[r] = __builtin_amdgcn_exp2f(p0[r]);
}
__device__ __forceinline__ void finishSM(f32x16& p0, f32x16& p1, float alpha, float& l_reg, bf16x8& pa0, bf16x8& pa1, bf16x8& pa2, bf16x8& pa3) {
#pragma unroll
  for (int r = 0; r < 16; ++r) p1[r] = __builtin_amdgcn_exp2f(p1[r]);
  float ps = 0;
#pragma unroll
  for (int r = 0; r < 16; ++r) ps += p0[r];
#pragma unroll
  for (int r = 0; r < 16; ++r) ps += p1[r];
  { auto rr = __builtin_amdgcn_permlane32_swap(__float_as_uint(ps), __float_as_uint(ps), false, false);
    ps = __uint_as_float(rr[0]) + __uint_as_float(rr[1]); }
  l_reg = l_reg * alpha + ps;
#define PK4(P, BASE, OUT) do { unsigned a0 = cvt_pk_bf16(P[BASE + 0], P[BASE + 1]), a1 = cvt_pk_bf16(P[BASE + 2], P[BASE + 3]);   \
    unsigned b0 = cvt_pk_bf16(P[BASE + 4], P[BASE + 5]), b1 = cvt_pk_bf16(P[BASE + 6], P[BASE + 7]);                              \
    auto r0 = __builtin_amdgcn_permlane32_swap(a0, b0, false, false); auto r1 = __builtin_amdgcn_permlane32_swap(a1, b1, false, false); \
    u32x4 w = {r0[0], r1[0], r0[1], r1[1]}; OUT = *reinterpret_cast<bf16x8*>(&w); } while (0)
  PK4(p0, 0, pa0); PK4(p0, 8, pa1); PK4(p1, 0, pa2); PK4(p1, 8, pa3);
#undef PK4
}
template <bool PRE>
__device__ __forceinline__ void attn_unit_dense(const bf16_t* __restrict__ Qb, long ldq, const bf16_t* __restrict__ Kh, const bf16_t* __restrict__ Vh, long ldk,
                                                bf16_t* __restrict__ Ob, long ldo, int ntile, float mfix2, char* lds) {
  const int tid = opaque_tid(), lane = tid & 63, r32 = lane & 31, hi = lane >> 5; const int wid = __builtin_amdgcn_readfirstlane(tid >> 6);
  float* ws = (float*)(lds + OFF_WS) + wid * 64; float* li_l = ws; float* al_l = ws + 32;
  const bool fixm = PRE && mfix2 >= 0.f;
  float m_reg = -1e30f, l_reg = 0; f32x16 o[4] = {}; bf16x8 qr[8];
  { const bf16_t* Qw = Qb + (long)(wid * QBLK + r32) * ldq + hi * 8;
#pragma unroll
    for (int d0 = 0; d0 < 8; ++d0) qr[d0] = *reinterpret_cast<const bf16x8*>(Qw + d0 * 16); }
  const int sr = tid >> 4, sc = (tid & 15) * 8, vst0 = v_st(sr, sc), vst1 = v_st(32 + sr, sc);
  const int vb0 = (int)(uintptr_t)lds + v_rd_base(lane);
  bf16x8 vsE0, vsE1, ksE0, ksE1, vsO0, vsO1, ksO0, ksO1;
#define SLOAD_E(k0) do { vsE0 = *reinterpret_cast<const bf16x8*>(&Vh[(long)((k0) + sr) * ldk + sc]); vsE1 = *reinterpret_cast<const bf16x8*>(&Vh[(long)((k0) + 32 + sr) * ldk + sc]); \
    ksE0 = *reinterpret_cast<const bf16x8*>(&Kh[(long)((k0) + sr) * ldk + sc]); ksE1 = *reinterpret_cast<const bf16x8*>(&Kh[(long)((k0) + 32 + sr) * ldk + sc]); } while (0)
#define SLOAD_O(k0) do { vsO0 = *reinterpret_cast<const bf16x8*>(&Vh[(long)((k0) + sr) * ldk + sc]); vsO1 = *reinterpret_cast<const bf16x8*>(&Vh[(long)((k0) + 32 + sr) * ldk + sc]); \
    ksO0 = *reinterpret_cast<const bf16x8*>(&Kh[(long)((k0) + sr) * ldk + sc]); ksO1 = *reinterpret_cast<const bf16x8*>(&Kh[(long)((k0) + 32 + sr) * ldk + sc]); } while (0)
#define SWRITE_E(bo) do { char* B_ = lds + (bo); *(bf16x8*)(B_ + vst0) = vsE0; *(bf16x8*)(B_ + vst1) = vsE1; const int kc = sc * 2; \
    *(bf16x8*)(B_ + SHM_V + KSWZ(sr, kc)) = ksE0; *(bf16x8*)(B_ + SHM_V + KSWZ(32 + sr, kc)) = ksE1; } while (0)
#define SWRITE_O(bo) do { char* B_ = lds + (bo); *(bf16x8*)(B_ + vst0) = vsO0; *(bf16x8*)(B_ + vst1) = vsO1; const int kc = sc * 2; \
    *(bf16x8*)(B_ + SHM_V + KSWZ(sr, kc)) = ksO0; *(bf16x8*)(B_ + SHM_V + KSWZ(32 + sr, kc)) = ksO1; } while (0)
#define SWAIT() asm volatile("s_waitcnt vmcnt(4)" ::: "memory")
#define PSM(P0, P1, MN, AL) do { if (fixm) { partialSM_fixed(P0); AL = 1.f; MN = 0.f; } else partialSM<PRE>(P0, P1, m_reg, MN, AL); } while (0)
#define RESC(a) do { if (!fixm) if (__any((a) < 1.f)) { if (hi == 0) al_l[r32] = (a); asm volatile("s_waitcnt lgkmcnt(0)" ::: "memory"); \
    _Pragma("unroll") for (int d = 0; d < 4; ++d) _Pragma("unroll") for (int r = 0; r < 16; ++r) o[d][r] *= al_l[crow(r, hi)]; } } while (0)
#define ROT3() do { const int t_ = bV; bV = bK; bK = bW; bW = t_; } while (0)
  f32x16 pA0, pA1, pB0, pB1; float mnA, mnB, alA, alB; bf16x8 pa0, pa1, pa2, pa3; const int NT = ntile;
  int bV = 0, bK = 0, bW = BUF3;
  SLOAD_E(0); SLOAD_O(KVBLK); asm volatile("s_waitcnt vmcnt(4)" ::: "memory"); SWRITE_E(0); SLOAD_E(2 * KVBLK);
  __syncthreads();
  SWAIT(); SWRITE_O(bW);
  qkt(pA0, pA1, lds + bK + SHM_V, qr, r32, hi); PSM(pA0, pA1, mnA, alA);
  if (3 < NT) SLOAD_O(3 * KVBLK);
  bV = 0; bK = BUF3; bW = 2 * BUF3;
  for (int j = 1; j + 1 < NT; j += 2) {
    __syncthreads(); SWAIT(); SWRITE_E(bW);
    SBAR(); qkt(pB0, pB1, lds + bK + SHM_V, qr, r32, hi);
    finishSM(pA0, pA1, alA, l_reg, pa0, pa1, pa2, pa3); SBAR();
    if (j + 3 < NT) SLOAD_E((j + 3) * KVBLK); SBAR();
    pv_d0(o, vb0 + bV, pa0, pa1, pa2, pa3); PSM(pB0, pB1, mnB, alB);
    RESC(alB); ROT3();
    __syncthreads(); SWAIT(); SWRITE_O(bW);
    SBAR(); qkt(pA0, pA1, lds + bK + SHM_V, qr, r32, hi);
    finishSM(pB0, pB1, alB, l_reg, pa0, pa1, pa2, pa3); SBAR();
    if (j + 4 < NT) SLOAD_O((j + 4) * KVBLK); SBAR();
    pv_d0(o, vb0 + bV, pa0, pa1, pa2, pa3); PSM(pA0, pA1, mnA, alA);
    RESC(alA); ROT3();
  }
  __syncthreads();
  SBAR(); qkt(pB0, pB1, lds + bK + SHM_V, qr, r32, hi);
  finishSM(pA0, pA1, alA, l_reg, pa0, pa1, pa2, pa3); SBAR();
  pv_d0(o, vb0 + bV, pa0, pa1, pa2, pa3); PSM(pB0, pB1, mnB, alB);
  RESC(alB); ROT3();
  finishSM(pB0, pB1, alB, l_reg, pa0, pa1, pa2, pa3); SBAR();
  pv_d0(o, vb0 + bV, pa0, pa1, pa2, pa3);
#undef ROT3
  if (hi == 0) li_l[r32] = l_reg; asm volatile("s_waitcnt lgkmcnt(0)" ::: "memory");
  float rli[16];
#pragma unroll
  for (int r = 0; r < 16; ++r) rli[r] = __builtin_amdgcn_rcpf(li_l[crow(r, hi)]);
  __syncthreads();
  bf16_t* stg = (bf16_t*)(lds + wid * 8192);
#pragma unroll
  for (int r = 0; r < 16; ++r) { const int orow = crow(r, hi);
#pragma unroll
    for (int d0 = 0; d0 < 4; ++d0) { const unsigned w = cvt_pk_bf16(o[d0][r] * rli[r], 0.f); stg[orow * 128 + d0 * 32 + r32] = (bf16_t)(w & 0xffffu); } }
  asm volatile("s_waitcnt lgkmcnt(0)" ::: "memory");
#pragma unroll
  for (int i = 0; i < 8; ++i) { const int row = i * 4 + (lane >> 4), ch = lane & 15; const u32x4 v = *(const u32x4*)(stg + row * 128 + ch * 8);
    *(u32x4*)(Ob + (long)(wid * QBLK + row) * ldo + ch * 8) = v; }
  __syncthreads();
#undef PSM
#undef SLOAD_E
#undef SLOAD_O
#undef SWRITE_E
#undef SWRITE_O
#undef SWAIT
#undef RESC
}
#undef SBAR
}

#define XB_TMO      128
#define XB_XCNT(j)  (256  + 64 * (j))
#define XB_XSUB(j)  (1280 + 64 * (j))
#define XB_XGEN(j)  (2304 + 64 * (j))
#define XB_TOP      3328
#define XB_TOPGEN   3392
#define XCD_BAR_WORDS 3456
#define XB_SPIN_CAP (1u << 18)
__device__ __forceinline__ unsigned xb_ld(unsigned* p)              { return __hip_atomic_load(p, __ATOMIC_RELAXED, __HIP_MEMORY_SCOPE_AGENT); }
__device__ __forceinline__ unsigned xb_add(unsigned* p, unsigned v) { return __hip_atomic_fetch_add(p, v, __ATOMIC_RELAXED, __HIP_MEMORY_SCOPE_AGENT); }
__device__ __forceinline__ unsigned xb_xcc_id() { return (unsigned)__builtin_amdgcn_s_getreg((3 << 11) | 20) & 0xFu; }
#define XB_SPIN(cond, bar) do { unsigned _sp = 0; while (cond) { __builtin_amdgcn_s_sleep(1); \
    if ((++_sp & 255u) == 0u) { if (xb_ld(&(bar)[XB_TMO])) break; if (_sp > XB_SPIN_CAP) { atomicAdd(&(bar)[XB_TMO], 1u); break; } } } } while (0)
struct XcdBarrier { unsigned* bar; unsigned x; volatile LAS unsigned* st; };
__device__ __forceinline__ XcdBarrier xcd_barrier_post(unsigned* bar, volatile LAS unsigned* st) {
    XcdBarrier b; b.bar = bar; b.x = xb_xcc_id(); b.st = st;
    if (threadIdx.x == 0) (void)xb_add(&bar[XB_XCNT(b.x)], 1u);
    return b;
}
__device__ __forceinline__ void xcd_barrier_complete(unsigned* bar, unsigned x, unsigned& nloc, unsigned& nx) {
    const unsigned G = gridDim.x * gridDim.y * gridDim.z;
    unsigned sum, cnt, mine, sp = 0u;
    for (;;) {
        sum = 0u; cnt = 0u; mine = 0u;
#pragma unroll
        for (unsigned j = 0; j < 16; ++j) { const unsigned c = xb_ld(&bar[XB_XCNT(j)]); sum += c; cnt += (c > 0u) ? 1u : 0u; mine = (j == x) ? c : mine; }
        if (sum == G) break;
        __builtin_amdgcn_s_sleep(1);
        if ((++sp & 255u) == 0u) { if (xb_ld(&bar[XB_TMO])) break; if (sp > XB_SPIN_CAP) { atomicAdd(&bar[XB_TMO], 1u); break; } }
    }
    nloc = mine > 0u ? mine : 1u; nx = cnt > 0u ? cnt : 1u;
}
__device__ __forceinline__ void xcd_barrier(const XcdBarrier& b) {
    asm volatile("s_waitcnt vmcnt(0)" ::: "memory");
    __syncthreads();
    if (threadIdx.x == 0) {
        unsigned* bar = b.bar;
        __builtin_amdgcn_s_waitcnt(0);
        unsigned nloc = b.st[0], nx = b.st[1];
        if (nloc == 0u) { xcd_barrier_complete(bar, b.x, nloc, nx); b.st[0] = nloc; b.st[1] = nx; }
        const unsigned old = xb_add(&bar[XB_XSUB(b.x)], 1u);
        const unsigned gen = old / nloc;
        if (old + 1u == (gen + 1u) * nloc) {
            __builtin_amdgcn_fence(__ATOMIC_RELEASE, "agent");
            asm volatile("s_waitcnt vmcnt(0)" ::: "memory");
            const unsigned og = xb_add(&bar[XB_TOP], 1u);
            const unsigned tg = og / nx;
            if (og + 1u == (tg + 1u) * nx) xb_add(&bar[XB_TOPGEN], 1u);
            else XB_SPIN(xb_ld(&bar[XB_TOPGEN]) == tg, bar);
            __builtin_amdgcn_fence(__ATOMIC_ACQUIRE, "agent");
            xb_add(&bar[XB_XGEN(b.x)], 1u);
            asm volatile("s_waitcnt vmcnt(0)" ::: "memory");
        } else {
            XB_SPIN(xb_ld(&bar[XB_XGEN(b.x)]) == gen, bar);
            __builtin_amdgcn_fence(__ATOMIC_ACQUIRE, "agent");
            asm volatile("s_waitcnt vmcnt(0)" ::: "memory");
        }
    }
    __syncthreads();
}

constexpr int NWAVES = 8;
constexpr int RING_BYTES = 131072, LDSCTL_OFF = RING_BYTES, MISC_OFF = LDSCTL_OFF + 320, LDS_BYTES = 147456;
static_assert(att::LDS_BYTES <= RING_BYTES, "attention scratch inside the ring region");

struct Args {
    const float* in[20]; float* out; unsigned char* ws; int ph_lo, ph_hi;
};

__device__ __forceinline__ float wave_sum(float v) {
#pragma unroll
    for (int o = 1; o < 64; o <<= 1) v += __shfl_xor(v, o);
    return v;
}
__device__ __forceinline__ unsigned f2bf(float f) { unsigned u = __builtin_bit_cast(unsigned, f); return (u + 0x7fffu + ((u >> 16) & 1u)) >> 16; }
__device__ __forceinline__ unsigned pk2(float lo, float hi) { return f2bf(lo) | (f2bf(hi) << 16); }

__device__ __forceinline__ void transpose_item(const float* W, const float* gain, int K, int N, bf16_t* WT, int k0, int n0, int drow0, LAS float* scr, int lane) {
    const int kr = lane >> 3, nq = lane & 7;
    f32x4 v[8]; float gk[8];
#pragma unroll
    for (int i = 0; i < 8; ++i) { v[i] = *(const GAS f32x4*)(W + (size_t)(k0 + kr + 8 * i) * N + n0 + 4 * nq); gk[i] = gain ? gain[k0 + kr + 8 * i] : 1.0f; }
#pragma unroll
    for (int i = 0; i < 8; ++i) { LAS float* d = scr + (kr + 8 * i) * 33 + 4 * nq; d[0] = v[i].x * gk[i]; d[1] = v[i].y * gk[i]; d[2] = v[i].z * gk[i]; d[3] = v[i].w * gk[i]; }
    asm volatile("s_waitcnt lgkmcnt(0)" ::: "memory");
    const int c = lane & 7;
#pragma unroll
    for (int j = 0; j < 4; ++j) { const int n = (lane >> 3) + 8 * j; const LAS float* s = scr + (8 * c) * 33 + n;
        u32x4 o; o.x = pk2(s[0 * 33], s[1 * 33]); o.y = pk2(s[2 * 33], s[3 * 33]); o.z = pk2(s[4 * 33], s[5 * 33]); o.w = pk2(s[6 * 33], s[7 * 33]);
        *(GAS u32x4*)(WT + (size_t)(drow0 + n) * K + k0 + 8 * c) = o; }
    asm volatile("s_waitcnt lgkmcnt(0)" ::: "memory");
}

__device__ __forceinline__ int t5_bucket(int rel) {
    const int n = rel < 0 ? -rel : rel; int b;
    if (n < 8) b = n; else { b = 8 + (n >= 15) + (n >= 27) + (n >= 50) + (n >= 91) + (n >= 166) + (n >= 305) + (n >= 559); if (b > 15) b = 15; }
    return b + (rel > 0 ? 16 : 0);
}
__device__ __forceinline__ void sincos_d(double a, double& s, double& c) {
    const double k = __builtin_rint(a * 0.63661977236758134308);
    const double r = (a - k * 1.57079632679489655800) - k * 6.12323399573676603587e-17;
    const double r2 = r * r;
    double ps = 1.0 / 6227020800.0;
    ps = ps * r2 - 1.0 / 39916800.0; ps = ps * r2 + 1.0 / 362880.0; ps = ps * r2 - 1.0 / 5040.0; ps = ps * r2 + 1.0 / 120.0; ps = ps * r2 - 1.0 / 6.0; ps = ps * r2 + 1.0;
    const double sr = r * ps;
    double pc = -1.0 / 87178291200.0;
    pc = pc * r2 + 1.0 / 479001600.0; pc = pc * r2 - 1.0 / 3628800.0; pc = pc * r2 + 1.0 / 40320.0; pc = pc * r2 - 1.0 / 720.0; pc = pc * r2 + 1.0 / 24.0; pc = pc * r2 - 0.5; pc = pc * r2 + 1.0;
    const int q = ((int)k) & 3;
    s = (q == 0) ? sr : (q == 1) ? pc : (q == 2) ? -sr : -pc;
    c = (q == 0) ? pc : (q == 1) ? -sr : (q == 2) ? -pc : sr;
}

__device__ __forceinline__ float row_to_bf16(const float* xrow, bf16_t* orow, int lane) {
    const GAS f32x4* xr = (const GAS f32x4*)xrow + lane;
    f32x4 v[8]; float s = 0.f;
#pragma unroll
    for (int j = 0; j < 8; ++j) { v[j] = xr[64 * j]; s += (v[j].x * v[j].x + v[j].y * v[j].y) + (v[j].z * v[j].z + v[j].w * v[j].w); }
    GAS u32x2* o8 = (GAS u32x2*)orow + lane;
#pragma unroll
    for (int j = 0; j < 8; ++j) { u32x2 w; w.x = cvt_pk_bf16(v[j].x, v[j].y); w.y = cvt_pk_bf16(v[j].z, v[j].w); o8[64 * j] = w; }
    return wave_sum(s);
}
__device__ __forceinline__ void rms_row_out(const bf16_t* xrow, float* orow, const float* g, float rstd, int lane) {
    const GAS u32x2* xr = (const GAS u32x2*)xrow + lane; GAS f32x4* o = (GAS f32x4*)orow + lane; const GAS f32x4* gr = (const GAS f32x4*)g + lane;
#pragma unroll
    for (int j = 0; j < 8; ++j) { const u32x2 w = xr[64 * j]; const f32x4 gg = gr[64 * j]; f32x4 v = {bflo(w.x), bfhi(w.x), bflo(w.y), bfhi(w.y)}; o[64 * j] = v * rstd * gg; }
}

__device__ __forceinline__ void qknorm_rows(bf16_t* qkv, const float* ropec, const float* ropes, const float* qg, const float* kg, int row_base, int tid) {
    const int lane = tid & 63, wave = tid >> 6;
    const int head = lane >> 3, q8 = lane & 7, hf = q8 >> 2, a = q8 & 3;
    const float* gp = (head < 6) ? qg : kg;
    const float osc = (head < 6) ? 0.088388347648318440f * 1.4426950408889634f : 1.0f;
    float g1[8], g2[8];
#pragma unroll
    for (int e = 0; e < 8; ++e) { g1[e] = gp[hf * 64 + 8 * a + e]; g2[e] = gp[hf * 64 + 32 + 8 * a + e]; }
    for (int t0 = 0; t0 < 32; t0 += 4) {
        u32x4 w1[4], w2[4]; f32x4 cs[4][4];
#pragma unroll
        for (int i = 0; i < 4; ++i) { const int m = row_base + wave + 8 * (t0 + i);
            const int s = (m < NPROMPT) ? (m & (SEQ_P - 1)) : ((m - NPROMPT) & (SEQ_S - 1)); const int n = hf ? (s & 63) : (s >> 6);
            const bf16_t* p1 = qkv + (size_t)m * PROJ + head * HD + hf * 64 + 8 * a;
            w1[i] = *(const GAS u32x4*)p1; w2[i] = *(const GAS u32x4*)(p1 + 32);
            cs[i][0] = *(const GAS f32x4*)(ropec + n * 32 + 8 * a); cs[i][1] = *(const GAS f32x4*)(ropec + n * 32 + 8 * a + 4);
            cs[i][2] = *(const GAS f32x4*)(ropes + n * 32 + 8 * a); cs[i][3] = *(const GAS f32x4*)(ropes + n * 32 + 8 * a + 4); }
#pragma unroll
        for (int i = 0; i < 4; ++i) { const int m = row_base + wave + 8 * (t0 + i);
            bf16_t* p1 = qkv + (size_t)m * PROJ + head * HD + hf * 64 + 8 * a;
            float x1[8], x2[8];
#pragma unroll
            for (int e = 0; e < 4; ++e) { x1[2 * e] = bflo(w1[i][e]); x1[2 * e + 1] = bfhi(w1[i][e]); x2[2 * e] = bflo(w2[i][e]); x2[2 * e + 1] = bfhi(w2[i][e]); }
            float ss = 0.f;
#pragma unroll
            for (int e = 0; e < 8; ++e) ss += x1[e] * x1[e] + x2[e] * x2[e];
            ss += __shfl_xor(ss, 1); ss += __shfl_xor(ss, 2); ss += __shfl_xor(ss, 4);
            const float rstd = 1.0f / sqrtf(ss * (1.f / HD) + RMS_EPS);
            float o1[8], o2[8];
#pragma unroll
            for (int e = 0; e < 8; ++e) { const float cc = e < 4 ? cs[i][0][e & 3] : cs[i][1][e & 3], sn = e < 4 ? cs[i][2][e & 3] : cs[i][3][e & 3];
                const float y1 = x1[e] * rstd * g1[e], y2 = x2[e] * rstd * g2[e]; o1[e] = (y1 * cc - y2 * sn) * osc; o2[e] = (y1 * sn + y2 * cc) * osc; }
            u32x4 r1, r2;
#pragma unroll
            for (int e = 0; e < 4; ++e) { r1[e] = cvt_pk_bf16(o1[2 * e], o1[2 * e + 1]); r2[e] = cvt_pk_bf16(o2[2 * e], o2[2 * e + 1]); }
            *(GAS u32x4*)p1 = r1; *(GAS u32x4*)(p1 + 32) = r2; }
    }
}
__device__ __forceinline__ void crescale_rows(bf16_t* mix, const float* lsebuf, int row_base, int tid) {
    const int lane = tid & 63, wave = tid >> 6;
    for (int t0 = 0; t0 < 32; t0 += 4) {
        float ls[4][6]; u32x2 w[4][3];
#pragma unroll
        for (int i = 0; i < 4; ++i) { const int m = row_base + wave + 8 * (t0 + i);
#pragma unroll
            for (int k = 0; k < 6; ++k) ls[i][k] = lsebuf[(size_t)m * 6 + k];
            const GAS u32x2* p = (const GAS u32x2*)(mix + (size_t)m * MIXW + 1280) + lane;
#pragma unroll
            for (int j = 0; j < 3; ++j) w[i][j] = p[64 * j]; }
#pragma unroll
        for (int i = 0; i < 4; ++i) { const int m = row_base + wave + 8 * (t0 + i);
            float al[6];
#pragma unroll
            for (int j = 0; j < 2; ++j) { const float mx = fmaxf(fmaxf(ls[i][j], ls[i][2 + j]), ls[i][4 + j]);
                const float e0 = __expf(ls[i][j] - mx), e1 = __expf(ls[i][2 + j] - mx), e2 = __expf(ls[i][4 + j] - mx); const float inv = 1.0f / (e0 + e1 + e2);
                al[j] = e0 * inv; al[2 + j] = e1 * inv; al[4 + j] = e2 * inv; }
            GAS u32x2* p = (GAS u32x2*)(mix + (size_t)m * MIXW + 1280) + lane;
#pragma unroll
            for (int j = 0; j < 3; ++j) { const int hc = (4 * lane + 256 * j) >> 7; const float a = (hc == 0) ? al[0] : (hc == 1) ? al[1] : (hc == 2) ? al[2] : (hc == 3) ? al[3] : (hc == 4) ? al[4] : al[5];
                u32x2 v = w[i][j]; v.x = cvt_pk_bf16(bflo(v.x) * a, bfhi(v.x) * a); v.y = cvt_pk_bf16(bflo(v.y) * a, bfhi(v.y) * a); p[64 * j] = v; } }
    }
}

__global__ void __launch_bounds__(NWAVES * 64, 2) fwd(Args args) {
    extern __shared__ __attribute__((aligned(16))) unsigned char lds[];
    LAS unsigned char* ldsl = (LAS unsigned char*)lds;
    volatile LAS unsigned* MISC = (volatile LAS unsigned*)(ldsl + MISC_OFF);
    const int G = gridDim.x;
    unsigned char* ws = args.ws;
    gu32* ctl = (gu32*)(ws + WS_CTL);
    { const int tid0 = threadIdx.x; for (int u = tid0; u < (LDS_BYTES - LDSCTL_OFF) / 4; u += NWAVES * 64) ((LAS unsigned*)(ldsl + LDSCTL_OFF))[u] = 0u; }
    __syncthreads();
    XcdBarrier bar; bar.bar = (unsigned*)ctl + CW_BAR; bar.x = 0; bar.st = nullptr;
    if (ONE_LAUNCH) bar = xcd_barrier_post((unsigned*)ctl + CW_BAR, MISC + 8);
    int bx = blockIdx.x;
    if (ONE_LAUNCH) {
        if (threadIdx.x == 0) { const unsigned xcc = xb_xcc_id(); const unsigned rk = __hip_atomic_fetch_add(ctl + CW_XRANK + 64 * (xcc & 15u), 1u, __ATOMIC_RELAXED, __HIP_MEMORY_SCOPE_AGENT); MISC[12] = rk * 8u + xcc; }
        xcd_barrier(bar);
        if (threadIdx.x == 0) { bool ok = (G % 8 == 0);
            for (unsigned j = 0; j < 16; ++j) { const unsigned cnt = __hip_atomic_load(ctl + CW_XRANK + 64 * j, __ATOMIC_RELAXED, __HIP_MEMORY_SCOPE_AGENT); ok = ok && (cnt == (j < 8 ? (unsigned)G / 8u : 0u)); }
            if (!ok) MISC[12] = blockIdx.x; }
        __syncthreads();
        bx = __builtin_amdgcn_readfirstlane((int)MISC[12]);
    }
    const int lo = args.ph_lo, hi = args.ph_hi;
#ifndef PHMASK
#define PHMASK 0xffff
#endif
#define IN(k) (lo <= (k) && (k) < hi)
#define EN(b) ((PHMASK >> (b)) & 1)
#ifndef PROBE_DUP
#define PROBE_DUP 0
#endif
#define NREP(b) (1 + ((PROBE_DUP >> (b)) & 1))
#define REPSEAM(b) do { if (ONE_LAUNCH && NREP(b) > 1 && rep == 0) xcd_barrier(bar); } while (0)
#define SEAM(k) do { if (ONE_LAUNCH && IN(k) && IN((k) + 1)) xcd_barrier(bar); } while (0)
#define LANE_ID() const int tid = opaque_tid(), lane = tid & 63, wave = __builtin_amdgcn_readfirstlane(tid >> 6); const int vcu = (G % 8 == 0) ? (bx % 8) * (G / 8) + bx / 8 : bx; const int gw = vcu * NWAVES + wave, NGW = G * NWAVES; (void)lane; (void)gw; (void)NGW
#define ROPEC ((float*)(ws + WS_TAB))
#define ROPES (ROPEC + 128 * 32)
#define TABB (ROPES + 128 * 32)
#define TABC (TABB + 4 * 512)
#define LSEBUF ((float*)(ws + WS_LSE))
#define XB ((bf16_t*)(ws + WS_XB))
#define MB ((bf16_t*)(ws + WS_MB))
#define SSBUF ((pg8::ss_t*)(ws + WS_SS))
#define RSM ((pg8::ss_t*)(ws + WS_RSM))
#define QKV ((bf16_t*)(ws + WS_QKV))
#define MIX ((bf16_t*)(ws + WS_MIX))
#define HID ((bf16_t*)(ws + WS_HID))
#define QX ((bf16_t*)(ws + WS_QX))
#define OX ((bf16_t*)(ws + WS_OX))
#define KVX ((bf16_t*)(ws + WS_KVX))
    float* out = args.out;

    if (EN(13) && IN(0)) {
        LANE_ID();
        float* ropec = ROPEC; float* ropes = ROPES; float* tabB = TABB; float* tabC = TABC;
        LAS float* scr = (LAS float*)(ldsl + wave * 16384);
        constexpr int I_IN = 32 * 120, I_OUT = 32 * 64, I_CQ = 32 * 16, I_CKV = 32 * 32, I_CO = 8 * 64, I_FI = 32 * 352, I_FO = 88 * 64;
        constexpr int I_LAYER = I_IN + I_OUT + I_CQ + I_CKV + I_CO + I_FI + I_FO;
        for (int it = gw; it < DEPTH * I_LAYER; it += NGW) {
            const int l = it / I_LAYER; int r = it % I_LAYER;
            const float* W; bf16_t* WT; int K, N; const float* gain = nullptr;
            if (r < I_IN) { gain = args.in[4] + (size_t)l * DM; W = args.in[5] + (size_t)l * DM * PROJ; WT = (bf16_t*)(ws + WS_WIN) + (size_t)l * PROJ * DM; K = DM; N = PROJ; }
            else if ((r -= I_IN) < I_OUT) { W = args.in[10] + (size_t)l * MIXW * DM; WT = (bf16_t*)(ws + WS_WOUT) + (size_t)l * DM * MIXW; K = MIXW; N = DM; }
            else if ((r -= I_OUT) < I_CQ) { gain = args.in[11] + (size_t)l * DM; W = args.in[13] + (size_t)l * DM * XW; WT = (bf16_t*)(ws + WS_WCQ) + (size_t)l * XW * DM; K = DM; N = XW; }
            else if ((r -= I_CQ) < I_CKV) { gain = args.in[12] + (size_t)l * DM; W = args.in[14] + (size_t)l * DM * 2 * XW; WT = (bf16_t*)(ws + WS_WCKV) + (size_t)l * 2 * XW * DM; K = DM; N = 2 * XW; }
            else if ((r -= I_CKV) < I_CO) { W = args.in[15] + (size_t)l * XW * DM; WT = (bf16_t*)(ws + WS_WCO) + (size_t)l * DM * XW; K = XW; N = DM; }
            else if ((r -= I_CO) < I_FI) { gain = args.in[16] + (size_t)l * DM; W = args.in[17] + (size_t)l * DM * 2 * DFF; WT = (bf16_t*)(ws + WS_WFI) + (size_t)l * 2 * DFF * DM; K = DM; N = 2 * DFF; }
            else { r -= I_FI; W = args.in[18] + (size_t)l * DFF * DM; WT = (bf16_t*)(ws + WS_WFO) + (size_t)l * DM * DFF; K = DFF; N = DM; }
            const int nblk = N / 32, kb = r / nblk, nb = r % nblk, n0 = 32 * nb;
            int drow0 = n0;
            if (N == 2 * DFF) drow0 = (n0 < DFF) ? 256 * (n0 / 128) + (n0 % 128) : 256 * ((n0 - DFF) / 128) + 128 + ((n0 - DFF) % 128);
            transpose_item(W, gain, K, N, WT, 64 * kb, n0, drow0, scr, lane);
        }
        { bf16_t* xb = XB; pg8::ss_t* ss0 = SSBUF; bf16_t* mb = MB; pg8::ss_t* rsm = RSM;
          for (int m = gw; m < NTOK; m += NGW) { const float* xr = (m < NPROMPT) ? args.in[0] + (size_t)m * DM : args.in[1] + (size_t)(m - NPROMPT) * DM;
              const float q = row_to_bf16(xr, xb + (size_t)m * DM, lane); if (lane == 0) ss0[m] = (pg8::ss_t)(q * pg8::SS_SCALE); }
          for (int m = gw; m < MEMROWS; m += NGW) { const float* mr = (m < 2 * MEMLEN) ? args.in[2] + (size_t)m * DM : args.in[3] + (size_t)(m - 2 * MEMLEN) * DM;
              const float q = row_to_bf16(mr, mb + (size_t)m * DM, lane); if (lane == 0) rsm[m] = (pg8::ss_t)(q * pg8::SS_SCALE); } }
        const int gt = vcu * (NWAVES * 64) + tid, NGT = G * NWAVES * 64;
        const float* rel_bias = args.in[9];
        for (int e = gt; e < 4096 + 2048 + 3072; e += NGT) {
            if (e < 4096) { const int n = e >> 5, i = e & 31;
                double invd = 1.0; for (int q = 0; q < i; ++q) invd *= 0.7498942093324559;
                const float inv = (float)invd;
                const float ang = (float)n * inv; double s, c; sincos_d((double)ang, s, c); ropec[e] = (float)c; ropes[e] = (float)s; }
            else if (e < 4096 + 2048) { const int t = e - 4096, h = t >> 9, i = t & 511; const int rel = i - 96 - 128;
                float v = -INFINITY; if (rel >= -128 && rel <= 128) v = rel_bias[t5_bucket(rel) * 10 + h] * att::LOG2E;
                tabB[t] = v; }
            else { const int t = e - 6144, hc = t >> 9, i = t & 511; const int off = i - 96 - 64; const int d = (hc < 2) ? 1 : (hc < 4) ? 4 : 16;
                float v = -INFINITY; if (off >= -64 && off <= 64) v = rel_bias[t5_bucket(off * d) * 10 + 4 + hc] * att::LOG2E;
                tabC[t] = v; }
        }
    }
    SEAM(0);

    for (int l = 0; l < DEPTH; ++l) {
        const int pb = 1 + PPL * l;
#define XS0 ((l == 0) ? args.in[0] : (const float*)out)
#define XS1 ((l == 0) ? args.in[1] : (const float*)out + (size_t)NPROMPT * DM)
        if (EN(0) && IN(pb + 0)) for (int rep = 0; rep < NREP(0); ++rep) {
            { const bf16_t* Win = (const bf16_t*)(ws + WS_WIN) + (size_t)l * PROJ * DM;
              pg8::Gemm g{XB, Win, NTOK, PROJ, DM}; pg8::StaticOrder S; S.init(NTOK, PROJ, G, bx);
              pg8::EpiBf16 E{QKV, PROJ, SSBUF + (size_t)(3 * l) * NTOK};
              pg8::gemm_phase<pg8::EpiBf16, pg8::StaticOrder, true, true>(ldsl, g, S, E); }
            if (l == 0) {
              pg8::Gemm g{MB, (const bf16_t*)(ws + WS_WCKV), MEMROWS, 4 * 2 * XW, DM}; pg8::StaticOrder S; S.init(MEMROWS, 4 * 2 * XW, G, (bx + G - 64) % G);
              pg8::EpiBf16 E{KVX, 4 * 2 * XW, RSM};
              pg8::gemm_phase<pg8::EpiBf16, pg8::StaticOrder, true, true>(ldsl, g, S, E); }
            REPSEAM(0);
        }
        SEAM(pb + 0);
        if (EN(1) && IN(pb + 1)) {
            const int tid = opaque_tid(); const float* tabC = TABC; float* lsebuf = LSEBUF;
            gu32* qhead = ctl + CW_QUEUE + 64 * (2 * l);
            volatile LAS unsigned* uidw = (volatile LAS unsigned*)(ldsl + att::OFF_UID);
            for (;;) {
                if (tid == 0) uidw[0] = __hip_atomic_fetch_add(qhead, 1u, __ATOMIC_RELAXED, __HIP_MEMORY_SCOPE_AGENT);
                __syncthreads();
                const int u = (int)uidw[0];
                __syncthreads();
                if (u >= 1344) break;
                if (u < 960 && u % 5 == 4) {
                    qknorm_rows(QKV, ROPEC, ROPES, args.in[6] + (size_t)l * HD, args.in[7] + (size_t)l * HD, (u / 5) * 256, tid);
                } else { const int v0 = (u < 960) ? u - u / 5 : u - 192;
                {
                    const int v = v0, gi = v % 3, idx = v / 3; const int d = (gi == 0) ? 1 : (gi == 1) ? 4 : 16;
                    long row0; int j, L;
                    if (idx < 128) { row0 = (long)(idx / 64) * SEQ_P; j = idx % 64; L = SEQ_P; } else { const int i2 = idx - 128; row0 = NPROMPT + (long)(i2 / 32) * SEQ_S; j = i2 % 32; L = SEQ_S; }
                    const int res = j % d, qbr = j / d, p0 = qbr * 128, Lr = L / d;
                    int tlo = p0 / 64 - 1, thi = p0 / 64 + 3; if (tlo < 0) tlo = 0; if (thi > Lr / 64) thi = Lr / 64;
                    const long rq = row0 + (long)p0 * d + res, rk = row0 + res; const int hc = 2 * gi;
                    att::attn_unit<true>(QKV + rq * PROJ + COL_QC + hc * HD, (long)d * PROJ, QKV + rk * PROJ + COL_KC + gi * HD, QKV + rk * PROJ + COL_VC + gi * HD, (long)d * PROJ,
                                         MIX + rq * MIXW + 1280 + hc * HD, (long)d * MIXW, tlo, thi, p0, 64, tabC + hc * 512, 321, -1e30f, -1e30f, 0.f, lsebuf + rq * 6 + hc, (long)d * 6, (char*)lds);
                } }
            }
        }
        SEAM(pb + 1);
        if (EN(2) && IN(pb + 2)) for (int rep = 0; rep < NREP(2); ++rep) {
            const int tid = opaque_tid(); const float* tabB = TABB;
            float mfix2;
            { const float* qg = args.in[6] + (size_t)l * HD; const float* kg = args.in[7] + (size_t)l * HD; const int ln = tid & 63;
              float a = fmaxf(fabsf(qg[ln]), fabsf(qg[ln + 64])), b = fmaxf(fabsf(kg[ln]), fabsf(kg[ln + 64]));
#pragma unroll
              for (int o = 1; o < 64; o <<= 1) { a = fmaxf(a, __shfl_xor(a, o)); b = fmaxf(b, __shfl_xor(b, o)); }
              mfix2 = __builtin_amdgcn_readfirstlane(128.f * a * b * 1.02f * att::C); if (!(mfix2 <= 40.f)) mfix2 = -1.f; }
            gu32* qhead = ctl + CW_QUEUE + 64 * (2 * l + 1 + 8 * rep);
            volatile LAS unsigned* uidw = (volatile LAS unsigned*)(ldsl + att::OFF_UID);
            const float* sink = args.in[8] + (size_t)l * 4;
            for (;;) {
                if (tid == 0) uidw[0] = __hip_atomic_fetch_add(qhead, 1u, __ATOMIC_RELAXED, __HIP_MEMORY_SCOPE_AGENT);
                __syncthreads();
                const int u = (int)uidw[0];
                __syncthreads();
                if (u >= 1152 + 192 + 768) break;
                if (u < 1152) {
                    int seq, kvh, qb, gi, L;
                    if (u < 384) { seq = u / 192; const int r = u % 192; kvh = r / 96; const int r2 = r % 96; qb = r2 / 3; gi = r2 % 3; L = SEQ_P; }
                    else { const int v = u - 384; seq = 2 + v / 96; const int r = v % 96; kvh = r / 48; const int r2 = r % 48; qb = r2 / 3; gi = r2 % 3; L = SEQ_S; }
                    const long row0 = (seq < 2) ? (long)seq * SEQ_P : (long)NPROMPT + (long)(seq - 2) * SEQ_S;
                    const int h = kvh * 3 + gi;
                    att::attn_unit_dense<true>(QKV + (row0 + qb * 256) * PROJ + COL_QA + h * HD, PROJ, QKV + row0 * PROJ + COL_KA + kvh * HD, QKV + row0 * PROJ + COL_VA + kvh * HD, PROJ,
                                         MIX + (row0 + qb * 256) * MIXW + h * HD, MIXW, L / 64, mfix2, (char*)lds);
                } else if (u < 1344) { if (rep == 0) crescale_rows(MIX, LSEBUF, (u - 1152) * 256, tid); }
                else {
                    const int v = u - 1344, qbg = v >> 1, kvh = v & 1; const long rowq = (long)qbg * 128;
                    long row0; int pos0, L;
                    if (rowq < NPROMPT) { row0 = (rowq / SEQ_P) * SEQ_P; pos0 = (int)(rowq % SEQ_P); L = SEQ_P; } else { const long rr = rowq - NPROMPT; row0 = NPROMPT + (rr / SEQ_S) * SEQ_S; pos0 = (int)(rr % SEQ_S); L = SEQ_S; }
                    int tlo = pos0 / 64 - 2, thi = pos0 / 64 + 4; if (tlo < 0) tlo = 0; if (thi > L / 64) thi = L / 64;
                    const int h = 2 * kvh;
                    att::attn_unit<true>(QKV + rowq * PROJ + COL_QB + h * HD, PROJ, QKV + row0 * PROJ + COL_KB + kvh * HD, QKV + row0 * PROJ + COL_VB + kvh * HD, PROJ,
                                         MIX + rowq * MIXW + 768 + h * HD, MIXW, tlo, thi, pos0, 128, tabB + h * 512, 449, sink[h] * att::LOG2E, sink[h + 1] * att::LOG2E, 1.0f, nullptr, 0, (char*)lds);
                }
            }
            REPSEAM(2);
        }
        SEAM(pb + 2);
        if (EN(3) && IN(pb + 3)) for (int rep = 0; rep < NREP(3); ++rep) {
            const bf16_t* Wout = (const bf16_t*)(ws + WS_WOUT) + (size_t)l * DM * MIXW;
            pg8::Gemm g{MIX, Wout, NTOK, DM, MIXW}; pg8::StaticOrder S; S.init(NTOK, DM, G, bx);
            pg8::EpiRes E{XB, SSBUF + (size_t)(rep ? NNORM : 3 * l + 1) * NTOK, rep ? 0.f : 1.f};
            pg8::gemm_phase<pg8::EpiRes, pg8::StaticOrder, true, true>(ldsl, g, S, E);
            REPSEAM(3);
        }
        SEAM(pb + 3);
        if (EN(4) && IN(pb + 4)) for (int rep = 0; rep < NREP(4); ++rep) {
            const bf16_t* Wcq = (const bf16_t*)(ws + WS_WCQ) + (size_t)l * XW * DM;
            pg8::Gemm g{XB, Wcq, NTOK, XW, DM}; pg8::StaticOrder S; S.init(NTOK, XW, G, bx); pg8::EpiBf16 E{QX, XW, SSBUF + (size_t)(3 * l + 1) * NTOK};
            pg8::gemm_phase<pg8::EpiBf16, pg8::StaticOrder, true, true>(ldsl, g, S, E);
            REPSEAM(4);
        }
        SEAM(pb + 4);
        if (EN(5) && IN(pb + 5)) for (int rep = 0; rep < NREP(5); ++rep) {
            for (int u = bx; u < 768; u += G) {
                const int qbg = u >> 2, h = u & 3; const long rowq = (long)qbg * 256;
                const int seq = (rowq < NPROMPT) ? (int)(rowq / SEQ_P) : 2 + (int)((rowq - NPROMPT) / SEQ_S);
                const bf16_t* kb = KVX + (size_t)seq * MEMLEN * (4 * 2 * XW) + l * (2 * XW) + h * HD;
                att::attn_unit_dense<false>(QX + rowq * XW + h * HD, XW, kb, kb + XW, 4 * 2 * XW, OX + rowq * XW + h * HD, XW, MEMLEN / 64, -1.f, (char*)lds);
            }
            REPSEAM(5);
        }
        SEAM(pb + 5);
        if (EN(6) && IN(pb + 6)) for (int rep = 0; rep < NREP(6); ++rep) {
            const bf16_t* Wco = (const bf16_t*)(ws + WS_WCO) + (size_t)l * DM * XW;
            pg8::Gemm g{OX, Wco, NTOK, DM, XW}; pg8::StaticOrder S; S.init(NTOK, DM, G, bx);
            pg8::EpiRes E{XB, SSBUF + (size_t)(rep ? NNORM : 3 * l + 2) * NTOK, rep ? 0.f : 1.f};
            pg8::gemm_phase<pg8::EpiRes, pg8::StaticOrder, true, true>(ldsl, g, S, E);
            REPSEAM(6);
        }
        SEAM(pb + 6);
        if (EN(7) && IN(pb + 7)) for (int rep = 0; rep < NREP(7); ++rep) {
            const bf16_t* Wfi = (const bf16_t*)(ws + WS_WFI) + (size_t)l * 2 * DFF * DM;
            pg8::Gemm g{XB, Wfi, NTOK, 2 * DFF, DM}; pg8::StaticOrder S; S.init(NTOK, 2 * DFF, G, bx);
            pg8::EpiSwiglu E{HID, DFF, SSBUF + (size_t)(3 * l + 2) * NTOK};
            pg8::gemm_phase<pg8::EpiSwiglu, pg8::StaticOrder, true, true>(ldsl, g, S, E);
            REPSEAM(7);
        }
        SEAM(pb + 7);
        if (EN(8) && IN(pb + 8)) for (int rep = 0; rep < NREP(8); ++rep) {
            const bf16_t* Wfo = (const bf16_t*)(ws + WS_WFO) + (size_t)l * DM * DFF;
            pg8::Gemm g{HID, Wfo, NTOK, DM, DFF}; pg8::StaticOrder S; S.init(NTOK, DM, G, bx);
            pg8::EpiRes E{XB, SSBUF + (size_t)(rep ? NNORM : 3 * l + 3) * NTOK, rep ? 0.f : 1.f};
            pg8::gemm_phase<pg8::EpiRes, pg8::StaticOrder, true, true>(ldsl, g, S, E);
            REPSEAM(8);
        }
        SEAM(pb + 8);
    }
    if (EN(14) && IN(NPHASE - 1)) {
        LANE_ID();
        const float* g = args.in[19]; const pg8::ss_t* ssl = SSBUF + (size_t)(NNORM - 1) * NTOK;
        for (int m = gw; m < NTOK; m += NGW) { const float rstd = 1.0f / sqrtf((float)ssl[m] * pg8::SS_INV_MEAN + RMS_EPS); rms_row_out(XB + (size_t)m * DM, out + (size_t)m * DM, g, rstd, lane); }
    }
#undef IN
#undef SEAM
}

extern "C" void kernel_launch(void* const* d_in, const int* in_sizes, int n_in, void* d_out, int out_size, void* d_ws, size_t ws_size, hipStream_t stream) {
    static int grid = 0;
    if (grid == 0) {
        if (n_in != 20 || out_size != NTOK * DM || ws_size < WS_END) { fprintf(stderr, "kernel_launch: unexpected shapes: n_in %d out %d ws %zu (need %zu)\n", n_in, out_size, ws_size, (size_t)WS_END); grid = -1; return; }
        int dev = 0, cus = 0, per_cu = 0;
        if (hipGetDevice(&dev) != hipSuccess || hipDeviceGetAttribute(&cus, hipDeviceAttributeMultiprocessorCount, dev) != hipSuccess) { grid = -1; return; }
        if (hipFuncSetAttribute((const void*)fwd, hipFuncAttributeMaxDynamicSharedMemorySize, LDS_BYTES) != hipSuccess) { fprintf(stderr, "kernel_launch: hipFuncSetAttribute failed\n"); grid = -1; return; }
        if (hipOccupancyMaxActiveBlocksPerMultiprocessor(&per_cu, (const void*)fwd, NWAVES * 64, LDS_BYTES) != hipSuccess || per_cu < 1) { fprintf(stderr, "kernel_launch: occupancy query says %d\n", per_cu); }
        (void)hipGetLastError();
        grid = cus;
    }
    if (grid < 0) return;
    (void)hipMemsetAsync((char*)d_ws + WS_CTL, 0, CTL_ZERO_BYTES, stream);
    Args a{};
    for (int i = 0; i < 20; ++i) a.in[i] = (const float*)d_in[i];
    a.out = (float*)d_out; a.ws = (unsigned char*)d_ws;
#if ONE_LAUNCH
    a.ph_lo = 0; a.ph_hi = NPHASE;
    hipLaunchKernelGGL(fwd, dim3(grid), dim3(NWAVES * 64), LDS_BYTES, stream, a);
#else
    for (int p = 0; p < NPHASE; ++p) { a.ph_lo = p; a.ph_hi = p + 1; hipLaunchKernelGGL(fwd, dim3(grid), dim3(NWAVES * 64), LDS_BYTES, stream, a); }
#endif
    const hipError_t le = hipPeekAtLastError();
    if (le != hipSuccess) fprintf(stderr, "kernel_launch: launch failed: %s\n", hipGetErrorName(le));
}
```

```cpp
#include <hip/hip_runtime.h>
#include <cstdio>
#include <cstdint>

#ifndef ONE_LAUNCH
#define ONE_LAUNCH 1
#endif

constexpr int DM = 2048, NTOK = 49152, NPROMPT = 16384, SEQ_P = 8192, SEQ_S = 4096, DEPTH = 4;
constexpr int PROJ = 3840, MIXW = 2048, XW = 512, DFF = 5632, MEMLEN = 256, MEMROWS = 2560, HD = 128;
constexpr int COL_QA = 0, COL_KA = 768, COL_VA = 1024, COL_QB = 1280, COL_KB = 1792, COL_VB = 2048, COL_QC = 2304, COL_KC = 3072, COL_VC = 3456;
constexpr float RMS_EPS = 1e-6f;
constexpr int PPL = 9;
constexpr int NPHASE = 2 + PPL * DEPTH;
constexpr int NNORM = 3 * DEPTH + 1;

constexpr size_t MiB = 1u << 20;
constexpr size_t WS_CTL = 0;
constexpr size_t WS_SS = 1 * MiB;
constexpr size_t CTL_ZERO_BYTES = 6 * MiB + 512 * 1024;
static_assert(WS_SS + (size_t)(NNORM + 1) * NTOK * 8 <= CTL_ZERO_BYTES, "ss inside the memset region");
constexpr size_t WS_TAB = 6 * MiB + 512 * 1024;
constexpr size_t WS_RSM = 7 * MiB;
constexpr size_t WS_LSE = 618 * MiB;
constexpr size_t WS_WIN = 8 * MiB, WS_WOUT = 68 * MiB, WS_WCQ = 100 * MiB, WS_WCKV = 108 * MiB, WS_WCO = 124 * MiB, WS_WFI = 132 * MiB, WS_WFO = 308 * MiB;
constexpr size_t WS_XB = 396 * MiB;
constexpr size_t WS_MB = 588 * MiB;
constexpr size_t WS_KVX = 598 * MiB;
constexpr size_t WS_QKV = 620 * MiB;
constexpr size_t WS_MIX = 980 * MiB;
constexpr size_t WS_HID = 620 * MiB;
constexpr size_t WS_QX = 620 * MiB, WS_OX = 668 * MiB;
constexpr size_t WS_END = 1172 * MiB;
constexpr int CW_BAR = 4096;
constexpr int CW_XRANK = 12288;
constexpr int CW_QUEUE = 16384;

#define GAS __attribute__((address_space(1)))
#define LAS __attribute__((address_space(3)))
typedef unsigned short bf16_t;
typedef short bf16x8 __attribute__((ext_vector_type(8)));
typedef short s16x4 __attribute__((ext_vector_type(4)));
typedef float f32x4 __attribute__((ext_vector_type(4)));
typedef float f32x16 __attribute__((ext_vector_type(16)));
typedef unsigned u32x4 __attribute__((ext_vector_type(4)));
typedef unsigned u32x2 __attribute__((ext_vector_type(2)));
typedef GAS unsigned gu32;

__device__ __forceinline__ int opaque_tid() { int t = threadIdx.x; asm volatile("" : "+v"(t)); return t; }
__device__ __forceinline__ unsigned cvt_pk_bf16(float lo, float hi) { unsigned r; asm volatile("v_cvt_pk_bf16_f32 %0, %1, %2" : "=v"(r) : "v"(lo), "v"(hi)); return r; }
__device__ __forceinline__ float bf2f(unsigned short b) { return __builtin_bit_cast(float, (unsigned)b << 16); }
__device__ __forceinline__ float bflo(unsigned w) { return __builtin_bit_cast(float, w << 16); }
__device__ __forceinline__ float bfhi(unsigned w) { return __builtin_bit_cast(float, w & 0xffff0000u); }

namespace pg8 {
#define PG8_LAS __attribute__((address_space(3)))
constexpr int BM = 256, BK = 64, HALF = 128, HTB = HALF * BK * 2, STAGE_BYTES = 8 * HTB, NXCD = 8, WGM = 4;
__host__ __device__ __forceinline__ int lds_byte(int r, int c) { const int st = (r >> 4) * 2 + (c >> 5), rr = r & 15, cc = c & 31, ob = rr * 64 + cc * 2; return st * 1024 + (ob ^ (((ob >> 9) & 1) << 5)); }
__host__ __device__ __forceinline__ void stage_rc(int b, int& R, int& C) { const int st = b / 1024, sb = b % 1024, swz = sb ^ (((sb >> 9) & 1) << 5); R = (st >> 1) * 16 + swz / 64; C = (st & 1) * 32 + (swz % 64) / 2; }
__host__ __device__ __forceinline__ int perm32(int rho) { const int n = rho >> 4, i = rho & 15; return 8 * (i >> 2) + 4 * n + (i & 3); }

struct Unit { int pm, pn; };
struct Gemm { const bf16_t* A; const bf16_t* Bt; int M, N, K; };

struct StaticOrder {
    int nM, nN, nwg, G, c, i_lo, i_hi, wgm = WGM;
    __host__ __device__ void init(int M, int N, int G_, int c_, int lo_ = 0, int hi_ = 1 << 30) { nM = M / BM; nN = N / BM; nwg = nM * nN; G = G_; c = c_; i_lo = lo_; i_hi = hi_; }
    __host__ __device__ bool next(int i, Unit& u) const {
        i += i_lo; if (i >= i_hi) return false;
        const long L = (long)i * G + c; if (L >= nwg) return false;
        int wgid = (int)L; { const int q = nwg / NXCD, r = nwg % NXCD, xcd = wgid % NXCD, off = wgid / NXCD; wgid = (xcd < r ? xcd * (q + 1) : r * (q + 1) + (xcd - r) * q) + off; }
        const int nig = wgm * nN, gid = wgid / nig, fm = gid * wgm, gsz = (nM - fm) < wgm ? (nM - fm) : wgm;
        u.pm = fm + ((wgid % nig) % gsz); u.pn = (wgid % nig) / gsz; return true;
    }
    __device__ __forceinline__ void a_ready(const Unit&) const {}
    __device__ __forceinline__ void done(const Unit&) const {}
};

typedef unsigned long long ss_t;
constexpr float SS_SCALE = 16777216.0f, SS_INV_MEAN = 1.0f / (16777216.0f * 2048.0f);
struct PreSS { ss_t v[2][4]; };
struct PreNone {};
__device__ __forceinline__ void ss_prefetch(PreSS& p, const ss_t* ss, int row0) {
#pragma unroll
    for (int ai = 0; ai < 2; ++ai)
#pragma unroll
        for (int m = 0; m < 4; ++m) p.v[ai][m] = ss[row0 + ai * HALF + m * 16];
}
__device__ __forceinline__ void row_rstd(const PreSS& p, float (&rs)[2][4]) {
#pragma unroll
    for (int ai = 0; ai < 2; ++ai)
#pragma unroll
        for (int m = 0; m < 4; ++m) {
            const ss_t v = p.v[ai][m]; const float f = (float)(unsigned)(v >> 32) * 4294967296.0f + (float)(unsigned)v;
            rs[ai][m] = __builtin_amdgcn_rsqf(f * SS_INV_MEAN + 1e-6f); }
}
struct EpiBf16 {
    static constexpr bool PERM = true, AFTER_DRAIN = false;
    bf16_t* O; int ldc; const ss_t* ss;
    typedef PreSS Pre;
    __device__ __forceinline__ void prefetch(Pre& p, const Unit& u, int wr, int fr) const { ss_prefetch(p, ss, u.pm * BM + wr * 64 + fr); }
    __device__ __forceinline__ void operator()(const f32x4 (&acc)[2][2][4][2], const Unit& u, int wr, int wc, int fr, int fq, const Pre& pre) const {
        const int row0 = u.pm * BM + wr * 64 + fr; const int col0 = u.pn * BM + wc * 32 + 8 * fq;
        float rs[2][4]; row_rstd(pre, rs);
#pragma unroll
        for (int ai = 0; ai < 2; ++ai)
#pragma unroll
            for (int m = 0; m < 4; ++m) { bf16_t* rowp = O + (size_t)(row0 + ai * HALF + m * 16) * ldc + col0; const float r = rs[ai][m];
#pragma unroll
                for (int bj = 0; bj < 2; ++bj) { const f32x4 v0 = acc[ai][bj][m][0] * r, v1 = acc[ai][bj][m][1] * r;
                    u32x4 w; w.x = cvt_pk_bf16(v0[0], v0[1]); w.y = cvt_pk_bf16(v0[2], v0[3]); w.z = cvt_pk_bf16(v1[0], v1[1]); w.w = cvt_pk_bf16(v1[2], v1[3]);
                    *(u32x4*)(rowp + bj * HALF) = w; } }
    }
};
struct EpiRes {
    static constexpr bool PERM = true, AFTER_DRAIN = false;
    bf16_t* xb; ss_t* ssout; float scale;
    typedef PreNone Pre;
    __device__ __forceinline__ void prefetch(Pre&, const Unit&, int, int) const {}
    __device__ __forceinline__ void operator()(const f32x4 (&acc)[2][2][4][2], const Unit& u, int wr, int wc, int fr, int fq, const Pre&) const {
        const int row0 = u.pm * BM + wr * 64 + fr; const int col0 = u.pn * BM + wc * 32 + 8 * fq;
        bf16_t* xbase = xb + (size_t)row0 * DM + col0;
#pragma unroll
        for (int ai = 0; ai < 2; ++ai) { float sq[4];
            u32x4 xv[4][2];
#pragma unroll
            for (int m = 0; m < 4; ++m)
#pragma unroll
                for (int bj = 0; bj < 2; ++bj) xv[m][bj] = *(const u32x4*)(xbase + (size_t)(ai * HALF + m * 16) * DM + bj * HALF);
#pragma unroll
            for (int m = 0; m < 4; ++m) { bf16_t* bp = xbase + (size_t)(ai * HALF + m * 16) * DM;
                float q = 0.f;
#pragma unroll
                for (int bj = 0; bj < 2; ++bj) { const u32x4 xw = xv[m][bj]; const f32x4 d0 = acc[ai][bj][m][0] * scale, d1 = acc[ai][bj][m][1] * scale;
                    u32x4 w; w.x = cvt_pk_bf16(bflo(xw.x) + d0[0], bfhi(xw.x) + d0[1]); w.y = cvt_pk_bf16(bflo(xw.y) + d0[2], bfhi(xw.y) + d0[3]);
                    w.z = cvt_pk_bf16(bflo(xw.z) + d1[0], bfhi(xw.z) + d1[1]); w.w = cvt_pk_bf16(bflo(xw.w) + d1[2], bfhi(xw.w) + d1[3]);
                    *(u32x4*)(bp + bj * HALF) = w;
                    const float e0 = bflo(w.x), e1 = bfhi(w.x), e2 = bflo(w.y), e3 = bfhi(w.y), e4 = bflo(w.z), e5 = bfhi(w.z), e6 = bflo(w.w), e7 = bfhi(w.w);
                    q += (e0 * e0 + e1 * e1) + (e2 * e2 + e3 * e3) + (e4 * e4 + e5 * e5) + (e6 * e6 + e7 * e7); }
                sq[m] = q; }
            asm volatile("" ::: "memory");
            const bool b0 = fq & 1, b1 = fq & 2;
            const float w0 = (b0 ? sq[1] : sq[0]) + __shfl_xor(b0 ? sq[0] : sq[1], 16), w1 = (b0 ? sq[3] : sq[2]) + __shfl_xor(b0 ? sq[2] : sq[3], 16);
            const float tot = (b1 ? w1 : w0) + __shfl_xor(b1 ? w0 : w1, 32);
            __hip_atomic_fetch_add(ssout + u.pm * BM + ai * HALF + wr * 64 + fq * 16 + fr, (ss_t)(tot * SS_SCALE), __ATOMIC_RELAXED, __HIP_MEMORY_SCOPE_AGENT); }
    }
};
struct EpiSwiglu {
    static constexpr bool PERM = true, AFTER_DRAIN = false;
    bf16_t* O; int ldc; const ss_t* ss;
    typedef PreSS Pre;
    __device__ __forceinline__ void prefetch(Pre& p, const Unit& u, int wr, int fr) const { ss_prefetch(p, ss, u.pm * BM + wr * 64 + fr); }
    __device__ __forceinline__ void operator()(const f32x4 (&acc)[2][2][4][2], const Unit& u, int wr, int wc, int fr, int fq, const Pre& pre) const {
        const int row0 = u.pm * BM + wr * 64 + fr; const int col0 = u.pn * HALF + wc * 32 + 8 * fq;
        float rs[2][4]; row_rstd(pre, rs);
#pragma unroll
        for (int ai = 0; ai < 2; ++ai)
#pragma unroll
            for (int m = 0; m < 4; ++m) {
                const float r = rs[ai][m], c = -1.4426950408889634f * r, r2 = r * r;
                const f32x4 g0 = acc[ai][0][m][0], g1 = acc[ai][0][m][1], u0 = acc[ai][1][m][0], u1 = acc[ai][1][m][1];
                const f32x4 t0 = g0 * c, t1 = g1 * c;
                f32x4 e0, e1;
#pragma unroll
                for (int i = 0; i < 4; ++i) { e0[i] = __builtin_amdgcn_exp2f(t0[i]); e1[i] = __builtin_amdgcn_exp2f(t1[i]); }
                const f32x4 d0 = e0 + 1.0f, d1 = e1 + 1.0f;
                f32x4 q0, q1;
#pragma unroll
                for (int i = 0; i < 4; ++i) { q0[i] = __builtin_amdgcn_rcpf(d0[i]); q1[i] = __builtin_amdgcn_rcpf(d1[i]); }
                const f32x4 h0 = (g0 * u0) * (q0 * r2), h1 = (g1 * u1) * (q1 * r2);
                u32x4 w; w.x = cvt_pk_bf16(h0[0], h0[1]); w.y = cvt_pk_bf16(h0[2], h0[3]); w.z = cvt_pk_bf16(h1[0], h1[1]); w.w = cvt_pk_bf16(h1[2], h1[3]);
                *(u32x4*)(O + (size_t)(row0 + ai * HALF + m * 16) * ldc + col0) = w; }
    }
};

template <class Epi, class Sched, bool ALIGN_EPI = false, bool SP2 = false>
__device__ __forceinline__ void gemm_phase(PG8_LAS unsigned char* lds, const Gemm g, const Sched& S, const Epi& E) {
    const int tid = opaque_tid(), wid = __builtin_amdgcn_readfirstlane(tid >> 6), lane = tid & 63, wr = wid >> 2, wc = wid & 3, fr = lane & 15, fq = lane >> 4;
    const int K = g.K, nt = K / BK;
    unsigned voffA[2], voffB[2];
#pragma unroll
    for (int i = 0; i < 2; ++i) { int R, C; stage_rc(tid * 16 + i * 8192, R, C); const int Rb = Epi::PERM ? ((R & ~31) + perm32(R & 31)) : R;
        voffA[i] = (unsigned)(R * K + C) * 2u; voffB[i] = (unsigned)(Rb * K + C) * 2u; }
    const size_t kstep = (size_t)(BK * 2);
    const size_t hstep = (size_t)HALF * K * 2;
    const size_t tstep = 2 * hstep;
    const unsigned ldsw = (unsigned)wid * 1024u;
    const int aoff = lds_byte(wr * 64 + fr, fq * 8), boff = lds_byte(wc * 32 + fr, fq * 8);
#define PG8_SA(b, h) (((b) * 2 + (h)) * HTB)
#define PG8_SB(b, h) ((4 + (b) * 2 + (h)) * HTB)
#define PG8_STAGE(bufoff, gbase, voff) do { _Pragma("unroll") for (int _i = 0; _i < 2; ++_i) \
        __builtin_amdgcn_global_load_lds((const unsigned*)((const char*)(gbase) + (voff)[_i]), (PG8_LAS unsigned*)(lds + (bufoff) + ldsw + _i * 8192), 16, 0, 0); } while (0)
#define PG8_LDA(dst, b, h) do { _Pragma("unroll") for (int m = 0; m < 4; ++m) _Pragma("unroll") for (int k = 0; k < 2; ++k) dst[m][k] = *(const PG8_LAS bf16x8*)(lds + PG8_SA(b, h) + aoff + m * 2048 + k * 1024); } while (0)
#define PG8_LDB(dst, b, h) do { _Pragma("unroll") for (int n = 0; n < 2; ++n) _Pragma("unroll") for (int k = 0; k < 2; ++k) dst[n][k] = *(const PG8_LAS bf16x8*)(lds + PG8_SB(b, h) + boff + n * 2048 + k * 1024); } while (0)
#define PG8_MMA(ai, bj, At, Bt) do { __builtin_amdgcn_s_setprio(1); _Pragma("unroll") for (int m = 0; m < 4; ++m) _Pragma("unroll") for (int n = 0; n < 2; ++n) _Pragma("unroll") for (int k = 0; k < 2; ++k) \
        acc[ai][bj][m][n] = __builtin_amdgcn_mfma_f32_16x16x32_bf16(Bt[n][k], At[m][k], acc[ai][bj][m][n], 0, 0, 0); __builtin_amdgcn_s_setprio(0); } while (0)
#define PG8_WAIT_V(n) asm volatile("s_waitcnt vmcnt(" #n ")" ::: "memory")
#define PG8_WAIT_L(n) asm volatile("s_waitcnt lgkmcnt(" #n ")" ::: "memory")
#define PG8_BAR __builtin_amdgcn_s_barrier()
#define PG8_SCHED __builtin_amdgcn_sched_barrier(0)
    Unit cur, nxt; int ui = 0;
    if (!S.next(0, cur)) return;
    f32x4 acc[2][2][4][2];
#pragma unroll
    for (int a = 0; a < 2; ++a)
#pragma unroll
        for (int b = 0; b < 2; ++b)
#pragma unroll
            for (int m = 0; m < 4; ++m)
#pragma unroll
                for (int n = 0; n < 2; ++n) acc[a][b][m][n] = (f32x4){0.f, 0.f, 0.f, 0.f};
    bf16x8 At[4][2], B0[2][2], B1[2][2];
    typename Epi::Pre pre;
    const char* cA = (const char*)g.A + (size_t)cur.pm * tstep; const char* cB = (const char*)g.Bt + (size_t)cur.pn * tstep;
    S.a_ready(cur);
    if constexpr (SP2) {
        PG8_STAGE(PG8_SB(0, 0), cB, voffB); PG8_STAGE(PG8_SB(0, 1), cB + hstep, voffB); PG8_STAGE(PG8_SA(0, 0), cA, voffA); PG8_STAGE(PG8_SA(0, 1), cA + hstep, voffA);
        if (wr == 1) PG8_BAR;
        PG8_WAIT_V(2); PG8_BAR;
        PG8_STAGE(PG8_SB(1, 0), cB + kstep, voffB); PG8_STAGE(PG8_SA(1, 0), cA + kstep, voffA); PG8_STAGE(PG8_SB(1, 1), cB + hstep + kstep, voffB);
        PG8_WAIT_V(6); PG8_BAR;
    } else {
        PG8_STAGE(PG8_SB(0, 0), cB, voffB); PG8_STAGE(PG8_SA(0, 0), cA, voffA); PG8_STAGE(PG8_SB(0, 1), cB + hstep, voffB); PG8_STAGE(PG8_SA(0, 1), cA + hstep, voffA);
        if (wr == 1) PG8_BAR;
        PG8_WAIT_V(4); PG8_BAR;
        PG8_STAGE(PG8_SB(1, 0), cB + kstep, voffB); PG8_STAGE(PG8_SA(1, 0), cA + kstep, voffA); PG8_STAGE(PG8_SB(1, 1), cB + hstep + kstep, voffB);
        PG8_WAIT_V(6); PG8_BAR;
    }
    for (;;) {
        const bool has_next = S.next(ui + 1, nxt);
        const char* nA = has_next ? (const char*)g.A + (size_t)nxt.pm * tstep : cA; const char* nB = has_next ? (const char*)g.Bt + (size_t)nxt.pn * tstep : cB;
        for (int t = 0; t < nt; t += 2) {
            const bool last = (t == nt - 2);
            const char* a1 = cA + (size_t)(t + 1) * kstep;
            const char* a2 = last ? nA : cA + (size_t)(t + 2) * kstep; const char* b2 = last ? nB : cB + (size_t)(t + 2) * kstep;
            const char* a3 = a2 + kstep; const char* b3 = b2 + kstep;
            if (last && has_next) S.a_ready(nxt);
            if (last) E.prefetch(pre, cur, wr, fr);
            if constexpr (SP2) {
            PG8_LDB(B0, 0, 0); PG8_LDB(B1, 0, 1); PG8_SCHED; PG8_LDA(At, 0, 0); PG8_STAGE(PG8_SA(1, 1), a1 + hstep, voffA);
            PG8_WAIT_V(8); PG8_WAIT_L(0); PG8_BAR; PG8_MMA(0, 0, At, B0); PG8_MMA(0, 1, At, B1); PG8_BAR; PG8_SCHED;
            PG8_LDA(At, 0, 1); PG8_STAGE(PG8_SB(0, 0), b2, voffB); PG8_STAGE(PG8_SB(0, 1), b2 + hstep, voffB); PG8_STAGE(PG8_SA(0, 0), a2, voffA);
            PG8_WAIT_V(8); PG8_WAIT_L(0); PG8_BAR; PG8_MMA(1, 0, At, B0); PG8_MMA(1, 1, At, B1); PG8_BAR; PG8_SCHED;
            PG8_LDB(B0, 1, 0); PG8_LDB(B1, 1, 1); PG8_SCHED; PG8_LDA(At, 1, 0); PG8_STAGE(PG8_SA(0, 1), a2 + hstep, voffA);
            PG8_WAIT_V(8); PG8_WAIT_L(0); PG8_BAR; PG8_MMA(0, 0, At, B0); PG8_MMA(0, 1, At, B1); PG8_BAR; PG8_SCHED;
            PG8_LDA(At, 1, 1); PG8_STAGE(PG8_SB(1, 0), b3, voffB); PG8_STAGE(PG8_SB(1, 1), b3 + hstep, voffB); PG8_STAGE(PG8_SA(1, 0), a3, voffA);
            PG8_WAIT_V(8); PG8_WAIT_L(0); PG8_BAR; PG8_MMA(1, 0, At, B0); PG8_MMA(1, 1, At, B1); PG8_BAR; PG8_SCHED;
            } else {
            PG8_LDB(B0, 0, 0); PG8_SCHED; PG8_LDA(At, 0, 0); PG8_STAGE(PG8_SA(1, 1), a1 + hstep, voffA);
            PG8_WAIT_L(8); PG8_BAR; PG8_WAIT_L(0); PG8_MMA(0, 0, At, B0); PG8_BAR; PG8_SCHED;
            PG8_LDB(B1, 0, 1); PG8_STAGE(PG8_SB(0, 0), b2, voffB);
            PG8_BAR; PG8_WAIT_L(0); PG8_MMA(0, 1, At, B1); PG8_BAR;
            PG8_LDA(At, 0, 1); PG8_STAGE(PG8_SA(0, 0), a2, voffA);
            PG8_BAR; PG8_WAIT_L(0); PG8_MMA(1, 0, At, B0); PG8_BAR; PG8_SCHED;
            PG8_STAGE(PG8_SB(0, 1), b2 + hstep, voffB);
            PG8_WAIT_V(6); PG8_BAR; PG8_MMA(1, 1, At, B1); PG8_BAR;
            PG8_LDB(B0, 1, 0); PG8_SCHED; PG8_LDA(At, 1, 0); PG8_STAGE(PG8_SA(0, 1), a2 + hstep, voffA);
            PG8_WAIT_L(8); PG8_BAR; PG8_WAIT_L(0); PG8_MMA(0, 0, At, B0); PG8_BAR; PG8_SCHED;
            PG8_LDB(B1, 1, 1); PG8_STAGE(PG8_SB(1, 0), b3, voffB);
            PG8_BAR; PG8_WAIT_L(0); PG8_MMA(0, 1, At, B1); PG8_BAR;
            PG8_LDA(At, 1, 1); PG8_STAGE(PG8_SA(1, 0), a3, voffA);
            PG8_BAR; PG8_WAIT_L(0); PG8_MMA(1, 0, At, B0); PG8_BAR; PG8_SCHED;
            PG8_STAGE(PG8_SB(1, 1), b3 + hstep, voffB);
            PG8_WAIT_V(6); PG8_BAR; PG8_MMA(1, 1, At, B1); PG8_BAR;
            }
        }
        if constexpr (ALIGN_EPI) { if (wr == 0) PG8_BAR; }
        if constexpr (!Epi::AFTER_DRAIN) { E(acc, cur, wr, wc, fr, fq, pre); S.done(cur); }
        if (!has_next) break;
#pragma unroll
        for (int a = 0; a < 2; ++a)
#pragma unroll
            for (int b = 0; b < 2; ++b)
#pragma unroll
                for (int m = 0; m < 4; ++m)
#pragma unroll
                    for (int n = 0; n < 2; ++n) acc[a][b][m][n] = (f32x4){0.f, 0.f, 0.f, 0.f};
        cur = nxt; cA = nA; cB = nB; ++ui;
        if constexpr (ALIGN_EPI) { if (wr == 1) PG8_BAR; }
    }
    PG8_WAIT_V(0);
    if constexpr (!ALIGN_EPI) { if (wr == 0) PG8_BAR; }
    PG8_BAR;
#undef PG8_SA
#undef PG8_SB
#undef PG8_STAGE
#undef PG8_LDA
#undef PG8_LDB
#undef PG8_MMA
#undef PG8_WAIT_V
#undef PG8_WAIT_L
#undef PG8_BAR
#undef PG8_SCHED
}
}

namespace att {
constexpr int D = 128, NW = 8, QBLK = 32, KVBLK = 64;
constexpr float SCALE = 0.088388347648318440f, LOG2E = 1.4426950408889634f, LN2 = 0.6931471805599453f;
constexpr float C = SCALE * LOG2E;
constexpr float THR2 = 8.f * LOG2E;
constexpr int SHM_V = KVBLK * D * 2, SHM_K = KVBLK * D * 2;
constexpr int OFF_V = 0, OFF_K = 2 * SHM_V, BUF3 = SHM_V + SHM_K  , OFF_WS = 3 * BUF3, OFF_TAB = OFF_WS + NW * 64 * 4, TAB_FLOATS = 1024, OFF_UID = OFF_TAB + TAB_FLOATS * 4, LDS_BYTES = OFF_UID + 64;
#define KSWZ(row, colB) ((row) * 256 + ((colB) ^ (((row) & 7) << 4)))
#define SBAR() __builtin_amdgcn_sched_barrier(0)
__device__ __forceinline__ int crow(int r, int hi) { return (r & 3) + 8 * (r >> 2) + 4 * hi; }
__device__ __forceinline__ void qkt(f32x16& p0, f32x16& p1, const char* Ks, const bf16x8* qr, int r32, int hi) {
  p0 = f32x16{}; p1 = f32x16{};
#pragma unroll
  for (int d0 = 0; d0 < 8; ++d0) { const int cb = (d0 * 16 + hi * 8) * 2;
    const bf16x8 b0 = *reinterpret_cast<const bf16x8*>(Ks + KSWZ(r32, cb));
    const bf16x8 b1 = *reinterpret_cast<const bf16x8*>(Ks + KSWZ(32 + r32, cb));
    p0 = __builtin_amdgcn_mfma_f32_32x32x16_bf16(b0, qr[d0], p0, 0, 0, 0);
    p1 = __builtin_amdgcn_mfma_f32_32x32x16_bf16(b1, qr[d0], p1, 0, 0, 0); }
}
__device__ __forceinline__ int v_st(int k, int c) { const int kk = (k & ~0xC) | ((k & 4) << 1) | ((k & 8) >> 1); return ((kk >> 3) * 4 + (c >> 5)) * 512 + ((kk & 7) * 32 + (c & 31)) * 2; }
__device__ __forceinline__ int v_rd_base(int lane) { return ((lane & 3) << 3) | (((lane >> 2) & 3) << 6) | (((lane >> 4) & 1) << 5) | (((lane >> 5) & 1) << 8); }
constexpr int v_rd_off(int d0, int ks, int half) { return d0 * 512 + ks * 4096 + half * 2048; }
template <int OFF> __device__ __forceinline__ s16x4 tr_read(int vb) {
  s16x4 r; asm volatile("ds_read_b64_tr_b16 %0, %1 offset:%2" : "=&v"(r) : "v"(vb), "i"(OFF) : "memory"); return r;
}
template <int D0> __device__ __forceinline__ void pv_one(f32x16& od, int vb, bf16x8 pa0, bf16x8 pa1, bf16x8 pa2, bf16x8 pa3) {
  const s16x4 l0 = tr_read<v_rd_off(D0, 0, 0)>(vb), h0 = tr_read<v_rd_off(D0, 0, 1)>(vb), l1 = tr_read<v_rd_off(D0, 1, 0)>(vb), h1 = tr_read<v_rd_off(D0, 1, 1)>(vb);
  const s16x4 l2 = tr_read<v_rd_off(D0, 2, 0)>(vb), h2 = tr_read<v_rd_off(D0, 2, 1)>(vb), l3 = tr_read<v_rd_off(D0, 3, 0)>(vb), h3 = tr_read<v_rd_off(D0, 3, 1)>(vb);
  asm volatile("s_waitcnt lgkmcnt(0)" ::: "memory"); SBAR();
#define PK(L, H) (bf16x8){L[0], L[1], L[2], L[3], H[0], H[1], H[2], H[3]}
  od = __builtin_amdgcn_mfma_f32_32x32x16_bf16(pa0, PK(l0, h0), od, 0, 0, 0);
  od = __builtin_amdgcn_mfma_f32_32x32x16_bf16(pa1, PK(l1, h1), od, 0, 0, 0);
  od = __builtin_amdgcn_mfma_f32_32x32x16_bf16(pa2, PK(l2, h2), od, 0, 0, 0);
  od = __builtin_amdgcn_mfma_f32_32x32x16_bf16(pa3, PK(l3, h3), od, 0, 0, 0);
#undef PK
}
__device__ __forceinline__ void pv_d0(f32x16* o, int vb, bf16x8 pa0, bf16x8 pa1, bf16x8 pa2, bf16x8 pa3) {
  pv_one<0>(o[0], vb, pa0, pa1, pa2, pa3); pv_one<1>(o[1], vb, pa0, pa1, pa2, pa3); pv_one<2>(o[2], vb, pa0, pa1, pa2, pa3); pv_one<3>(o[3], vb, pa0, pa1, pa2, pa3);
}

template <bool TAB>
__device__ __forceinline__ void attn_unit(const bf16_t* __restrict__ Qb, long ldq, const bf16_t* __restrict__ Kh, const bf16_t* __restrict__ Vh, long ldk,
                                          bf16_t* __restrict__ Ob, long ldo, int t_lo, int t_hi, int qpos0, int W, const float* __restrict__ tabg, int tablen,
                                          float m_init0, float m_init1, float l_init, float* __restrict__ lse, long ldlse, char* lds) {
  const int tid = opaque_tid(), lane = tid & 63, r32 = lane & 31, hi = lane >> 5; const int wid = __builtin_amdgcn_readfirstlane(tid >> 6);
  const int hw = wid >> 2, wq = wid & 3;
  char* V_lds = lds + OFF_V; char* K_lds = lds + OFF_K;
  float* ws = (float*)(lds + OFF_WS) + wid * 64; float* li_l = ws; float* al_l = ws + 32;
  float* tab = (float*)(lds + OFF_TAB);
  bf16x8 qr[8];
  { const bf16_t* Qw = Qb + hw * D + (long)(wq * QBLK + r32) * ldq + hi * 8;
#pragma unroll
    for (int d0 = 0; d0 < 8; ++d0) qr[d0] = *reinterpret_cast<const bf16x8*>(Qw + d0 * 16); }
  if (TAB) { for (int i = tid; i < 2 * 512; i += NW * 64) tab[i] = ((i & 511) < tablen) ? tabg[i] : 0.f; }
  const int sr = tid >> 4, sc = (tid & 15) * 8, vst0 = v_st(sr, sc), vst1 = v_st(32 + sr, sc);
  const int vb0 = (int)(uintptr_t)V_lds + v_rd_base(lane);
  bf16x8 vs0, vs1, ks0, ks1;
#define SLOAD(k0) do { vs0 = *reinterpret_cast<const bf16x8*>(&Vh[(long)((k0) + sr) * ldk + sc]); vs1 = *reinterpret_cast<const bf16x8*>(&Vh[(long)((k0) + 32 + sr) * ldk + sc]); \
    ks0 = *reinterpret_cast<const bf16x8*>(&Kh[(long)((k0) + sr) * ldk + sc]); ks1 = *reinterpret_cast<const bf16x8*>(&Kh[(long)((k0) + 32 + sr) * ldk + sc]); } while (0)
#define SWRITE(b) do { *(bf16x8*)(V_lds + (b) * SHM_V + vst0) = vs0; *(bf16x8*)(V_lds + (b) * SHM_V + vst1) = vs1; const int kc = sc * 2; \
    *(bf16x8*)(K_lds + (b) * SHM_K + KSWZ(sr, kc)) = ks0; *(bf16x8*)(K_lds + (b) * SHM_K + KSWZ(32 + sr, kc)) = ks1; } while (0)
  float m_reg = hw ? m_init1 : m_init0, l_reg = l_init; f32x16 o[4] = {};
  const int qw0 = qpos0 + wq * QBLK;
  SLOAD(t_lo * KVBLK); SWRITE(0); __syncthreads();
  for (int t = t_lo; t < t_hi; ++t) {
    const int b = (t - t_lo) & 1; const bool more = (t + 1 < t_hi);
    if (more) SLOAD((t + 1) * KVBLK);
    const bool active = !TAB || (KVBLK * t + KVBLK - 1 >= qw0 - W && KVBLK * t <= qw0 + QBLK - 1 + W);
    if (active) {
      f32x16 p0, p1; qkt(p0, p1, K_lds + b * SHM_K, qr, r32, hi);
      if (TAB) { const float* tl = tab + hw * 512 + (KVBLK * t - qw0 - r32 + 4 * hi + W + 96);
#pragma unroll
        for (int r = 0; r < 16; ++r) { const int ix = (r & 3) + 8 * (r >> 2); p0[r] = fmaf(p0[r], C, tl[ix]); p1[r] = fmaf(p1[r], C, tl[ix + 32]); } }
      else {
#pragma unroll
        for (int r = 0; r < 16; ++r) { p0[r] *= C; p1[r] *= C; } }
      float pmax = p0[0];
#pragma unroll
      for (int r = 1; r < 16; ++r) pmax = fmaxf(pmax, p0[r]);
#pragma unroll
      for (int r = 0; r < 16; ++r) pmax = fmaxf(pmax, p1[r]);
      { auto rr = __builtin_amdgcn_permlane32_swap(__float_as_uint(pmax), __float_as_uint(pmax), false, false);
        pmax = fmaxf(__uint_as_float(rr[0]), __uint_as_float(rr[1])); }
      if (!__all(pmax - m_reg <= THR2)) {
        const float mn = fmaxf(m_reg, pmax); const float alpha = __builtin_amdgcn_exp2f(m_reg - mn); m_reg = mn; l_reg *= alpha;
        if (hi == 0) al_l[r32] = alpha; asm volatile("s_waitcnt lgkmcnt(0)" ::: "memory");
#pragma unroll
        for (int d = 0; d < 4; ++d)
#pragma unroll
          for (int r = 0; r < 16; ++r) o[d][r] *= al_l[crow(r, hi)];
      }
#pragma unroll
      for (int r = 0; r < 16; ++r) { p0[r] = __builtin_amdgcn_exp2f(p0[r] - m_reg); p1[r] = __builtin_amdgcn_exp2f(p1[r] - m_reg); }
      float ps = 0.f;
#pragma unroll
      for (int r = 0; r < 16; ++r) ps += p0[r];
#pragma unroll
      for (int r = 0; r < 16; ++r) ps += p1[r];
      { auto rr = __builtin_amdgcn_permlane32_swap(__float_as_uint(ps), __float_as_uint(ps), false, false);
        ps = __uint_as_float(rr[0]) + __uint_as_float(rr[1]); }
      l_reg += ps;
      bf16x8 pa0, pa1, pa2, pa3;
#define PK4(P, BASE, OUT) do { unsigned a0 = cvt_pk_bf16(P[BASE + 0], P[BASE + 1]), a1 = cvt_pk_bf16(P[BASE + 2], P[BASE + 3]);   \
    unsigned b0 = cvt_pk_bf16(P[BASE + 4], P[BASE + 5]), b1 = cvt_pk_bf16(P[BASE + 6], P[BASE + 7]);                              \
    auto r0 = __builtin_amdgcn_permlane32_swap(a0, b0, false, false); auto r1 = __builtin_amdgcn_permlane32_swap(a1, b1, false, false); \
    u32x4 w = {r0[0], r1[0], r0[1], r1[1]}; OUT = *reinterpret_cast<bf16x8*>(&w); } while (0)
      PK4(p0, 0, pa0); PK4(p0, 8, pa1); PK4(p1, 0, pa2); PK4(p1, 8, pa3);
#undef PK4
      SBAR();
      pv_d0(o, vb0 + b * SHM_V, pa0, pa1, pa2, pa3);
    }
    if (more) SWRITE(b ^ 1);
    __syncthreads();
  }
  if (hi == 0) li_l[r32] = l_reg; asm volatile("s_waitcnt lgkmcnt(0)" ::: "memory");
  float rli[16];
#pragma unroll
  for (int r = 0; r < 16; ++r) rli[r] = __builtin_amdgcn_rcpf(li_l[crow(r, hi)]);
  bf16_t* stg = (bf16_t*)(lds + wid * 8192);
#pragma unroll
  for (int r = 0; r < 16; ++r) { const int orow = crow(r, hi);
#pragma unroll
    for (int d0 = 0; d0 < 4; ++d0) { const unsigned w = cvt_pk_bf16(o[d0][r] * rli[r], 0.f); stg[orow * 128 + d0 * 32 + r32] = (bf16_t)(w & 0xffffu); } }
  asm volatile("s_waitcnt lgkmcnt(0)" ::: "memory");
#pragma unroll
  for (int i = 0; i < 8; ++i) { const int row = i * 4 + (lane >> 4), ch = lane & 15; const u32x4 v = *(const u32x4*)(stg + row * 128 + ch * 8);
    *(u32x4*)(Ob + hw * D + (long)(wq * QBLK + row) * ldo + ch * 8) = v; }
  if (lse != nullptr && hi == 0) lse[hw + (long)(wq * QBLK + r32) * ldlse] = (m_reg + __builtin_amdgcn_logf(l_reg)) * LN2;
  __syncthreads();
#undef SLOAD
#undef SWRITE
}
template <bool PRE>
__device__ __forceinline__ void partialSM(f32x16& p0, f32x16& p1, float& m_reg, float& mn, float& alpha) {
  constexpr float cs = PRE ? 1.0f : C;
  float pmax = p0[0];
#pragma unroll
  for (int r = 1; r < 16; ++r) pmax = fmaxf(pmax, p0[r]);
#pragma unroll
  for (int r = 0; r < 16; ++r) pmax = fmaxf(pmax, p1[r]);
  { auto rr = __builtin_amdgcn_permlane32_swap(__float_as_uint(pmax), __float_as_uint(pmax), false, false);
    pmax = fmaxf(__uint_as_float(rr[0]), __uint_as_float(rr[1])); }
  if (__builtin_expect(__all((pmax - m_reg) * cs <= THR2), 1)) { mn = m_reg; alpha = 1.f; }
  else { mn = fmaxf(m_reg, pmax); alpha = __builtin_amdgcn_exp2f((m_reg - mn) * cs); m_reg = mn; }
  const float mnC = -mn * cs;
#pragma unroll
  for (int r = 0; r < 16; ++r) p0[r] = fmaf(p0[r], cs, mnC);
#pragma unroll
  for (int r = 0; r < 16; ++r) p1[r] = fmaf(p1[r], cs, mnC);
#pragma unroll
  for (int r = 0; r < 16; ++r) p0[r] = __builtin_amdgcn_exp2f(p0[r]);
}
__device__ __forceinline__ void partialSM_fixed(f32x16& p0) {
#pragma unroll
  for (int r = 0; r < 16; ++r) p0[r] = __builtin_amdgcn_exp2f(p0[r]);
}
__device__ __forceinline__ void finishSM(f32x16& p0, f32x16& p1, float alpha, float& l_reg, bf16x8& pa0, bf16x8& pa1, bf16x8& pa2, bf16x8& pa3) {
#pragma unroll
  for (int r = 0; r < 16; ++r) p1[r] = __builtin_amdgcn_exp2f(p1[r]);
  float ps = 0;
#pragma unroll
  for (int r = 0; r < 16; ++r) ps += p0[r];
#pragma unroll
  for (int r = 0; r < 16; ++r) ps += p1[r];
  { auto rr = __builtin_amdgcn_permlane32_swap(__float_as_uint(ps), __float_as_uint(ps), false, false);
    ps = __uint_as_float(rr[0]) + __uint_as_float(rr[1]); }
  l_reg = l_reg * alpha + ps;
#define PK4(P, BASE, OUT) do { unsigned a0 = cvt_pk_bf16(P[BASE + 0], P[BASE + 1]), a1 = cvt_pk_bf16(P[BASE + 2], P[BASE + 3]);   \
    unsigned b0 = cvt_pk_bf16(P[BASE + 4], P[BASE + 5]), b1 = cvt_pk_bf16(P[BASE + 6], P[BASE + 7]);                              \
    auto r0 = __builtin_amdgcn_permlane32_swap(a0, b0, false, false); auto r1 = __builtin_amdgcn_permlane32_swap(a1, b1, false, false); \
    u32x4 w = {r0[0], r1[0], r0[1], r1[1]}; OUT = *reinterpret_cast<bf16x8*>(&w); } while (0)
  PK4(p0, 0, pa0); PK4(p0, 8, pa1); PK4(p1, 0, pa2); PK4(p1, 8, pa3);
#undef PK4
}
template <bool PRE>
__device__ __forceinline__ void attn_unit_dense(const bf16_t* __restrict__ Qb, long ldq, const bf16_t* __restrict__ Kh, const bf16_t* __restrict__ Vh, long ldk,
                                                bf16_t* __restrict__ Ob, long ldo, int ntile, float mfix2, char* lds) {
  const int tid = opaque_tid(), lane = tid & 63, r32 = lane & 31, hi = lane >> 5; const int wid = __builtin_amdgcn_readfirstlane(tid >> 6);
  float* ws = (float*)(lds + OFF_WS) + wid * 64; float* li_l = ws; float* al_l = ws + 32;
  const bool fixm = PRE && mfix2 >= 0.f;
  float m_reg = -1e30f, l_reg = 0; f32x16 o[4] = {}; bf16x8 qr[8];
  { const bf16_t* Qw = Qb + (long)(wid * QBLK + r32) * ldq + hi * 8;
#pragma unroll
    for (int d0 = 0; d0 < 8; ++d0) qr[d0] = *reinterpret_cast<const bf16x8*>(Qw + d0 * 16); }
  const int sr = tid >> 4, sc = (tid & 15) * 8, vst0 = v_st(sr, sc), vst1 = v_st(32 + sr, sc);
  const int vb0 = (int)(uintptr_t)lds + v_rd_base(lane);
  bf16x8 vsE0, vsE1, ksE0, ksE1, vsO0, vsO1, ksO0, ksO1;
#define SLOAD_E(k0) do { vsE0 = *reinterpret_cast<const bf16x8*>(&Vh[(long)((k0) + sr) * ldk + sc]); vsE1 = *reinterpret_cast<const bf16x8*>(&Vh[(long)((k0) + 32 + sr) * ldk + sc]); \
    ksE0 = *reinterpret_cast<const bf16x8*>(&Kh[(long)((k0) + sr) * ldk + sc]); ksE1 = *reinterpret_cast<const bf16x8*>(&Kh[(long)((k0) + 32 + sr) * ldk + sc]); } while (0)
#define SLOAD_O(k0) do { vsO0 = *reinterpret_cast<const bf16x8*>(&Vh[(long)((k0) + sr) * ldk + sc]); vsO1 = *reinterpret_cast<const bf16x8*>(&Vh[(long)((k0) + 32 + sr) * ldk + sc]); \
    ksO0 = *reinterpret_cast<const bf16x8*>(&Kh[(long)((k0) + sr) * ldk + sc]); ksO1 = *reinterpret_cast<const bf16x8*>(&Kh[(long)((k0) + 32 + sr) * ldk + sc]); } while (0)
#define SWRITE_E(bo) do { char* B_ = lds + (bo); *(bf16x8*)(B_ + vst0) = vsE0; *(bf16x8*)(B_ + vst1) = vsE1; const int kc = sc * 2; \
    *(bf16x8*)(B_ + SHM_V + KSWZ(sr, kc)) = ksE0; *(bf16x8*)(B_ + SHM_V + KSWZ(32 + sr, kc)) = ksE1; } while (0)
#define SWRITE_O(bo) do { char* B_ = lds + (bo); *(bf16x8*)(B_ + vst0) = vsO0; *(bf16x8*)(B_ + vst1) = vsO1; const int kc = sc * 2; \
    *(bf16x8*)(B_ + SHM_V + KSWZ(sr, kc)) = ksO0; *(bf16x8*)(B_ + SHM_V + KSWZ(32 + sr, kc)) = ksO1; } while (0)
#define SWAIT() asm volatile("s_waitcnt vmcnt(4)" ::: "memory")
#define PSM(P0, P1, MN, AL) do { if (fixm) { partialSM_fixed(P0); AL = 1.f; MN = 0.f; } else partialSM<PRE>(P0, P1, m_reg, MN, AL); } while (0)
#define RESC(a) do { if (!fixm) if (__any((a) < 1.f)) { if (hi == 0) al_l[r32] = (a); asm volatile("s_waitcnt lgkmcnt(0)" ::: "memory"); \
    _Pragma("unroll") for (int d = 0; d < 4; ++d) _Pragma("unroll") for (int r = 0; r < 16; ++r) o[d][r] *= al_l[crow(r, hi)]; } } while (0)
#define ROT3() do { const int t_ = bV; bV = bK; bK = bW; bW = t_; } while (0)
  f32x16 pA0, pA1, pB0, pB1; float mnA, mnB, alA, alB; bf16x8 pa0, pa1, pa2, pa3; const int NT = ntile;
  int bV = 0, bK = 0, bW = BUF3;
  SLOAD_E(0); SLOAD_O(KVBLK); asm volatile("s_waitcnt vmcnt(4)" ::: "memory"); SWRITE_E(0); SLOAD_E(2 * KVBLK);
  __syncthreads();
  SWAIT(); SWRITE_O(bW);
  qkt(pA0, pA1, lds + bK + SHM_V, qr, r32, hi); PSM(pA0, pA1, mnA, alA);
  if (3 < NT) SLOAD_O(3 * KVBLK);
  bV = 0; bK = BUF3; bW = 2 * BUF3;
  for (int j = 1; j + 1 < NT; j += 2) {
    __syncthreads(); SWAIT(); SWRITE_E(bW);
    SBAR(); qkt(pB0, pB1, lds + bK + SHM_V, qr, r32, hi);
    finishSM(pA0, pA1, alA, l_reg, pa0, pa1, pa2, pa3); SBAR();
    if (j + 3 < NT) SLOAD_E((j + 3) * KVBLK); SBAR();
    pv_d0(o, vb0 + bV, pa0, pa1, pa2, pa3); PSM(pB0, pB1, mnB, alB);
    RESC(alB); ROT3();
    __syncthreads(); SWAIT(); SWRITE_O(bW);
    SBAR(); qkt(pA0, pA1, lds + bK + SHM_V, qr, r32, hi);
    finishSM(pB0, pB1, alB, l_reg, pa0, pa1, pa2, pa3); SBAR();
    if (j + 4 < NT) SLOAD_O((j + 4) * KVBLK); SBAR();
    pv_d0(o, vb0 + bV, pa0, pa1, pa2, pa3); PSM(pA0, pA1, mnA, alA);
    RESC(alA); ROT3();
  }
  __syncthreads();
  SBAR(); qkt(pB0, pB1, lds + bK + SHM_V, qr, r32, hi);
  finishSM(pA0, pA1, alA, l_reg, pa0, pa1, pa2, pa3); SBAR();
  pv_d0(o, vb0 + bV, pa0, pa1, pa2, pa3); PSM(pB0, pB1, mnB, alB);
  RESC(alB); ROT3();
  finishSM(pB0, pB1, alB, l_reg, pa0, pa1, pa2, pa3); SBAR();
  pv_d0(o, vb0 + bV, pa0, pa1, pa2, pa3);
#undef ROT3
  if (hi == 0) li_l[r32] = l_reg; asm volatile("s_waitcnt lgkmcnt(0)" ::: "memory");
  float rli[16];
#pragma unroll
  for (int r = 0; r < 16; ++r) rli[r] = __builtin_amdgcn_rcpf(li_l[crow(r, hi)]);
  __syncthreads();
  bf16_t* stg = (bf16_t*)(lds + wid * 8192);
#pragma unroll
  for (int r = 0; r < 16; ++r) { const int orow = crow(r, hi);
#pragma unroll
    for (int d0 = 0; d0 < 4; ++d0) { const unsigned w = cvt_pk_bf16(o[d0][r] * rli[r], 0.f); stg[orow * 128 + d0 * 32 + r32] = (bf16_t)(w & 0xffffu); } }
  asm volatile("s_waitcnt lgkmcnt(0)" ::: "memory");
#pragma unroll
  for (int i = 0; i < 8; ++i) { const int row = i * 4 + (lane >> 4), ch = lane & 15; const u32x4 v = *(const u32x4*)(stg + row * 128 + ch * 8);
    *(u32x4*)(Ob + (long)(wid * QBLK + row) * ldo + ch * 8) = v; }
  __syncthreads();
#undef PSM
#undef SLOAD_E
#undef SLOAD_O
#undef SWRITE_E
#undef SWRITE_O
#undef SWAIT
#undef RESC
}
#undef SBAR
}

#define XB_TMO      128
#define XB_XCNT(j)  (256  + 64 * (j))
#define XB_XSUB(j)  (1280 + 64 * (j))
#define XB_XGEN(j)  (2304 + 64 * (j))
#define XB_TOP      3328
#define XB_TOPGEN   3392
#define XCD_BAR_WORDS 3456
#define XB_SPIN_CAP (1u << 18)
__device__ __forceinline__ unsigned xb_ld(unsigned* p)              { return __hip_atomic_load(p, __ATOMIC_RELAXED, __HIP_MEMORY_SCOPE_AGENT); }
__device__ __forceinline__ unsigned xb_add(unsigned* p, unsigned v) { return __hip_atomic_fetch_add(p, v, __ATOMIC_RELAXED, __HIP_MEMORY_SCOPE_AGENT); }
__device__ __forceinline__ unsigned xb_xcc_id() { return (unsigned)__builtin_amdgcn_s_getreg((3 << 11) | 20) & 0xFu; }
#define XB_SPIN(cond, bar) do { unsigned _sp = 0; while (cond) { __builtin_amdgcn_s_sleep(1); \
    if ((++_sp & 255u) == 0u) { if (xb_ld(&(bar)[XB_TMO])) break; if (_sp > XB_SPIN_CAP) { atomicAdd(&(bar)[XB_TMO], 1u); break; } } } } while (0)
struct XcdBarrier { unsigned* bar; unsigned x; volatile LAS unsigned* st; };
__device__ __forceinline__ XcdBarrier xcd_barrier_post(unsigned* bar, volatile LAS unsigned* st) {
    XcdBarrier b; b.bar = bar; b.x = xb_xcc_id(); b.st = st;
    if (threadIdx.x == 0) (void)xb_add(&bar[XB_XCNT(b.x)], 1u);
    return b;
}
__device__ __forceinline__ void xcd_barrier_complete(unsigned* bar, unsigned x, unsigned& nloc, unsigned& nx) {
    const unsigned G = gridDim.x * gridDim.y * gridDim.z;
    unsigned sum, cnt, mine, sp = 0u;
    for (;;) {
        sum = 0u; cnt = 0u; mine = 0u;
#pragma unroll
        for (unsigned j = 0; j < 16; ++j) { const unsigned c = xb_ld(&bar[XB_XCNT(j)]); sum += c; cnt += (c > 0u) ? 1u : 0u; mine = (j == x) ? c : mine; }
        if (sum == G) break;
        __builtin_amdgcn_s_sleep(1);
        if ((++sp & 255u) == 0u) { if (xb_ld(&bar[XB_TMO])) break; if (sp > XB_SPIN_CAP) { atomicAdd(&bar[XB_TMO], 1u); break; } }
    }
    nloc = mine > 0u ? mine : 1u; nx = cnt > 0u ? cnt : 1u;
}
__device__ __forceinline__ void xcd_barrier(const XcdBarrier& b) {
    asm volatile("s_waitcnt vmcnt(0)" ::: "memory");
    __syncthreads();
    if (threadIdx.x == 0) {
        unsigned* bar = b.bar;
        __builtin_amdgcn_s_waitcnt(0);
        unsigned nloc = b.st[0], nx = b.st[1];
        if (nloc == 0u) { xcd_barrier_complete(bar, b.x, nloc, nx); b.st[0] = nloc; b.st[1] = nx; }
        const unsigned old = xb_add(&bar[XB_XSUB(b.x)], 1u);
        const unsigned gen = old / nloc;
        if (old + 1u == (gen + 1u) * nloc) {
            __builtin_amdgcn_fence(__ATOMIC_RELEASE, "agent");
            asm volatile("s_waitcnt vmcnt(0)" ::: "memory");
            const unsigned og = xb_add(&bar[XB_TOP], 1u);
            const unsigned tg = og / nx;
            if (og + 1u == (tg + 1u) * nx) xb_add(&bar[XB_TOPGEN], 1u);
            else XB_SPIN(xb_ld(&bar[XB_TOPGEN]) == tg, bar);
            __builtin_amdgcn_fence(__ATOMIC_ACQUIRE, "agent");
            xb_add(&bar[XB_XGEN(b.x)], 1u);
            asm volatile("s_waitcnt vmcnt(0)" ::: "memory");
        } else {
            XB_SPIN(xb_ld(&bar[XB_XGEN(b.x)]) == gen, bar);
            __builtin_amdgcn_fence(__ATOMIC_ACQUIRE, "agent");
            asm volatile("s_waitcnt vmcnt(0)" ::: "memory");
        }
    }
    __syncthreads();
}

constexpr int NWAVES = 8;
constexpr int RING_BYTES = 131072, LDSCTL_OFF = RING_BYTES, MISC_OFF = LDSCTL_OFF + 320, LDS_BYTES = 147456;
static_assert(att::LDS_BYTES <= RING_BYTES, "attention scratch inside the ring region");

struct Args {
    const float* in[20]; float* out; unsigned char* ws; int ph_lo, ph_hi;
};

__device__ __forceinline__ float wave_sum(float v) {
#pragma unroll
    for (int o = 1; o < 64; o <<= 1) v += __shfl_xor(v, o);
    return v;
}
__device__ __forceinline__ unsigned f2bf(float f) { unsigned u = __builtin_bit_cast(unsigned, f); return (u + 0x7fffu + ((u >> 16) & 1u)) >> 16; }
__device__ __forceinline__ unsigned pk2(float lo, float hi) { return f2bf(lo) | (f2bf(hi) << 16); }

__device__ __forceinline__ void transpose_item(const float* W, const float* gain, int K, int N, bf16_t* WT, int k0, int n0, int drow0, LAS float* scr, int lane) {
    const int kr = lane >> 3, nq = lane & 7;
    f32x4 v[8]; float gk[8];
#pragma unroll
    for (int i = 0; i < 8; ++i) { v[i] = *(const GAS f32x4*)(W + (size_t)(k0 + kr + 8 * i) * N + n0 + 4 * nq); gk[i] = gain ? gain[k0 + kr + 8 * i] : 1.0f; }
#pragma unroll
    for (int i = 0; i < 8; ++i) { LAS float* d = scr + (kr + 8 * i) * 33 + 4 * nq; d[0] = v[i].x * gk[i]; d[1] = v[i].y * gk[i]; d[2] = v[i].z * gk[i]; d[3] = v[i].w * gk[i]; }
    asm volatile("s_waitcnt lgkmcnt(0)" ::: "memory");
    const int c = lane & 7;
#pragma unroll
    for (int j = 0; j < 4; ++j) { const int n = (lane >> 3) + 8 * j; const LAS float* s = scr + (8 * c) * 33 + n;
        u32x4 o; o.x = pk2(s[0 * 33], s[1 * 33]); o.y = pk2(s[2 * 33], s[3 * 33]); o.z = pk2(s[4 * 33], s[5 * 33]); o.w = pk2(s[6 * 33], s[7 * 33]);
        *(GAS u32x4*)(WT + (size_t)(drow0 + n) * K + k0 + 8 * c) = o; }
    asm volatile("s_waitcnt lgkmcnt(0)" ::: "memory");
}

__device__ __forceinline__ int t5_bucket(int rel) {
    const int n = rel < 0 ? -rel : rel; int b;
    if (n < 8) b = n; else { b = 8 + (n >= 15) + (n >= 27) + (n >= 50) + (n >= 91) + (n >= 166) + (n >= 305) + (n >= 559); if (b > 15) b = 15; }
    return b + (rel > 0 ? 16 : 0);
}
__device__ __forceinline__ void sincos_d(double a, double& s, double& c) {
    const double k = __builtin_rint(a * 0.63661977236758134308);
    const double r = (a - k * 1.57079632679489655800) - k * 6.12323399573676603587e-17;
    const double r2 = r * r;
    double ps = 1.0 / 6227020800.0;
    ps = ps * r2 - 1.0 / 39916800.0; ps = ps * r2 + 1.0 / 362880.0; ps = ps * r2 - 1.0 / 5040.0; ps = ps * r2 + 1.0 / 120.0; ps = ps * r2 - 1.0 / 6.0; ps = ps * r2 + 1.0;
    const double sr = r * ps;
    double pc = -1.0 / 87178291200.0;
    pc = pc * r2 + 1.0 / 479001600.0; pc = pc * r2 - 1.0 / 3628800.0; pc = pc * r2 + 1.0 / 40320.0; pc = pc * r2 - 1.0 / 720.0; pc = pc * r2 + 1.0 / 24.0; pc = pc * r2 - 0.5; pc = pc * r2 + 1.0;
    const int q = ((int)k) & 3;
    s = (q == 0) ? sr : (q == 1) ? pc : (q == 2) ? -sr : -pc;
    c = (q == 0) ? pc : (q == 1) ? -sr : (q == 2) ? -pc : sr;
}

__device__ __forceinline__ float row_to_bf16(const float* xrow, bf16_t* orow, int lane) {
    const GAS f32x4* xr = (const GAS f32x4*)xrow + lane;
    f32x4 v[8]; float s = 0.f;
#pragma unroll
    for (int j = 0; j < 8; ++j) { v[j] = xr[64 * j]; s += (v[j].x * v[j].x + v[j].y * v[j].y) + (v[j].z * v[j].z + v[j].w * v[j].w); }
    GAS u32x2* o8 = (GAS u32x2*)orow + lane;
#pragma unroll
    for (int j = 0; j < 8; ++j) { u32x2 w; w.x = cvt_pk_bf16(v[j].x, v[j].y); w.y = cvt_pk_bf16(v[j].z, v[j].w); o8[64 * j] = w; }
    return wave_sum(s);
}
__device__ __forceinline__ void rms_row_out(const bf16_t* xrow, float* orow, const float* g, float rstd, int lane) {
    const GAS u32x2* xr = (const GAS u32x2*)xrow + lane; GAS f32x4* o = (GAS f32x4*)orow + lane; const GAS f32x4* gr = (const GAS f32x4*)g + lane;
#pragma unroll
    for (int j = 0; j < 8; ++j) { const u32x2 w = xr[64 * j]; const f32x4 gg = gr[64 * j]; f32x4 v = {bflo(w.x), bfhi(w.x), bflo(w.y), bfhi(w.y)}; o[64 * j] = v * rstd * gg; }
}

__device__ __forceinline__ void qknorm_rows(bf16_t* qkv, const float* ropec, const float* ropes, const float* qg, const float* kg, int row_base, int tid) {
    const int lane = tid & 63, wave = tid >> 6;
    const int head = lane >> 3, q8 = lane & 7, hf = q8 >> 2, a = q8 & 3;
    const float* gp = (head < 6) ? qg : kg;
    const float osc = (head < 6) ? 0.088388347648318440f * 1.4426950408889634f : 1.0f;
    float g1[8], g2[8];
#pragma unroll
    for (int e = 0; e < 8; ++e) { g1[e] = gp[hf * 64 + 8 * a + e]; g2[e] = gp[hf * 64 + 32 + 8 * a + e]; }
    for (int t0 = 0; t0 < 32; t0 += 4) {
        u32x4 w1[4], w2[4]; f32x4 cs[4][4];
#pragma unroll
        for (int i = 0; i < 4; ++i) { const int m = row_base + wave + 8 * (t0 + i);
            const int s = (m < NPROMPT) ? (m & (SEQ_P - 1)) : ((m - NPROMPT) & (SEQ_S - 1)); const int n = hf ? (s & 63) : (s >> 6);
            const bf16_t* p1 = qkv + (size_t)m * PROJ + head * HD + hf * 64 + 8 * a;
            w1[i] = *(const GAS u32x4*)p1; w2[i] = *(const GAS u32x4*)(p1 + 32);
            cs[i][0] = *(const GAS f32x4*)(ropec + n * 32 + 8 * a); cs[i][1] = *(const GAS f32x4*)(ropec + n * 32 + 8 * a + 4);
            cs[i][2] = *(const GAS f32x4*)(ropes + n * 32 + 8 * a); cs[i][3] = *(const GAS f32x4*)(ropes + n * 32 + 8 * a + 4); }
#pragma unroll
        for (int i = 0; i < 4; ++i) { const int m = row_base + wave + 8 * (t0 + i);
            bf16_t* p1 = qkv + (size_t)m * PROJ + head * HD + hf * 64 + 8 * a;
            float x1[8], x2[8];
#pragma unroll
            for (int e = 0; e < 4; ++e) { x1[2 * e] = bflo(w1[i][e]); x1[2 * e + 1] = bfhi(w1[i][e]); x2[2 * e] = bflo(w2[i][e]); x2[2 * e + 1] = bfhi(w2[i][e]); }
            float ss = 0.f;
#pragma unroll
            for (int e = 0; e < 8; ++e) ss += x1[e] * x1[e] + x2[e] * x2[e];
            ss += __shfl_xor(ss, 1); ss += __shfl_xor(ss, 2); ss += __shfl_xor(ss, 4);
            const float rstd = 1.0f / sqrtf(ss * (1.f / HD) + RMS_EPS);
            float o1[8], o2[8];
#pragma unroll
            for (int e = 0; e < 8; ++e) { const float cc = e < 4 ? cs[i][0][e & 3] : cs[i][1][e & 3], sn = e < 4 ? cs[i][2][e & 3] : cs[i][3][e & 3];
                const float y1 = x1[e] * rstd * g1[e], y2 = x2[e] * rstd * g2[e]; o1[e] = (y1 * cc - y2 * sn) * osc; o2[e] = (y1 * sn + y2 * cc) * osc; }
            u32x4 r1, r2;
#pragma unroll
            for (int e = 0; e < 4; ++e) { r1[e] = cvt_pk_bf16(o1[2 * e], o1[2 * e + 1]); r2[e] = cvt_pk_bf16(o2[2 * e], o2[2 * e + 1]); }
            *(GAS u32x4*)p1 = r1; *(GAS u32x4*)(p1 + 32) = r2; }
    }
}
__device__ __forceinline__ void crescale_rows(bf16_t* mix, const float* lsebuf, int row_base, int tid) {
    const int lane = tid & 63, wave = tid >> 6;
    for (int t0 = 0; t0 < 32; t0 += 4) {
        float ls[4][6]; u32x2 w[4][3];
#pragma unroll
        for (int i = 0; i < 4; ++i) { const int m = row_base + wave + 8 * (t0 + i);
#pragma unroll
            for (int k = 0; k < 6; ++k) ls[i][k] = lsebuf[(size_t)m * 6 + k];
            const GAS u32x2* p = (const GAS u32x2*)(mix + (size_t)m * MIXW + 1280) + lane;
#pragma unroll
            for (int j = 0; j < 3; ++j) w[i][j] = p[64 * j]; }
#pragma unroll
        for (int i = 0; i < 4; ++i) { const int m = row_base + wave + 8 * (t0 + i);
            float al[6];
#pragma unroll
            for (int j = 0; j < 2; ++j) { const float mx = fmaxf(fmaxf(ls[i][j], ls[i][2 + j]), ls[i][4 + j]);
                const float e0 = __expf(ls[i][j] - mx), e1 = __expf(ls[i][2 + j] - mx), e2 = __expf(ls[i][4 + j] - mx); const float inv = 1.0f / (e0 + e1 + e2);
                al[j] = e0 * inv; al[2 + j] = e1 * inv; al[4 + j] = e2 * inv; }
            GAS u32x2* p = (GAS u32x2*)(mix + (size_t)m * MIXW + 1280) + lane;
#pragma unroll
            for (int j = 0; j < 3; ++j) { const int hc = (4 * lane + 256 * j) >> 7; const float a = (hc == 0) ? al[0] : (hc == 1) ? al[1] : (hc == 2) ? al[2] : (hc == 3) ? al[3] : (hc == 4) ? al[4] : al[5];
                u32x2 v = w[i][j]; v.x = cvt_pk_bf16(bflo(v.x) * a, bfhi(v.x) * a); v.y = cvt_pk_bf16(bflo(v.y) * a, bfhi(v.y) * a); p[64 * j] = v; } }
    }
}

__global__ void __launch_bounds__(NWAVES * 64, 2) fwd(Args args) {
    extern __shared__ __attribute__((aligned(16))) unsigned char lds[];
    LAS unsigned char* ldsl = (LAS unsigned char*)lds;
    volatile LAS unsigned* MISC = (volatile LAS unsigned*)(ldsl + MISC_OFF);
    const int G = gridDim.x;
    unsigned char* ws = args.ws;
    gu32* ctl = (gu32*)(ws + WS_CTL);
    { const int tid0 = threadIdx.x; for (int u = tid0; u < (LDS_BYTES - LDSCTL_OFF) / 4; u += NWAVES * 64) ((LAS unsigned*)(ldsl + LDSCTL_OFF))[u] = 0u; }
    __syncthreads();
    XcdBarrier bar; bar.bar = (unsigned*)ctl + CW_BAR; bar.x = 0; bar.st = nullptr;
    if (ONE_LAUNCH) bar = xcd_barrier_post((unsigned*)ctl + CW_BAR, MISC + 8);
    int bx = blockIdx.x;
    if (ONE_LAUNCH) {
        if (threadIdx.x == 0) { const unsigned xcc = xb_xcc_id(); const unsigned rk = __hip_atomic_fetch_add(ctl + CW_XRANK + 64 * (xcc & 15u), 1u, __ATOMIC_RELAXED, __HIP_MEMORY_SCOPE_AGENT); MISC[12] = rk * 8u + xcc; }
        xcd_barrier(bar);
        if (threadIdx.x == 0) { bool ok = (G % 8 == 0);
            for (unsigned j = 0; j < 16; ++j) { const unsigned cnt = __hip_atomic_load(ctl + CW_XRANK + 64 * j, __ATOMIC_RELAXED, __HIP_MEMORY_SCOPE_AGENT); ok = ok && (cnt == (j < 8 ? (unsigned)G / 8u : 0u)); }
            if (!ok) MISC[12] = blockIdx.x; }
        __syncthreads();
        bx = __builtin_amdgcn_readfirstlane((int)MISC[12]);
    }
    const int lo = args.ph_lo, hi = args.ph_hi;
#ifndef PHMASK
#define PHMASK 0xffff
#endif
#define IN(k) (lo <= (k) && (k) < hi)
#define EN(b) ((PHMASK >> (b)) & 1)
#ifndef PROBE_DUP
#define PROBE_DUP 0
#endif
#define NREP(b) (1 + ((PROBE_DUP >> (b)) & 1))
#define REPSEAM(b) do { if (ONE_LAUNCH && NREP(b) > 1 && rep == 0) xcd_barrier(bar); } while (0)
#define SEAM(k) do { if (ONE_LAUNCH && IN(k) && IN((k) + 1)) xcd_barrier(bar); } while (0)
#define LANE_ID() const int tid = opaque_tid(), lane = tid & 63, wave = __builtin_amdgcn_readfirstlane(tid >> 6); const int vcu = (G % 8 == 0) ? (bx % 8) * (G / 8) + bx / 8 : bx; const int gw = vcu * NWAVES + wave, NGW = G * NWAVES; (void)lane; (void)gw; (void)NGW
#define ROPEC ((float*)(ws + WS_TAB))
#define ROPES (ROPEC + 128 * 32)
#define TABB (ROPES + 128 * 32)
#define TABC (TABB + 4 * 512)
#define LSEBUF ((float*)(ws + WS_LSE))
#define XB ((bf16_t*)(ws + WS_XB))
#define MB ((bf16_t*)(ws + WS_MB))
#define SSBUF ((pg8::ss_t*)(ws + WS_SS))
#define RSM ((pg8::ss_t*)(ws + WS_RSM))
#define QKV ((bf16_t*)(ws + WS_QKV))
#define MIX ((bf16_t*)(ws + WS_MIX))
#define HID ((bf16_t*)(ws + WS_HID))
#define QX ((bf16_t*)(ws + WS_QX))
#define OX ((bf16_t*)(ws + WS_OX))
#define KVX ((bf16_t*)(ws + WS_KVX))
    float* out = args.out;

    if (EN(13) && IN(0)) {
        LANE_ID();
        float* ropec = ROPEC; float* ropes = ROPES; float* tabB = TABB; float* tabC = TABC;
        LAS float* scr = (LAS float*)(ldsl + wave * 16384);
        constexpr int I_IN = 32 * 120, I_OUT = 32 * 64, I_CQ = 32 * 16, I_CKV = 32 * 32, I_CO = 8 * 64, I_FI = 32 * 352, I_FO = 88 * 64;
        constexpr int I_LAYER = I_IN + I_OUT + I_CQ + I_CKV + I_CO + I_FI + I_FO;
        for (int it = gw; it < DEPTH * I_LAYER; it += NGW) {
            const int l = it / I_LAYER; int r = it % I_LAYER;
            const float* W; bf16_t* WT; int K, N; const float* gain = nullptr;
            if (r < I_IN) { gain = args.in[4] + (size_t)l * DM; W = args.in[5] + (size_t)l * DM * PROJ; WT = (bf16_t*)(ws + WS_WIN) + (size_t)l * PROJ * DM; K = DM; N = PROJ; }
            else if ((r -= I_IN) < I_OUT) { W = args.in[10] + (size_t)l * MIXW * DM; WT = (bf16_t*)(ws + WS_WOUT) + (size_t)l * DM * MIXW; K = MIXW; N = DM; }
            else if ((r -= I_OUT) < I_CQ) { gain = args.in[11] + (size_t)l * DM; W = args.in[13] + (size_t)l * DM * XW; WT = (bf16_t*)(ws + WS_WCQ) + (size_t)l * XW * DM; K = DM; N = XW; }
            else if ((r -= I_CQ) < I_CKV) { gain = args.in[12] + (size_t)l * DM; W = args.in[14] + (size_t)l * DM * 2 * XW; WT = (bf16_t*)(ws + WS_WCKV) + (size_t)l * 2 * XW * DM; K = DM; N = 2 * XW; }
            else if ((r -= I_CKV) < I_CO) { W = args.in[15] + (size_t)l * XW * DM; WT = (bf16_t*)(ws + WS_WCO) + (size_t)l * DM * XW; K = XW; N = DM; }
            else if ((r -= I_CO) < I_FI) { gain = args.in[16] + (size_t)l * DM; W = args.in[17] + (size_t)l * DM * 2 * DFF; WT = (bf16_t*)(ws + WS_WFI) + (size_t)l * 2 * DFF * DM; K = DM; N = 2 * DFF; }
            else { r -= I_FI; W = args.in[18] + (size_t)l * DFF * DM; WT = (bf16_t*)(ws + WS_WFO) + (size_t)l * DM * DFF; K = DFF; N = DM; }
            const int nblk = N / 32, kb = r / nblk, nb = r % nblk, n0 = 32 * nb;
            int drow0 = n0;
            if (N == 2 * DFF) drow0 = (n0 < DFF) ? 256 * (n0 / 128) + (n0 % 128) : 256 * ((n0 - DFF) / 128) + 128 + ((n0 - DFF) % 128);
            transpose_item(W, gain, K, N, WT, 64 * kb, n0, drow0, scr, lane);
        }
        { bf16_t* xb = XB; pg8::ss_t* ss0 = SSBUF; bf16_t* mb = MB; pg8::ss_t* rsm = RSM;
          for (int m = gw; m < NTOK; m += NGW) { const float* xr = (m < NPROMPT) ? args.in[0] + (size_t)m * DM : args.in[1] + (size_t)(m - NPROMPT) * DM;
              const float q = row_to_bf16(xr, xb + (size_t)m * DM, lane); if (lane == 0) ss0[m] = (pg8::ss_t)(q * pg8::SS_SCALE); }
          for (int m = gw; m < MEMROWS; m += NGW) { const float* mr = (m < 2 * MEMLEN) ? args.in[2] + (size_t)m * DM : args.in[3] + (size_t)(m - 2 * MEMLEN) * DM;
              const float q = row_to_bf16(mr, mb + (size_t)m * DM, lane); if (lane == 0) rsm[m] = (pg8::ss_t)(q * pg8::SS_SCALE); } }
        const int gt = vcu * (NWAVES * 64) + tid, NGT = G * NWAVES * 64;
        const float* rel_bias = args.in[9];
        for (int e = gt; e < 4096 + 2048 + 3072; e += NGT) {
            if (e < 4096) { const int n = e >> 5, i = e & 31;
                double invd = 1.0; for (int q = 0; q < i; ++q) invd *= 0.7498942093324559;
                const float inv = (float)invd;
                const float ang = (float)n * inv; double s, c; sincos_d((double)ang, s, c); ropec[e] = (float)c; ropes[e] = (float)s; }
            else if (e < 4096 + 2048) { const int t = e - 4096, h = t >> 9, i = t & 511; const int rel = i - 96 - 128;
                float v = -INFINITY; if (rel >= -128 && rel <= 128) v = rel_bias[t5_bucket(rel) * 10 + h] * att::LOG2E;
                tabB[t] = v; }
            else { const int t = e - 6144, hc = t >> 9, i = t & 511; const int off = i - 96 - 64; const int d = (hc < 2) ? 1 : (hc < 4) ? 4 : 16;
                float v = -INFINITY; if (off >= -64 && off <= 64) v = rel_bias[t5_bucket(off * d) * 10 + 4 + hc] * att::LOG2E;
                tabC[t] = v; }
        }
    }
    SEAM(0);

    for (int l = 0; l < DEPTH; ++l) {
        const int pb = 1 + PPL * l;
#define XS0 ((l == 0) ? args.in[0] : (const float*)out)
#define XS1 ((l == 0) ? args.in[1] : (const float*)out + (size_t)NPROMPT * DM)
        if (EN(0) && IN(pb + 0)) for (int rep = 0; rep < NREP(0); ++rep) {
            { const bf16_t* Win = (const bf16_t*)(ws + WS_WIN) + (size_t)l * PROJ * DM;
              pg8::Gemm g{XB, Win, NTOK, PROJ, DM}; pg8::StaticOrder S; S.init(NTOK, PROJ, G, bx);
              pg8::EpiBf16 E{QKV, PROJ, SSBUF + (size_t)(3 * l) * NTOK};
              pg8::gemm_phase<pg8::EpiBf16, pg8::StaticOrder, true, true>(ldsl, g, S, E); }
            if (l == 0) {
              pg8::Gemm g{MB, (const bf16_t*)(ws + WS_WCKV), MEMROWS, 4 * 2 * XW, DM}; pg8::StaticOrder S; S.init(MEMROWS, 4 * 2 * XW, G, (bx + G - 64) % G);
              pg8::EpiBf16 E{KVX, 4 * 2 * XW, RSM};
              pg8::gemm_phase<pg8::EpiBf16, pg8::StaticOrder, true, true>(ldsl, g, S, E); }
            REPSEAM(0);
        }
        SEAM(pb + 0);
        if (EN(1) && IN(pb + 1)) {
            const int tid = opaque_tid(); const float* tabC = TABC; float* lsebuf = LSEBUF;
            gu32* qhead = ctl + CW_QUEUE + 64 * (2 * l);
            volatile LAS unsigned* uidw = (volatile LAS unsigned*)(ldsl + att::OFF_UID);
            for (;;) {
                if (tid == 0) uidw[0] = __hip_atomic_fetch_add(qhead, 1u, __ATOMIC_RELAXED, __HIP_MEMORY_SCOPE_AGENT);
                __syncthreads();
                const int u = (int)uidw[0];
                __syncthreads();
                if (u >= 1344) break;
                if (u < 960 && u % 5 == 4) {
                    qknorm_rows(QKV, ROPEC, ROPES, args.in[6] + (size_t)l * HD, args.in[7] + (size_t)l * HD, (u / 5) * 256, tid);
                } else { const int v0 = (u < 960) ? u - u / 5 : u - 192;
                {
                    const int v = v0, gi = v % 3, idx = v / 3; const int d = (gi == 0) ? 1 : (gi == 1) ? 4 : 16;
                    long row0; int j, L;
                    if (idx < 128) { row0 = (long)(idx / 64) * SEQ_P; j = idx % 64; L = SEQ_P; } else { const int i2 = idx - 128; row0 = NPROMPT + (long)(i2 / 32) * SEQ_S; j = i2 % 32; L = SEQ_S; }
                    const int res = j % d, qbr = j / d, p0 = qbr * 128, Lr = L / d;
                    int tlo = p0 / 64 - 1, thi = p0 / 64 + 3; if (tlo < 0) tlo = 0; if (thi > Lr / 64) thi = Lr / 64;
                    const long rq = row0 + (long)p0 * d + res, rk = row0 + res; const int hc = 2 * gi;
                    att::attn_unit<true>(QKV + rq * PROJ + COL_QC + hc * HD, (long)d * PROJ, QKV + rk * PROJ + COL_KC + gi * HD, QKV + rk * PROJ + COL_VC + gi * HD, (long)d * PROJ,
                                         MIX + rq * MIXW + 1280 + hc * HD, (long)d * MIXW, tlo, thi, p0, 64, tabC + hc * 512, 321, -1e30f, -1e30f, 0.f, lsebuf + rq * 6 + hc, (long)d * 6, (char*)lds);
                } }
            }
        }
        SEAM(pb + 1);
        if (EN(2) && IN(pb + 2)) for (int rep = 0; rep < NREP(2); ++rep) {
            const int tid = opaque_tid(); const float* tabB = TABB;
            float mfix2;
            { const float* qg = args.in[6] + (size_t)l * HD; const float* kg = args.in[7] + (size_t)l * HD; const int ln = tid & 63;
              float a = fmaxf(fabsf(qg[ln]), fabsf(qg[ln + 64])), b = fmaxf(fabsf(kg[ln]), fabsf(kg[ln + 64]));
#pragma unroll
              for (int o = 1; o < 64; o <<= 1) { a = fmaxf(a, __shfl_xor(a, o)); b = fmaxf(b, __shfl_xor(b, o)); }
              mfix2 = __builtin_amdgcn_readfirstlane(128.f * a * b * 1.02f * att::C); if (!(mfix2 <= 40.f)) mfix2 = -1.f; }
            gu32* qhead = ctl + CW_QUEUE + 64 * (2 * l + 1 + 8 * rep);
            volatile LAS unsigned* uidw = (volatile LAS unsigned*)(ldsl + att::OFF_UID);
            const float* sink = args.in[8] + (size_t)l * 4;
            for (;;) {
                if (tid == 0) uidw[0] = __hip_atomic_fetch_add(qhead, 1u, __ATOMIC_RELAXED, __HIP_MEMORY_SCOPE_AGENT);
                __syncthreads();
                const int u = (int)uidw[0];
                __syncthreads();
                if (u >= 1152 + 192 + 768) break;
                if (u < 1152) {
                    int seq, kvh, qb, gi, L;
                    if (u < 384) { seq = u / 192; const int r = u % 192; kvh = r / 96; const int r2 = r % 96; qb = r2 / 3; gi = r2 % 3; L = SEQ_P; }
                    else { const int v = u - 384; seq = 2 + v / 96; const int r = v % 96; kvh = r / 48; const int r2 = r % 48; qb = r2 / 3; gi = r2 % 3; L = SEQ_S; }
                    const long row0 = (seq < 2) ? (long)seq * SEQ_P : (long)NPROMPT + (long)(seq - 2) * SEQ_S;
                    const int h = kvh * 3 + gi;
                    att::attn_unit_dense<true>(QKV + (row0 + qb * 256) * PROJ + COL_QA + h * HD, PROJ, QKV + row0 * PROJ + COL_KA + kvh * HD, QKV + row0 * PROJ + COL_VA + kvh * HD, PROJ,
                                         MIX + (row0 + qb * 256) * MIXW + h * HD, MIXW, L / 64, mfix2, (char*)lds);
                } else if (u < 1344) { if (rep == 0) crescale_rows(MIX, LSEBUF, (u - 1152) * 256, tid); }
                else {
                    const int v = u - 1344, qbg = v >> 1, kvh = v & 1; const long rowq = (long)qbg * 128;
                    long row0; int pos0, L;
                    if (rowq < NPROMPT) { row0 = (rowq / SEQ_P) * SEQ_P; pos0 = (int)(rowq % SEQ_P); L = SEQ_P; } else { const long rr = rowq - NPROMPT; row0 = NPROMPT + (rr / SEQ_S) * SEQ_S; pos0 = (int)(rr % SEQ_S); L = SEQ_S; }
                    int tlo = pos0 / 64 - 2, thi = pos0 / 64 + 4; if (tlo < 0) tlo = 0; if (thi > L / 64) thi = L / 64;
                    const int h = 2 * kvh;
                    att::attn_unit<true>(QKV + rowq * PROJ + COL_QB + h * HD, PROJ, QKV + row0 * PROJ + COL_KB + kvh * HD, QKV + row0 * PROJ + COL_VB + kvh * HD, PROJ,
                                         MIX + rowq * MIXW + 768 + h * HD, MIXW, tlo, thi, pos0, 128, tabB + h * 512, 449, sink[h] * att::LOG2E, sink[h + 1] * att::LOG2E, 1.0f, nullptr, 0, (char*)lds);
                }
            }
            REPSEAM(2);
        }
        SEAM(pb + 2);
        if (EN(3) && IN(pb + 3)) for (int rep = 0; rep < NREP(3); ++rep) {
            const bf16_t* Wout = (const bf16_t*)(ws + WS_WOUT) + (size_t)l * DM * MIXW;
            pg8::Gemm g{MIX, Wout, NTOK, DM, MIXW}; pg8::StaticOrder S; S.init(NTOK, DM, G, bx);
            pg8::EpiRes E{XB, SSBUF + (size_t)(rep ? NNORM : 3 * l + 1) * NTOK, rep ? 0.f : 1.f};
            pg8::gemm_phase<pg8::EpiRes, pg8::StaticOrder, true, true>(ldsl, g, S, E);
            REPSEAM(3);
        }
        SEAM(pb + 3);
        if (EN(4) && IN(pb + 4)) for (int rep = 0; rep < NREP(4); ++rep) {
            const bf16_t* Wcq = (const bf16_t*)(ws + WS_WCQ) + (size_t)l * XW * DM;
            pg8::Gemm g{XB, Wcq, NTOK, XW, DM}; pg8::StaticOrder S; S.init(NTOK, XW, G, bx); pg8::EpiBf16 E{QX, XW, SSBUF + (size_t)(3 * l + 1) * NTOK};
            pg8::gemm_phase<pg8::EpiBf16, pg8::StaticOrder, true, true>(ldsl, g, S, E);
            REPSEAM(4);
        }
        SEAM(pb + 4);
        if (EN(5) && IN(pb + 5)) for (int rep = 0; rep < NREP(5); ++rep) {
            for (int u = bx; u < 768; u += G) {
                const int qbg = u >> 2, h = u & 3; const long rowq = (long)qbg * 256;
                const int seq = (rowq < NPROMPT) ? (int)(rowq / SEQ_P) : 2 + (int)((rowq - NPROMPT) / SEQ_S);
                const bf16_t* kb = KVX + (size_t)seq * MEMLEN * (4 * 2 * XW) + l * (2 * XW) + h * HD;
                att::attn_unit_dense<false>(QX + rowq * XW + h * HD, XW, kb, kb + XW, 4 * 2 * XW, OX + rowq * XW + h * HD, XW, MEMLEN / 64, -1.f, (char*)lds);
            }
            REPSEAM(5);
        }
        SEAM(pb + 5);
        if (EN(6) && IN(pb + 6)) for (int rep = 0; rep < NREP(6); ++rep) {
            const bf16_t* Wco = (const bf16_t*)(ws + WS_WCO) + (size_t)l * DM * XW;
            pg8::Gemm g{OX, Wco, NTOK, DM, XW}; pg8::StaticOrder S; S.init(NTOK, DM, G, bx);
            pg8::EpiRes E{XB, SSBUF + (size_t)(rep ? NNORM : 3 * l + 2) * NTOK, rep ? 0.f : 1.f};
            pg8::gemm_phase<pg8::EpiRes, pg8::StaticOrder, true, true>(ldsl, g, S, E);
            REPSEAM(6);
        }
        SEAM(pb + 6);
        if (EN(7) && IN(pb + 7)) for (int rep = 0; rep < NREP(7); ++rep) {
            const bf16_t* Wfi = (const bf16_t*)(ws + WS_WFI) + (size_t)l * 2 * DFF * DM;
            pg8::Gemm g{XB, Wfi, NTOK, 2 * DFF, DM}; pg8::StaticOrder S; S.init(NTOK, 2 * DFF, G, bx);
            pg8::EpiSwiglu E{HID, DFF, SSBUF + (size_t)(3 * l + 2) * NTOK};
            pg8::gemm_phase<pg8::EpiSwiglu, pg8::StaticOrder, true, true>(ldsl, g, S, E);
            REPSEAM(7);
        }
        SEAM(pb + 7);
        if (EN(8) && IN(pb + 8)) for (int rep = 0; rep < NREP(8); ++rep) {
            const bf16_t* Wfo = (const bf16_t*)(ws + WS_WFO) + (size_t)l * DM * DFF;
            pg8::Gemm g{HID, Wfo, NTOK, DM, DFF}; pg8::StaticOrder S; S.init(NTOK, DM, G, bx);
            pg8::EpiRes E{XB, SSBUF + (size_t)(rep ? NNORM : 3 * l + 3) * NTOK, rep ? 0.f : 1.f};
            pg8::gemm_phase<pg8::EpiRes, pg8::StaticOrder, true, true>(ldsl, g, S, E);
            REPSEAM(8);
        }
        SEAM(pb + 8);
    }
    if (EN(14) && IN(NPHASE - 1)) {
        LANE_ID();
        const float* g = args.in[19]; const pg8::ss_t* ssl = SSBUF + (size_t)(NNORM - 1) * NTOK;
        for (int m = gw; m < NTOK; m += NGW) { const float rstd = 1.0f / sqrtf((float)ssl[m] * pg8::SS_INV_MEAN + RMS_EPS); rms_row_out(XB + (size_t)m * DM, out + (size_t)m * DM, g, rstd, lane); }
    }
#undef IN
#undef SEAM
}

extern "C" void kernel_launch(void* const* d_in, const int* in_sizes, int n_in, void* d_out, int out_size, void* d_ws, size_t ws_size, hipStream_t stream) {
    static int grid = 0;
    if (grid == 0) {
        if (n_in != 20 || out_size != NTOK * DM || ws_size < WS_END) { fprintf(stderr, "kernel_launch: unexpected shapes: n_in %d out %d ws %zu (need %zu)\n", n_in, out_size, ws_size, (size_t)WS_END); grid = -1; return; }
        int dev = 0, cus = 0, per_cu = 0;
        if (hipGetDevice(&dev) != hipSuccess || hipDeviceGetAttribute(&cus, hipDeviceAttributeMultiprocessorCount, dev) != hipSuccess) { grid = -1; return; }
        if (hipFuncSetAttribute((const void*)fwd, hipFuncAttributeMaxDynamicSharedMemorySize, LDS_BYTES) != hipSuccess) { fprintf(stderr, "kernel_launch: hipFuncSetAttribute failed\n"); grid = -1; return; }
        if (hipOccupancyMaxActiveBlocksPerMultiprocessor(&per_cu, (const void*)fwd, NWAVES * 64, LDS_BYTES) != hipSuccess || per_cu < 1) { fprintf(stderr, "kernel_launch: occupancy query says %d\n", per_cu); }
        (void)hipGetLastError();
        grid = cus;
    }
    if (grid < 0) return;
    (void)hipMemsetAsync((char*)d_ws + WS_CTL, 0, CTL_ZERO_BYTES, stream);
    Args a{};
    for (int i = 0; i < 20; ++i) a.in[i] = (const float*)d_in[i];
    a.out = (float*)d_out; a.ws = (unsigned char*)d_ws;
#if ONE_LAUNCH
    a.ph_lo = 0; a.ph_hi = NPHASE;
    hipLaunchKernelGGL(fwd, dim3(grid), dim3(NWAVES * 64), LDS_BYTES, stream, a);
#else
    for (int p = 0; p < NPHASE; ++p) { a.ph_lo = p; a.ph_hi = p + 1; hipLaunchKernelGGL(fwd, dim3(grid), dim3(NWAVES * 64), LDS_BYTES, stream, a); }
#endif
    const hipError_t le = hipPeekAtLastError();
    if (le != hipSuccess) fprintf(stderr, "kernel_launch: launch failed: %s\n", hipGetErrorName(le));
}
```

```cpp
#include <hip/hip_runtime.h>
#include <cstdio>
#include <cstdint>

#ifndef ONE_LAUNCH
#define ONE_LAUNCH 1
#endif

constexpr int DM = 2048, NTOK = 49152, NPROMPT = 16384, SEQ_P = 8192, SEQ_S = 4096, DEPTH = 4;
constexpr int PROJ = 3840, MIXW = 2048, XW = 512, DFF = 5632, MEMLEN = 256, MEMROWS = 2560, HD = 128;
constexpr int COL_QA = 0, COL_KA = 768, COL_VA = 1024, COL_QB = 1280, COL_KB = 1792, COL_VB = 2048, COL_QC = 2304, COL_KC = 3072, COL_VC = 3456;
constexpr float RMS_EPS = 1e-6f;
constexpr int PPL = 9;
constexpr int NPHASE = 2 + PPL * DEPTH;
constexpr int NNORM = 3 * DEPTH + 1;

constexpr size_t MiB = 1u << 20;
constexpr size_t WS_CTL = 0;
constexpr size_t WS_SS = 1 * MiB;
constexpr size_t CTL_ZERO_BYTES = 6 * MiB + 512 * 1024;
static_assert(WS_SS + (size_t)(NNORM + 1) * NTOK * 8 <= CTL_ZERO_BYTES, "ss inside the memset region");
constexpr size_t WS_TAB = 6 * MiB + 512 * 1024;
constexpr size_t WS_RSM = 7 * MiB;
constexpr size_t WS_LSE = 618 * MiB;
constexpr size_t WS_WIN = 8 * MiB, WS_WOUT = 68 * MiB, WS_WCQ = 100 * MiB, WS_WCKV = 108 * MiB, WS_WCO = 124 * MiB, WS_WFI = 132 * MiB, WS_WFO = 308 * MiB;
constexpr size_t WS_XB = 396 * MiB;
constexpr size_t WS_MB = 588 * MiB;
constexpr size_t WS_KVX = 598 * MiB;
constexpr size_t WS_QKV = 620 * MiB;
constexpr size_t WS_MIX = 980 * MiB;
constexpr size_t WS_HID = 620 * MiB;
constexpr size_t WS_QX = 620 * MiB, WS_OX = 668 * MiB;
constexpr size_t WS_END = 1172 * MiB;
constexpr int CW_BAR = 4096;
constexpr int CW_XRANK = 12288;
constexpr int CW_QUEUE = 16384;

#define GAS __attribute__((address_space(1)))
#define LAS __attribute__((address_space(3)))
typedef unsigned short bf16_t;
typedef short bf16x8 __attribute__((ext_vector_type(8)));
typedef short s16x4 __attribute__((ext_vector_type(4)));
typedef float f32x4 __attribute__((ext_vector_type(4)));
typedef float f32x16 __attribute__((ext_vector_type(16)));
typedef unsigned u32x4 __attribute__((ext_vector_type(4)));
typedef unsigned u32x2 __attribute__((ext_vector_type(2)));
typedef GAS unsigned gu32;

__device__ __forceinline__ int opaque_tid() { int t = threadIdx.x; asm volatile("" : "+v"(t)); return t; }
__device__ __forceinline__ unsigned cvt_pk_bf16(float lo, float hi) { unsigned r; asm volatile("v_cvt_pk_bf16_f32 %0, %1, %2" : "=v"(r) : "v"(lo), "v"(hi)); return r; }
__device__ __forceinline__ float bf2f(unsigned short b) { return __builtin_bit_cast(float, (unsigned)b << 16); }
__device__ __forceinline__ float bflo(unsigned w) { return __builtin_bit_cast(float, w << 16); }
__device__ __forceinline__ float bfhi(unsigned w) { return __builtin_bit_cast(float, w & 0xffff0000u); }

namespace pg8 {
#define PG8_LAS __attribute__((address_space(3)))
constexpr int BM = 256, BK = 64, HALF = 128, HTB = HALF * BK * 2, STAGE_BYTES = 8 * HTB, NXCD = 8, WGM = 4;
__host__ __device__ __forceinline__ int lds_byte(int r, int c) { const int st = (r >> 4) * 2 + (c >> 5), rr = r & 15, cc = c & 31, ob = rr * 64 + cc * 2; return st * 1024 + (ob ^ (((ob >> 9) & 1) << 5)); }
__host__ __device__ __forceinline__ void stage_rc(int b, int& R, int& C) { const int st = b / 1024, sb = b % 1024, swz = sb ^ (((sb >> 9) & 1) << 5); R = (st >> 1) * 16 + swz / 64; C = (st & 1) * 32 + (swz % 64) / 2; }
__host__ __device__ __forceinline__ int perm32(int rho) { const int n = rho >> 4, i = rho & 15; return 8 * (i >> 2) + 4 * n + (i & 3); }

struct Unit { int pm, pn; };
struct Gemm { const bf16_t* A; const bf16_t* Bt; int M, N, K; };

struct StaticOrder {
    int nM, nN, nwg, G, c, i_lo, i_hi, wgm = WGM;
    __host__ __device__ void init(int M, int N, int G_, int c_, int lo_ = 0, int hi_ = 1 << 30) { nM = M / BM; nN = N / BM; nwg = nM * nN; G = G_; c = c_; i_lo = lo_; i_hi = hi_; }
    __host__ __device__ bool next(int i, Unit& u) const {
        i += i_lo; if (i >= i_hi) return false;
        const long L = (long)i * G + c; if (L >= nwg) return false;
        int wgid = (int)L; { const int q = nwg / NXCD, r = nwg % NXCD, xcd = wgid % NXCD, off = wgid / NXCD; wgid = (xcd < r ? xcd * (q + 1) : r * (q + 1) + (xcd - r) * q) + off; }
        const int nig = wgm * nN, gid = wgid / nig, fm = gid * wgm, gsz = (nM - fm) < wgm ? (nM - fm) : wgm;
        u.pm = fm + ((wgid % nig) % gsz); u.pn = (wgid % nig) / gsz; return true;
    }
    __device__ __forceinline__ void a_ready(const Unit&) const {}
    __device__ __forceinline__ void done(const Unit&) const {}
};

typedef unsigned long long ss_t;
constexpr float SS_SCALE = 16777216.0f, SS_INV_MEAN = 1.0f / (16777216.0f * 2048.0f);
struct PreSS { ss_t v[2][4]; };
struct PreNone {};
__device__ __forceinline__ unsigned lane_perm(int src4, unsigned v) { return (unsigned)__builtin_amdgcn_ds_bpermute(src4, (int)v); }
__device__ __forceinline__ void ss_prefetch(PreSS& p, const ss_t* ss, int row0) {
#pragma unroll
    for (int ai = 0; ai < 2; ++ai)
#pragma unroll
        for (int m = 0; m < 4; ++m) p.v[ai][m] = ss[row0 + ai * HALF + m * 16];
}
__device__ __forceinline__ void row_rstd(const PreSS& p, float (&rs)[2][4]) {
#pragma unroll
    for (int ai = 0; ai < 2; ++ai)
#pragma unroll
        for (int m = 0; m < 4; ++m) {
            const ss_t v = p.v[ai][m]; const float f = (float)(unsigned)(v >> 32) * 4294967296.0f + (float)(unsigned)v;
            rs[ai][m] = __builtin_amdgcn_rsqf(f * SS_INV_MEAN + 1e-6f); }
}
struct EpiBf16 {
    static constexpr bool PERM = true, AFTER_DRAIN = false;
    bf16_t* O; int ldc; const ss_t* ss;
    typedef PreSS Pre;
    __device__ __forceinline__ void prefetch(Pre& p, const Unit& u, int wr, int fr) const { ss_prefetch(p, ss, u.pm * BM + wr * 64 + fr); }
    __device__ __forceinline__ void operator()(const f32x4 (&acc)[2][2][4][2], const Unit& u, int wr, int wc, int fr, int fq, const Pre& pre) const {
        const int row0 = u.pm * BM + wr * 64 + fr; const int col0 = u.pn * BM + wc * 32 + 8 * fq;
        float rs[2][4]; row_rstd(pre, rs);
#pragma unroll
        for (int ai = 0; ai < 2; ++ai)
#pragma unroll
            for (int m = 0; m < 4; ++m) { bf16_t* rowp = O + (size_t)(row0 + ai * HALF + m * 16) * ldc + col0; const float r = rs[ai][m];
#pragma unroll
                for (int bj = 0; bj < 2; ++bj) { const f32x4 v0 = acc[ai][bj][m][0] * r, v1 = acc[ai][bj][m][1] * r;
                    u32x4 w; w.x = cvt_pk_bf16(v0[0], v0[1]); w.y = cvt_pk_bf16(v0[2], v0[3]); w.z = cvt_pk_bf16(v1[0], v1[1]); w.w = cvt_pk_bf16(v1[2], v1[3]);
                    *(u32x4*)(rowp + bj * HALF) = w; } }
    }
};
struct EpiRes {
    static constexpr bool PERM = true, AFTER_DRAIN = false;
    bf16_t* xb; ss_t* ssout; float scale;
    typedef PreNone Pre;
    __device__ __forceinline__ void prefetch(Pre&, const Unit&, int, int) const {}
    __device__ __forceinline__ void operator()(const f32x4 (&acc)[2][2][4][2], const Unit& u, int wr, int wc, int fr, int fq, const Pre&) const {
        const int row0 = u.pm * BM + wr * 64 + fr; const int col0 = u.pn * BM + wc * 32 + 8 * fq;
        bf16_t* xbase = xb + (size_t)row0 * DM + col0;
        const int pl = fq * 16 + fr, psrc = (4 * fr + fq) * 4;
        const bf16_t* xload = xb + (size_t)(u.pm * BM + wr * 64 + (pl >> 2)) * DM + u.pn * BM + wc * 32 + 8 * (pl & 3);
#pragma unroll
        for (int ai = 0; ai < 2; ++ai) { float sq[4];
            u32x4 xv[4][2];
#pragma unroll
            for (int m = 0; m < 4; ++m)
#pragma unroll
                for (int bj = 0; bj < 2; ++bj) xv[m][bj] = *(const u32x4*)(xload + (size_t)(ai * HALF + m * 16) * DM + bj * HALF);
#pragma unroll
            for (int m = 0; m < 4; ++m) { bf16_t* bp = xbase + (size_t)(ai * HALF + m * 16) * DM;
                float q = 0.f;
#pragma unroll
                for (int bj = 0; bj < 2; ++bj) { const u32x4 xq = xv[m][bj]; u32x4 xw; xw.x = lane_perm(psrc, xq.x); xw.y = lane_perm(psrc, xq.y); xw.z = lane_perm(psrc, xq.z); xw.w = lane_perm(psrc, xq.w);
                    const f32x4 d0 = acc[ai][bj][m][0] * scale, d1 = acc[ai][bj][m][1] * scale;
                    u32x4 w; w.x = cvt_pk_bf16(bflo(xw.x) + d0[0], bfhi(xw.x) + d0[1]); w.y = cvt_pk_bf16(bflo(xw.y) + d0[2], bfhi(xw.y) + d0[3]);
                    w.z = cvt_pk_bf16(bflo(xw.z) + d1[0], bfhi(xw.z) + d1[1]); w.w = cvt_pk_bf16(bflo(xw.w) + d1[2], bfhi(xw.w) + d1[3]);
                    *(u32x4*)(bp + bj * HALF) = w;
                    const float e0 = bflo(w.x), e1 = bfhi(w.x), e2 = bflo(w.y), e3 = bfhi(w.y), e4 = bflo(w.z), e5 = bfhi(w.z), e6 = bflo(w.w), e7 = bfhi(w.w);
                    q += (e0 * e0 + e1 * e1) + (e2 * e2 + e3 * e3) + (e4 * e4 + e5 * e5) + (e6 * e6 + e7 * e7); }
                sq[m] = q; }
            asm volatile("" ::: "memory");
            const bool b0 = fq & 1, b1 = fq & 2;
            const float w0 = (b0 ? sq[1] : sq[0]) + __shfl_xor(b0 ? sq[0] : sq[1], 16), w1 = (b0 ? sq[3] : sq[2]) + __shfl_xor(b0 ? sq[2] : sq[3], 16);
            const float tot = (b1 ? w1 : w0) + __shfl_xor(b1 ? w0 : w1, 32);
            __hip_atomic_fetch_add(ssout + u.pm * BM + ai * HALF + wr * 64 + fq * 16 + fr, (ss_t)(tot * SS_SCALE), __ATOMIC_RELAXED, __HIP_MEMORY_SCOPE_AGENT); }
    }
};
struct EpiSwiglu {
    static constexpr bool PERM = true, AFTER_DRAIN = false;
    bf16_t* O; int ldc; const ss_t* ss;
    typedef PreSS Pre;
    __device__ __forceinline__ void prefetch(Pre& p, const Unit& u, int wr, int fr) const { ss_prefetch(p, ss, u.pm * BM + wr * 64 + fr); }
    __device__ __forceinline__ void operator()(const f32x4 (&acc)[2][2][4][2], const Unit& u, int wr, int wc, int fr, int fq, const Pre& pre) const {
        const int row0 = u.pm * BM + wr * 64 + fr; const int col0 = u.pn * HALF + wc * 32 + 8 * fq;
        float rs[2][4]; row_rstd(pre, rs);
#pragma unroll
        for (int ai = 0; ai < 2; ++ai)
#pragma unroll
            for (int m = 0; m < 4; ++m) {
                const float r = rs[ai][m], c = -1.4426950408889634f * r, r2 = r * r;
                const f32x4 g0 = acc[ai][0][m][0], g1 = acc[ai][0][m][1], u0 = acc[ai][1][m][0], u1 = acc[ai][1][m][1];
                const f32x4 t0 = g0 * c, t1 = g1 * c;
                f32x4 e0, e1;
#pragma unroll
                for (int i = 0; i < 4; ++i) { e0[i] = __builtin_amdgcn_exp2f(t0[i]); e1[i] = __builtin_amdgcn_exp2f(t1[i]); }
                const f32x4 d0 = e0 + 1.0f, d1 = e1 + 1.0f;
                f32x4 q0, q1;
#pragma unroll
                for (int i = 0; i < 4; ++i) { q0[i] = __builtin_amdgcn_rcpf(d0[i]); q1[i] = __builtin_amdgcn_rcpf(d1[i]); }
                const f32x4 h0 = (g0 * u0) * (q0 * r2), h1 = (g1 * u1) * (q1 * r2);
                u32x4 w; w.x = cvt_pk_bf16(h0[0], h0[1]); w.y = cvt_pk_bf16(h0[2], h0[3]); w.z = cvt_pk_bf16(h1[0], h1[1]); w.w = cvt_pk_bf16(h1[2], h1[3]);
                *(u32x4*)(O + (size_t)(row0 + ai * HALF + m * 16) * ldc + col0) = w; }
    }
};

template <class Epi, class Sched, bool ALIGN_EPI = false, bool SP2 = false>
__device__ __forceinline__ void gemm_phase(PG8_LAS unsigned char* lds, const Gemm g, const Sched& S, const Epi& E) {
    const int tid = opaque_tid(), wid = __builtin_amdgcn_readfirstlane(tid >> 6), lane = tid & 63, wr = wid >> 2, wc = wid & 3, fr = lane & 15, fq = lane >> 4;
    const int K = g.K, nt = K / BK;
    unsigned voffA[2], voffB[2];
#pragma unroll
    for (int i = 0; i < 2; ++i) { int R, C; stage_rc(tid * 16 + i * 8192, R, C); const int Rb = Epi::PERM ? ((R & ~31) + perm32(R & 31)) : R;
        voffA[i] = (unsigned)(R * K + C) * 2u; voffB[i] = (unsigned)(Rb * K + C) * 2u; }
    const size_t kstep = (size_t)(BK * 2);
    const size_t hstep = (size_t)HALF * K * 2;
    const size_t tstep = 2 * hstep;
    const unsigned ldsw = (unsigned)wid * 1024u;
    const int aoff = lds_byte(wr * 64 + fr, fq * 8), boff = lds_byte(wc * 32 + fr, fq * 8);
#define PG8_SA(b, h) (((b) * 2 + (h)) * HTB)
#define PG8_SB(b, h) ((4 + (b) * 2 + (h)) * HTB)
#define PG8_STAGE(bufoff, gbase, voff) do { _Pragma("unroll") for (int _i = 0; _i < 2; ++_i) \
        __builtin_amdgcn_global_load_lds((const unsigned*)((const char*)(gbase) + (voff)[_i]), (PG8_LAS unsigned*)(lds + (bufoff) + ldsw + _i * 8192), 16, 0, 0); } while (0)
#define PG8_LDA(dst, b, h) do { _Pragma("unroll") for (int m = 0; m < 4; ++m) _Pragma("unroll") for (int k = 0; k < 2; ++k) dst[m][k] = *(const PG8_LAS bf16x8*)(lds + PG8_SA(b, h) + aoff + m * 2048 + k * 1024); } while (0)
#define PG8_LDB(dst, b, h) do { _Pragma("unroll") for (int n = 0; n < 2; ++n) _Pragma("unroll") for (int k = 0; k < 2; ++k) dst[n][k] = *(const PG8_LAS bf16x8*)(lds + PG8_SB(b, h) + boff + n * 2048 + k * 1024); } while (0)
#define PG8_MMA(ai, bj, At, Bt) do { __builtin_amdgcn_s_setprio(1); _Pragma("unroll") for (int m = 0; m < 4; ++m) _Pragma("unroll") for (int n = 0; n < 2; ++n) _Pragma("unroll") for (int k = 0; k < 2; ++k) \
        acc[ai][bj][m][n] = __builtin_amdgcn_mfma_f32_16x16x32_bf16(Bt[n][k], At[m][k], acc[ai][bj][m][n], 0, 0, 0); __builtin_amdgcn_s_setprio(0); } while (0)
#define PG8_WAIT_V(n) asm volatile("s_waitcnt vmcnt(" #n ")" ::: "memory")
#define PG8_WAIT_L(n) asm volatile("s_waitcnt lgkmcnt(" #n ")" ::: "memory")
#define PG8_BAR __builtin_amdgcn_s_barrier()
#define PG8_SCHED __builtin_amdgcn_sched_barrier(0)
    Unit cur, nxt; int ui = 0;
    if (!S.next(0, cur)) return;
    f32x4 acc[2][2][4][2];
#pragma unroll
    for (int a = 0; a < 2; ++a)
#pragma unroll
        for (int b = 0; b < 2; ++b)
#pragma unroll
            for (int m = 0; m < 4; ++m)
#pragma unroll
                for (int n = 0; n < 2; ++n) acc[a][b][m][n] = (f32x4){0.f, 0.f, 0.f, 0.f};
    bf16x8 At[4][2], B0[2][2], B1[2][2];
    typename Epi::Pre pre;
    const char* cA = (const char*)g.A + (size_t)cur.pm * tstep; const char* cB = (const char*)g.Bt + (size_t)cur.pn * tstep;
    S.a_ready(cur);
    if constexpr (SP2) {
        PG8_STAGE(PG8_SB(0, 0), cB, voffB); PG8_STAGE(PG8_SB(0, 1), cB + hstep, voffB); PG8_STAGE(PG8_SA(0, 0), cA, voffA); PG8_STAGE(PG8_SA(0, 1), cA + hstep, voffA);
        if (wr == 1) PG8_BAR;
        PG8_WAIT_V(2); PG8_BAR;
        PG8_STAGE(PG8_SB(1, 0), cB + kstep, voffB); PG8_STAGE(PG8_SA(1, 0), cA + kstep, voffA); PG8_STAGE(PG8_SB(1, 1), cB + hstep + kstep, voffB);
        PG8_WAIT_V(6); PG8_BAR;
    } else {
        PG8_STAGE(PG8_SB(0, 0), cB, voffB); PG8_STAGE(PG8_SA(0, 0), cA, voffA); PG8_STAGE(PG8_SB(0, 1), cB + hstep, voffB); PG8_STAGE(PG8_SA(0, 1), cA + hstep, voffA);
        if (wr == 1) PG8_BAR;
        PG8_WAIT_V(4); PG8_BAR;
        PG8_STAGE(PG8_SB(1, 0), cB + kstep, voffB); PG8_STAGE(PG8_SA(1, 0), cA + kstep, voffA); PG8_STAGE(PG8_SB(1, 1), cB + hstep + kstep, voffB);
        PG8_WAIT_V(6); PG8_BAR;
    }
    for (;;) {
        const bool has_next = S.next(ui + 1, nxt);
        const char* nA = has_next ? (const char*)g.A + (size_t)nxt.pm * tstep : cA; const char* nB = has_next ? (const char*)g.Bt + (size_t)nxt.pn * tstep : cB;
        for (int t = 0; t < nt; t += 2) {
            const bool last = (t == nt - 2);
            const char* a1 = cA + (size_t)(t + 1) * kstep;
            const char* a2 = last ? nA : cA + (size_t)(t + 2) * kstep; const char* b2 = last ? nB : cB + (size_t)(t + 2) * kstep;
            const char* a3 = a2 + kstep; const char* b3 = b2 + kstep;
            if (last && has_next) S.a_ready(nxt);
            if (last) E.prefetch(pre, cur, wr, fr);
            if constexpr (SP2) {
            PG8_LDB(B0, 0, 0); PG8_LDB(B1, 0, 1); PG8_SCHED; PG8_LDA(At, 0, 0); PG8_STAGE(PG8_SA(1, 1), a1 + hstep, voffA);
            PG8_WAIT_V(8); PG8_WAIT_L(0); PG8_BAR; PG8_MMA(0, 0, At, B0); PG8_MMA(0, 1, At, B1); PG8_BAR; PG8_SCHED;
            PG8_LDA(At, 0, 1); PG8_STAGE(PG8_SB(0, 0), b2, voffB); PG8_STAGE(PG8_SB(0, 1), b2 + hstep, voffB); PG8_STAGE(PG8_SA(0, 0), a2, voffA);
            PG8_WAIT_V(8); PG8_WAIT_L(0); PG8_BAR; PG8_MMA(1, 0, At, B0); PG8_MMA(1, 1, At, B1); PG8_BAR; PG8_SCHED;
            PG8_LDB(B0, 1, 0); PG8_LDB(B1, 1, 1); PG8_SCHED; PG8_LDA(At, 1, 0); PG8_STAGE(PG8_SA(0, 1), a2 + hstep, voffA);
            PG8_WAIT_V(8); PG8_WAIT_L(0); PG8_BAR; PG8_MMA(0, 0, At, B0); PG8_MMA(0, 1, At, B1); PG8_BAR; PG8_SCHED;
            PG8_LDA(At, 1, 1); PG8_STAGE(PG8_SB(1, 0), b3, voffB); PG8_STAGE(PG8_SB(1, 1), b3 + hstep, voffB); PG8_STAGE(PG8_SA(1, 0), a3, voffA);
            PG8_WAIT_V(8); PG8_WAIT_L(0); PG8_BAR; PG8_MMA(1, 0, At, B0); PG8_MMA(1, 1, At, B1); PG8_BAR; PG8_SCHED;
            } else {
            PG8_LDB(B0, 0, 0); PG8_SCHED; PG8_LDA(At, 0, 0); PG8_STAGE(PG8_SA(1, 1), a1 + hstep, voffA);
            PG8_WAIT_L(8); PG8_BAR; PG8_WAIT_L(0); PG8_MMA(0, 0, At, B0); PG8_BAR; PG8_SCHED;
            PG8_LDB(B1, 0, 1); PG8_STAGE(PG8_SB(0, 0), b2, voffB);
            PG8_BAR; PG8_WAIT_L(0); PG8_MMA(0, 1, At, B1); PG8_BAR;
            PG8_LDA(At, 0, 1); PG8_STAGE(PG8_SA(0, 0), a2, voffA);
            PG8_BAR; PG8_WAIT_L(0); PG8_MMA(1, 0, At, B0); PG8_BAR; PG8_SCHED;
            PG8_STAGE(PG8_SB(0, 1), b2 + hstep, voffB);
            PG8_WAIT_V(6); PG8_BAR; PG8_MMA(1, 1, At, B1); PG8_BAR;
            PG8_LDB(B0, 1, 0); PG8_SCHED; PG8_LDA(At, 1, 0); PG8_STAGE(PG8_SA(0, 1), a2 + hstep, voffA);
            PG8_WAIT_L(8); PG8_BAR; PG8_WAIT_L(0); PG8_MMA(0, 0, At, B0); PG8_BAR; PG8_SCHED;
            PG8_LDB(B1, 1, 1); PG8_STAGE(PG8_SB(1, 0), b3, voffB);
            PG8_BAR; PG8_WAIT_L(0); PG8_MMA(0, 1, At, B1); PG8_BAR;
            PG8_LDA(At, 1, 1); PG8_STAGE(PG8_SA(1, 0), a3, voffA);
            PG8_BAR; PG8_WAIT_L(0); PG8_MMA(1, 0, At, B0); PG8_BAR; PG8_SCHED;
            PG8_STAGE(PG8_SB(1, 1), b3 + hstep, voffB);
            PG8_WAIT_V(6); PG8_BAR; PG8_MMA(1, 1, At, B1); PG8_BAR;
            }
        }
        if constexpr (ALIGN_EPI) { if (wr == 0) PG8_BAR; }
        if constexpr (!Epi::AFTER_DRAIN) { E(acc, cur, wr, wc, fr, fq, pre); S.done(cur); }
        if (!has_next) break;
#pragma unroll
        for (int a = 0; a < 2; ++a)
#pragma unroll
            for (int b = 0; b < 2; ++b)
#pragma unroll
                for (int m = 0; m < 4; ++m)
#pragma unroll
                    for (int n = 0; n < 2; ++n) acc[a][b][m][n] = (f32x4){0.f, 0.f, 0.f, 0.f};
        cur = nxt; cA = nA; cB = nB; ++ui;
        if constexpr (ALIGN_EPI) { if (wr == 1) PG8_BAR; }
    }
    PG8_WAIT_V(0);
    if constexpr (!ALIGN_EPI) { if (wr == 0) PG8_BAR; }
    PG8_BAR;
#undef PG8_SA
#undef PG8_SB
#undef PG8_STAGE
#undef PG8_LDA
#undef PG8_LDB
#undef PG8_MMA
#undef PG8_WAIT_V
#undef PG8_WAIT_L
#undef PG8_BAR
#undef PG8_SCHED
}
}

namespace att {
constexpr int D = 128, NW = 8, QBLK = 32, KVBLK = 64;
constexpr float SCALE = 0.088388347648318440f, LOG2E = 1.4426950408889634f, LN2 = 0.6931471805599453f;
constexpr float C = SCALE * LOG2E;
constexpr float THR2 = 8.f * LOG2E;
constexpr int SHM_V = KVBLK * D * 2, SHM_K = KVBLK * D * 2;
constexpr int OFF_V = 0, OFF_K = 2 * SHM_V, BUF3 = SHM_V + SHM_K  , OFF_WS = 3 * BUF3, OFF_TAB = OFF_WS + NW * 64 * 4, TAB_FLOATS = 1024, OFF_UID = OFF_TAB + TAB_FLOATS * 4, LDS_BYTES = OFF_UID + 64;
#define KSWZ(row, colB) ((row) * 256 + ((colB) ^ (((row) & 7) << 4)))
#define SBAR() __builtin_amdgcn_sched_barrier(0)
__device__ __forceinline__ int crow(int r, int hi) { return (r & 3) + 8 * (r >> 2) + 4 * hi; }
__device__ __forceinline__ void qkt(f32x16& p0, f32x16& p1, const char* Ks, const bf16x8* qr, int r32, int hi) {
  p0 = f32x16{}; p1 = f32x16{};
#pragma unroll
  for (int d0 = 0; d0 < 8; ++d0) { const int cb = (d0 * 16 + hi * 8) * 2;
    const bf16x8 b0 = *reinterpret_cast<const bf16x8*>(Ks + KSWZ(r32, cb));
    const bf16x8 b1 = *reinterpret_cast<const bf16x8*>(Ks + KSWZ(32 + r32, cb));
    p0 = __builtin_amdgcn_mfma_f32_32x32x16_bf16(b0, qr[d0], p0, 0, 0, 0);
    p1 = __builtin_amdgcn_mfma_f32_32x32x16_bf16(b1, qr[d0], p1, 0, 0, 0); }
}
__device__ __forceinline__ int v_st(int k, int c) { const int kk = (k & ~0xC) | ((k & 4) << 1) | ((k & 8) >> 1); return ((kk >> 3) * 4 + (c >> 5)) * 512 + ((kk & 7) * 32 + (c & 31)) * 2; }
__device__ __forceinline__ int v_rd_base(int lane) { return ((lane & 3) << 3) | (((lane >> 2) & 3) << 6) | (((lane >> 4) & 1) << 5) | (((lane >> 5) & 1) << 8); }
constexpr int v_rd_off(int d0, int ks, int half) { return d0 * 512 + ks * 4096 + half * 2048; }
template <int OFF> __device__ __forceinline__ s16x4 tr_read(int vb) {
  s16x4 r; asm volatile("ds_read_b64_tr_b16 %0, %1 offset:%2" : "=&v"(r) : "v"(vb), "i"(OFF) : "memory"); return r;
}
template <int D0> __device__ __forceinline__ void pv_one(f32x16& od, int vb, bf16x8 pa0, bf16x8 pa1, bf16x8 pa2, bf16x8 pa3) {
  const s16x4 l0 = tr_read<v_rd_off(D0, 0, 0)>(vb), h0 = tr_read<v_rd_off(D0, 0, 1)>(vb), l1 = tr_read<v_rd_off(D0, 1, 0)>(vb), h1 = tr_read<v_rd_off(D0, 1, 1)>(vb);
  const s16x4 l2 = tr_read<v_rd_off(D0, 2, 0)>(vb), h2 = tr_read<v_rd_off(D0, 2, 1)>(vb), l3 = tr_read<v_rd_off(D0, 3, 0)>(vb), h3 = tr_read<v_rd_off(D0, 3, 1)>(vb);
  asm volatile("s_waitcnt lgkmcnt(0)" ::: "memory"); SBAR();
#define PK(L, H) (bf16x8){L[0], L[1], L[2], L[3], H[0], H[1], H[2], H[3]}
  od = __builtin_amdgcn_mfma_f32_32x32x16_bf16(pa0, PK(l0, h0), od, 0, 0, 0);
  od = __builtin_amdgcn_mfma_f32_32x32x16_bf16(pa1, PK(l1, h1), od, 0, 0, 0);
  od = __builtin_amdgcn_mfma_f32_32x32x16_bf16(pa2, PK(l2, h2), od, 0, 0, 0);
  od = __builtin_amdgcn_mfma_f32_32x32x16_bf16(pa3, PK(l3, h3), od, 0, 0, 0);
#undef PK
}
__device__ __forceinline__ void pv_d0(f32x16* o, int vb, bf16x8 pa0, bf16x8 pa1, bf16x8 pa2, bf16x8 pa3) {
  pv_one<0>(o[0], vb, pa0, pa1, pa2, pa3); pv_one<1>(o[1], vb, pa0, pa1, pa2, pa3); pv_one<2>(o[2], vb, pa0, pa1, pa2, pa3); pv_one<3>(o[3], vb, pa0, pa1, pa2, pa3);
}

template <bool TAB>
__device__ __forceinline__ void attn_unit(const bf16_t* __restrict__ Qb, long ldq, const bf16_t* __restrict__ Kh, const bf16_t* __restrict__ Vh, long ldk,
                                          bf16_t* __restrict__ Ob, long ldo, int t_lo, int t_hi, int qpos0, int W, const float* __restrict__ tabg, int tablen,
                                          float m_init0, float m_init1, float l_init, float* __restrict__ lse, long ldlse, char* lds) {
  const int tid = opaque_tid(), lane = tid & 63, r32 = lane & 31, hi = lane >> 5; const int wid = __builtin_amdgcn_readfirstlane(tid >> 6);
  const int hw = wid >> 2, wq = wid & 3;
  char* V_lds = lds + OFF_V; char* K_lds = lds + OFF_K;
  float* ws = (float*)(lds + OFF_WS) + wid * 64; float* li_l = ws; float* al_l = ws + 32;
  float* tab = (float*)(lds + OFF_TAB);
  bf16x8 qr[8];
  { const bf16_t* Qw = Qb + hw * D + (long)(wq * QBLK + r32) * ldq + hi * 8;
#pragma unroll
    for (int d0 = 0; d0 < 8; ++d0) qr[d0] = *reinterpret_cast<const bf16x8*>(Qw + d0 * 16); }
  if (TAB) { for (int i = tid; i < 2 * 512; i += NW * 64) tab[i] = ((i & 511) < tablen) ? tabg[i] : 0.f; }
  const int sr = tid >> 4, sc = (tid & 15) * 8, vst0 = v_st(sr, sc), vst1 = v_st(32 + sr, sc);
  const int vb0 = (int)(uintptr_t)V_lds + v_rd_base(lane);
  bf16x8 vs0, vs1, ks0, ks1;
#define SLOAD(k0) do { vs0 = *reinterpret_cast<const bf16x8*>(&Vh[(long)((k0) + sr) * ldk + sc]); vs1 = *reinterpret_cast<const bf16x8*>(&Vh[(long)((k0) + 32 + sr) * ldk + sc]); \
    ks0 = *reinterpret_cast<const bf16x8*>(&Kh[(long)((k0) + sr) * ldk + sc]); ks1 = *reinterpret_cast<const bf16x8*>(&Kh[(long)((k0) + 32 + sr) * ldk + sc]); } while (0)
#define SWRITE(b) do { *(bf16x8*)(V_lds + (b) * SHM_V + vst0) = vs0; *(bf16x8*)(V_lds + (b) * SHM_V + vst1) = vs1; const int kc = sc * 2; \
    *(bf16x8*)(K_lds + (b) * SHM_K + KSWZ(sr, kc)) = ks0; *(bf16x8*)(K_lds + (b) * SHM_K + KSWZ(32 + sr, kc)) = ks1; } while (0)
  float m_reg = hw ? m_init1 : m_init0, l_reg = l_init; f32x16 o[4] = {};
  const int qw0 = qpos0 + wq * QBLK;
  SLOAD(t_lo * KVBLK); SWRITE(0); __syncthreads();
  for (int t = t_lo; t < t_hi; ++t) {
    const int b = (t - t_lo) & 1; const bool more = (t + 1 < t_hi);
    if (more) SLOAD((t + 1) * KVBLK);
    const bool active = !TAB || (KVBLK * t + KVBLK - 1 >= qw0 - W && KVBLK * t <= qw0 + QBLK - 1 + W);
    if (active) {
      f32x16 p0, p1; qkt(p0, p1, K_lds + b * SHM_K, qr, r32, hi);
      if (TAB) { const float* tl = tab + hw * 512 + (KVBLK * t - qw0 - r32 + 4 * hi + W + 96);
#pragma unroll
        for (int r = 0; r < 16; ++r) { const int ix = (r & 3) + 8 * (r >> 2); p0[r] = fmaf(p0[r], C, tl[ix]); p1[r] = fmaf(p1[r], C, tl[ix + 32]); } }
      else {
#pragma unroll
        for (int r = 0; r < 16; ++r) { p0[r] *= C; p1[r] *= C; } }
      float pmax = p0[0];
#pragma unroll
      for (int r = 1; r < 16; ++r) pmax = fmaxf(pmax, p0[r]);
#pragma unroll
      for (int r = 0; r < 16; ++r) pmax = fmaxf(pmax, p1[r]);
      { auto rr = __builtin_amdgcn_permlane32_swap(__float_as_uint(pmax), __float_as_uint(pmax), false, false);
        pmax = fmaxf(__uint_as_float(rr[0]), __uint_as_float(rr[1])); }
      if (!__all(pmax - m_reg <= THR2)) {
        const float mn = fmaxf(m_reg, pmax); const float alpha = __builtin_amdgcn_exp2f(m_reg - mn); m_reg = mn; l_reg *= alpha;
        if (hi == 0) al_l[r32] = alpha; asm volatile("s_waitcnt lgkmcnt(0)" ::: "memory");
#pragma unroll
        for (int d = 0; d < 4; ++d)
#pragma unroll
          for (int r = 0; r < 16; ++r) o[d][r] *= al_l[crow(r, hi)];
      }
#pragma unroll
      for (int r = 0; r < 16; ++r) { p0[r] = __builtin_amdgcn_exp2f(p0[r] - m_reg); p1[r] = __builtin_amdgcn_exp2f(p1[r] - m_reg); }
      float ps = 0.f;
#pragma unroll
      for (int r = 0; r < 16; ++r) ps += p0[r];
#pragma unroll
      for (int r = 0; r < 16; ++r) ps += p1[r];
      { auto rr = __builtin_amdgcn_permlane32_swap(__float_as_uint(ps), __float_as_uint(ps), false, false);
        ps = __uint_as_float(rr[0]) + __uint_as_float(rr[1]); }
      l_reg += ps;
      bf16x8 pa0, pa1, pa2, pa3;
#define PK4(P, BASE, OUT) do { unsigned a0 = cvt_pk_bf16(P[BASE + 0], P[BASE + 1]), a1 = cvt_pk_bf16(P[BASE + 2], P[BASE + 3]);   \
    unsigned b0 = cvt_pk_bf16(P[BASE + 4], P[BASE + 5]), b1 = cvt_pk_bf16(P[BASE + 6], P[BASE + 7]);                              \
    auto r0 = __builtin_amdgcn_permlane32_swap(a0, b0, false, false); auto r1 = __builtin_amdgcn_permlane32_swap(a1, b1, false, false); \
    u32x4 w = {r0[0], r1[0], r0[1], r1[1]}; OUT = *reinterpret_cast<bf16x8*>(&w); } while (0)
      PK4(p0, 0, pa0); PK4(p0, 8, pa1); PK4(p1, 0, pa2); PK4(p1, 8, pa3);
#undef PK4
      SBAR();
      pv_d0(o, vb0 + b * SHM_V, pa0, pa1, pa2, pa3);
    }
    if (more) SWRITE(b ^ 1);
    __syncthreads();
  }
  if (hi == 0) li_l[r32] = l_reg; asm volatile("s_waitcnt lgkmcnt(0)" ::: "memory");
  float rli[16];
#pragma unroll
  for (int r = 0; r < 16; ++r) rli[r] = __builtin_amdgcn_rcpf(li_l[crow(r, hi)]);
  bf16_t* stg = (bf16_t*)(lds + wid * 8192);
#pragma unroll
  for (int r = 0; r < 16; ++r) { const int orow = crow(r, hi);
#pragma unroll
    for (int d0 = 0; d0 < 4; ++d0) { const unsigned w = cvt_pk_bf16(o[d0][r] * rli[r], 0.f); stg[orow * 128 + d0 * 32 + r32] = (bf16_t)(w & 0xffffu); } }
  asm volatile("s_waitcnt lgkmcnt(0)" ::: "memory");
#pragma unroll
  for (int i = 0; i < 8; ++i) { const int row = i * 4 + (lane >> 4), ch = lane & 15; const u32x4 v = *(const u32x4*)(stg + row * 128 + ch * 8);
    *(u32x4*)(Ob + hw * D + (long)(wq * QBLK + row) * ldo + ch * 8) = v; }
  if (lse != nullptr && hi == 0) lse[hw + (long)(wq * QBLK + r32) * ldlse] = (m_reg + __builtin_amdgcn_logf(l_reg)) * LN2;
  __syncthreads();
#undef SLOAD
#undef SWRITE
}
template <bool PRE>
__device__ __forceinline__ void partialSM(f32x16& p0, f32x16& p1, float& m_reg, float& mn, float& alpha) {
  constexpr float cs = PRE ? 1.0f : C;
  float pmax = p0[0];
#pragma unroll
  for (int r = 1; r < 16; ++r) pmax = fmaxf(pmax, p0[r]);
#pragma unroll
  for (int r = 0; r < 16; ++r) pmax = fmaxf(pmax, p1[r]);
  { auto rr = __builtin_amdgcn_permlane32_swap(__float_as_uint(pmax), __float_as_uint(pmax), false, false);
    pmax = fmaxf(__uint_as_float(rr[0]), __uint_as_float(rr[1])); }
  if (__builtin_expect(__all((pmax - m_reg) * cs <= THR2), 1)) { mn = m_reg; alpha = 1.f; }
  else { mn = fmaxf(m_reg, pmax); alpha = __builtin_amdgcn_exp2f((m_reg - mn) * cs); m_reg = mn; }
  const float mnC = -mn * cs;
#pragma unroll
  for (int r = 0; r < 16; ++r) p0[r] = fmaf(p0[r], cs, mnC);
#pragma unroll
  for (int r = 0; r < 16; ++r) p1[r] = fmaf(p1[r], cs, mnC);
#pragma unroll
  for (int r = 0; r < 16; ++r) p0[r] = __builtin_amdgcn_exp2f(p0[r]);
}
__device__ __forceinline__ void partialSM_fixed(f32x16& p0) {
#pragma unroll
  for (int r = 0; r < 16; ++r) p0[r] = __builtin_amdgcn_exp2f(p0[r]);
}
__device__ __forceinline__ void finishSM(f32x16& p0, f32x16& p1, float alpha, float& l_reg, bf16x8& pa0, bf16x8& pa1, bf16x8& pa2, bf16x8& pa3) {
#pragma unroll
  for (int r = 0; r < 16; ++r) p1[r] = __builtin_amdgcn_exp2f(p1[r]);
  float ps = 0;
#pragma unroll
  for (int r = 0; r < 16; ++r) ps += p0[r];
#pragma unroll
  for (int r = 0; r < 16; ++r) ps += p1[r];
  { auto rr = __builtin_amdgcn_permlane32_swap(__float_as_uint(ps), __float_as_uint(ps), false, false);
    ps = __uint_as_float(rr[0]) + __uint_as_float(rr[1]); }
  l_reg = l_reg * alpha + ps;
#define PK4(P, BASE, OUT) do { unsigned a0 = cvt_pk_bf16(P[BASE + 0], P[BASE + 1]), a1 = cvt_pk_bf16(P[BASE + 2], P[BASE + 3]);   \
    unsigned b0 = cvt_pk_bf16(P[BASE + 4], P[BASE + 5]), b1 = cvt_pk_bf16(P[BASE + 6], P[BASE + 7]);                              \
    auto r0 = __builtin_amdgcn_permlane32_swap(a0, b0, false, false); auto r1 = __builtin_amdgcn_permlane32_swap(a1, b1, false, false); \
    u32x4 w = {r0[0], r1[0], r0[1], r1[1]}; OUT = *reinterpret_cast<bf16x8*>(&w); } while (0)
  PK4(p0, 0, pa0); PK4(p0, 8, pa1); PK4(p1, 0, pa2); PK4(p1, 8, pa3);
#undef PK4
}
template <bool PRE>
__device__ __forceinline__ void attn_unit_dense(const bf16_t* __restrict__ Qb, long ldq, const bf16_t* __restrict__ Kh, const bf16_t* __restrict__ Vh, long ldk,
                                                bf16_t* __restrict__ Ob, long ldo, int ntile, float mfix2, char* lds) {
  const int tid = opaque_tid(), lane = tid & 63, r32 = lane & 31, hi = lane >> 5; const int wid = __builtin_amdgcn_readfirstlane(tid >> 6);
  float* ws = (float*)(lds + OFF_WS) + wid * 64; float* li_l = ws; float* al_l = ws + 32;
  const bool fixm = PRE && mfix2 >= 0.f;
  float m_reg = -1e30f, l_reg = 0; f32x16 o[4] = {}; bf16x8 qr[8];
  { const bf16_t* Qw = Qb + (long)(wid * QBLK + r32) * ldq + hi * 8;
#pragma unroll
    for (int d0 = 0; d0 < 8; ++d0) qr[d0] = *reinterpret_cast<const bf16x8*>(Qw + d0 * 16); }
  const int sr = tid >> 4, sc = (tid & 15) * 8, vst0 = v_st(sr, sc), vst1 = v_st(32 + sr, sc);
  const int vb0 = (int)(uintptr_t)lds + v_rd_base(lane);
  bf16x8 vsE0, vsE1, ksE0, ksE1, vsO0, vsO1, ksO0, ksO1;
#define SLOAD_E(k0) do { vsE0 = *reinterpret_cast<const bf16x8*>(&Vh[(long)((k0) + sr) * ldk + sc]); vsE1 = *reinterpret_cast<const bf16x8*>(&Vh[(long)((k0) + 32 + sr) * ldk + sc]); \
    ksE0 = *reinterpret_cast<const bf16x8*>(&Kh[(long)((k0) + sr) * ldk + sc]); ksE1 = *reinterpret_cast<const bf16x8*>(&Kh[(long)((k0) + 32 + sr) * ldk + sc]); } while (0)
#define SLOAD_O(k0) do { vsO0 = *reinterpret_cast<const bf16x8*>(&Vh[(long)((k0) + sr) * ldk + sc]); vsO1 = *reinterpret_cast<const bf16x8*>(&Vh[(long)((k0) + 32 + sr) * ldk + sc]); \
    ksO0 = *reinterpret_cast<const bf16x8*>(&Kh[(long)((k0) + sr) * ldk + sc]); ksO1 = *reinterpret_cast<const bf16x8*>(&Kh[(long)((k0) + 32 + sr) * ldk + sc]); } while (0)
#define SWRITE_E(bo) do { char* B_ = lds + (bo); *(bf16x8*)(B_ + vst0) = vsE0; *(bf16x8*)(B_ + vst1) = vsE1; const int kc = sc * 2; \
    *(bf16x8*)(B_ + SHM_V + KSWZ(sr, kc)) = ksE0; *(bf16x8*)(B_ + SHM_V + KSWZ(32 + sr, kc)) = ksE1; } while (0)
#define SWRITE_O(bo) do { char* B_ = lds + (bo); *(bf16x8*)(B_ + vst0) = vsO0; *(bf16x8*)(B_ + vst1) = vsO1; const int kc = sc * 2; \
    *(bf16x8*)(B_ + SHM_V + KSWZ(sr, kc)) = ksO0; *(bf16x8*)(B_ + SHM_V + KSWZ(32 + sr, kc)) = ksO1; } while (0)
#define SWAIT() asm volatile("s_waitcnt vmcnt(4)" ::: "memory")
#define PSM(P0, P1, MN, AL) do { if (fixm) { partialSM_fixed(P0); AL = 1.f; MN = 0.f; } else partialSM<PRE>(P0, P1, m_reg, MN, AL); } while (0)
#define RESC(a) do { if (!fixm) if (__any((a) < 1.f)) { if (hi == 0) al_l[r32] = (a); asm volatile("s_waitcnt lgkmcnt(0)" ::: "memory"); \
    _Pragma("unroll") for (int d = 0; d < 4; ++d) _Pragma("unroll") for (int r = 0; r < 16; ++r) o[d][r] *= al_l[crow(r, hi)]; } } while (0)
#define ROT3() do { const int t_ = bV; bV = bK; bK = bW; bW = t_; } while (0)
  f32x16 pA0, pA1, pB0, pB1; float mnA, mnB, alA, alB; bf16x8 pa0, pa1, pa2, pa3; const int NT = ntile;
  int bV = 0, bK = 0, bW = BUF3;
  SLOAD_E(0); SLOAD_O(KVBLK); asm volatile("s_waitcnt vmcnt(4)" ::: "memory"); SWRITE_E(0); SLOAD_E(2 * KVBLK);
  __syncthreads();
  SWAIT(); SWRITE_O(bW);
  qkt(pA0, pA1, lds + bK + SHM_V, qr, r32, hi); PSM(pA0, pA1, mnA, alA);
  if (3 < NT) SLOAD_O(3 * KVBLK);
  bV = 0; bK = BUF3; bW = 2 * BUF3;
  for (int j = 1; j + 1 < NT; j += 2) {
    __syncthreads(); SWAIT(); SWRITE_E(bW);
    SBAR(); qkt(pB0, pB1, lds + bK + SHM_V, qr, r32, hi);
    finishSM(pA0, pA1, alA, l_reg, pa0, pa1, pa2, pa3); SBAR();
    if (j + 3 < NT) SLOAD_E((j + 3) * KVBLK); SBAR();
    pv_d0(o, vb0 + bV, pa0, pa1, pa2, pa3); PSM(pB0, pB1, mnB, alB);
    RESC(alB); ROT3();
    __syncthreads(); SWAIT(); SWRITE_O(bW);
    SBAR(); qkt(pA0, pA1, lds + bK + SHM_V, qr, r32, hi);
    finishSM(pB0, pB1, alB, l_reg, pa0, pa1, pa2, pa3); SBAR();
    if (j + 4 < NT) SLOAD_O((j + 4) * KVBLK); SBAR();
    pv_d0(o, vb0 + bV, pa0, pa1, pa2, pa3); PSM(pA0, pA1, mnA, alA);
    RESC(alA); ROT3();
  }
  __syncthreads();
  SBAR(); qkt(pB0, pB1, lds + bK + SHM_V, qr, r32, hi);
  finishSM(pA0, pA1, alA, l_reg, pa0, pa1, pa2, pa3); SBAR();
  pv_d0(o, vb0 + bV, pa0, pa1, pa2, pa3); PSM(pB0, pB1, mnB, alB);
  RESC(alB); ROT3();
  finishSM(pB0, pB1, alB, l_reg, pa0, pa1, pa2, pa3); SBAR();
  pv_d0(o, vb0 + bV, pa0, pa1, pa2, pa3);
#undef ROT3
  if (hi == 0) li_l[r32] = l_reg; asm volatile("s_waitcnt lgkmcnt(0)" ::: "memory");
  float rli[16];
#pragma unroll
  for (int r = 0; r < 16; ++r) rli[r] = __builtin_amdgcn_rcpf(li_l[crow(r, hi)]);
  __syncthreads();
  bf16_t* stg = (bf16_t*)(lds + wid * 8192);
#pragma unroll
  for (int r = 0; r < 16; ++r) { const int orow = crow(r, hi);
#pragma unroll
    for (int d0 = 0; d0 < 4; ++d0) { const unsigned w = cvt_pk_bf16(o[d0][r] * rli[r], 0.f); stg[orow * 128 + d0 * 32 + r32] = (bf16_t)(w & 0xffffu); } }
  asm volatile("s_waitcnt lgkmcnt(0)" ::: "memory");
#pragma unroll
  for (int i = 0; i < 8; ++i) { const int row = i * 4 + (lane >> 4), ch = lane & 15; const u32x4 v = *(const u32x4*)(stg + row * 128 + ch * 8);
    *(u32x4*)(Ob + (long)(wid * QBLK + row) * ldo + ch * 8) = v; }
  __syncthreads();
#undef PSM
#undef SLOAD_E
#undef SLOAD_O
#undef SWRITE_E
#undef SWRITE_O
#undef SWAIT
#undef RESC
}
#undef SBAR
}

#define XB_TMO      128
#define XB_XCNT(j)  (256  + 64 * (j))
#define XB_XSUB(j)  (1280 + 64 * (j))
#define XB_XGEN(j)  (2304 + 64 * (j))
#define XB_TOP      3328
#define XB_TOPGEN   3392
#define XCD_BAR_WORDS 3456
#define XB_SPIN_CAP (1u << 18)
__device__ __forceinline__ unsigned xb_ld(unsigned* p)              { return __hip_atomic_load(p, __ATOMIC_RELAXED, __HIP_MEMORY_SCOPE_AGENT); }
__device__ __forceinline__ unsigned xb_add(unsigned* p, unsigned v) { return __hip_atomic_fetch_add(p, v, __ATOMIC_RELAXED, __HIP_MEMORY_SCOPE_AGENT); }
__device__ __forceinline__ unsigned xb_xcc_id() { return (unsigned)__builtin_amdgcn_s_getreg((3 << 11) | 20) & 0xFu; }
#define XB_SPIN(cond, bar) do { unsigned _sp = 0; while (cond) { __builtin_amdgcn_s_sleep(1); \
    if ((++_sp & 255u) == 0u) { if (xb_ld(&(bar)[XB_TMO])) break; if (_sp > XB_SPIN_CAP) { atomicAdd(&(bar)[XB_TMO], 1u); break; } } } } while (0)
struct XcdBarrier { unsigned* bar; unsigned x; volatile LAS unsigned* st; };
__device__ __forceinline__ XcdBarrier xcd_barrier_post(unsigned* bar, volatile LAS unsigned* st) {
    XcdBarrier b; b.bar = bar; b.x = xb_xcc_id(); b.st = st;
    if (threadIdx.x == 0) (void)xb_add(&bar[XB_XCNT(b.x)], 1u);
    return b;
}
__device__ __forceinline__ void xcd_barrier_complete(unsigned* bar, unsigned x, unsigned& nloc, unsigned& nx) {
    const unsigned G = gridDim.x * gridDim.y * gridDim.z;
    unsigned sum, cnt, mine, sp = 0u;
    for (;;) {
        sum = 0u; cnt = 0u; mine = 0u;
#pragma unroll
        for (unsigned j = 0; j < 16; ++j) { const unsigned c = xb_ld(&bar[XB_XCNT(j)]); sum += c; cnt += (c > 0u) ? 1u : 0u; mine = (j == x) ? c : mine; }
        if (sum == G) break;
        __builtin_amdgcn_s_sleep(1);
        if ((++sp & 255u) == 0u) { if (xb_ld(&bar[XB_TMO])) break; if (sp > XB_SPIN_CAP) { atomicAdd(&bar[XB_TMO], 1u); break; } }
    }
    nloc = mine > 0u ? mine : 1u; nx = cnt > 0u ? cnt : 1u;
}
__device__ __forceinline__ void xcd_barrier(const XcdBarrier& b) {
    asm volatile("s_waitcnt vmcnt(0)" ::: "memory");
    __syncthreads();
    if (threadIdx.x == 0) {
        unsigned* bar = b.bar;
        __builtin_amdgcn_s_waitcnt(0);
        unsigned nloc = b.st[0], nx = b.st[1];
        if (nloc == 0u) { xcd_barrier_complete(bar, b.x, nloc, nx); b.st[0] = nloc; b.st[1] = nx; }
        const unsigned old = xb_add(&bar[XB_XSUB(b.x)], 1u);
        const unsigned gen = old / nloc;
        if (old + 1u == (gen + 1u) * nloc) {
            __builtin_amdgcn_fence(__ATOMIC_RELEASE, "agent");
            asm volatile("s_waitcnt vmcnt(0)" ::: "memory");
            const unsigned og = xb_add(&bar[XB_TOP], 1u);
            const unsigned tg = og / nx;
            if (og + 1u == (tg + 1u) * nx) xb_add(&bar[XB_TOPGEN], 1u);
            else XB_SPIN(xb_ld(&bar[XB_TOPGEN]) == tg, bar);
            __builtin_amdgcn_fence(__ATOMIC_ACQUIRE, "agent");
            xb_add(&bar[XB_XGEN(b.x)], 1u);
            asm volatile("s_waitcnt vmcnt(0)" ::: "memory");
        } else {
            XB_SPIN(xb_ld(&bar[XB_XGEN(b.x)]) == gen, bar);
            __builtin_amdgcn_fence(__ATOMIC_ACQUIRE, "agent");
            asm volatile("s_waitcnt vmcnt(0)" ::: "memory");
        }
    }
    __syncthreads();
}

constexpr int NWAVES = 8;
constexpr int RING_BYTES = 131072, LDSCTL_OFF = RING_BYTES, MISC_OFF = LDSCTL_OFF + 320, LDS_BYTES = 147456;
static_assert(att::LDS_BYTES <= RING_BYTES, "attention scratch inside the ring region");

struct Args {
    const float* in[20]; float* out; unsigned char* ws; int ph_lo, ph_hi;
};

__device__ __forceinline__ float wave_sum(float v) {
#pragma unroll
    for (int o = 1; o < 64; o <<= 1) v += __shfl_xor(v, o);
    return v;
}
__device__ __forceinline__ unsigned f2bf(float f) { unsigned u = __builtin_bit_cast(unsigned, f); return (u + 0x7fffu + ((u >> 16) & 1u)) >> 16; }
__device__ __forceinline__ unsigned pk2(float lo, float hi) { return f2bf(lo) | (f2bf(hi) << 16); }

__device__ __forceinline__ void transpose_item(const float* W, const float* gain, int K, int N, bf16_t* WT, int k0, int n0, int drow0, LAS float* scr, int lane) {
    const int kr = lane >> 3, nq = lane & 7;
    f32x4 v[8]; float gk[8];
#pragma unroll
    for (int i = 0; i < 8; ++i) { v[i] = *(const GAS f32x4*)(W + (size_t)(k0 + kr + 8 * i) * N + n0 + 4 * nq); gk[i] = gain ? gain[k0 + kr + 8 * i] : 1.0f; }
#pragma unroll
    for (int i = 0; i < 8; ++i) { LAS float* d = scr + (kr + 8 * i) * 33 + 4 * nq; d[0] = v[i].x * gk[i]; d[1] = v[i].y * gk[i]; d[2] = v[i].z * gk[i]; d[3] = v[i].w * gk[i]; }
    asm volatile("s_waitcnt lgkmcnt(0)" ::: "memory");
    const int c = lane & 7;
#pragma unroll
    for (int j = 0; j < 4; ++j) { const int n = (lane >> 3) + 8 * j; const LAS float* s = scr + (8 * c) * 33 + n;
        u32x4 o; o.x = pk2(s[0 * 33], s[1 * 33]); o.y = pk2(s[2 * 33], s[3 * 33]); o.z = pk2(s[4 * 33], s[5 * 33]); o.w = pk2(s[6 * 33], s[7 * 33]);
        *(GAS u32x4*)(WT + (size_t)(drow0 + n) * K + k0 + 8 * c) = o; }
    asm volatile("s_waitcnt lgkmcnt(0)" ::: "memory");
}

__device__ __forceinline__ int t5_bucket(int rel) {
    const int n = rel < 0 ? -rel : rel; int b;
    if (n < 8) b = n; else { b = 8 + (n >= 15) + (n >= 27) + (n >= 50) + (n >= 91) + (n >= 166) + (n >= 305) + (n >= 559); if (b > 15) b = 15; }
    return b + (rel > 0 ? 16 : 0);
}
__device__ __forceinline__ void sincos_d(double a, double& s, double& c) {
    const double k = __builtin_rint(a * 0.63661977236758134308);
    const double r = (a - k * 1.57079632679489655800) - k * 6.12323399573676603587e-17;
    const double r2 = r * r;
    double ps = 1.0 / 6227020800.0;
    ps = ps * r2 - 1.0 / 39916800.0; ps = ps * r2 + 1.0 / 362880.0; ps = ps * r2 - 1.0 / 5040.0; ps = ps * r2 + 1.0 / 120.0; ps = ps * r2 - 1.0 / 6.0; ps = ps * r2 + 1.0;
    const double sr = r * ps;
    double pc = -1.0 / 87178291200.0;
    pc = pc * r2 + 1.0 / 479001600.0; pc = pc * r2 - 1.0 / 3628800.0; pc = pc * r2 + 1.0 / 40320.0; pc = pc * r2 - 1.0 / 720.0; pc = pc * r2 + 1.0 / 24.0; pc = pc * r2 - 0.5; pc = pc * r2 + 1.0;
    const int q = ((int)k) & 3;
    s = (q == 0) ? sr : (q == 1) ? pc : (q == 2) ? -sr : -pc;
    c = (q == 0) ? pc : (q == 1) ? -sr : (q == 2) ? -pc : sr;
}

__device__ __forceinline__ float row_to_bf16(const float* xrow, bf16_t* orow, int lane) {
    const GAS f32x4* xr = (const GAS f32x4*)xrow + lane;
    f32x4 v[8]; float s = 0.f;
#pragma unroll
    for (int j = 0; j < 8; ++j) { v[j] = xr[64 * j]; s += (v[j].x * v[j].x + v[j].y * v[j].y) + (v[j].z * v[j].z + v[j].w * v[j].w); }
    GAS u32x2* o8 = (GAS u32x2*)orow + lane;
#pragma unroll
    for (int j = 0; j < 8; ++j) { u32x2 w; w.x = cvt_pk_bf16(v[j].x, v[j].y); w.y = cvt_pk_bf16(v[j].z, v[j].w); o8[64 * j] = w; }
    return wave_sum(s);
}
__device__ __forceinline__ void rms_row_out(const bf16_t* xrow, float* orow, const float* g, float rstd, int lane) {
    const GAS u32x2* xr = (const GAS u32x2*)xrow + lane; GAS f32x4* o = (GAS f32x4*)orow + lane; const GAS f32x4* gr = (const GAS f32x4*)g + lane;
#pragma unroll
    for (int j = 0; j < 8; ++j) { const u32x2 w = xr[64 * j]; const f32x4 gg = gr[64 * j]; f32x4 v = {bflo(w.x), bfhi(w.x), bflo(w.y), bfhi(w.y)}; o[64 * j] = v * rstd * gg; }
}

__device__ __forceinline__ void qknorm_rows(bf16_t* qkv, const float* ropec, const float* ropes, const float* qg, const float* kg, int row_base, int tid) {
    const int lane = tid & 63, wave = tid >> 6;
    const int head = lane >> 3, q8 = lane & 7, hf = q8 >> 2, a = q8 & 3;
    const float* gp = (head < 6) ? qg : kg;
    const float osc = (head < 6) ? 0.088388347648318440f * 1.4426950408889634f : 1.0f;
    float g1[8], g2[8];
#pragma unroll
    for (int e = 0; e < 8; ++e) { g1[e] = gp[hf * 64 + 8 * a + e]; g2[e] = gp[hf * 64 + 32 + 8 * a + e]; }
    for (int t0 = 0; t0 < 32; t0 += 4) {
        u32x4 w1[4], w2[4]; f32x4 cs[4][4];
#pragma unroll
        for (int i = 0; i < 4; ++i) { const int m = row_base + wave + 8 * (t0 + i);
            const int s = (m < NPROMPT) ? (m & (SEQ_P - 1)) : ((m - NPROMPT) & (SEQ_S - 1)); const int n = hf ? (s & 63) : (s >> 6);
            const bf16_t* p1 = qkv + (size_t)m * PROJ + head * HD + hf * 64 + 8 * a;
            w1[i] = *(const GAS u32x4*)p1; w2[i] = *(const GAS u32x4*)(p1 + 32);
            cs[i][0] = *(const GAS f32x4*)(ropec + n * 32 + 8 * a); cs[i][1] = *(const GAS f32x4*)(ropec + n * 32 + 8 * a + 4);
            cs[i][2] = *(const GAS f32x4*)(ropes + n * 32 + 8 * a); cs[i][3] = *(const GAS f32x4*)(ropes + n * 32 + 8 * a + 4); }
#pragma unroll
        for (int i = 0; i < 4; ++i) { const int m = row_base + wave + 8 * (t0 + i);
            bf16_t* p1 = qkv + (size_t)m * PROJ + head * HD + hf * 64 + 8 * a;
            float x1[8], x2[8];
#pragma unroll
            for (int e = 0; e < 4; ++e) { x1[2 * e] = bflo(w1[i][e]); x1[2 * e + 1] = bfhi(w1[i][e]); x2[2 * e] = bflo(w2[i][e]); x2[2 * e + 1] = bfhi(w2[i][e]); }
            float ss = 0.f;
#pragma unroll
            for (int e = 0; e < 8; ++e) ss += x1[e] * x1[e] + x2[e] * x2[e];
            ss += __shfl_xor(ss, 1); ss += __shfl_xor(ss, 2); ss += __shfl_xor(ss, 4);
            const float rstd = 1.0f / sqrtf(ss * (1.f / HD) + RMS_EPS);
            float o1[8], o2[8];
#pragma unroll
            for (int e = 0; e < 8; ++e) { const float cc = e < 4 ? cs[i][0][e & 3] : cs[i][1][e & 3], sn = e < 4 ? cs[i][2][e & 3] : cs[i][3][e & 3];
                const float y1 = x1[e] * rstd * g1[e], y2 = x2[e] * rstd * g2[e]; o1[e] = (y1 * cc - y2 * sn) * osc; o2[e] = (y1 * sn + y2 * cc) * osc; }
            u32x4 r1, r2;
#pragma unroll
            for (int e = 0; e < 4; ++e) { r1[e] = cvt_pk_bf16(o1[2 * e], o1[2 * e + 1]); r2[e] = cvt_pk_bf16(o2[2 * e], o2[2 * e + 1]); }
            *(GAS u32x4*)p1 = r1; *(GAS u32x4*)(p1 + 32) = r2; }
    }
}
__device__ __forceinline__ void crescale_rows(bf16_t* mix, const float* lsebuf, int row_base, int tid) {
    const int lane = tid & 63, wave = tid >> 6;
    for (int t0 = 0; t0 < 32; t0 += 4) {
        float ls[4][6]; u32x2 w[4][3];
#pragma unroll
        for (int i = 0; i < 4; ++i) { const int m = row_base + wave + 8 * (t0 + i);
#pragma unroll
            for (int k = 0; k < 6; ++k) ls[i][k] = lsebuf[(size_t)m * 6 + k];
            const GAS u32x2* p = (const GAS u32x2*)(mix + (size_t)m * MIXW + 1280) + lane;
#pragma unroll
            for (int j = 0; j < 3; ++j) w[i][j] = p[64 * j]; }
#pragma unroll
        for (int i = 0; i < 4; ++i) { const int m = row_base + wave + 8 * (t0 + i);
            float al[6];
#pragma unroll
            for (int j = 0; j < 2; ++j) { const float mx = fmaxf(fmaxf(ls[i][j], ls[i][2 + j]), ls[i][4 + j]);
                const float e0 = __expf(ls[i][j] - mx), e1 = __expf(ls[i][2 + j] - mx), e2 = __expf(ls[i][4 + j] - mx); const float inv = 1.0f / (e0 + e1 + e2);
                al[j] = e0 * inv; al[2 + j] = e1 * inv; al[4 + j] = e2 * inv; }
            GAS u32x2* p = (GAS u32x2*)(mix + (size_t)m * MIXW + 1280) + lane;
#pragma unroll
            for (int j = 0; j < 3; ++j) { const int hc = (4 * lane + 256 * j) >> 7; const float a = (hc == 0) ? al[0] : (hc == 1) ? al[1] : (hc == 2) ? al[2] : (hc == 3) ? al[3] : (hc == 4) ? al[4] : al[5];
                u32x2 v = w[i][j]; v.x = cvt_pk_bf16(bflo(v.x) * a, bfhi(v.x) * a); v.y = cvt_pk_bf16(bflo(v.y) * a, bfhi(v.y) * a); p[64 * j] = v; } }
    }
}

__global__ void __launch_bounds__(NWAVES * 64, 2) fwd(Args args) {
    extern __shared__ __attribute__((aligned(16))) unsigned char lds[];
    LAS unsigned char* ldsl = (LAS unsigned char*)lds;
    volatile LAS unsigned* MISC = (volatile LAS unsigned*)(ldsl + MISC_OFF);
    const int G = gridDim.x;
    unsigned char* ws = args.ws;
    gu32* ctl = (gu32*)(ws + WS_CTL);
    { const int tid0 = threadIdx.x; for (int u = tid0; u < (LDS_BYTES - LDSCTL_OFF) / 4; u += NWAVES * 64) ((LAS unsigned*)(ldsl + LDSCTL_OFF))[u] = 0u; }
    __syncthreads();
    XcdBarrier bar; bar.bar = (unsigned*)ctl + CW_BAR; bar.x = 0; bar.st = nullptr;
    if (ONE_LAUNCH) bar = xcd_barrier_post((unsigned*)ctl + CW_BAR, MISC + 8);
    int bx = blockIdx.x;
    if (ONE_LAUNCH) {
        if (threadIdx.x == 0) { const unsigned xcc = xb_xcc_id(); const unsigned rk = __hip_atomic_fetch_add(ctl + CW_XRANK + 64 * (xcc & 15u), 1u, __ATOMIC_RELAXED, __HIP_MEMORY_SCOPE_AGENT); MISC[12] = rk * 8u + xcc; }
        xcd_barrier(bar);
        if (threadIdx.x == 0) { bool ok = (G % 8 == 0);
            for (unsigned j = 0; j < 16; ++j) { const unsigned cnt = __hip_atomic_load(ctl + CW_XRANK + 64 * j, __ATOMIC_RELAXED, __HIP_MEMORY_SCOPE_AGENT); ok = ok && (cnt == (j < 8 ? (unsigned)G / 8u : 0u)); }
            if (!ok) MISC[12] = blockIdx.x; }
        __syncthreads();
        bx = __builtin_amdgcn_readfirstlane((int)MISC[12]);
    }
    const int lo = args.ph_lo, hi = args.ph_hi;
#ifndef PHMASK
#define PHMASK 0xffff
#endif
#define IN(k) (lo <= (k) && (k) < hi)
#define EN(b) ((PHMASK >> (b)) & 1)
#ifndef PROBE_DUP
#define PROBE_DUP 0
#endif
#define NREP(b) (1 + ((PROBE_DUP >> (b)) & 1))
#define REPSEAM(b) do { if (ONE_LAUNCH && NREP(b) > 1 && rep == 0) xcd_barrier(bar); } while (0)
#define SEAM(k) do { if (ONE_LAUNCH && IN(k) && IN((k) + 1)) xcd_barrier(bar); } while (0)
#define LANE_ID() const int tid = opaque_tid(), lane = tid & 63, wave = __builtin_amdgcn_readfirstlane(tid >> 6); const int vcu = (G % 8 == 0) ? (bx % 8) * (G / 8) + bx / 8 : bx; const int gw = vcu * NWAVES + wave, NGW = G * NWAVES; (void)lane; (void)gw; (void)NGW
#define ROPEC ((float*)(ws + WS_TAB))
#define ROPES (ROPEC + 128 * 32)
#define TABB (ROPES + 128 * 32)
#define TABC (TABB + 4 * 512)
#define LSEBUF ((float*)(ws + WS_LSE))
#define XB ((bf16_t*)(ws + WS_XB))
#define MB ((bf16_t*)(ws + WS_MB))
#define SSBUF ((pg8::ss_t*)(ws + WS_SS))
#define RSM ((pg8::ss_t*)(ws + WS_RSM))
#define QKV ((bf16_t*)(ws + WS_QKV))
#define MIX ((bf16_t*)(ws + WS_MIX))
#define HID ((bf16_t*)(ws + WS_HID))
#define QX ((bf16_t*)(ws + WS_QX))
#define OX ((bf16_t*)(ws + WS_OX))
#define KVX ((bf16_t*)(ws + WS_KVX))
    float* out = args.out;

    if (EN(13) && IN(0)) {
        LANE_ID();
        float* ropec = ROPEC; float* ropes = ROPES; float* tabB = TABB; float* tabC = TABC;
        LAS float* scr = (LAS float*)(ldsl + wave * 16384);
        constexpr int I_IN = 32 * 120, I_OUT = 32 * 64, I_CQ = 32 * 16, I_CKV = 32 * 32, I_CO = 8 * 64, I_FI = 32 * 352, I_FO = 88 * 64;
        constexpr int I_LAYER = I_IN + I_OUT + I_CQ + I_CKV + I_CO + I_FI + I_FO;
        for (int it = gw; it < DEPTH * I_LAYER; it += NGW) {
            const int l = it / I_LAYER; int r = it % I_LAYER;
            const float* W; bf16_t* WT; int K, N; const float* gain = nullptr;
            if (r < I_IN) { gain = args.in[4] + (size_t)l * DM; W = args.in[5] + (size_t)l * DM * PROJ; WT = (bf16_t*)(ws + WS_WIN) + (size_t)l * PROJ * DM; K = DM; N = PROJ; }
            else if ((r -= I_IN) < I_OUT) { W = args.in[10] + (size_t)l * MIXW * DM; WT = (bf16_t*)(ws + WS_WOUT) + (size_t)l * DM * MIXW; K = MIXW; N = DM; }
            else if ((r -= I_OUT) < I_CQ) { gain = args.in[11] + (size_t)l * DM; W = args.in[13] + (size_t)l * DM * XW; WT = (bf16_t*)(ws + WS_WCQ) + (size_t)l * XW * DM; K = DM; N = XW; }
            else if ((r -= I_CQ) < I_CKV) { gain = args.in[12] + (size_t)l * DM; W = args.in[14] + (size_t)l * DM * 2 * XW; WT = (bf16_t*)(ws + WS_WCKV) + (size_t)l * 2 * XW * DM; K = DM; N = 2 * XW; }
            else if ((r -= I_CKV) < I_CO) { W = args.in[15] + (size_t)l * XW * DM; WT = (bf16_t*)(ws + WS_WCO) + (size_t)l * DM * XW; K = XW; N = DM; }
            else if ((r -= I_CO) < I_FI) { gain = args.in[16] + (size_t)l * DM; W = args.in[17] + (size_t)l * DM * 2 * DFF; WT = (bf16_t*)(ws + WS_WFI) + (size_t)l * 2 * DFF * DM; K = DM; N = 2 * DFF; }
            else { r -= I_FI; W = args.in[18] + (size_t)l * DFF * DM; WT = (bf16_t*)(ws + WS_WFO) + (size_t)l * DM * DFF; K = DFF; N = DM; }
            const int nblk = N / 32, kb = r / nblk, nb = r % nblk, n0 = 32 * nb;
            int drow0 = n0;
            if (N == 2 * DFF) drow0 = (n0 < DFF) ? 256 * (n0 / 128) + (n0 % 128) : 256 * ((n0 - DFF) / 128) + 128 + ((n0 - DFF) % 128);
            transpose_item(W, gain, K, N, WT, 64 * kb, n0, drow0, scr, lane);
        }
        { bf16_t* xb = XB; pg8::ss_t* ss0 = SSBUF; bf16_t* mb = MB; pg8::ss_t* rsm = RSM;
          for (int m = gw; m < NTOK; m += NGW) { const float* xr = (m < NPROMPT) ? args.in[0] + (size_t)m * DM : args.in[1] + (size_t)(m - NPROMPT) * DM;
              const float q = row_to_bf16(xr, xb + (size_t)m * DM, lane); if (lane == 0) ss0[m] = (pg8::ss_t)(q * pg8::SS_SCALE); }
          for (int m = gw; m < MEMROWS; m += NGW) { const float* mr = (m < 2 * MEMLEN) ? args.in[2] + (size_t)m * DM : args.in[3] + (size_t)(m - 2 * MEMLEN) * DM;
              const float q = row_to_bf16(mr, mb + (size_t)m * DM, lane); if (lane == 0) rsm[m] = (pg8::ss_t)(q * pg8::SS_SCALE); } }
        const int gt = vcu * (NWAVES * 64) + tid, NGT = G * NWAVES * 64;
        const float* rel_bias = args.in[9];
        for (int e = gt; e < 4096 + 2048 + 3072; e += NGT) {
            if (e < 4096) { const int n = e >> 5, i = e & 31;
                double invd = 1.0; for (int q = 0; q < i; ++q) invd *= 0.7498942093324559;
                const float inv = (float)invd;
                const float ang = (float)n * inv; double s, c; sincos_d((double)ang, s, c); ropec[e] = (float)c; ropes[e] = (float)s; }
            else if (e < 4096 + 2048) { const int t = e - 4096, h = t >> 9, i = t & 511; const int rel = i - 96 - 128;
                float v = -INFINITY; if (rel >= -128 && rel <= 128) v = rel_bias[t5_bucket(rel) * 10 + h] * att::LOG2E;
                tabB[t] = v; }
            else { const int t = e - 6144, hc = t >> 9, i = t & 511; const int off = i - 96 - 64; const int d = (hc < 2) ? 1 : (hc < 4) ? 4 : 16;
                float v = -INFINITY; if (off >= -64 && off <= 64) v = rel_bias[t5_bucket(off * d) * 10 + 4 + hc] * att::LOG2E;
                tabC[t] = v; }
        }
    }
    SEAM(0);

    for (int l = 0; l < DEPTH; ++l) {
        const int pb = 1 + PPL * l;
#define XS0 ((l == 0) ? args.in[0] : (const float*)out)
#define XS1 ((l == 0) ? args.in[1] : (const float*)out + (size_t)NPROMPT * DM)
        if (EN(0) && IN(pb + 0)) for (int rep = 0; rep < NREP(0); ++rep) {
            { const bf16_t* Win = (const bf16_t*)(ws + WS_WIN) + (size_t)l * PROJ * DM;
              pg8::Gemm g{XB, Win, NTOK, PROJ, DM}; pg8::StaticOrder S; S.init(NTOK, PROJ, G, bx);
              pg8::EpiBf16 E{QKV, PROJ, SSBUF + (size_t)(3 * l) * NTOK};
              pg8::gemm_phase<pg8::EpiBf16, pg8::StaticOrder, true, true>(ldsl, g, S, E); }
            if (l == 0) {
              pg8::Gemm g{MB, (const bf16_t*)(ws + WS_WCKV), MEMROWS, 4 * 2 * XW, DM}; pg8::StaticOrder S; S.init(MEMROWS, 4 * 2 * XW, G, (bx + G - 64) % G);
              pg8::EpiBf16 E{KVX, 4 * 2 * XW, RSM};
              pg8::gemm_phase<pg8::EpiBf16, pg8::StaticOrder, true, true>(ldsl, g, S, E); }
            REPSEAM(0);
        }
        SEAM(pb + 0);
        if (EN(1) && IN(pb + 1)) {
            const int tid = opaque_tid(); const float* tabC = TABC; float* lsebuf = LSEBUF;
            gu32* qhead = ctl + CW_QUEUE + 64 * (2 * l);
            volatile LAS unsigned* uidw = (volatile LAS unsigned*)(ldsl + att::OFF_UID);
            for (;;) {
                if (tid == 0) uidw[0] = __hip_atomic_fetch_add(qhead, 1u, __ATOMIC_RELAXED, __HIP_MEMORY_SCOPE_AGENT);
                __syncthreads();
                const int u = (int)uidw[0];
                __syncthreads();
                if (u >= 1344) break;
                if (u < 960 && u % 5 == 4) {
                    qknorm_rows(QKV, ROPEC, ROPES, args.in[6] + (size_t)l * HD, args.in[7] + (size_t)l * HD, (u / 5) * 256, tid);
                } else { const int v0 = (u < 960) ? u - u / 5 : u - 192;
                {
                    const int v = v0, gi = v % 3, idx = v / 3; const int d = (gi == 0) ? 1 : (gi == 1) ? 4 : 16;
                    long row0; int j, L;
                    if (idx < 128) { row0 = (long)(idx / 64) * SEQ_P; j = idx % 64; L = SEQ_P; } else { const int i2 = idx - 128; row0 = NPROMPT + (long)(i2 / 32) * SEQ_S; j = i2 % 32; L = SEQ_S; }
                    const int res = j % d, qbr = j / d, p0 = qbr * 128, Lr = L / d;
                    int tlo = p0 / 64 - 1, thi = p0 / 64 + 3; if (tlo < 0) tlo = 0; if (thi > Lr / 64) thi = Lr / 64;
                    const long rq = row0 + (long)p0 * d + res, rk = row0 + res; const int hc = 2 * gi;
                    att::attn_unit<true>(QKV + rq * PROJ + COL_QC + hc * HD, (long)d * PROJ, QKV + rk * PROJ + COL_KC + gi * HD, QKV + rk * PROJ + COL_VC + gi * HD, (long)d * PROJ,
                                         MIX + rq * MIXW + 1280 + hc * HD, (long)d * MIXW, tlo, thi, p0, 64, tabC + hc * 512, 321, -1e30f, -1e30f, 0.f, lsebuf + rq * 6 + hc, (long)d * 6, (char*)lds);
                } }
            }
        }
        SEAM(pb + 1);
        if (EN(2) && IN(pb + 2)) for (int rep = 0; rep < NREP(2); ++rep) {
            const int tid = opaque_tid(); const float* tabB = TABB;
            float mfix2;
            { const float* qg = args.in[6] + (size_t)l * HD; const float* kg = args.in[7] + (size_t)l * HD; const int ln = tid & 63;
              float a = fmaxf(fabsf(qg[ln]), fabsf(qg[ln + 64])), b = fmaxf(fabsf(kg[ln]), fabsf(kg[ln + 64]));
#pragma unroll
              for (int o = 1; o < 64; o <<= 1) { a = fmaxf(a, __shfl_xor(a, o)); b = fmaxf(b, __shfl_xor(b, o)); }
              mfix2 = __builtin_amdgcn_readfirstlane(128.f * a * b * 1.02f * att::C); if (!(mfix2 <= 40.f)) mfix2 = -1.f; }
            gu32* qhead = ctl + CW_QUEUE + 64 * (2 * l + 1 + 8 * rep);
            volatile LAS unsigned* uidw = (volatile LAS unsigned*)(ldsl + att::OFF_UID);
            const float* sink = args.in[8] + (size_t)l * 4;
            for (;;) {
                if (tid == 0) uidw[0] = __hip_atomic_fetch_add(qhead, 1u, __ATOMIC_RELAXED, __HIP_MEMORY_SCOPE_AGENT);
                __syncthreads();
                const int u = (int)uidw[0];
                __syncthreads();
                if (u >= 1152 + 192 + 768) break;
                if (u < 1152) {
                    int seq, kvh, qb, gi, L;
                    if (u < 384) { seq = u / 192; const int r = u % 192; kvh = r / 96; const int r2 = r % 96; qb = r2 / 3; gi = r2 % 3; L = SEQ_P; }
                    else { const int v = u - 384; seq = 2 + v / 96; const int r = v % 96; kvh = r / 48; const int r2 = r % 48; qb = r2 / 3; gi = r2 % 3; L = SEQ_S; }
                    const long row0 = (seq < 2) ? (long)seq * SEQ_P : (long)NPROMPT + (long)(seq - 2) * SEQ_S;
                    const int h = kvh * 3 + gi;
                    att::attn_unit_dense<true>(QKV + (row0 + qb * 256) * PROJ + COL_QA + h * HD, PROJ, QKV + row0 * PROJ + COL_KA + kvh * HD, QKV + row0 * PROJ + COL_VA + kvh * HD, PROJ,
                                         MIX + (row0 + qb * 256) * MIXW + h * HD, MIXW, L / 64, mfix2, (char*)lds);
                } else if (u < 1344) { if (rep == 0) crescale_rows(MIX, LSEBUF, (u - 1152) * 256, tid); }
                else {
                    const int v = u - 1344, qbg = v >> 1, kvh = v & 1; const long rowq = (long)qbg * 128;
                    long row0; int pos0, L;
                    if (rowq < NPROMPT) { row0 = (rowq / SEQ_P) * SEQ_P; pos0 = (int)(rowq % SEQ_P); L = SEQ_P; } else { const long rr = rowq - NPROMPT; row0 = NPROMPT + (rr / SEQ_S) * SEQ_S; pos0 = (int)(rr % SEQ_S); L = SEQ_S; }
                    int tlo = pos0 / 64 - 2, thi = pos0 / 64 + 4; if (tlo < 0) tlo = 0; if (thi > L / 64) thi = L / 64;
                    const int h = 2 * kvh;
                    att::attn_unit<true>(QKV + rowq * PROJ + COL_QB + h * HD, PROJ, QKV + row0 * PROJ + COL_KB + kvh * HD, QKV + row0 * PROJ + COL_VB + kvh * HD, PROJ,
                                         MIX + rowq * MIXW + 768 + h * HD, MIXW, tlo, thi, pos0, 128, tabB + h * 512, 449, sink[h] * att::LOG2E, sink[h + 1] * att::LOG2E, 1.0f, nullptr, 0, (char*)lds);
                }
            }
            REPSEAM(2);
        }
        SEAM(pb + 2);
        if (EN(3) && IN(pb + 3)) for (int rep = 0; rep < NREP(3); ++rep) {
            const bf16_t* Wout = (const bf16_t*)(ws + WS_WOUT) + (size_t)l * DM * MIXW;
            pg8::Gemm g{MIX, Wout, NTOK, DM, MIXW}; pg8::StaticOrder S; S.init(NTOK, DM, G, bx);
            pg8::EpiRes E{XB, SSBUF + (size_t)(rep ? NNORM : 3 * l + 1) * NTOK, rep ? 0.f : 1.f};
            pg8::gemm_phase<pg8::EpiRes, pg8::StaticOrder, true, true>(ldsl, g, S, E);
            REPSEAM(3);
        }
        SEAM(pb + 3);
        if (EN(4) && IN(pb + 4)) for (int rep = 0; rep < NREP(4); ++rep) {
            const bf16_t* Wcq = (const bf16_t*)(ws + WS_WCQ) + (size_t)l * XW * DM;
            pg8::Gemm g{XB, Wcq, NTOK, XW, DM}; pg8::StaticOrder S; S.init(NTOK, XW, G, bx); pg8::EpiBf16 E{QX, XW, SSBUF + (size_t)(3 * l + 1) * NTOK};
            pg8::gemm_phase<pg8::EpiBf16, pg8::StaticOrder, true, true>(ldsl, g, S, E);
            REPSEAM(4);
        }
        SEAM(pb + 4);
        if (EN(5) && IN(pb + 5)) for (int rep = 0; rep < NREP(5); ++rep) {
            for (int u = bx; u < 768; u += G) {
                const int qbg = u >> 2, h = u & 3; const long rowq = (long)qbg * 256;
                const int seq = (rowq < NPROMPT) ? (int)(rowq / SEQ_P) : 2 + (int)((rowq - NPROMPT) / SEQ_S);
                const bf16_t* kb = KVX + (size_t)seq * MEMLEN * (4 * 2 * XW) + l * (2 * XW) + h * HD;
                att::attn_unit_dense<false>(QX + rowq * XW + h * HD, XW, kb, kb + XW, 4 * 2 * XW, OX + rowq * XW + h * HD, XW, MEMLEN / 64, -1.f, (char*)lds);
            }
            REPSEAM(5);
        }
        SEAM(pb + 5);
        if (EN(6) && IN(pb + 6)) for (int rep = 0; rep < NREP(6); ++rep) {
            const bf16_t* Wco = (const bf16_t*)(ws + WS_WCO) + (size_t)l * DM * XW;
            pg8::Gemm g{OX, Wco, NTOK, DM, XW}; pg8::StaticOrder S; S.init(NTOK, DM, G, bx);
            pg8::EpiRes E{XB, SSBUF + (size_t)(rep ? NNORM : 3 * l + 2) * NTOK, rep ? 0.f : 1.f};
            pg8::gemm_phase<pg8::EpiRes, pg8::StaticOrder, true, true>(ldsl, g, S, E);
            REPSEAM(6);
        }
        SEAM(pb + 6);
        if (EN(7) && IN(pb + 7)) for (int rep = 0; rep < NREP(7); ++rep) {
            const bf16_t* Wfi = (const bf16_t*)(ws + WS_WFI) + (size_t)l * 2 * DFF * DM;
            pg8::Gemm g{XB, Wfi, NTOK, 2 * DFF, DM}; pg8::StaticOrder S; S.init(NTOK, 2 * DFF, G, bx);
            pg8::EpiSwiglu E{HID, DFF, SSBUF + (size_t)(3 * l + 2) * NTOK};
            pg8::gemm_phase<pg8::EpiSwiglu, pg8::StaticOrder, true, true>(ldsl, g, S, E);
            REPSEAM(7);
        }
        SEAM(pb + 7);
        if (EN(8) && IN(pb + 8)) for (int rep = 0; rep < NREP(8); ++rep) {
            const bf16_t* Wfo = (const bf16_t*)(ws + WS_WFO) + (size_t)l * DM * DFF;
            pg8::Gemm g{HID, Wfo, NTOK, DM, DFF}; pg8::StaticOrder S; S.init(NTOK, DM, G, bx);
            pg8::EpiRes E{XB, SSBUF + (size_t)(rep ? NNORM : 3 * l + 3) * NTOK, rep ? 0.f : 1.f};
            pg8::gemm_phase<pg8::EpiRes, pg8::StaticOrder, true, true>(ldsl, g, S, E);
            REPSEAM(8);
        }
        SEAM(pb + 8);
    }
    if (EN(14) && IN(NPHASE - 1)) {
        LANE_ID();
        const float* g = args.in[19]; const pg8::ss_t* ssl = SSBUF + (size_t)(NNORM - 1) * NTOK;
        for (int m = gw; m < NTOK; m += NGW) { const float rstd = 1.0f / sqrtf((float)ssl[m] * pg8::SS_INV_MEAN + RMS_EPS); rms_row_out(XB + (size_t)m * DM, out + (size_t)m * DM, g, rstd, lane); }
    }
#undef IN
#undef SEAM
}

extern "C" void kernel_launch(void* const* d_in, const int* in_sizes, int n_in, void* d_out, int out_size, void* d_ws, size_t ws_size, hipStream_t stream) {
    static int grid = 0;
    if (grid == 0) {
        if (n_in != 20 || out_size != NTOK * DM || ws_size < WS_END) { fprintf(stderr, "kernel_launch: unexpected shapes: n_in %d out %d ws %zu (need %zu)\n", n_in, out_size, ws_size, (size_t)WS_END); grid = -1; return; }
        int dev = 0, cus = 0, per_cu = 0;
        if (hipGetDevice(&dev) != hipSuccess || hipDeviceGetAttribute(&cus, hipDeviceAttributeMultiprocessorCount, dev) != hipSuccess) { grid = -1; return; }
        if (hipFuncSetAttribute((const void*)fwd, hipFuncAttributeMaxDynamicSharedMemorySize, LDS_BYTES) != hipSuccess) { fprintf(stderr, "kernel_launch: hipFuncSetAttribute failed\n"); grid = -1; return; }
        if (hipOccupancyMaxActiveBlocksPerMultiprocessor(&per_cu, (const void*)fwd, NWAVES * 64, LDS_BYTES) != hipSuccess || per_cu < 1) { fprintf(stderr, "kernel_launch: occupancy query says %d\n", per_cu); }
        (void)hipGetLastError();
        grid = cus;
    }
    if (grid < 0) return;
    (void)hipMemsetAsync((char*)d_ws + WS_CTL, 0, CTL_ZERO_BYTES, stream);
    Args a{};
    for (int i = 0; i < 20; ++i) a.in[i] = (const float*)d_in[i];
    a.out = (float*)d_out; a.ws = (unsigned char*)d_ws;
#if ONE_LAUNCH
    a.ph_lo = 0; a.ph_hi = NPHASE;
    hipLaunchKernelGGL(fwd, dim3(grid), dim3(NWAVES * 64), LDS_BYTES, stream, a);
#else
    for (int p = 0; p < NPHASE; ++p) { a.ph_lo = p; a.ph_hi = p + 1; hipLaunchKernelGGL(fwd, dim3(grid), dim3(NWAVES * 64), LDS_BYTES, stream, a); }
#endif
    const hipError_t le = hipPeekAtLastError();
    if (le != hipSuccess) fprintf(stderr, "kernel_launch: launch failed: %s\n", hipGetErrorName(le));
}
```

```cpp
#include <hip/hip_runtime.h>
#include <cstdio>
#include <cstdint>

#ifndef ONE_LAUNCH
#define ONE_LAUNCH 1
#endif

constexpr int DM = 2048, NTOK = 49152, NPROMPT = 16384, SEQ_P = 8192, SEQ_S = 4096, DEPTH = 4;
constexpr int PROJ = 3840, MIXW = 2048, XW = 512, DFF = 5632, MEMLEN = 256, MEMROWS = 2560, HD = 128;
constexpr int COL_QA = 0, COL_KA = 768, COL_VA = 1024, COL_QB = 1280, COL_KB = 1792, COL_VB = 2048, COL_QC = 2304, COL_KC = 3072, COL_VC = 3456;
constexpr float RMS_EPS = 1e-6f;
constexpr int PPL = 9;
constexpr int NPHASE = 2 + PPL * DEPTH;
constexpr int NNORM = 3 * DEPTH + 1;

constexpr size_t MiB = 1u << 20;
constexpr size_t WS_CTL = 0;
constexpr size_t WS_SS = 1 * MiB;
constexpr size_t CTL_ZERO_BYTES = 6 * MiB + 512 * 1024;
static_assert(WS_SS + (size_t)(NNORM + 1) * NTOK * 8 <= CTL_ZERO_BYTES, "ss inside the memset region");
constexpr size_t WS_TAB = 6 * MiB + 512 * 1024;
constexpr size_t WS_RSM = 7 * MiB;
constexpr size_t WS_LSE = 618 * MiB;
constexpr size_t WS_WIN = 8 * MiB, WS_WOUT = 68 * MiB, WS_WCQ = 100 * MiB, WS_WCKV = 108 * MiB, WS_WCO = 124 * MiB, WS_WFI = 132 * MiB, WS_WFO = 308 * MiB;
constexpr size_t WS_XB = 396 * MiB;
constexpr size_t WS_MB = 588 * MiB;
constexpr size_t WS_KVX = 598 * MiB;
constexpr size_t WS_QKV = 620 * MiB;
constexpr size_t WS_MIX = 980 * MiB;
constexpr size_t WS_HID = 620 * MiB;
constexpr size_t WS_QX = 620 * MiB, WS_OX = 668 * MiB;
constexpr size_t WS_END = 1172 * MiB;
constexpr int CW_BAR = 4096;
constexpr int CW_XRANK = 12288;
constexpr int CW_QUEUE = 16384;

#define GAS __attribute__((address_space(1)))
#define LAS __attribute__((address_space(3)))
typedef unsigned short bf16_t;
typedef short bf16x8 __attribute__((ext_vector_type(8)));
typedef short s16x4 __attribute__((ext_vector_type(4)));
typedef float f32x4 __attribute__((ext_vector_type(4)));
typedef float f32x16 __attribute__((ext_vector_type(16)));
typedef unsigned u32x4 __attribute__((ext_vector_type(4)));
typedef unsigned u32x2 __attribute__((ext_vector_type(2)));
typedef GAS unsigned gu32;

__device__ __forceinline__ int opaque_tid() { int t = threadIdx.x; asm volatile("" : "+v"(t)); return t; }
__device__ __forceinline__ unsigned cvt_pk_bf16(float lo, float hi) { unsigned r; asm volatile("v_cvt_pk_bf16_f32 %0, %1, %2" : "=v"(r) : "v"(lo), "v"(hi)); return r; }
__device__ __forceinline__ float bf2f(unsigned short b) { return __builtin_bit_cast(float, (unsigned)b << 16); }
__device__ __forceinline__ float bflo(unsigned w) { return __builtin_bit_cast(float, w << 16); }
__device__ __forceinline__ float bfhi(unsigned w) { return __builtin_bit_cast(float, w & 0xffff0000u); }

namespace pg8 {
#define PG8_LAS __attribute__((address_space(3)))
constexpr int BM = 256, BK = 64, HALF = 128, HTB = HALF * BK * 2, STAGE_BYTES = 8 * HTB, NXCD = 8, WGM = 4;
__host__ __device__ __forceinline__ int lds_byte(int r, int c) { const int st = (r >> 4) * 2 + (c >> 5), rr = r & 15, cc = c & 31, ob = rr * 64 + cc * 2; return st * 1024 + (ob ^ (((ob >> 9) & 1) << 5)); }
__host__ __device__ __forceinline__ void stage_rc(int b, int& R, int& C) { const int st = b / 1024, sb = b % 1024, swz = sb ^ (((sb >> 9) & 1) << 5); R = (st >> 1) * 16 + swz / 64; C = (st & 1) * 32 + (swz % 64) / 2; }
__host__ __device__ __forceinline__ int perm32(int rho) { const int n = rho >> 4, i = rho & 15; return 8 * (i >> 2) + 4 * n + (i & 3); }

struct Unit { int pm, pn; };
struct Gemm { const bf16_t* A; const bf16_t* Bt; int M, N, K; };

struct StaticOrder {
    int nM, nN, nwg, G, c, i_lo, i_hi, wgm = WGM;
    __host__ __device__ void init(int M, int N, int G_, int c_, int lo_ = 0, int hi_ = 1 << 30) { nM = M / BM; nN = N / BM; nwg = nM * nN; G = G_; c = c_; i_lo = lo_; i_hi = hi_; }
    __host__ __device__ bool next(int i, Unit& u) const {
        i += i_lo; if (i >= i_hi) return false;
        const long L = (long)i * G + c; if (L >= nwg) return false;
        int wgid = (int)L; { const int q = nwg / NXCD, r = nwg % NXCD, xcd = wgid % NXCD, off = wgid / NXCD; wgid = (xcd < r ? xcd * (q + 1) : r * (q + 1) + (xcd - r) * q) + off; }
        const int nig = wgm * nN, gid = wgid / nig, fm = gid * wgm, gsz = (nM - fm) < wgm ? (nM - fm) : wgm;
        u.pm = fm + ((wgid % nig) % gsz); u.pn = (wgid % nig) / gsz; return true;
    }
    __device__ __forceinline__ void a_ready(const Unit&) const {}
    __device__ __forceinline__ void done(const Unit&) const {}
};

typedef unsigned long long ss_t;
constexpr float SS_SCALE = 16777216.0f, SS_INV_MEAN = 1.0f / (16777216.0f * 2048.0f);
struct PreSS { ss_t v[2][4]; };
struct PreNone {};
__device__ __forceinline__ unsigned lane_perm(int src4, unsigned v) { return (unsigned)__builtin_amdgcn_ds_bpermute(src4, (int)v); }
__device__ __forceinline__ void ss_prefetch(PreSS& p, const ss_t* ss, int row0) {
#pragma unroll
    for (int ai = 0; ai < 2; ++ai)
#pragma unroll
        for (int m = 0; m < 4; ++m) p.v[ai][m] = ss[row0 + ai * HALF + m * 16];
}
__device__ __forceinline__ void row_rstd(const PreSS& p, float (&rs)[2][4]) {
#pragma unroll
    for (int ai = 0; ai < 2; ++ai)
#pragma unroll
        for (int m = 0; m < 4; ++m) {
            const ss_t v = p.v[ai][m]; const float f = (float)(unsigned)(v >> 32) * 4294967296.0f + (float)(unsigned)v;
            rs[ai][m] = __builtin_amdgcn_rsqf(f * SS_INV_MEAN + 1e-6f); }
}
struct EpiBf16 {
    static constexpr bool PERM = true, AFTER_DRAIN = false;
    bf16_t* O; int ldc; const ss_t* ss;
    typedef PreSS Pre;
    __device__ __forceinline__ void prefetch(Pre& p, const Unit& u, int wr, int fr) const { ss_prefetch(p, ss, u.pm * BM + wr * 64 + fr); }
    __device__ __forceinline__ void operator()(const f32x4 (&acc)[2][2][4][2], const Unit& u, int wr, int wc, int fr, int fq, const Pre& pre) const {
        const int row0 = u.pm * BM + wr * 64 + fr; const int col0 = u.pn * BM + wc * 32 + 8 * fq;
        float rs[2][4]; row_rstd(pre, rs);
#pragma unroll
        for (int ai = 0; ai < 2; ++ai)
#pragma unroll
            for (int m = 0; m < 4; ++m) { bf16_t* rowp = O + (size_t)(row0 + ai * HALF + m * 16) * ldc + col0; const float r = rs[ai][m];
#pragma unroll
                for (int bj = 0; bj < 2; ++bj) { const f32x4 v0 = acc[ai][bj][m][0] * r, v1 = acc[ai][bj][m][1] * r;
                    u32x4 w; w.x = cvt_pk_bf16(v0[0], v0[1]); w.y = cvt_pk_bf16(v0[2], v0[3]); w.z = cvt_pk_bf16(v1[0], v1[1]); w.w = cvt_pk_bf16(v1[2], v1[3]);
                    *(u32x4*)(rowp + bj * HALF) = w; } }
    }
};
struct EpiRes {
    static constexpr bool PERM = true, AFTER_DRAIN = false;
    bf16_t* xb; ss_t* ssout; float scale;
    typedef PreNone Pre;
    __device__ __forceinline__ void prefetch(Pre&, const Unit&, int, int) const {}
    __device__ __forceinline__ void operator()(const f32x4 (&acc)[2][2][4][2], const Unit& u, int wr, int wc, int fr, int fq, const Pre&) const {
        const int row0 = u.pm * BM + wr * 64 + fr; const int col0 = u.pn * BM + wc * 32 + 8 * fq;
        bf16_t* xbase = xb + (size_t)row0 * DM + col0;
        const int pl = fq * 16 + fr, psrc = (4 * fr + fq) * 4;
        const bf16_t* xload = xb + (size_t)(u.pm * BM + wr * 64 + (pl >> 2)) * DM + u.pn * BM + wc * 32 + 8 * (pl & 3);
#pragma unroll
        for (int ai = 0; ai < 2; ++ai) { float sq[4];
            u32x4 xv[4][2];
#pragma unroll
            for (int m = 0; m < 4; ++m)
#pragma unroll
                for (int bj = 0; bj < 2; ++bj) xv[m][bj] = *(const u32x4*)(xload + (size_t)(ai * HALF + m * 16) * DM + bj * HALF);
#pragma unroll
            for (int m = 0; m < 4; ++m) { bf16_t* bp = xbase + (size_t)(ai * HALF + m * 16) * DM;
                float q = 0.f;
#pragma unroll
                for (int bj = 0; bj < 2; ++bj) { const u32x4 xq = xv[m][bj]; u32x4 xw; xw.x = lane_perm(psrc, xq.x); xw.y = lane_perm(psrc, xq.y); xw.z = lane_perm(psrc, xq.z); xw.w = lane_perm(psrc, xq.w);
                    const f32x4 d0 = acc[ai][bj][m][0] * scale, d1 = acc[ai][bj][m][1] * scale;
                    u32x4 w; w.x = cvt_pk_bf16(bflo(xw.x) + d0[0], bfhi(xw.x) + d0[1]); w.y = cvt_pk_bf16(bflo(xw.y) + d0[2], bfhi(xw.y) + d0[3]);
                    w.z = cvt_pk_bf16(bflo(xw.z) + d1[0], bfhi(xw.z) + d1[1]); w.w = cvt_pk_bf16(bflo(xw.w) + d1[2], bfhi(xw.w) + d1[3]);
                    *(u32x4*)(bp + bj * HALF) = w;
                    const float e0 = bflo(w.x), e1 = bfhi(w.x), e2 = bflo(w.y), e3 = bfhi(w.y), e4 = bflo(w.z), e5 = bfhi(w.z), e6 = bflo(w.w), e7 = bfhi(w.w);
                    q += (e0 * e0 + e1 * e1) + (e2 * e2 + e3 * e3) + (e4 * e4 + e5 * e5) + (e6 * e6 + e7 * e7); }
                sq[m] = q; }
            asm volatile("" ::: "memory");
            const bool b0 = fq & 1, b1 = fq & 2;
            const float w0 = (b0 ? sq[1] : sq[0]) + __shfl_xor(b0 ? sq[0] : sq[1], 16), w1 = (b0 ? sq[3] : sq[2]) + __shfl_xor(b0 ? sq[2] : sq[3], 16);
            const float tot = (b1 ? w1 : w0) + __shfl_xor(b1 ? w0 : w1, 32);
            __hip_atomic_fetch_add(ssout + u.pm * BM + ai * HALF + wr * 64 + fq * 16 + fr, (ss_t)(tot * SS_SCALE), __ATOMIC_RELAXED, __HIP_MEMORY_SCOPE_AGENT); }
    }
};
struct EpiSwiglu {
    static constexpr bool PERM = true, AFTER_DRAIN = false;
    bf16_t* O; int ldc; const ss_t* ss;
    typedef PreSS Pre;
    __device__ __forceinline__ void prefetch(Pre& p, const Unit& u, int wr, int fr) const { ss_prefetch(p, ss, u.pm * BM + wr * 64 + fr); }
    __device__ __forceinline__ void operator()(const f32x4 (&acc)[2][2][4][2], const Unit& u, int wr, int wc, int fr, int fq, const Pre& pre) const {
        const int row0 = u.pm * BM + wr * 64 + fr; const int col0 = u.pn * HALF + wc * 32 + 8 * fq;
        float rs[2][4]; row_rstd(pre, rs);
#pragma unroll
        for (int ai = 0; ai < 2; ++ai)
#pragma unroll
            for (int m = 0; m < 4; ++m) {
                const float r = rs[ai][m], c = -1.4426950408889634f * r, r2 = r * r;
                const f32x4 g0 = acc[ai][0][m][0], g1 = acc[ai][0][m][1], u0 = acc[ai][1][m][0], u1 = acc[ai][1][m][1];
                const f32x4 t0 = g0 * c, t1 = g1 * c;
                f32x4 e0, e1;
#pragma unroll
                for (int i = 0; i < 4; ++i) { e0[i] = __builtin_amdgcn_exp2f(t0[i]); e1[i] = __builtin_amdgcn_exp2f(t1[i]); }
                const f32x4 d0 = e0 + 1.0f, d1 = e1 + 1.0f;
                f32x4 q0, q1;
#pragma unroll
                for (int i = 0; i < 4; ++i) { q0[i] = __builtin_amdgcn_rcpf(d0[i]); q1[i] = __builtin_amdgcn_rcpf(d1[i]); }
                const f32x4 h0 = (g0 * u0) * (q0 * r2), h1 = (g1 * u1) * (q1 * r2);
                u32x4 w; w.x = cvt_pk_bf16(h0[0], h0[1]); w.y = cvt_pk_bf16(h0[2], h0[3]); w.z = cvt_pk_bf16(h1[0], h1[1]); w.w = cvt_pk_bf16(h1[2], h1[3]);
                *(u32x4*)(O + (size_t)(row0 + ai * HALF + m * 16) * ldc + col0) = w; }
    }
};

template <class Epi, class Sched, bool ALIGN_EPI = false, bool SP2 = false>
__device__ __forceinline__ void gemm_phase(PG8_LAS unsigned char* lds, const Gemm g, const Sched& S, const Epi& E) {
    const int tid = opaque_tid(), wid = __builtin_amdgcn_readfirstlane(tid >> 6), lane = tid & 63, wr = wid >> 2, wc = wid & 3, fr = lane & 15, fq = lane >> 4;
    const int K = g.K, nt = K / BK;
    unsigned voffA[2], voffB[2];
#pragma unroll
    for (int i = 0; i < 2; ++i) { int R, C; stage_rc(tid * 16 + i * 8192, R, C); const int Rb = Epi::PERM ? ((R & ~31) + perm32(R & 31)) : R;
        voffA[i] = (unsigned)(R * K + C) * 2u; voffB[i] = (unsigned)(Rb * K + C) * 2u; }
    const size_t kstep = (size_t)(BK * 2);
    const size_t hstep = (size_t)HALF * K * 2;
    const size_t tstep = 2 * hstep;
    const unsigned ldsw = (unsigned)wid * 1024u;
    const int aoff = lds_byte(wr * 64 + fr, fq * 8), boff = lds_byte(wc * 32 + fr, fq * 8);
#define PG8_SA(b, h) (((b) * 2 + (h)) * HTB)
#define PG8_SB(b, h) ((4 + (b) * 2 + (h)) * HTB)
#define PG8_STAGE(bufoff, gbase, voff) do { _Pragma("unroll") for (int _i = 0; _i < 2; ++_i) \
        __builtin_amdgcn_global_load_lds((const unsigned*)((const char*)(gbase) + (voff)[_i]), (PG8_LAS unsigned*)(lds + (bufoff) + ldsw + _i * 8192), 16, 0, 0); } while (0)
#define PG8_LDA(dst, b, h) do { _Pragma("unroll") for (int m = 0; m < 4; ++m) _Pragma("unroll") for (int k = 0; k < 2; ++k) dst[m][k] = *(const PG8_LAS bf16x8*)(lds + PG8_SA(b, h) + aoff + m * 2048 + k * 1024); } while (0)
#define PG8_LDB(dst, b, h) do { _Pragma("unroll") for (int n = 0; n < 2; ++n) _Pragma("unroll") for (int k = 0; k < 2; ++k) dst[n][k] = *(const PG8_LAS bf16x8*)(lds + PG8_SB(b, h) + boff + n * 2048 + k * 1024); } while (0)
#define PG8_MMA(ai, bj, At, Bt) do { __builtin_amdgcn_s_setprio(1); _Pragma("unroll") for (int m = 0; m < 4; ++m) _Pragma("unroll") for (int n = 0; n < 2; ++n) _Pragma("unroll") for (int k = 0; k < 2; ++k) \
        acc[ai][bj][m][n] = __builtin_amdgcn_mfma_f32_16x16x32_bf16(Bt[n][k], At[m][k], acc[ai][bj][m][n], 0, 0, 0); __builtin_amdgcn_s_setprio(0); } while (0)
#define PG8_WAIT_V(n) asm volatile("s_waitcnt vmcnt(" #n ")" ::: "memory")
#define PG8_WAIT_L(n) asm volatile("s_waitcnt lgkmcnt(" #n ")" ::: "memory")
#define PG8_BAR __builtin_amdgcn_s_barrier()
#define PG8_SCHED __builtin_amdgcn_sched_barrier(0)
    Unit cur, nxt; int ui = 0;
    if (!S.next(0, cur)) return;
    f32x4 acc[2][2][4][2];
#pragma unroll
    for (int a = 0; a < 2; ++a)
#pragma unroll
        for (int b = 0; b < 2; ++b)
#pragma unroll
            for (int m = 0; m < 4; ++m)
#pragma unroll
                for (int n = 0; n < 2; ++n) acc[a][b][m][n] = (f32x4){0.f, 0.f, 0.f, 0.f};
    bf16x8 At[4][2], B0[2][2], B1[2][2];
    typename Epi::Pre pre;
    const char* cA = (const char*)g.A + (size_t)cur.pm * tstep; const char* cB = (const char*)g.Bt + (size_t)cur.pn * tstep;
    S.a_ready(cur);
    if constexpr (SP2) {
        PG8_STAGE(PG8_SB(0, 0), cB, voffB); PG8_STAGE(PG8_SB(0, 1), cB + hstep, voffB); PG8_STAGE(PG8_SA(0, 0), cA, voffA); PG8_STAGE(PG8_SA(0, 1), cA + hstep, voffA);
        if (wr == 1) PG8_BAR;
        PG8_WAIT_V(2); PG8_BAR;
        PG8_STAGE(PG8_SB(1, 0), cB + kstep, voffB); PG8_STAGE(PG8_SA(1, 0), cA + kstep, voffA); PG8_STAGE(PG8_SB(1, 1), cB + hstep + kstep, voffB);
        PG8_WAIT_V(6); PG8_BAR;
    } else {
        PG8_STAGE(PG8_SB(0, 0), cB, voffB); PG8_STAGE(PG8_SA(0, 0), cA, voffA); PG8_STAGE(PG8_SB(0, 1), cB + hstep, voffB); PG8_STAGE(PG8_SA(0, 1), cA + hstep, voffA);
        if (wr == 1) PG8_BAR;
        PG8_WAIT_V(4); PG8_BAR;
        PG8_STAGE(PG8_SB(1, 0), cB + kstep, voffB); PG8_STAGE(PG8_SA(1, 0), cA + kstep, voffA); PG8_STAGE(PG8_SB(1, 1), cB + hstep + kstep, voffB);
        PG8_WAIT_V(6); PG8_BAR;
    }
    for (;;) {
        const bool has_next = S.next(ui + 1, nxt);
        const char* nA = has_next ? (const char*)g.A + (size_t)nxt.pm * tstep : cA; const char* nB = has_next ? (const char*)g.Bt + (size_t)nxt.pn * tstep : cB;
        for (int t = 0; t < nt; t += 2) {
            const bool last = (t == nt - 2);
            const char* a1 = cA + (size_t)(t + 1) * kstep;
            const char* a2 = last ? nA : cA + (size_t)(t + 2) * kstep; const char* b2 = last ? nB : cB + (size_t)(t + 2) * kstep;
            const char* a3 = a2 + kstep; const char* b3 = b2 + kstep;
            if (last && has_next) S.a_ready(nxt);
            if (last) E.prefetch(pre, cur, wr, fr);
            if constexpr (SP2) {
            PG8_LDB(B0, 0, 0); PG8_LDB(B1, 0, 1); PG8_SCHED; PG8_LDA(At, 0, 0); PG8_STAGE(PG8_SA(1, 1), a1 + hstep, voffA);
            PG8_WAIT_V(8); PG8_WAIT_L(0); PG8_BAR; PG8_MMA(0, 0, At, B0); PG8_MMA(0, 1, At, B1); PG8_BAR; PG8_SCHED;
            PG8_LDA(At, 0, 1); PG8_STAGE(PG8_SB(0, 0), b2, voffB); PG8_STAGE(PG8_SB(0, 1), b2 + hstep, voffB); PG8_STAGE(PG8_SA(0, 0), a2, voffA);
            PG8_WAIT_V(8); PG8_WAIT_L(0); PG8_BAR; PG8_MMA(1, 0, At, B0); PG8_MMA(1, 1, At, B1); PG8_BAR; PG8_SCHED;
            PG8_LDB(B0, 1, 0); PG8_LDB(B1, 1, 1); PG8_SCHED; PG8_LDA(At, 1, 0); PG8_STAGE(PG8_SA(0, 1), a2 + hstep, voffA);
            PG8_WAIT_V(8); PG8_WAIT_L(0); PG8_BAR; PG8_MMA(0, 0, At, B0); PG8_MMA(0, 1, At, B1); PG8_BAR; PG8_SCHED;
            PG8_LDA(At, 1, 1); PG8_STAGE(PG8_SB(1, 0), b3, voffB); PG8_STAGE(PG8_SB(1, 1), b3 + hstep, voffB); PG8_STAGE(PG8_SA(1, 0), a3, voffA);
            PG8_WAIT_V(8); PG8_WAIT_L(0); PG8_BAR; PG8_MMA(1, 0, At, B0); PG8_MMA(1, 1, At, B1); PG8_BAR; PG8_SCHED;
            } else {
            PG8_LDB(B0, 0, 0); PG8_SCHED; PG8_LDA(At, 0, 0); PG8_STAGE(PG8_SA(1, 1), a1 + hstep, voffA);
            PG8_WAIT_L(8); PG8_BAR; PG8_WAIT_L(0); PG8_MMA(0, 0, At, B0); PG8_BAR; PG8_SCHED;
            PG8_LDB(B1, 0, 1); PG8_STAGE(PG8_SB(0, 0), b2, voffB);
            PG8_BAR; PG8_WAIT_L(0); PG8_MMA(0, 1, At, B1); PG8_BAR;
            PG8_LDA(At, 0, 1); PG8_STAGE(PG8_SA(0, 0), a2, voffA);
            PG8_BAR; PG8_WAIT_L(0); PG8_MMA(1, 0, At, B0); PG8_BAR; PG8_SCHED;
            PG8_STAGE(PG8_SB(0, 1), b2 + hstep, voffB);
            PG8_WAIT_V(6); PG8_BAR; PG8_MMA(1, 1, At, B1); PG8_BAR;
            PG8_LDB(B0, 1, 0); PG8_SCHED; PG8_LDA(At, 1, 0); PG8_STAGE(PG8_SA(0, 1), a2 + hstep, voffA);
            PG8_WAIT_L(8); PG8_BAR; PG8_WAIT_L(0); PG8_MMA(0, 0, At, B0); PG8_BAR; PG8_SCHED;
            PG8_LDB(B1, 1, 1); PG8_STAGE(PG8_SB(1, 0), b3, voffB);
            PG8_BAR; PG8_WAIT_L(0); PG8_MMA(0, 1, At, B1); PG8_BAR;
            PG8_LDA(At, 1, 1); PG8_STAGE(PG8_SA(1, 0), a3, voffA);
            PG8_BAR; PG8_WAIT_L(0); PG8_MMA(1, 0, At, B0); PG8_BAR; PG8_SCHED;
            PG8_STAGE(PG8_SB(1, 1), b3 + hstep, voffB);
            PG8_WAIT_V(6); PG8_BAR; PG8_MMA(1, 1, At, B1); PG8_BAR;
            }
        }
        if constexpr (ALIGN_EPI) { if (wr == 0) PG8_BAR; }
        if constexpr (!Epi::AFTER_DRAIN) { E(acc, cur, wr, wc, fr, fq, pre); S.done(cur); }
        if (!has_next) break;
#pragma unroll
        for (int a = 0; a < 2; ++a)
#pragma unroll
            for (int b = 0; b < 2; ++b)
#pragma unroll
                for (int m = 0; m < 4; ++m)
#pragma unroll
                    for (int n = 0; n < 2; ++n) acc[a][b][m][n] = (f32x4){0.f, 0.f, 0.f, 0.f};
        cur = nxt; cA = nA; cB = nB; ++ui;
        if constexpr (ALIGN_EPI) { if (wr == 1) PG8_BAR; }
    }
    PG8_WAIT_V(0);
    if constexpr (!ALIGN_EPI) { if (wr == 0) PG8_BAR; }
    PG8_BAR;
#undef PG8_SA
#undef PG8_SB
#undef PG8_STAGE
#undef PG8_LDA
#undef PG8_LDB
#undef PG8_MMA
#undef PG8_WAIT_V
#undef PG8_WAIT_L
#undef PG8_BAR
#undef PG8_SCHED
}
}

namespace att {
constexpr int D = 128, NW = 8, QBLK = 32, KVBLK = 64;
constexpr float SCALE = 0.088388347648318440f, LOG2E = 1.4426950408889634f, LN2 = 0.6931471805599453f;
constexpr float C = SCALE * LOG2E;
constexpr float THR2 = 8.f * LOG2E;
constexpr int SHM_V = KVBLK * D * 2, SHM_K = KVBLK * D * 2;
constexpr int OFF_V = 0, OFF_K = 2 * SHM_V, BUF3 = SHM_V + SHM_K  , OFF_WS = 3 * BUF3, OFF_TAB = OFF_WS + NW * 64 * 4, TAB_FLOATS = 1024, OFF_UID = OFF_TAB + TAB_FLOATS * 4, LDS_BYTES = OFF_UID + 64;
#define KSWZ(row, colB) ((row) * 256 + ((colB) ^ (((row) & 7) << 4)))
#define SBAR() __builtin_amdgcn_sched_barrier(0)
__device__ __forceinline__ int crow(int r, int hi) { return (r & 3) + 8 * (r >> 2) + 4 * hi; }
__device__ __forceinline__ void qkt(f32x16& p0, f32x16& p1, const char* Ks, const bf16x8* qr, int r32, int hi) {
  p0 = f32x16{}; p1 = f32x16{};
#pragma unroll
  for (int d0 = 0; d0 < 8; ++d0) { const int cb = (d0 * 16 + hi * 8) * 2;
    const bf16x8 b0 = *reinterpret_cast<const bf16x8*>(Ks + KSWZ(r32, cb));
    const bf16x8 b1 = *reinterpret_cast<const bf16x8*>(Ks + KSWZ(32 + r32, cb));
    p0 = __builtin_amdgcn_mfma_f32_32x32x16_bf16(b0, qr[d0], p0, 0, 0, 0);
    p1 = __builtin_amdgcn_mfma_f32_32x32x16_bf16(b1, qr[d0], p1, 0, 0, 0); }
}
__device__ __forceinline__ int v_st(int k, int c) { const int kk = (k & ~0xC) | ((k & 4) << 1) | ((k & 8) >> 1); return ((kk >> 3) * 4 + (c >> 5)) * 512 + ((kk & 7) * 32 + (c & 31)) * 2; }
__device__ __forceinline__ int v_rd_base(int lane) { return ((lane & 3) << 3) | (((lane >> 2) & 3) << 6) | (((lane >> 4) & 1) << 5) | (((lane >> 5) & 1) << 8); }
constexpr int v_rd_off(int d0, int ks, int half) { return d0 * 512 + ks * 4096 + half * 2048; }
template <int OFF> __device__ __forceinline__ s16x4 tr_read(int vb) {
  s16x4 r; asm volatile("ds_read_b64_tr_b16 %0, %1 offset:%2" : "=&v"(r) : "v"(vb), "i"(OFF) : "memory"); return r;
}
template <int D0> __device__ __forceinline__ void pv_one(f32x16& od, int vb, bf16x8 pa0, bf16x8 pa1, bf16x8 pa2, bf16x8 pa3) {
  const s16x4 l0 = tr_read<v_rd_off(D0, 0, 0)>(vb), h0 = tr_read<v_rd_off(D0, 0, 1)>(vb), l1 = tr_read<v_rd_off(D0, 1, 0)>(vb), h1 = tr_read<v_rd_off(D0, 1, 1)>(vb);
  const s16x4 l2 = tr_read<v_rd_off(D0, 2, 0)>(vb), h2 = tr_read<v_rd_off(D0, 2, 1)>(vb), l3 = tr_read<v_rd_off(D0, 3, 0)>(vb), h3 = tr_read<v_rd_off(D0, 3, 1)>(vb);
  asm volatile("s_waitcnt lgkmcnt(0)" ::: "memory"); SBAR();
#define PK(L, H) (bf16x8){L[0], L[1], L[2], L[3], H[0], H[1], H[2], H[3]}
  od = __builtin_amdgcn_mfma_f32_32x32x16_bf16(pa0, PK(l0, h0), od, 0, 0, 0);
  od = __builtin_amdgcn_mfma_f32_32x32x16_bf16(pa1, PK(l1, h1), od, 0, 0, 0);
  od = __builtin_amdgcn_mfma_f32_32x32x16_bf16(pa2, PK(l2, h2), od, 0, 0, 0);
  od = __builtin_amdgcn_mfma_f32_32x32x16_bf16(pa3, PK(l3, h3), od, 0, 0, 0);
#undef PK
}
__device__ __forceinline__ void pv_d0(f32x16* o, int vb, bf16x8 pa0, bf16x8 pa1, bf16x8 pa2, bf16x8 pa3) {
  pv_one<0>(o[0], vb, pa0, pa1, pa2, pa3); pv_one<1>(o[1], vb, pa0, pa1, pa2, pa3); pv_one<2>(o[2], vb, pa0, pa1, pa2, pa3); pv_one<3>(o[3], vb, pa0, pa1, pa2, pa3);
}

template <bool TAB>
__device__ __forceinline__ void attn_unit(const bf16_t* __restrict__ Qb, long ldq, const bf16_t* __restrict__ Kh, const bf16_t* __restrict__ Vh, long ldk,
                                          bf16_t* __restrict__ Ob, long ldo, int t_lo, int t_hi, int qpos0, int W, const float* __restrict__ tabg, int tablen,
                                          float m_init0, float m_init1, float l_init, float* __restrict__ lse, long ldlse, char* lds) {
  const int tid = opaque_tid(), lane = tid & 63, r32 = lane & 31, hi = lane >> 5; const int wid = __builtin_amdgcn_readfirstlane(tid >> 6);
  const int hw = wid >> 2, wq = wid & 3;
  char* V_lds = lds + OFF_V; char* K_lds = lds + OFF_K;
  float* ws = (float*)(lds + OFF_WS) + wid * 64; float* li_l = ws; float* al_l = ws + 32;
  float* tab = (float*)(lds + OFF_TAB);
  bf16x8 qr[8];
  { const bf16_t* Qw = Qb + hw * D + (long)(wq * QBLK + r32) * ldq + hi * 8;
#pragma unroll
    for (int d0 = 0; d0 < 8; ++d0) qr[d0] = *reinterpret_cast<const bf16x8*>(Qw + d0 * 16); }
  if (TAB) { for (int i = tid; i < 2 * 512; i += NW * 64) tab[i] = ((i & 511) < tablen) ? tabg[i] : 0.f; }
  const int sr = tid >> 4, sc = (tid & 15) * 8, vst0 = v_st(sr, sc), vst1 = v_st(32 + sr, sc);
  const int vb0 = (int)(uintptr_t)V_lds + v_rd_base(lane);
  bf16x8 vs0, vs1, ks0, ks1;
#define SLOAD(k0) do { vs0 = *reinterpret_cast<const bf16x8*>(&Vh[(long)((k0) + sr) * ldk + sc]); vs1 = *reinterpret_cast<const bf16x8*>(&Vh[(long)((k0) + 32 + sr) * ldk + sc]); \
    ks0 = *reinterpret_cast<const bf16x8*>(&Kh[(long)((k0) + sr) * ldk + sc]); ks1 = *reinterpret_cast<const bf16x8*>(&Kh[(long)((k0) + 32 + sr) * ldk + sc]); } while (0)
#define SWRITE(b) do { *(bf16x8*)(V_lds + (b) * SHM_V + vst0) = vs0; *(bf16x8*)(V_lds + (b) * SHM_V + vst1) = vs1; const int kc = sc * 2; \
    *(bf16x8*)(K_lds + (b) * SHM_K + KSWZ(sr, kc)) = ks0; *(bf16x8*)(K_lds + (b) * SHM_K + KSWZ(32 + sr, kc)) = ks1; } while (0)
  float m_reg = hw ? m_init1 : m_init0, l_reg = l_init; f32x16 o[4] = {};
  const int qw0 = qpos0 + wq * QBLK;
  SLOAD(t_lo * KVBLK); SWRITE(0); __syncthreads();
  for (int t = t_lo; t < t_hi; ++t) {
    const int b = (t - t_lo) & 1; const bool more = (t + 1 < t_hi);
    if (more) SLOAD((t + 1) * KVBLK);
    const bool active = !TAB || (KVBLK * t + KVBLK - 1 >= qw0 - W && KVBLK * t <= qw0 + QBLK - 1 + W);
    if (active) {
      f32x16 p0, p1; qkt(p0, p1, K_lds + b * SHM_K, qr, r32, hi);
      if (TAB) { const float* tl = tab + hw * 512 + (KVBLK * t - qw0 - r32 + 4 * hi + W + 96);
#pragma unroll
        for (int r = 0; r < 16; ++r) { const int ix = (r & 3) + 8 * (r >> 2); p0[r] = fmaf(p0[r], C, tl[ix]); p1[r] = fmaf(p1[r], C, tl[ix + 32]); } }
      else {
#pragma unroll
        for (int r = 0; r < 16; ++r) { p0[r] *= C; p1[r] *= C; } }
      float pmax = p0[0];
#pragma unroll
      for (int r = 1; r < 16; ++r) pmax = fmaxf(pmax, p0[r]);
#pragma unroll
      for (int r = 0; r < 16; ++r) pmax = fmaxf(pmax, p1[r]);
      { auto rr = __builtin_amdgcn_permlane32_swap(__float_as_uint(pmax), __float_as_uint(pmax), false, false);
        pmax = fmaxf(__uint_as_float(rr[0]), __uint_as_float(rr[1])); }
      if (!__all(pmax - m_reg <= THR2)) {
        const float mn = fmaxf(m_reg, pmax); const float alpha = __builtin_amdgcn_exp2f(m_reg - mn); m_reg = mn; l_reg *= alpha;
        if (hi == 0) al_l[r32] = alpha; asm volatile("s_waitcnt lgkmcnt(0)" ::: "memory");
#pragma unroll
        for (int d = 0; d < 4; ++d)
#pragma unroll
          for (int r = 0; r < 16; ++r) o[d][r] *= al_l[crow(r, hi)];
      }
#pragma unroll
      for (int r = 0; r < 16; ++r) { p0[r] = __builtin_amdgcn_exp2f(p0[r] - m_reg); p1[r] = __builtin_amdgcn_exp2f(p1[r] - m_reg); }
      float ps = 0.f;
#pragma unroll
      for (int r = 0; r < 16; ++r) ps += p0[r];
#pragma unroll
      for (int r = 0; r < 16; ++r) ps += p1[r];
      { auto rr = __builtin_amdgcn_permlane32_swap(__float_as_uint(ps), __float_as_uint(ps), false, false);
        ps = __uint_as_float(rr[0]) + __uint_as_float(rr[1]); }
      l_reg += ps;
      bf16x8 pa0, pa1, pa2, pa3;
#define PK4(P, BASE, OUT) do { unsigned a0 = cvt_pk_bf16(P[BASE + 0], P[BASE + 1]), a1 = cvt_pk_bf16(P[BASE + 2], P[BASE + 3]);   \
    unsigned b0 = cvt_pk_bf16(P[BASE + 4], P[BASE + 5]), b1 = cvt_pk_bf16(P[BASE + 6], P[BASE + 7]);                              \
    auto r0 = __builtin_amdgcn_permlane32_swap(a0, b0, false, false); auto r1 = __builtin_amdgcn_permlane32_swap(a1, b1, false, false); \
    u32x4 w = {r0[0], r1[0], r0[1], r1[1]}; OUT = *reinterpret_cast<bf16x8*>(&w); } while (0)
      PK4(p0, 0, pa0); PK4(p0, 8, pa1); PK4(p1, 0, pa2); PK4(p1, 8, pa3);
#undef PK4
      SBAR();
      pv_d0(o, vb0 + b * SHM_V, pa0, pa1, pa2, pa3);
    }
    if (more) SWRITE(b ^ 1);
    __syncthreads();
  }
  if (hi == 0) li_l[r32] = l_reg; asm volatile("s_waitcnt lgkmcnt(0)" ::: "memory");
  float rli[16];
#pragma unroll
  for (int r = 0; r < 16; ++r) rli[r] = __builtin_amdgcn_rcpf(li_l[crow(r, hi)]);
  bf16_t* stg = (bf16_t*)(lds + wid * 8192);
#pragma unroll
  for (int r = 0; r < 16; ++r) { const int orow = crow(r, hi);
#pragma unroll
    for (int d0 = 0; d0 < 4; ++d0) { const unsigned w = cvt_pk_bf16(o[d0][r] * rli[r], 0.f); stg[orow * 128 + d0 * 32 + r32] = (bf16_t)(w & 0xffffu); } }
  asm volatile("s_waitcnt lgkmcnt(0)" ::: "memory");
#pragma unroll
  for (int i = 0; i < 8; ++i) { const int row = i * 4 + (lane >> 4), ch = lane & 15; const u32x4 v = *(const u32x4*)(stg + row * 128 + ch * 8);
    *(u32x4*)(Ob + hw * D + (long)(wq * QBLK + row) * ldo + ch * 8) = v; }
  if (lse != nullptr && hi == 0) lse[hw + (long)(wq * QBLK + r32) * ldlse] = (m_reg + __builtin_amdgcn_logf(l_reg)) * LN2;
  __syncthreads();
#undef SLOAD
#undef SWRITE
}
template <bool PRE>
__device__ __forceinline__ void partialSM(f32x16& p0, f32x16& p1, float& m_reg, float& mn, float& alpha) {
  constexpr float cs = PRE ? 1.0f : C;
  float pmax = p0[0];
#pragma unroll
  for (int r = 1; r < 16; ++r) pmax = fmaxf(pmax, p0[r]);
#pragma unroll
  for (int r = 0; r < 16; ++r) pmax = fmaxf(pmax, p1[r]);
  { auto rr = __builtin_amdgcn_permlane32_swap(__float_as_uint(pmax), __float_as_uint(pmax), false, false);
    pmax = fmaxf(__uint_as_float(rr[0]), __uint_as_float(rr[1])); }
  if (__builtin_expect(__all((pmax - m_reg) * cs <= THR2), 1)) { mn = m_reg; alpha = 1.f; }
  else { mn = fmaxf(m_reg, pmax); alpha = __builtin_amdgcn_exp2f((m_reg - mn) * cs); m_reg = mn; }
  const float mnC = -mn * cs;
#pragma unroll
  for (int r = 0; r < 16; ++r) p0[r] = fmaf(p0[r], cs, mnC);
#pragma unroll
  for (int r = 0; r < 16; ++r) p1[r] = fmaf(p1[r], cs, mnC);
#pragma unroll
  for (int r = 0; r < 16; ++r) p0[r] = __builtin_amdgcn_exp2f(p0[r]);
}
__device__ __forceinline__ void partialSM_fixed(f32x16& p0) {
#pragma unroll
  for (int r = 0; r < 16; ++r) p0[r] = __builtin_amdgcn_exp2f(p0[r]);
}
__device__ __forceinline__ void finishSM(f32x16& p0, f32x16& p1, float alpha, float& l_reg, bf16x8& pa0, bf16x8& pa1, bf16x8& pa2, bf16x8& pa3) {
#pragma unroll
  for (int r = 0; r < 16; ++r) p1[r] = __builtin_amdgcn_exp2f(p1[r]);
  float ps = 0;
#pragma unroll
  for (int r = 0; r < 16; ++r) ps += p0[r];
#pragma unroll
  for (int r = 0; r < 16; ++r) ps += p1[r];
  { auto rr = __builtin_amdgcn_permlane32_swap(__float_as_uint(ps), __float_as_uint(ps), false, false);
    ps = __uint_as_float(rr[0]) + __uint_as_float(rr[1]); }
  l_reg = l_reg * alpha + ps;
#define PK4(P, BASE, OUT) do { unsigned a0 = cvt_pk_bf16(P[BASE + 0], P[BASE + 1]), a1 = cvt_pk_bf16(P[BASE + 2], P[BASE + 3]);   \
    unsigned b0 = cvt_pk_bf16(P[BASE + 4], P[BASE + 5]), b1 = cvt_pk_bf16(P[BASE + 6], P[BASE + 7]);                              \
    auto r0 = __builtin_amdgcn_permlane32_swap(a0, b0, false, false); auto r1 = __builtin_amdgcn_permlane32_swap(a1, b1, false, false); \
    u32x4 w = {r0[0], r1[0], r0[1], r1[1]}; OUT = *reinterpret_cast<bf16x8*>(&w); } while (0)
  PK4(p0, 0, pa0); PK4(p0, 8, pa1); PK4(p1, 0, pa2); PK4(p1, 8, pa3);
#undef PK4
}
template <bool PRE>
__device__ __forceinline__ void attn_unit_dense(const bf16_t* __restrict__ Qb, long ldq, const bf16_t* __restrict__ Kh, const bf16_t* __restrict__ Vh, long ldk,
                                                bf16_t* __restrict__ Ob, long ldo, int ntile, float mfix2, char* lds) {
  const int tid = opaque_tid(), lane = tid & 63, r32 = lane & 31, hi = lane >> 5; const int wid = __builtin_amdgcn_readfirstlane(tid >> 6);
  float* ws = (float*)(lds + OFF_WS) + wid * 64; float* li_l = ws; float* al_l = ws + 32;
  const bool fixm = PRE && mfix2 >= 0.f;
  float m_reg = -1e30f, l_reg = 0; f32x16 o[4] = {}; bf16x8 qr[8];
  { const bf16_t* Qw = Qb + (long)(wid * QBLK + r32) * ldq + hi * 8;
#pragma unroll
    for (int d0 = 0; d0 < 8; ++d0) qr[d0] = *reinterpret_cast<const bf16x8*>(Qw + d0 * 16); }
  const int sr = tid >> 4, sc = (tid & 15) * 8, vst0 = v_st(sr, sc), vst1 = v_st(32 + sr, sc);
  const int vb0 = (int)(uintptr_t)lds + v_rd_base(lane);
  bf16x8 vsE0, vsE1, ksE0, ksE1, vsO0, vsO1, ksO0, ksO1;
#define SLOAD_E(k0) do { vsE0 = *reinterpret_cast<const bf16x8*>(&Vh[(long)((k0) + sr) * ldk + sc]); vsE1 = *reinterpret_cast<const bf16x8*>(&Vh[(long)((k0) + 32 + sr) * ldk + sc]); \
    ksE0 = *reinterpret_cast<const bf16x8*>(&Kh[(long)((k0) + sr) * ldk + sc]); ksE1 = *reinterpret_cast<const bf16x8*>(&Kh[(long)((k0) + 32 + sr) * ldk + sc]); } while (0)
#define SLOAD_O(k0) do { vsO0 = *reinterpret_cast<const bf16x8*>(&Vh[(long)((k0) + sr) * ldk + sc]); vsO1 = *reinterpret_cast<const bf16x8*>(&Vh[(long)((k0) + 32 + sr) * ldk + sc]); \
    ksO0 = *reinterpret_cast<const bf16x8*>(&Kh[(long)((k0) + sr) * ldk + sc]); ksO1 = *reinterpret_cast<const bf16x8*>(&Kh[(long)((k0) + 32 + sr) * ldk + sc]); } while (0)
#define SWRITE_E(bo) do { char* B_ = lds + (bo); *(bf16x8*)(B_ + vst0) = vsE0; *(bf16x8*)(B_ + vst1) = vsE1; const int kc = sc * 2; \
    *(bf16x8*)(B_ + SHM_V + KSWZ(sr, kc)) = ksE0; *(bf16x8*)(B_ + SHM_V + KSWZ(32 + sr, kc)) = ksE1; } while (0)
#define SWRITE_O(bo) do { char* B_ = lds + (bo); *(bf16x8*)(B_ + vst0) = vsO0; *(bf16x8*)(B_ + vst1) = vsO1; const int kc = sc * 2; \
    *(bf16x8*)(B_ + SHM_V + KSWZ(sr, kc)) = ksO0; *(bf16x8*)(B_ + SHM_V + KSWZ(32 + sr, kc)) = ksO1; } while (0)
#define SWAIT() asm volatile("s_waitcnt vmcnt(4)" ::: "memory")
#define PSM(P0, P1, MN, AL) do { if (fixm) { partialSM_fixed(P0); AL = 1.f; MN = 0.f; } else partialSM<PRE>(P0, P1, m_reg, MN, AL); } while (0)
#define RESC(a) do { if (!fixm) if (__any((a) < 1.f)) { if (hi == 0) al_l[r32] = (a); asm volatile("s_waitcnt lgkmcnt(0)" ::: "memory"); \
    _Pragma("unroll") for (int d = 0; d < 4; ++d) _Pragma("unroll") for (int r = 0; r < 16; ++r) o[d][r] *= al_l[crow(r, hi)]; } } while (0)
#define ROT3() do { const int t_ = bV; bV = bK; bK = bW; bW = t_; } while (0)
  f32x16 pA0, pA1, pB0, pB1; float mnA, mnB, alA, alB; bf16x8 pa0, pa1, pa2, pa3; const int NT = ntile;
  int bV = 0, bK = 0, bW = BUF3;
  SLOAD_E(0); SLOAD_O(KVBLK); asm volatile("s_waitcnt vmcnt(4)" ::: "memory"); SWRITE_E(0); SLOAD_E(2 * KVBLK);
  __syncthreads();
  SWAIT(); SWRITE_O(bW);
  qkt(pA0, pA1, lds + bK + SHM_V, qr, r32, hi); PSM(pA0, pA1, mnA, alA);
  if (3 < NT) SLOAD_O(3 * KVBLK);
  bV = 0; bK = BUF3; bW = 2 * BUF3;
  for (int j = 1; j + 1 < NT; j += 2) {
    __syncthreads(); SWAIT(); SWRITE_E(bW);
    SBAR(); qkt(pB0, pB1, lds + bK + SHM_V, qr, r32, hi);
    finishSM(pA0, pA1, alA, l_reg, pa0, pa1, pa2, pa3); SBAR();
    if (j + 3 < NT) SLOAD_E((j + 3) * KVBLK); SBAR();
    pv_d0(o, vb0 + bV, pa0, pa1, pa2, pa3); PSM(pB0, pB1, mnB, alB);
    RESC(alB); ROT3();
    __syncthreads(); SWAIT(); SWRITE_O(bW);
    SBAR(); qkt(pA0, pA1, lds + bK + SHM_V, qr, r32, hi);
    finishSM(pB0, pB1, alB, l_reg, pa0, pa1, pa2, pa3); SBAR();
    if (j + 4 < NT) SLOAD_O((j + 4) * KVBLK); SBAR();
    pv_d0(o, vb0 + bV, pa0, pa1, pa2, pa3); PSM(pA0, pA1, mnA, alA);
    RESC(alA); ROT3();
  }
  __syncthreads();
  SBAR(); qkt(pB0, pB1, lds + bK + SHM_V, qr, r32, hi);
  finishSM(pA0, pA1, alA, l_reg, pa0, pa1, pa2, pa3); SBAR();
  pv_d0(o, vb0 + bV, pa0, pa1, pa2, pa3); PSM(pB0, pB1, mnB, alB);
  RESC(alB); ROT3();
  finishSM(pB0, pB1, alB, l_reg, pa0, pa1, pa2, pa3); SBAR();
  pv_d0(o, vb0 + bV, pa0, pa1, pa2, pa3);
#undef ROT3
  if (hi == 0) li_l[r32] = l_reg; asm volatile("s_waitcnt lgkmcnt(0)" ::: "memory");
  float rli[16];
#pragma unroll
  for (int r = 0; r < 16; ++r) rli[r] = __builtin_amdgcn_rcpf(li_l[crow(r, hi)]);
  __syncthreads();
  bf16_t* stg = (bf16_t*)(lds + wid * 8192);
#pragma unroll
  for (int r = 0; r < 16; ++r) { const int orow = crow(r, hi);
#pragma unroll
    for (int d0 = 0; d0 < 4; ++d0) { const unsigned w = cvt_pk_bf16(o[d0][r] * rli[r], 0.f); stg[orow * 128 + d0 * 32 + r32] = (bf16_t)(w & 0xffffu); } }
  asm volatile("s_waitcnt lgkmcnt(0)" ::: "memory");
#pragma unroll
  for (int i = 0; i < 8; ++i) { const int row = i * 4 + (lane >> 4), ch = lane & 15; const u32x4 v = *(const u32x4*)(stg + row * 128 + ch * 8);
    *(u32x4*)(Ob + (long)(wid * QBLK + row) * ldo + ch * 8) = v; }
  __syncthreads();
#undef PSM
#undef SLOAD_E
#undef SLOAD_O
#undef SWRITE_E
#undef SWRITE_O
#undef SWAIT
#undef RESC
}
#undef SBAR
}

#define XB_TMO      128
#define XB_XCNT(j)  (256  + 64 * (j))
#define XB_XSUB(j)  (1280 + 64 * (j))
#define XB_XGEN(j)  (2304 + 64 * (j))
#define XB_TOP      3328
#define XB_TOPGEN   3392
#define XCD_BAR_WORDS 3456
#define XB_SPIN_CAP (1u << 18)
__device__ __forceinline__ unsigned xb_ld(unsigned* p)              { return __hip_atomic_load(p, __ATOMIC_RELAXED, __HIP_MEMORY_SCOPE_AGENT); }
__device__ __forceinline__ unsigned xb_add(unsigned* p, unsigned v) { return __hip_atomic_fetch_add(p, v, __ATOMIC_RELAXED, __HIP_MEMORY_SCOPE_AGENT); }
__device__ __forceinline__ unsigned xb_xcc_id() { return (unsigned)__builtin_amdgcn_s_getreg((3 << 11) | 20) & 0xFu; }
#define XB_SPIN(cond, bar) do { unsigned _sp = 0; while (cond) { __builtin_amdgcn_s_sleep(1); \
    if ((++_sp & 255u) == 0u) { if (xb_ld(&(bar)[XB_TMO])) break; if (_sp > XB_SPIN_CAP) { atomicAdd(&(bar)[XB_TMO], 1u); break; } } } } while (0)
struct XcdBarrier { unsigned* bar; unsigned x; volatile LAS unsigned* st; };
__device__ __forceinline__ XcdBarrier xcd_barrier_post(unsigned* bar, volatile LAS unsigned* st) {
    XcdBarrier b; b.bar = bar; b.x = xb_xcc_id(); b.st = st;
    if (threadIdx.x == 0) (void)xb_add(&bar[XB_XCNT(b.x)], 1u);
    return b;
}
__device__ __forceinline__ void xcd_barrier_complete(unsigned* bar, unsigned x, unsigned& nloc, unsigned& nx) {
    const unsigned G = gridDim.x * gridDim.y * gridDim.z;
    unsigned sum, cnt, mine, sp = 0u;
    for (;;) {
        sum = 0u; cnt = 0u; mine = 0u;
#pragma unroll
        for (unsigned j = 0; j < 16; ++j) { const unsigned c = xb_ld(&bar[XB_XCNT(j)]); sum += c; cnt += (c > 0u) ? 1u : 0u; mine = (j == x) ? c : mine; }
        if (sum == G) break;
        __builtin_amdgcn_s_sleep(1);
        if ((++sp & 255u) == 0u) { if (xb_ld(&bar[XB_TMO])) break; if (sp > XB_SPIN_CAP) { atomicAdd(&bar[XB_TMO], 1u); break; } }
    }
    nloc = mine > 0u ? mine : 1u; nx = cnt > 0u ? cnt : 1u;
}
__device__ __forceinline__ void xcd_barrier(const XcdBarrier& b) {
    asm volatile("s_waitcnt vmcnt(0)" ::: "memory");
    __syncthreads();
    if (threadIdx.x == 0) {
        unsigned* bar = b.bar;
        __builtin_amdgcn_s_waitcnt(0);
        unsigned nloc = b.st[0], nx = b.st[1];
        if (nloc == 0u) { xcd_barrier_complete(bar, b.x, nloc, nx); b.st[0] = nloc; b.st[1] = nx; }
        const unsigned old = xb_add(&bar[XB_XSUB(b.x)], 1u);
        const unsigned gen = old / nloc;
        if (old + 1u == (gen + 1u) * nloc) {
            __builtin_amdgcn_fence(__ATOMIC_RELEASE, "agent");
            asm volatile("s_waitcnt vmcnt(0)" ::: "memory");
            const unsigned og = xb_add(&bar[XB_TOP], 1u);
            const unsigned tg = og / nx;
            if (og + 1u == (tg + 1u) * nx) xb_add(&bar[XB_TOPGEN], 1u);
            else XB_SPIN(xb_ld(&bar[XB_TOPGEN]) == tg, bar);
            __builtin_amdgcn_fence(__ATOMIC_ACQUIRE, "agent");
            xb_add(&bar[XB_XGEN(b.x)], 1u);
            asm volatile("s_waitcnt vmcnt(0)" ::: "memory");
        } else {
            XB_SPIN(xb_ld(&bar[XB_XGEN(b.x)]) == gen, bar);
            __builtin_amdgcn_fence(__ATOMIC_ACQUIRE, "agent");
            asm volatile("s_waitcnt vmcnt(0)" ::: "memory");
        }
    }
    __syncthreads();
}

constexpr int NWAVES = 8;
constexpr int RING_BYTES = 131072, LDSCTL_OFF = RING_BYTES, MISC_OFF = LDSCTL_OFF + 320, LDS_BYTES = 147456;
static_assert(att::LDS_BYTES <= RING_BYTES, "attention scratch inside the ring region");

struct Args {
    const float* in[20]; float* out; unsigned char* ws; int ph_lo, ph_hi;
};

__device__ __forceinline__ float wave_sum(float v) {
#pragma unroll
    for (int o = 1; o < 64; o <<= 1) v += __shfl_xor(v, o);
    return v;
}
__device__ __forceinline__ unsigned f2bf(float f) { unsigned u = __builtin_bit_cast(unsigned, f); return (u + 0x7fffu + ((u >> 16) & 1u)) >> 16; }
__device__ __forceinline__ unsigned pk2(float lo, float hi) { return f2bf(lo) | (f2bf(hi) << 16); }

__device__ __forceinline__ void transpose_item(const float* W, const float* gain, int K, int N, bf16_t* WT, int k0, int n0, int drow0, LAS float* scr, int lane) {
    const int kr = lane >> 3, nq = lane & 7;
    f32x4 v[8]; float gk[8];
#pragma unroll
    for (int i = 0; i < 8; ++i) { v[i] = *(const GAS f32x4*)(W + (size_t)(k0 + kr + 8 * i) * N + n0 + 4 * nq); gk[i] = gain ? gain[k0 + kr + 8 * i] : 1.0f; }
#pragma unroll
    for (int i = 0; i < 8; ++i) { LAS float* d = scr + (kr + 8 * i) * 33 + 4 * nq; d[0] = v[i].x * gk[i]; d[1] = v[i].y * gk[i]; d[2] = v[i].z * gk[i]; d[3] = v[i].w * gk[i]; }
    asm volatile("s_waitcnt lgkmcnt(0)" ::: "memory");
    const int c = lane & 7;
#pragma unroll
    for (int j = 0; j < 4; ++j) { const int n = (lane >> 3) + 8 * j; const LAS float* s = scr + (8 * c) * 33 + n;
        u32x4 o; o.x = pk2(s[0 * 33], s[1 * 33]); o.y = pk2(s[2 * 33], s[3 * 33]); o.z = pk2(s[4 * 33], s[5 * 33]); o.w = pk2(s[6 * 33], s[7 * 33]);
        *(GAS u32x4*)(WT + (size_t)(drow0 + n) * K + k0 + 8 * c) = o; }
    asm volatile("s_waitcnt lgkmcnt(0)" ::: "memory");
}

__device__ __forceinline__ int t5_bucket(int rel) {
    const int n = rel < 0 ? -rel : rel; int b;
    if (n < 8) b = n; else { b = 8 + (n >= 15) + (n >= 27) + (n >= 50) + (n >= 91) + (n >= 166) + (n >= 305) + (n >= 559); if (b > 15) b = 15; }
    return b + (rel > 0 ? 16 : 0);
}
__device__ __forceinline__ void sincos_d(double a, double& s, double& c) {
    const double k = __builtin_rint(a * 0.63661977236758134308);
    const double r = (a - k * 1.57079632679489655800) - k * 6.12323399573676603587e-17;
    const double r2 = r * r;
    double ps = 1.0 / 6227020800.0;
    ps = ps * r2 - 1.0 / 39916800.0; ps = ps * r2 + 1.0 / 362880.0; ps = ps * r2 - 1.0 / 5040.0; ps = ps * r2 + 1.0 / 120.0; ps = ps * r2 - 1.0 / 6.0; ps = ps * r2 + 1.0;
    const double sr = r * ps;
    double pc = -1.0 / 87178291200.0;
    pc = pc * r2 + 1.0 / 479001600.0; pc = pc * r2 - 1.0 / 3628800.0; pc = pc * r2 + 1.0 / 40320.0; pc = pc * r2 - 1.0 / 720.0; pc = pc * r2 + 1.0 / 24.0; pc = pc * r2 - 0.5; pc = pc * r2 + 1.0;
    const int q = ((int)k) & 3;
    s = (q == 0) ? sr : (q == 1) ? pc : (q == 2) ? -sr : -pc;
    c = (q == 0) ? pc : (q == 1) ? -sr : (q == 2) ? -pc : sr;
}

__device__ __forceinline__ float row_to_bf16(const float* xrow, bf16_t* orow, int lane) {
    const GAS f32x4* xr = (const GAS f32x4*)xrow + lane;
    f32x4 v[8]; float s = 0.f;
#pragma unroll
    for (int j = 0; j < 8; ++j) { v[j] = xr[64 * j]; s += (v[j].x * v[j].x + v[j].y * v[j].y) + (v[j].z * v[j].z + v[j].w * v[j].w); }
    GAS u32x2* o8 = (GAS u32x2*)orow + lane;
#pragma unroll
    for (int j = 0; j < 8; ++j) { u32x2 w; w.x = cvt_pk_bf16(v[j].x, v[j].y); w.y = cvt_pk_bf16(v[j].z, v[j].w); o8[64 * j] = w; }
    return wave_sum(s);
}
__device__ __forceinline__ void rms_row_out(const bf16_t* xrow, float* orow, const float* g, float rstd, int lane) {
    const GAS u32x2* xr = (const GAS u32x2*)xrow + lane; GAS f32x4* o = (GAS f32x4*)orow + lane; const GAS f32x4* gr = (const GAS f32x4*)g + lane;
#pragma unroll
    for (int j = 0; j < 8; ++j) { const u32x2 w = xr[64 * j]; const f32x4 gg = gr[64 * j]; f32x4 v = {bflo(w.x), bfhi(w.x), bflo(w.y), bfhi(w.y)}; o[64 * j] = v * rstd * gg; }
}

__device__ __forceinline__ void qknorm_rows(bf16_t* qkv, const float* ropec, const float* ropes, const float* qg, const float* kg, int row_base, int tid) {
    const int lane = tid & 63, wave = tid >> 6;
    const int head = lane >> 3, q8 = lane & 7, hf = q8 >> 2, a = q8 & 3;
    const float* gp = (head < 6) ? qg : kg;
    const float osc = (head < 6) ? 0.088388347648318440f * 1.4426950408889634f : 1.0f;
    float g1[8], g2[8];
#pragma unroll
    for (int e = 0; e < 8; ++e) { g1[e] = gp[hf * 64 + 8 * a + e]; g2[e] = gp[hf * 64 + 32 + 8 * a + e]; }
    for (int t0 = 0; t0 < 32; t0 += 4) {
        u32x4 w1[4], w2[4]; f32x4 cs[4][4];
#pragma unroll
        for (int i = 0; i < 4; ++i) { const int m = row_base + wave + 8 * (t0 + i);
            const int s = (m < NPROMPT) ? (m & (SEQ_P - 1)) : ((m - NPROMPT) & (SEQ_S - 1)); const int n = hf ? (s & 63) : (s >> 6);
            const bf16_t* p1 = qkv + (size_t)m * PROJ + head * HD + hf * 64 + 8 * a;
            w1[i] = *(const GAS u32x4*)p1; w2[i] = *(const GAS u32x4*)(p1 + 32);
            cs[i][0] = *(const GAS f32x4*)(ropec + n * 32 + 8 * a); cs[i][1] = *(const GAS f32x4*)(ropec + n * 32 + 8 * a + 4);
            cs[i][2] = *(const GAS f32x4*)(ropes + n * 32 + 8 * a); cs[i][3] = *(const GAS f32x4*)(ropes + n * 32 + 8 * a + 4); }
#pragma unroll
        for (int i = 0; i < 4; ++i) { const int m = row_base + wave + 8 * (t0 + i);
            bf16_t* p1 = qkv + (size_t)m * PROJ + head * HD + hf * 64 + 8 * a;
            float x1[8], x2[8];
#pragma unroll
            for (int e = 0; e < 4; ++e) { x1[2 * e] = bflo(w1[i][e]); x1[2 * e + 1] = bfhi(w1[i][e]); x2[2 * e] = bflo(w2[i][e]); x2[2 * e + 1] = bfhi(w2[i][e]); }
            float ss = 0.f;
#pragma unroll
            for (int e = 0; e < 8; ++e) ss += x1[e] * x1[e] + x2[e] * x2[e];
            ss += __shfl_xor(ss, 1); ss += __shfl_xor(ss, 2); ss += __shfl_xor(ss, 4);
            const float rstd = 1.0f / sqrtf(ss * (1.f / HD) + RMS_EPS);
            float o1[8], o2[8];
#pragma unroll
            for (int e = 0; e < 8; ++e) { const float cc = e < 4 ? cs[i][0][e & 3] : cs[i][1][e & 3], sn = e < 4 ? cs[i][2][e & 3] : cs[i][3][e & 3];
                const float y1 = x1[e] * rstd * g1[e], y2 = x2[e] * rstd * g2[e]; o1[e] = (y1 * cc - y2 * sn) * osc; o2[e] = (y1 * sn + y2 * cc) * osc; }
            u32x4 r1, r2;
#pragma unroll
            for (int e = 0; e < 4; ++e) { r1[e] = cvt_pk_bf16(o1[2 * e], o1[2 * e + 1]); r2[e] = cvt_pk_bf16(o2[2 * e], o2[2 * e + 1]); }
            *(GAS u32x4*)p1 = r1; *(GAS u32x4*)(p1 + 32) = r2; }
    }
}
__device__ __forceinline__ void crescale_rows(bf16_t* mix, const float* lsebuf, int row_base, int tid) {
    const int lane = tid & 63, wave = tid >> 6;
    for (int t0 = 0; t0 < 32; t0 += 4) {
        float ls[4][6]; u32x2 w[4][3];
#pragma unroll
        for (int i = 0; i < 4; ++i) { const int m = row_base + wave + 8 * (t0 + i);
#pragma unroll
            for (int k = 0; k < 6; ++k) ls[i][k] = lsebuf[(size_t)m * 6 + k];
            const GAS u32x2* p = (const GAS u32x2*)(mix + (size_t)m * MIXW + 1280) + lane;
#pragma unroll
            for (int j = 0; j < 3; ++j) w[i][j] = p[64 * j]; }
#pragma unroll
        for (int i = 0; i < 4; ++i) { const int m = row_base + wave + 8 * (t0 + i);
            float al[6];
#pragma unroll
            for (int j = 0; j < 2; ++j) { const float mx = fmaxf(fmaxf(ls[i][j], ls[i][2 + j]), ls[i][4 + j]);
                const float e0 = __expf(ls[i][j] - mx), e1 = __expf(ls[i][2 + j] - mx), e2 = __expf(ls[i][4 + j] - mx); const float inv = 1.0f / (e0 + e1 + e2);
                al[j] = e0 * inv; al[2 + j] = e1 * inv; al[4 + j] = e2 * inv; }
            GAS u32x2* p = (GAS u32x2*)(mix + (size_t)m * MIXW + 1280) + lane;
#pragma unroll
            for (int j = 0; j < 3; ++j) { const int hc = (4 * lane + 256 * j) >> 7; const float a = (hc == 0) ? al[0] : (hc == 1) ? al[1] : (hc == 2) ? al[2] : (hc == 3) ? al[3] : (hc == 4) ? al[4] : al[5];
                u32x2 v = w[i][j]; v.x = cvt_pk_bf16(bflo(v.x) * a, bfhi(v.x) * a); v.y = cvt_pk_bf16(bflo(v.y) * a, bfhi(v.y) * a); p[64 * j] = v; } }
    }
}

__global__ void __launch_bounds__(NWAVES * 64, 2) fwd(Args args) {
    extern __shared__ __attribute__((aligned(16))) unsigned char lds[];
    LAS unsigned char* ldsl = (LAS unsigned char*)lds;
    volatile LAS unsigned* MISC = (volatile LAS unsigned*)(ldsl + MISC_OFF);
    const int G = gridDim.x;
    unsigned char* ws = args.ws;
    gu32* ctl = (gu32*)(ws + WS_CTL);
    { const int tid0 = threadIdx.x; for (int u = tid0; u < (LDS_BYTES - LDSCTL_OFF) / 4; u += NWAVES * 64) ((LAS unsigned*)(ldsl + LDSCTL_OFF))[u] = 0u; }
    __syncthreads();
    XcdBarrier bar; bar.bar = (unsigned*)ctl + CW_BAR; bar.x = 0; bar.st = nullptr;
    if (ONE_LAUNCH) bar = xcd_barrier_post((unsigned*)ctl + CW_BAR, MISC + 8);
    int bx = blockIdx.x;
    if (ONE_LAUNCH) {
        if (threadIdx.x == 0) { const unsigned xcc = xb_xcc_id(); const unsigned rk = __hip_atomic_fetch_add(ctl + CW_XRANK + 64 * (xcc & 15u), 1u, __ATOMIC_RELAXED, __HIP_MEMORY_SCOPE_AGENT); MISC[12] = rk * 8u + xcc; }
        xcd_barrier(bar);
        if (threadIdx.x == 0) { bool ok = (G % 8 == 0);
            for (unsigned j = 0; j < 16; ++j) { const unsigned cnt = __hip_atomic_load(ctl + CW_XRANK + 64 * j, __ATOMIC_RELAXED, __HIP_MEMORY_SCOPE_AGENT); ok = ok && (cnt == (j < 8 ? (unsigned)G / 8u : 0u)); }
            if (!ok) MISC[12] = blockIdx.x; }
        __syncthreads();
        bx = __builtin_amdgcn_readfirstlane((int)MISC[12]);
    }
    const int lo = args.ph_lo, hi = args.ph_hi;
#ifndef PHMASK
#define PHMASK 0xffff
#endif
#define IN(k) (lo <= (k) && (k) < hi)
#define EN(b) ((PHMASK >> (b)) & 1)
#ifndef PROBE_DUP
#define PROBE_DUP 0
#endif
#define NREP(b) (1 + ((PROBE_DUP >> (b)) & 1))
#define REPSEAM(b) do { if (ONE_LAUNCH && NREP(b) > 1 && rep == 0) xcd_barrier(bar); } while (0)
#define SEAM(k) do { if (ONE_LAUNCH && IN(k) && IN((k) + 1)) xcd_barrier(bar); } while (0)
#define LANE_ID() const int tid = opaque_tid(), lane = tid & 63, wave = __builtin_amdgcn_readfirstlane(tid >> 6); const int vcu = (G % 8 == 0) ? (bx % 8) * (G / 8) + bx / 8 : bx; const int gw = vcu * NWAVES + wave, NGW = G * NWAVES; (void)lane; (void)gw; (void)NGW
#define ROPEC ((float*)(ws + WS_TAB))
#define ROPES (ROPEC + 128 * 32)
#define TABB (ROPES + 128 * 32)
#define TABC (TABB + 4 * 512)
#define LSEBUF ((float*)(ws + WS_LSE))
#define XB ((bf16_t*)(ws + WS_XB))
#define MB ((bf16_t*)(ws + WS_MB))
#define SSBUF ((pg8::ss_t*)(ws + WS_SS))
#define RSM ((pg8::ss_t*)(ws + WS_RSM))
#define QKV ((bf16_t*)(ws + WS_QKV))
#define MIX ((bf16_t*)(ws + WS_MIX))
#define HID ((bf16_t*)(ws + WS_HID))
#define QX ((bf16_t*)(ws + WS_QX))
#define OX ((bf16_t*)(ws + WS_OX))
#define KVX ((bf16_t*)(ws + WS_KVX))
    float* out = args.out;

    if (EN(13) && IN(0)) {
        LANE_ID();
        float* ropec = ROPEC; float* ropes = ROPES; float* tabB = TABB; float* tabC = TABC;
        LAS float* scr = (LAS float*)(ldsl + wave * 16384);
        constexpr int I_IN = 32 * 120, I_OUT = 32 * 64, I_CQ = 32 * 16, I_CKV = 32 * 32, I_CO = 8 * 64, I_FI = 32 * 352, I_FO = 88 * 64;
        constexpr int I_LAYER = I_IN + I_OUT + I_CQ + I_CKV + I_CO + I_FI + I_FO;
        for (int it = gw; it < DEPTH * I_LAYER; it += NGW) {
            const int l = it / I_LAYER; int r = it % I_LAYER;
            const float* W; bf16_t* WT; int K, N; const float* gain = nullptr;
            if (r < I_IN) { gain = args.in[4] + (size_t)l * DM; W = args.in[5] + (size_t)l * DM * PROJ; WT = (bf16_t*)(ws + WS_WIN) + (size_t)l * PROJ * DM; K = DM; N = PROJ; }
            else if ((r -= I_IN) < I_OUT) { W = args.in[10] + (size_t)l * MIXW * DM; WT = (bf16_t*)(ws + WS_WOUT) + (size_t)l * DM * MIXW; K = MIXW; N = DM; }
            else if ((r -= I_OUT) < I_CQ) { gain = args.in[11] + (size_t)l * DM; W = args.in[13] + (size_t)l * DM * XW; WT = (bf16_t*)(ws + WS_WCQ) + (size_t)l * XW * DM; K = DM; N = XW; }
            else if ((r -= I_CQ) < I_CKV) { gain = args.in[12] + (size_t)l * DM; W = args.in[14] + (size_t)l * DM * 2 * XW; WT = (bf16_t*)(ws + WS_WCKV) + (size_t)l * 2 * XW * DM; K = DM; N = 2 * XW; }
            else if ((r -= I_CKV) < I_CO) { W = args.in[15] + (size_t)l * XW * DM; WT = (bf16_t*)(ws + WS_WCO) + (size_t)l * DM * XW; K = XW; N = DM; }
            else if ((r -= I_CO) < I_FI) { gain = args.in[16] + (size_t)l * DM; W = args.in[17] + (size_t)l * DM * 2 * DFF; WT = (bf16_t*)(ws + WS_WFI) + (size_t)l * 2 * DFF * DM; K = DM; N = 2 * DFF; }
            else { r -= I_FI; W = args.in[18] + (size_t)l * DFF * DM; WT = (bf16_t*)(ws + WS_WFO) + (size_t)l * DM * DFF; K = DFF; N = DM; }
            const int nblk = N / 32, kb = r / nblk, nb = r % nblk, n0 = 32 * nb;
            int drow0 = n0;
            if (N == 2 * DFF) drow0 = (n0 < DFF) ? 256 * (n0 / 128) + (n0 % 128) : 256 * ((n0 - DFF) / 128) + 128 + ((n0 - DFF) % 128);
            transpose_item(W, gain, K, N, WT, 64 * kb, n0, drow0, scr, lane);
        }
        { bf16_t* xb = XB; pg8::ss_t* ss0 = SSBUF; bf16_t* mb = MB; pg8::ss_t* rsm = RSM;
          for (int m = gw; m < NTOK; m += NGW) { const float* xr = (m < NPROMPT) ? args.in[0] + (size_t)m * DM : args.in[1] + (size_t)(m - NPROMPT) * DM;
              const float q = row_to_bf16(xr, xb + (size_t)m * DM, lane); if (lane == 0) ss0[m] = (pg8::ss_t)(q * pg8::SS_SCALE); }
          for (int m = gw; m < MEMROWS; m += NGW) { const float* mr = (m < 2 * MEMLEN) ? args.in[2] + (size_t)m * DM : args.in[3] + (size_t)(m - 2 * MEMLEN) * DM;
              const float q = row_to_bf16(mr, mb + (size_t)m * DM, lane); if (lane == 0) rsm[m] = (pg8::ss_t)(q * pg8::SS_SCALE); } }
        const int gt = vcu * (NWAVES * 64) + tid, NGT = G * NWAVES * 64;
        const float* rel_bias = args.in[9];
        for (int e = gt; e < 4096 + 2048 + 3072; e += NGT) {
            if (e < 4096) { const int n = e >> 5, i = e & 31;
                double invd = 1.0; for (int q = 0; q < i; ++q) invd *= 0.7498942093324559;
                const float inv = (float)invd;
                const float ang = (float)n * inv; double s, c; sincos_d((double)ang, s, c); ropec[e] = (float)c; ropes[e] = (float)s; }
            else if (e < 4096 + 2048) { const int t = e - 4096, h = t >> 9, i = t & 511; const int rel = i - 96 - 128;
                float v = -INFINITY; if (rel >= -128 && rel <= 128) v = rel_bias[t5_bucket(rel) * 10 + h] * att::LOG2E;
                tabB[t] = v; }
            else { const int t = e - 6144, hc = t >> 9, i = t & 511; const int off = i - 96 - 64; const int d = (hc < 2) ? 1 : (hc < 4) ? 4 : 16;
                float v = -INFINITY; if (off >= -64 && off <= 64) v = rel_bias[t5_bucket(off * d) * 10 + 4 + hc] * att::LOG2E;
                tabC[t] = v; }
        }
    }
    SEAM(0);

    for (int l = 0; l < DEPTH; ++l) {
        const int pb = 1 + PPL * l;
#define XS0 ((l == 0) ? args.in[0] : (const float*)out)
#define XS1 ((l == 0) ? args.in[1] : (const float*)out + (size_t)NPROMPT * DM)
        if (EN(0) && IN(pb + 0)) for (int rep = 0; rep < NREP(0); ++rep) {
            { const bf16_t* Win = (const bf16_t*)(ws + WS_WIN) + (size_t)l * PROJ * DM;
              pg8::Gemm g{XB, Win, NTOK, PROJ, DM}; pg8::StaticOrder S; S.init(NTOK, PROJ, G, bx);
              pg8::EpiBf16 E{QKV, PROJ, SSBUF + (size_t)(3 * l) * NTOK};
              pg8::gemm_phase<pg8::EpiBf16, pg8::StaticOrder, true, true>(ldsl, g, S, E); }
            if (l == 0) {
              pg8::Gemm g{MB, (const bf16_t*)(ws + WS_WCKV), MEMROWS, 4 * 2 * XW, DM}; pg8::StaticOrder S; S.init(MEMROWS, 4 * 2 * XW, G, (bx + G - 64) % G);
              pg8::EpiBf16 E{KVX, 4 * 2 * XW, RSM};
              pg8::gemm_phase<pg8::EpiBf16, pg8::StaticOrder, true, true>(ldsl, g, S, E); }
            REPSEAM(0);
        }
        SEAM(pb + 0);
        if (EN(1) && IN(pb + 1)) {
            const int tid = opaque_tid(); const float* tabC = TABC; float* lsebuf = LSEBUF;
            gu32* qhead = ctl + CW_QUEUE + 64 * (2 * l);
            volatile LAS unsigned* uidw = (volatile LAS unsigned*)(ldsl + att::OFF_UID);
            for (;;) {
                if (tid == 0) uidw[0] = __hip_atomic_fetch_add(qhead, 1u, __ATOMIC_RELAXED, __HIP_MEMORY_SCOPE_AGENT);
                __syncthreads();
                const int u = (int)uidw[0];
                __syncthreads();
                if (u >= 1344) break;
                if (u < 960 && u % 5 == 4) {
                    qknorm_rows(QKV, ROPEC, ROPES, args.in[6] + (size_t)l * HD, args.in[7] + (size_t)l * HD, (u / 5) * 256, tid);
                } else { const int v0 = (u < 960) ? u - u / 5 : u - 192;
                {
                    const int v = v0, gi = v % 3, idx = v / 3; const int d = (gi == 0) ? 1 : (gi == 1) ? 4 : 16;
                    long row0; int j, L;
                    if (idx < 128) { row0 = (long)(idx / 64) * SEQ_P; j = idx % 64; L = SEQ_P; } else { const int i2 = idx - 128; row0 = NPROMPT + (long)(i2 / 32) * SEQ_S; j = i2 % 32; L = SEQ_S; }
                    const int res = j % d, qbr = j / d, p0 = qbr * 128, Lr = L / d;
                    int tlo = p0 / 64 - 1, thi = p0 / 64 + 3; if (tlo < 0) tlo = 0; if (thi > Lr / 64) thi = Lr / 64;
                    const long rq = row0 + (long)p0 * d + res, rk = row0 + res; const int hc = 2 * gi;
                    att::attn_unit<true>(QKV + rq * PROJ + COL_QC + hc * HD, (long)d * PROJ, QKV + rk * PROJ + COL_KC + gi * HD, QKV + rk * PROJ + COL_VC + gi * HD, (long)d * PROJ,
                                         MIX + rq * MIXW + 1280 + hc * HD, (long)d * MIXW, tlo, thi, p0, 64, tabC + hc * 512, 321, -1e30f, -1e30f, 0.f, lsebuf + rq * 6 + hc, (long)d * 6, (char*)lds);
                } }
            }
        }
        SEAM(pb + 1);
        if (EN(2) && IN(pb + 2)) for (int rep = 0; rep < NREP(2); ++rep) {
            const int tid = opaque_tid(); const float* tabB = TABB;
            float mfix2;
            { const float* qg = args.in[6] + (size_t)l * HD; const float* kg = args.in[7] + (size_t)l * HD; const int ln = tid & 63;
              float a = fmaxf(fabsf(qg[ln]), fabsf(qg[ln + 64])), b = fmaxf(fabsf(kg[ln]), fabsf(kg[ln + 64]));
#pragma unroll
              for (int o = 1; o < 64; o <<= 1) { a = fmaxf(a, __shfl_xor(a, o)); b = fmaxf(b, __shfl_xor(b, o)); }
              mfix2 = __builtin_amdgcn_readfirstlane(128.f * a * b * 1.02f * att::C); if (!(mfix2 <= 40.f)) mfix2 = -1.f; }
            gu32* qhead = ctl + CW_QUEUE + 64 * (2 * l + 1 + 8 * rep);
            volatile LAS unsigned* uidw = (volatile LAS unsigned*)(ldsl + att::OFF_UID);
            const float* sink = args.in[8] + (size_t)l * 4;
            for (;;) {
                if (tid == 0) uidw[0] = __hip_atomic_fetch_add(qhead, 1u, __ATOMIC_RELAXED, __HIP_MEMORY_SCOPE_AGENT);
                __syncthreads();
                const int u = (int)uidw[0];
                __syncthreads();
                if (u >= 1152 + 192 + 768) break;
                if (u < 1152) {
                    int seq, kvh, qb, gi, L;
                    if (u < 384) { seq = u / 192; const int r = u % 192; kvh = r / 96; const int r2 = r % 96; qb = r2 / 3; gi = r2 % 3; L = SEQ_P; }
                    else { const int v = u - 384; seq = 2 + v / 96; const int r = v % 96; kvh = r / 48; const int r2 = r % 48; qb = r2 / 3; gi = r2 % 3; L = SEQ_S; }
                    const long row0 = (seq < 2) ? (long)seq * SEQ_P : (long)NPROMPT + (long)(seq - 2) * SEQ_S;
                    const int h = kvh * 3 + gi;
                    att::attn_unit_dense<true>(QKV + (row0 + qb * 256) * PROJ + COL_QA + h * HD, PROJ, QKV + row0 * PROJ + COL_KA + kvh * HD, QKV + row0 * PROJ + COL_VA + kvh * HD, PROJ,
                                         MIX + (row0 + qb * 256) * MIXW + h * HD, MIXW, L / 64, mfix2, (char*)lds);
                } else if (u < 1344) { if (rep == 0) crescale_rows(MIX, LSEBUF, (u - 1152) * 256, tid); }
                else {
                    const int v = u - 1344, qbg = v >> 1, kvh = v & 1; const long rowq = (long)qbg * 128;
                    long row0; int pos0, L;
                    if (rowq < NPROMPT) { row0 = (rowq / SEQ_P) * SEQ_P; pos0 = (int)(rowq % SEQ_P); L = SEQ_P; } else { const long rr = rowq - NPROMPT; row0 = NPROMPT + (rr / SEQ_S) * SEQ_S; pos0 = (int)(rr % SEQ_S); L = SEQ_S; }
                    int tlo = pos0 / 64 - 2, thi = pos0 / 64 + 4; if (tlo < 0) tlo = 0; if (thi > L / 64) thi = L / 64;
                    const int h = 2 * kvh;
                    att::attn_unit<true>(QKV + rowq * PROJ + COL_QB + h * HD, PROJ, QKV + row0 * PROJ + COL_KB + kvh * HD, QKV + row0 * PROJ + COL_VB + kvh * HD, PROJ,
                                         MIX + rowq * MIXW + 768 + h * HD, MIXW, tlo, thi, pos0, 128, tabB + h * 512, 449, sink[h] * att::LOG2E, sink[h + 1] * att::LOG2E, 1.0f, nullptr, 0, (char*)lds);
                }
            }
            REPSEAM(2);
        }
        SEAM(pb + 2);
        if (EN(3) && IN(pb + 3)) for (int rep = 0; rep < NREP(3); ++rep) {
            const bf16_t* Wout = (const bf16_t*)(ws + WS_WOUT) + (size_t)l * DM * MIXW;
            pg8::Gemm g{MIX, Wout, NTOK, DM, MIXW}; pg8::StaticOrder S; S.init(NTOK, DM, G, bx);
            pg8::EpiRes E{XB, SSBUF + (size_t)(rep ? NNORM : 3 * l + 1) * NTOK, rep ? 0.f : 1.f};
            pg8::gemm_phase<pg8::EpiRes, pg8::StaticOrder, true, true>(ldsl, g, S, E);
            REPSEAM(3);
        }
        SEAM(pb + 3);
        if (EN(4) && IN(pb + 4)) for (int rep = 0; rep < NREP(4); ++rep) {
            const bf16_t* Wcq = (const bf16_t*)(ws + WS_WCQ) + (size_t)l * XW * DM;
            pg8::Gemm g{XB, Wcq, NTOK, XW, DM}; pg8::StaticOrder S; S.init(NTOK, XW, G, bx); pg8::EpiBf16 E{QX, XW, SSBUF + (size_t)(3 * l + 1) * NTOK};
            pg8::gemm_phase<pg8::EpiBf16, pg8::StaticOrder, true, true>(ldsl, g, S, E);
            REPSEAM(4);
        }
        SEAM(pb + 4);
        if (EN(5) && IN(pb + 5)) for (int rep = 0; rep < NREP(5); ++rep) {
            for (int u = bx; u < 768; u += G) {
                const int qbg = u >> 2, h = u & 3; const long rowq = (long)qbg * 256;
                const int seq = (rowq < NPROMPT) ? (int)(rowq / SEQ_P) : 2 + (int)((rowq - NPROMPT) / SEQ_S);
                const bf16_t* kb = KVX + (size_t)seq * MEMLEN * (4 * 2 * XW) + l * (2 * XW) + h * HD;
                att::attn_unit_dense<false>(QX + rowq * XW + h * HD, XW, kb, kb + XW, 4 * 2 * XW, OX + rowq * XW + h * HD, XW, MEMLEN / 64, -1.f, (char*)lds);
            }
            REPSEAM(5);
        }
        SEAM(pb + 5);
        if (EN(6) && IN(pb + 6)) for (int rep = 0; rep < NREP(6); ++rep) {
            const bf16_t* Wco = (const bf16_t*)(ws + WS_WCO) + (size_t)l * DM * XW;
            pg8::Gemm g{OX, Wco, NTOK, DM, XW}; pg8::StaticOrder S; S.init(NTOK, DM, G, bx);
            pg8::EpiRes E{XB, SSBUF + (size_t)(rep ? NNORM : 3 * l + 2) * NTOK, rep ? 0.f : 1.f};
            pg8::gemm_phase<pg8::EpiRes, pg8::StaticOrder, true, true>(ldsl, g, S, E);
            REPSEAM(6);
        }
        SEAM(pb + 6);
        if (EN(7) && IN(pb + 7)) for (int rep = 0; rep < NREP(7); ++rep) {
            const bf16_t* Wfi = (const bf16_t*)(ws + WS_WFI) + (size_t)l * 2 * DFF * DM;
            pg8::Gemm g{XB, Wfi, NTOK, 2 * DFF, DM}; pg8::StaticOrder S; S.init(NTOK, 2 * DFF, G, bx);
            pg8::EpiSwiglu E{HID, DFF, SSBUF + (size_t)(3 * l + 2) * NTOK};
            pg8::gemm_phase<pg8::EpiSwiglu, pg8::StaticOrder, true, true>(ldsl, g, S, E);
            REPSEAM(7);
        }
        SEAM(pb + 7);
        if (EN(8) && IN(pb + 8)) for (int rep = 0; rep < NREP(8); ++rep) {
            const bf16_t* Wfo = (const bf16_t*)(ws + WS_WFO) + (size_t)l * DM * DFF;
            pg8::Gemm g{HID, Wfo, NTOK, DM, DFF}; pg8::StaticOrder S; S.init(NTOK, DM, G, bx);
            pg8::EpiRes E{XB, SSBUF + (size_t)(rep ? NNORM : 3 * l + 3) * NTOK, rep ? 0.f : 1.f};
            pg8::gemm_phase<pg8::EpiRes, pg8::StaticOrder, true, true>(ldsl, g, S, E);
            REPSEAM(8);
        }
        SEAM(pb + 8);
    }
    if (EN(14) && IN(NPHASE - 1)) {
        LANE_ID();
        const float* g = args.in[19]; const pg8::ss_t* ssl = SSBUF + (size_t)(NNORM - 1) * NTOK;
        f32x4 gg[8];
#pragma unroll
        for (int j = 0; j < 8; ++j) gg[j] = ((const GAS f32x4*)g)[lane + 64 * j];
        for (int m = gw; m < NTOK; m += 4 * NGW) {
            u32x2 w[4][8]; float rstd[4];
#pragma unroll
            for (int i = 0; i < 4; ++i) { const int mi = m + i * NGW; const int mc = mi < NTOK ? mi : m;
                rstd[i] = __builtin_amdgcn_rsqf((float)ssl[mc] * pg8::SS_INV_MEAN + RMS_EPS);
#pragma unroll
                for (int j = 0; j < 8; ++j) w[i][j] = ((const GAS u32x2*)(XB + (size_t)mc * DM))[lane + 64 * j]; }
#pragma unroll
            for (int i = 0; i < 4; ++i) { const int mi = m + i * NGW; if (mi < NTOK) { GAS f32x4* o = (GAS f32x4*)(out + (size_t)mi * DM) + lane;
#pragma unroll
                for (int j = 0; j < 8; ++j) { const f32x4 v = {bflo(w[i][j].x), bfhi(w[i][j].x), bflo(w[i][j].y), bfhi(w[i][j].y)}; o[64 * j] = v * rstd[i] * gg[j]; } } }
        }
    }
#undef IN
#undef SEAM
}

extern "C" void kernel_launch(void* const* d_in, const int* in_sizes, int n_in, void* d_out, int out_size, void* d_ws, size_t ws_size, hipStream_t stream) {
    static int grid = 0;
    if (grid == 0) {
        if (n_in != 20 || out_size != NTOK * DM || ws_size < WS_END) { fprintf(stderr, "kernel_launch: unexpected shapes: n_in %d out %d ws %zu (need %zu)\n", n_in, out_size, ws_size, (size_t)WS_END); grid = -1; return; }
        int dev = 0, cus = 0, per_cu = 0;
        if (hipGetDevice(&dev) != hipSuccess || hipDeviceGetAttribute(&cus, hipDeviceAttributeMultiprocessorCount, dev) != hipSuccess) { grid = -1; return; }
        if (hipFuncSetAttribute((const void*)fwd, hipFuncAttributeMaxDynamicSharedMemorySize, LDS_BYTES) != hipSuccess) { fprintf(stderr, "kernel_launch: hipFuncSetAttribute failed\n"); grid = -1; return; }
        if (hipOccupancyMaxActiveBlocksPerMultiprocessor(&per_cu, (const void*)fwd, NWAVES * 64, LDS_BYTES) != hipSuccess || per_cu < 1) { fprintf(stderr, "kernel_launch: occupancy query says %d\n", per_cu); }
        (void)hipGetLastError();
        grid = cus;
    }
    if (grid < 0) return;
    (void)hipMemsetAsync((char*)d_ws + WS_CTL, 0, CTL_ZERO_BYTES, stream);
    Args a{};
    for (int i = 0; i < 20; ++i) a.in[i] = (const float*)d_in[i];
    a.out = (float*)d_out; a.ws = (unsigned char*)d_ws;
#if ONE_LAUNCH
    a.ph_lo = 0; a.ph_hi = NPHASE;
    hipLaunchKernelGGL(fwd, dim3(grid), dim3(NWAVES * 64), LDS_BYTES, stream, a);
#else
    for (int p = 0; p < NPHASE; ++p) { a.ph_lo = p; a.ph_hi = p + 1; hipLaunchKernelGGL(fwd, dim3(grid), dim3(NWAVES * 64), LDS_BYTES, stream, a); }
#endif
    const hipError_t le = hipPeekAtLastError();
    if (le != hipSuccess) fprintf(stderr, "kernel_launch: launch failed: %s\n", hipGetErrorName(le));
}
```

```cpp
#include <hip/hip_runtime.h>
#include <cstdio>
#include <cstdint>

#ifndef ONE_LAUNCH
#define ONE_LAUNCH 1
#endif

constexpr int DM = 2048, NTOK = 49152, NPROMPT = 16384, SEQ_P = 8192, SEQ_S = 4096, DEPTH = 4;
constexpr int PROJ = 3840, MIXW = 2048, XW = 512, DFF = 5632, MEMLEN = 256, MEMROWS = 2560, HD = 128;
constexpr int COL_QA = 0, COL_KA = 768, COL_VA = 1024, COL_QB = 1280, COL_KB = 1792, COL_VB = 2048, COL_QC = 2304, COL_KC = 3072, COL_VC = 3456;
constexpr float RMS_EPS = 1e-6f;
constexpr int PPL = 9;
constexpr int NPHASE = 2 + PPL * DEPTH;
constexpr int NNORM = 3 * DEPTH + 1;

constexpr size_t MiB = 1u << 20;
constexpr size_t WS_CTL = 0;
constexpr size_t WS_SS = 1 * MiB;
constexpr size_t CTL_ZERO_BYTES = 6 * MiB + 512 * 1024;
static_assert(WS_SS + (size_t)(NNORM + 1) * NTOK * 8 <= CTL_ZERO_BYTES, "ss inside the memset region");
constexpr size_t WS_TAB = 6 * MiB + 512 * 1024;
constexpr size_t WS_RSM = 7 * MiB;
constexpr size_t WS_LSE = 618 * MiB;
constexpr size_t WS_WIN = 8 * MiB, WS_WOUT = 68 * MiB, WS_WCQ = 100 * MiB, WS_WCKV = 108 * MiB, WS_WCO = 124 * MiB, WS_WFI = 132 * MiB, WS_WFO = 308 * MiB;
constexpr size_t WS_XB = 396 * MiB;
constexpr size_t WS_MB = 588 * MiB;
constexpr size_t WS_KVX = 598 * MiB;
constexpr size_t WS_QKV = 620 * MiB;
constexpr size_t WS_MIX = 980 * MiB;
constexpr size_t WS_HID = 620 * MiB;
constexpr size_t WS_QX = 620 * MiB, WS_OX = 668 * MiB;
constexpr size_t WS_END = 1172 * MiB;
constexpr int CW_BAR = 4096;
constexpr int CW_XRANK = 12288;
constexpr int CW_QUEUE = 16384;

#define GAS __attribute__((address_space(1)))
#define LAS __attribute__((address_space(3)))
typedef unsigned short bf16_t;
typedef short bf16x8 __attribute__((ext_vector_type(8)));
typedef short s16x4 __attribute__((ext_vector_type(4)));
typedef float f32x4 __attribute__((ext_vector_type(4)));
typedef float f32x16 __attribute__((ext_vector_type(16)));
typedef unsigned u32x4 __attribute__((ext_vector_type(4)));
typedef unsigned u32x2 __attribute__((ext_vector_type(2)));
typedef GAS unsigned gu32;

__device__ __forceinline__ int opaque_tid() { int t = threadIdx.x; asm volatile("" : "+v"(t)); return t; }
__device__ __forceinline__ unsigned cvt_pk_bf16(float lo, float hi) { unsigned r; asm volatile("v_cvt_pk_bf16_f32 %0, %1, %2" : "=v"(r) : "v"(lo), "v"(hi)); return r; }
__device__ __forceinline__ float bf2f(unsigned short b) { return __builtin_bit_cast(float, (unsigned)b << 16); }
__device__ __forceinline__ float bflo(unsigned w) { return __builtin_bit_cast(float, w << 16); }
__device__ __forceinline__ float bfhi(unsigned w) { return __builtin_bit_cast(float, w & 0xffff0000u); }

namespace pg8 {
#define PG8_LAS __attribute__((address_space(3)))
constexpr int BM = 256, BK = 64, HALF = 128, HTB = HALF * BK * 2, STAGE_BYTES = 8 * HTB, NXCD = 8, WGM = 4;
__host__ __device__ __forceinline__ int lds_byte(int r, int c) { const int st = (r >> 4) * 2 + (c >> 5), rr = r & 15, cc = c & 31, ob = rr * 64 + cc * 2; return st * 1024 + (ob ^ (((ob >> 9) & 1) << 5)); }
__host__ __device__ __forceinline__ void stage_rc(int b, int& R, int& C) { const int st = b / 1024, sb = b % 1024, swz = sb ^ (((sb >> 9) & 1) << 5); R = (st >> 1) * 16 + swz / 64; C = (st & 1) * 32 + (swz % 64) / 2; }
__host__ __device__ __forceinline__ int perm32(int rho) { const int n = rho >> 4, i = rho & 15; return 8 * (i >> 2) + 4 * n + (i & 3); }

struct Unit { int pm, pn; };
struct Gemm { const bf16_t* A; const bf16_t* Bt; int M, N, K; };

struct StaticOrder {
    int nM, nN, nwg, G, c, i_lo, i_hi, wgm = WGM;
    __host__ __device__ void init(int M, int N, int G_, int c_, int lo_ = 0, int hi_ = 1 << 30) { nM = M / BM; nN = N / BM; nwg = nM * nN; G = G_; c = c_; i_lo = lo_; i_hi = hi_; }
    __host__ __device__ bool next(int i, Unit& u) const {
        i += i_lo; if (i >= i_hi) return false;
        const long L = (long)i * G + c; if (L >= nwg) return false;
        int wgid = (int)L; { const int q = nwg / NXCD, r = nwg % NXCD, xcd = wgid % NXCD, off = wgid / NXCD; wgid = (xcd < r ? xcd * (q + 1) : r * (q + 1) + (xcd - r) * q) + off; }
        const int nig = wgm * nN, gid = wgid / nig, fm = gid * wgm, gsz = (nM - fm) < wgm ? (nM - fm) : wgm;
        u.pm = fm + ((wgid % nig) % gsz); u.pn = (wgid % nig) / gsz; return true;
    }
    __device__ __forceinline__ void a_ready(const Unit&) const {}
    __device__ __forceinline__ void done(const Unit&) const {}
};

struct TailHalfOrder {
    StaticOrder F; int c;
    __host__ __device__ void init(int M, int N, int G_, int c_, int round) { F.init(M, N, G_, c_ >> 1, round, round + 1); c = c_; }
    __host__ __device__ bool next(int i, Unit& u) const { if (i != 0) return false; Unit f; if (!F.next(0, f)) return false; u.pm = f.pm; u.pn = 2 * f.pn + (c & 1); return true; }
    __device__ __forceinline__ void a_ready(const Unit&) const {}
    __device__ __forceinline__ void done(const Unit&) const {}
};

typedef unsigned long long ss_t;
constexpr float SS_SCALE = 16777216.0f, SS_INV_MEAN = 1.0f / (16777216.0f * 2048.0f);
struct PreSS { ss_t v[2][4]; };
struct PreNone {};
__device__ __forceinline__ unsigned lane_perm(int src4, unsigned v) { return (unsigned)__builtin_amdgcn_ds_bpermute(src4, (int)v); }
__device__ __forceinline__ void ss_prefetch(PreSS& p, const ss_t* ss, int row0) {
#pragma unroll
    for (int ai = 0; ai < 2; ++ai)
#pragma unroll
        for (int m = 0; m < 4; ++m) p.v[ai][m] = ss[row0 + ai * HALF + m * 16];
}
__device__ __forceinline__ void row_rstd(const PreSS& p, float (&rs)[2][4]) {
#pragma unroll
    for (int ai = 0; ai < 2; ++ai)
#pragma unroll
        for (int m = 0; m < 4; ++m) {
            const ss_t v = p.v[ai][m]; const float f = (float)(unsigned)(v >> 32) * 4294967296.0f + (float)(unsigned)v;
            rs[ai][m] = __builtin_amdgcn_rsqf(f * SS_INV_MEAN + 1e-6f); }
}
template <int NBJ>
struct EpiBf16T {
    static constexpr bool PERM = true, AFTER_DRAIN = false;
    bf16_t* O; int ldc; const ss_t* ss;
    typedef PreSS Pre;
    __device__ __forceinline__ void prefetch(Pre& p, const Unit& u, int wr, int fr) const { ss_prefetch(p, ss, u.pm * BM + wr * 64 + fr); }
    __device__ __forceinline__ void operator()(const f32x4 (&acc)[2][2][4][2], const Unit& u, int wr, int wc, int fr, int fq, const Pre& pre) const {
        const int row0 = u.pm * BM + wr * 64 + fr; const int col0 = u.pn * (NBJ * HALF) + wc * 32 + 8 * fq;
        float rs[2][4]; row_rstd(pre, rs);
#pragma unroll
        for (int ai = 0; ai < 2; ++ai)
#pragma unroll
            for (int m = 0; m < 4; ++m) { bf16_t* rowp = O + (size_t)(row0 + ai * HALF + m * 16) * ldc + col0; const float r = rs[ai][m];
#pragma unroll
                for (int bj = 0; bj < NBJ; ++bj) { const f32x4 v0 = acc[ai][bj][m][0] * r, v1 = acc[ai][bj][m][1] * r;
                    u32x4 w; w.x = cvt_pk_bf16(v0[0], v0[1]); w.y = cvt_pk_bf16(v0[2], v0[3]); w.z = cvt_pk_bf16(v1[0], v1[1]); w.w = cvt_pk_bf16(v1[2], v1[3]);
                    *(u32x4*)(rowp + bj * HALF) = w; } }
    }
};
typedef EpiBf16T<2> EpiBf16; typedef EpiBf16T<1> EpiBf16H;
struct EpiRes {
    static constexpr bool PERM = true, AFTER_DRAIN = false;
    bf16_t* xb; ss_t* ssout; float scale;
    typedef PreNone Pre;
    __device__ __forceinline__ void prefetch(Pre&, const Unit&, int, int) const {}
    __device__ __forceinline__ void operator()(const f32x4 (&acc)[2][2][4][2], const Unit& u, int wr, int wc, int fr, int fq, const Pre&) const {
        const int row0 = u.pm * BM + wr * 64 + fr; const int col0 = u.pn * BM + wc * 32 + 8 * fq;
        bf16_t* xbase = xb + (size_t)row0 * DM + col0;
        const int pl = fq * 16 + fr, psrc = (4 * fr + fq) * 4;
        const bf16_t* xload = xb + (size_t)(u.pm * BM + wr * 64 + (pl >> 2)) * DM + u.pn * BM + wc * 32 + 8 * (pl & 3);
#pragma unroll
        for (int ai = 0; ai < 2; ++ai) { float sq[4];
            u32x4 xv[4][2];
#pragma unroll
            for (int m = 0; m < 4; ++m)
#pragma unroll
                for (int bj = 0; bj < 2; ++bj) xv[m][bj] = *(const u32x4*)(xload + (size_t)(ai * HALF + m * 16) * DM + bj * HALF);
#pragma unroll
            for (int m = 0; m < 4; ++m) { bf16_t* bp = xbase + (size_t)(ai * HALF + m * 16) * DM;
                float q = 0.f;
#pragma unroll
                for (int bj = 0; bj < 2; ++bj) { const u32x4 xq = xv[m][bj]; u32x4 xw; xw.x = lane_perm(psrc, xq.x); xw.y = lane_perm(psrc, xq.y); xw.z = lane_perm(psrc, xq.z); xw.w = lane_perm(psrc, xq.w);
                    const f32x4 d0 = acc[ai][bj][m][0] * scale, d1 = acc[ai][bj][m][1] * scale;
                    u32x4 w; w.x = cvt_pk_bf16(bflo(xw.x) + d0[0], bfhi(xw.x) + d0[1]); w.y = cvt_pk_bf16(bflo(xw.y) + d0[2], bfhi(xw.y) + d0[3]);
                    w.z = cvt_pk_bf16(bflo(xw.z) + d1[0], bfhi(xw.z) + d1[1]); w.w = cvt_pk_bf16(bflo(xw.w) + d1[2], bfhi(xw.w) + d1[3]);
                    *(u32x4*)(bp + bj * HALF) = w;
                    const float e0 = bflo(w.x), e1 = bfhi(w.x), e2 = bflo(w.y), e3 = bfhi(w.y), e4 = bflo(w.z), e5 = bfhi(w.z), e6 = bflo(w.w), e7 = bfhi(w.w);
                    q += (e0 * e0 + e1 * e1) + (e2 * e2 + e3 * e3) + (e4 * e4 + e5 * e5) + (e6 * e6 + e7 * e7); }
                sq[m] = q; }
            asm volatile("" ::: "memory");
            const bool b0 = fq & 1, b1 = fq & 2;
            const float w0 = (b0 ? sq[1] : sq[0]) + __shfl_xor(b0 ? sq[0] : sq[1], 16), w1 = (b0 ? sq[3] : sq[2]) + __shfl_xor(b0 ? sq[2] : sq[3], 16);
            const float tot = (b1 ? w1 : w0) + __shfl_xor(b1 ? w0 : w1, 32);
            __hip_atomic_fetch_add(ssout + u.pm * BM + ai * HALF + wr * 64 + fq * 16 + fr, (ss_t)(tot * SS_SCALE), __ATOMIC_RELAXED, __HIP_MEMORY_SCOPE_AGENT); }
    }
};
struct EpiSwiglu {
    static constexpr bool PERM = true, AFTER_DRAIN = false;
    bf16_t* O; int ldc; const ss_t* ss;
    typedef PreSS Pre;
    __device__ __forceinline__ void prefetch(Pre& p, const Unit& u, int wr, int fr) const { ss_prefetch(p, ss, u.pm * BM + wr * 64 + fr); }
    __device__ __forceinline__ void operator()(const f32x4 (&acc)[2][2][4][2], const Unit& u, int wr, int wc, int fr, int fq, const Pre& pre) const {
        const int row0 = u.pm * BM + wr * 64 + fr; const int col0 = u.pn * HALF + wc * 32 + 8 * fq;
        float rs[2][4]; row_rstd(pre, rs);
#pragma unroll
        for (int ai = 0; ai < 2; ++ai)
#pragma unroll
            for (int m = 0; m < 4; ++m) {
                const float r = rs[ai][m], c = -1.4426950408889634f * r, r2 = r * r;
                const f32x4 g0 = acc[ai][0][m][0], g1 = acc[ai][0][m][1], u0 = acc[ai][1][m][0], u1 = acc[ai][1][m][1];
                const f32x4 t0 = g0 * c, t1 = g1 * c;
                f32x4 e0, e1;
#pragma unroll
                for (int i = 0; i < 4; ++i) { e0[i] = __builtin_amdgcn_exp2f(t0[i]); e1[i] = __builtin_amdgcn_exp2f(t1[i]); }
                const f32x4 d0 = e0 + 1.0f, d1 = e1 + 1.0f;
                f32x4 q0, q1;
#pragma unroll
                for (int i = 0; i < 4; ++i) { q0[i] = __builtin_amdgcn_rcpf(d0[i]); q1[i] = __builtin_amdgcn_rcpf(d1[i]); }
                const f32x4 h0 = (g0 * u0) * (q0 * r2), h1 = (g1 * u1) * (q1 * r2);
                u32x4 w; w.x = cvt_pk_bf16(h0[0], h0[1]); w.y = cvt_pk_bf16(h0[2], h0[3]); w.z = cvt_pk_bf16(h1[0], h1[1]); w.w = cvt_pk_bf16(h1[2], h1[3]);
                *(u32x4*)(O + (size_t)(row0 + ai * HALF + m * 16) * ldc + col0) = w; }
    }
};

template <class Epi, class Sched, bool ALIGN_EPI = false, bool SP2 = false, bool HALFN = false>
__device__ __forceinline__ void gemm_phase(PG8_LAS unsigned char* lds, const Gemm g, const Sched& S, const Epi& E) {
    const int tid = opaque_tid(), wid = __builtin_amdgcn_readfirstlane(tid >> 6), lane = tid & 63, wr = wid >> 2, wc = wid & 3, fr = lane & 15, fq = lane >> 4;
    const int K = g.K, nt = K / BK;
    unsigned voffA[2], voffB[2];
#pragma unroll
    for (int i = 0; i < 2; ++i) { int R, C; stage_rc(tid * 16 + i * 8192, R, C); const int Rb = Epi::PERM ? ((R & ~31) + perm32(R & 31)) : R;
        voffA[i] = (unsigned)(R * K + C) * 2u; voffB[i] = (unsigned)(Rb * K + C) * 2u; }
    const size_t kstep = (size_t)(BK * 2);
    const size_t hstep = (size_t)HALF * K * 2;
    const size_t tstep = 2 * hstep;
    const size_t bstep = HALFN ? hstep : tstep;
    const unsigned ldsw = (unsigned)wid * 1024u;
    const int aoff = lds_byte(wr * 64 + fr, fq * 8), boff = lds_byte(wc * 32 + fr, fq * 8);
#define PG8_SA(b, h) (((b) * 2 + (h)) * HTB)
#define PG8_SB(b, h) ((4 + (b) * 2 + (h)) * HTB)
#define PG8_STAGE(bufoff, gbase, voff) do { _Pragma("unroll") for (int _i = 0; _i < 2; ++_i) \
        __builtin_amdgcn_global_load_lds((const unsigned*)((const char*)(gbase) + (voff)[_i]), (PG8_LAS unsigned*)(lds + (bufoff) + ldsw + _i * 8192), 16, 0, 0); } while (0)
#define PG8_LDA(dst, b, h) do { _Pragma("unroll") for (int m = 0; m < 4; ++m) _Pragma("unroll") for (int k = 0; k < 2; ++k) dst[m][k] = *(const PG8_LAS bf16x8*)(lds + PG8_SA(b, h) + aoff + m * 2048 + k * 1024); } while (0)
#define PG8_LDB(dst, b, h) do { _Pragma("unroll") for (int n = 0; n < 2; ++n) _Pragma("unroll") for (int k = 0; k < 2; ++k) dst[n][k] = *(const PG8_LAS bf16x8*)(lds + PG8_SB(b, h) + boff + n * 2048 + k * 1024); } while (0)
#define PG8_MMA(ai, bj, At, Bt) do { __builtin_amdgcn_s_setprio(1); _Pragma("unroll") for (int m = 0; m < 4; ++m) _Pragma("unroll") for (int n = 0; n < 2; ++n) _Pragma("unroll") for (int k = 0; k < 2; ++k) \
        acc[ai][bj][m][n] = __builtin_amdgcn_mfma_f32_16x16x32_bf16(Bt[n][k], At[m][k], acc[ai][bj][m][n], 0, 0, 0); __builtin_amdgcn_s_setprio(0); } while (0)
#define PG8_WAIT_V(n) asm volatile("s_waitcnt vmcnt(" #n ")" ::: "memory")
#define PG8_WAIT_L(n) asm volatile("s_waitcnt lgkmcnt(" #n ")" ::: "memory")
#define PG8_BAR __builtin_amdgcn_s_barrier()
#define PG8_SCHED __builtin_amdgcn_sched_barrier(0)
    Unit cur, nxt; int ui = 0;
    if (!S.next(0, cur)) return;
    f32x4 acc[2][2][4][2];
#pragma unroll
    for (int a = 0; a < 2; ++a)
#pragma unroll
        for (int b = 0; b < 2; ++b)
#pragma unroll
            for (int m = 0; m < 4; ++m)
#pragma unroll
                for (int n = 0; n < 2; ++n) acc[a][b][m][n] = (f32x4){0.f, 0.f, 0.f, 0.f};
    bf16x8 At[4][2], B0[2][2], B1[2][2];
    typename Epi::Pre pre;
    const char* cA = (const char*)g.A + (size_t)cur.pm * tstep; const char* cB = (const char*)g.Bt + (size_t)cur.pn * bstep;
    S.a_ready(cur);
    if constexpr (SP2 && HALFN) {
        PG8_STAGE(PG8_SB(0, 0), cB, voffB); PG8_STAGE(PG8_SA(0, 0), cA, voffA); PG8_STAGE(PG8_SA(0, 1), cA + hstep, voffA);
        if (wr == 1) PG8_BAR;
        PG8_WAIT_V(2); PG8_BAR;
        PG8_STAGE(PG8_SB(1, 0), cB + kstep, voffB); PG8_STAGE(PG8_SA(1, 0), cA + kstep, voffA);
        PG8_WAIT_V(4); PG8_BAR;
    } else if constexpr (SP2) {
        PG8_STAGE(PG8_SB(0, 0), cB, voffB); PG8_STAGE(PG8_SB(0, 1), cB + hstep, voffB); PG8_STAGE(PG8_SA(0, 0), cA, voffA); PG8_STAGE(PG8_SA(0, 1), cA + hstep, voffA);
        if (wr == 1) PG8_BAR;
        PG8_WAIT_V(2); PG8_BAR;
        PG8_STAGE(PG8_SB(1, 0), cB + kstep, voffB); PG8_STAGE(PG8_SA(1, 0), cA + kstep, voffA); PG8_STAGE(PG8_SB(1, 1), cB + hstep + kstep, voffB);
        PG8_WAIT_V(6); PG8_BAR;
    } else {
        PG8_STAGE(PG8_SB(0, 0), cB, voffB); PG8_STAGE(PG8_SA(0, 0), cA, voffA); PG8_STAGE(PG8_SB(0, 1), cB + hstep, voffB); PG8_STAGE(PG8_SA(0, 1), cA + hstep, voffA);
        if (wr == 1) PG8_BAR;
        PG8_WAIT_V(4); PG8_BAR;
        PG8_STAGE(PG8_SB(1, 0), cB + kstep, voffB); PG8_STAGE(PG8_SA(1, 0), cA + kstep, voffA); PG8_STAGE(PG8_SB(1, 1), cB + hstep + kstep, voffB);
        PG8_WAIT_V(6); PG8_BAR;
    }
    for (;;) {
        const bool has_next = S.next(ui + 1, nxt);
        const char* nA = has_next ? (const char*)g.A + (size_t)nxt.pm * tstep : cA; const char* nB = has_next ? (const char*)g.Bt + (size_t)nxt.pn * bstep : cB;
        for (int t = 0; t < nt; t += 2) {
            const bool last = (t == nt - 2);
            const char* a1 = cA + (size_t)(t + 1) * kstep;
            const char* a2 = last ? nA : cA + (size_t)(t + 2) * kstep; const char* b2 = last ? nB : cB + (size_t)(t + 2) * kstep;
            const char* a3 = a2 + kstep; const char* b3 = b2 + kstep;
            if (last && has_next) S.a_ready(nxt);
            if (last) E.prefetch(pre, cur, wr, fr);
            if constexpr (SP2 && HALFN) {
            PG8_LDB(B0, 0, 0); PG8_SCHED; PG8_LDA(At, 0, 0); PG8_STAGE(PG8_SA(1, 1), a1 + hstep, voffA);
            PG8_WAIT_V(6); PG8_WAIT_L(0); PG8_BAR; PG8_MMA(0, 0, At, B0); PG8_BAR; PG8_SCHED;
            PG8_LDA(At, 0, 1); PG8_STAGE(PG8_SB(0, 0), b2, voffB); PG8_STAGE(PG8_SA(0, 0), a2, voffA);
            PG8_WAIT_V(6); PG8_WAIT_L(0); PG8_BAR; PG8_MMA(1, 0, At, B0); PG8_BAR; PG8_SCHED;
            PG8_LDB(B0, 1, 0); PG8_SCHED; PG8_LDA(At, 1, 0); PG8_STAGE(PG8_SA(0, 1), a2 + hstep, voffA);
            PG8_WAIT_V(6); PG8_WAIT_L(0); PG8_BAR; PG8_MMA(0, 0, At, B0); PG8_BAR; PG8_SCHED;
            PG8_LDA(At, 1, 1); PG8_STAGE(PG8_SB(1, 0), b3, voffB); PG8_STAGE(PG8_SA(1, 0), a3, voffA);
            PG8_WAIT_V(6); PG8_WAIT_L(0); PG8_BAR; PG8_MMA(1, 0, At, B0); PG8_BAR; PG8_SCHED;
            } else if constexpr (SP2) {
            PG8_LDB(B0, 0, 0); PG8_LDB(B1, 0, 1); PG8_SCHED; PG8_LDA(At, 0, 0); PG8_STAGE(PG8_SA(1, 1), a1 + hstep, voffA);
            PG8_WAIT_V(8); PG8_WAIT_L(0); PG8_BAR; PG8_MMA(0, 0, At, B0); PG8_MMA(0, 1, At, B1); PG8_BAR; PG8_SCHED;
            PG8_LDA(At, 0, 1); PG8_STAGE(PG8_SB(0, 0), b2, voffB); PG8_STAGE(PG8_SB(0, 1), b2 + hstep, voffB); PG8_STAGE(PG8_SA(0, 0), a2, voffA);
            PG8_WAIT_V(8); PG8_WAIT_L(0); PG8_BAR; PG8_MMA(1, 0, At, B0); PG8_MMA(1, 1, At, B1); PG8_BAR; PG8_SCHED;
            PG8_LDB(B0, 1, 0); PG8_LDB(B1, 1, 1); PG8_SCHED; PG8_LDA(At, 1, 0); PG8_STAGE(PG8_SA(0, 1), a2 + hstep, voffA);
            PG8_WAIT_V(8); PG8_WAIT_L(0); PG8_BAR; PG8_MMA(0, 0, At, B0); PG8_MMA(0, 1, At, B1); PG8_BAR; PG8_SCHED;
            PG8_LDA(At, 1, 1); PG8_STAGE(PG8_SB(1, 0), b3, voffB); PG8_STAGE(PG8_SB(1, 1), b3 + hstep, voffB); PG8_STAGE(PG8_SA(1, 0), a3, voffA);
            PG8_WAIT_V(8); PG8_WAIT_L(0); PG8_BAR; PG8_MMA(1, 0, At, B0); PG8_MMA(1, 1, At, B1); PG8_BAR; PG8_SCHED;
            } else {
            PG8_LDB(B0, 0, 0); PG8_SCHED; PG8_LDA(At, 0, 0); PG8_STAGE(PG8_SA(1, 1), a1 + hstep, voffA);
            PG8_WAIT_L(8); PG8_BAR; PG8_WAIT_L(0); PG8_MMA(0, 0, At, B0); PG8_BAR; PG8_SCHED;
            PG8_LDB(B1, 0, 1); PG8_STAGE(PG8_SB(0, 0), b2, voffB);
            PG8_BAR; PG8_WAIT_L(0); PG8_MMA(0, 1, At, B1); PG8_BAR;
            PG8_LDA(At, 0, 1); PG8_STAGE(PG8_SA(0, 0), a2, voffA);
            PG8_BAR; PG8_WAIT_L(0); PG8_MMA(1, 0, At, B0); PG8_BAR; PG8_SCHED;
            PG8_STAGE(PG8_SB(0, 1), b2 + hstep, voffB);
            PG8_WAIT_V(6); PG8_BAR; PG8_MMA(1, 1, At, B1); PG8_BAR;
            PG8_LDB(B0, 1, 0); PG8_SCHED; PG8_LDA(At, 1, 0); PG8_STAGE(PG8_SA(0, 1), a2 + hstep, voffA);
            PG8_WAIT_L(8); PG8_BAR; PG8_WAIT_L(0); PG8_MMA(0, 0, At, B0); PG8_BAR; PG8_SCHED;
            PG8_LDB(B1, 1, 1); PG8_STAGE(PG8_SB(1, 0), b3, voffB);
            PG8_BAR; PG8_WAIT_L(0); PG8_MMA(0, 1, At, B1); PG8_BAR;
            PG8_LDA(At, 1, 1); PG8_STAGE(PG8_SA(1, 0), a3, voffA);
            PG8_BAR; PG8_WAIT_L(0); PG8_MMA(1, 0, At, B0); PG8_BAR; PG8_SCHED;
            PG8_STAGE(PG8_SB(1, 1), b3 + hstep, voffB);
            PG8_WAIT_V(6); PG8_BAR; PG8_MMA(1, 1, At, B1); PG8_BAR;
            }
        }
        if constexpr (ALIGN_EPI) { if (wr == 0) PG8_BAR; }
        if constexpr (!Epi::AFTER_DRAIN) { E(acc, cur, wr, wc, fr, fq, pre); S.done(cur); }
        if (!has_next) break;
#pragma unroll
        for (int a = 0; a < 2; ++a)
#pragma unroll
            for (int b = 0; b < 2; ++b)
#pragma unroll
                for (int m = 0; m < 4; ++m)
#pragma unroll
                    for (int n = 0; n < 2; ++n) acc[a][b][m][n] = (f32x4){0.f, 0.f, 0.f, 0.f};
        cur = nxt; cA = nA; cB = nB; ++ui;
        if constexpr (ALIGN_EPI) { if (wr == 1) PG8_BAR; }
    }
    PG8_WAIT_V(0);
    if constexpr (!ALIGN_EPI) { if (wr == 0) PG8_BAR; }
    PG8_BAR;
#undef PG8_SA
#undef PG8_SB
#undef PG8_STAGE
#undef PG8_LDA
#undef PG8_LDB
#undef PG8_MMA
#undef PG8_WAIT_V
#undef PG8_WAIT_L
#undef PG8_BAR
#undef PG8_SCHED
}
}

namespace att {
constexpr int D = 128, NW = 8, QBLK = 32, KVBLK = 64;
constexpr float SCALE = 0.088388347648318440f, LOG2E = 1.4426950408889634f, LN2 = 0.6931471805599453f;
constexpr float C = SCALE * LOG2E;
constexpr float THR2 = 8.f * LOG2E;
constexpr int SHM_V = KVBLK * D * 2, SHM_K = KVBLK * D * 2;
constexpr int OFF_V = 0, OFF_K = 2 * SHM_V, BUF3 = SHM_V + SHM_K  , OFF_WS = 3 * BUF3, OFF_TAB = OFF_WS + NW * 64 * 4, TAB_FLOATS = 1024, OFF_UID = OFF_TAB + TAB_FLOATS * 4, LDS_BYTES = OFF_UID + 64;
#define KSWZ(row, colB) ((row) * 256 + ((colB) ^ (((row) & 7) << 4)))
#define SBAR() __builtin_amdgcn_sched_barrier(0)
__device__ __forceinline__ int crow(int r, int hi) { return (r & 3) + 8 * (r >> 2) + 4 * hi; }
__device__ __forceinline__ void qkt(f32x16& p0, f32x16& p1, const char* Ks, const bf16x8* qr, int r32, int hi) {
  p0 = f32x16{}; p1 = f32x16{};
#pragma unroll
  for (int d0 = 0; d0 < 8; ++d0) { const int cb = (d0 * 16 + hi * 8) * 2;
    const bf16x8 b0 = *reinterpret_cast<const bf16x8*>(Ks + KSWZ(r32, cb));
    const bf16x8 b1 = *reinterpret_cast<const bf16x8*>(Ks + KSWZ(32 + r32, cb));
    p0 = __builtin_amdgcn_mfma_f32_32x32x16_bf16(b0, qr[d0], p0, 0, 0, 0);
    p1 = __builtin_amdgcn_mfma_f32_32x32x16_bf16(b1, qr[d0], p1, 0, 0, 0); }
}
__device__ __forceinline__ int v_st(int k, int c) { const int kk = (k & ~0xC) | ((k & 4) << 1) | ((k & 8) >> 1); return ((kk >> 3) * 4 + (c >> 5)) * 512 + ((kk & 7) * 32 + (c & 31)) * 2; }
__device__ __forceinline__ int v_rd_base(int lane) { return ((lane & 3) << 3) | (((lane >> 2) & 3) << 6) | (((lane >> 4) & 1) << 5) | (((lane >> 5) & 1) << 8); }
constexpr int v_rd_off(int d0, int ks, int half) { return d0 * 512 + ks * 4096 + half * 2048; }
template <int OFF> __device__ __forceinline__ s16x4 tr_read(int vb) {
  s16x4 r; asm volatile("ds_read_b64_tr_b16 %0, %1 offset:%2" : "=&v"(r) : "v"(vb), "i"(OFF) : "memory"); return r;
}
template <int D0> __device__ __forceinline__ void pv_one(f32x16& od, int vb, bf16x8 pa0, bf16x8 pa1, bf16x8 pa2, bf16x8 pa3) {
  const s16x4 l0 = tr_read<v_rd_off(D0, 0, 0)>(vb), h0 = tr_read<v_rd_off(D0, 0, 1)>(vb), l1 = tr_read<v_rd_off(D0, 1, 0)>(vb), h1 = tr_read<v_rd_off(D0, 1, 1)>(vb);
  const s16x4 l2 = tr_read<v_rd_off(D0, 2, 0)>(vb), h2 = tr_read<v_rd_off(D0, 2, 1)>(vb), l3 = tr_read<v_rd_off(D0, 3, 0)>(vb), h3 = tr_read<v_rd_off(D0, 3, 1)>(vb);
  asm volatile("s_waitcnt lgkmcnt(0)" ::: "memory"); SBAR();
#define PK(L, H) (bf16x8){L[0], L[1], L[2], L[3], H[0], H[1], H[2], H[3]}
  od = __builtin_amdgcn_mfma_f32_32x32x16_bf16(pa0, PK(l0, h0), od, 0, 0, 0);
  od = __builtin_amdgcn_mfma_f32_32x32x16_bf16(pa1, PK(l1, h1), od, 0, 0, 0);
  od = __builtin_amdgcn_mfma_f32_32x32x16_bf16(pa2, PK(l2, h2), od, 0, 0, 0);
  od = __builtin_amdgcn_mfma_f32_32x32x16_bf16(pa3, PK(l3, h3), od, 0, 0, 0);
#undef PK
}
__device__ __forceinline__ void pv_d0(f32x16* o, int vb, bf16x8 pa0, bf16x8 pa1, bf16x8 pa2, bf16x8 pa3) {
  pv_one<0>(o[0], vb, pa0, pa1, pa2, pa3); pv_one<1>(o[1], vb, pa0, pa1, pa2, pa3); pv_one<2>(o[2], vb, pa0, pa1, pa2, pa3); pv_one<3>(o[3], vb, pa0, pa1, pa2, pa3);
}

template <bool TAB>
__device__ __forceinline__ void attn_unit(const bf16_t* __restrict__ Qb, long ldq, const bf16_t* __restrict__ Kh, const bf16_t* __restrict__ Vh, long ldk,
                                          bf16_t* __restrict__ Ob, long ldo, int t_lo, int t_hi, int qpos0, int W, const float* __restrict__ tabg, int tablen,
                                          float m_init0, float m_init1, float l_init, float* __restrict__ lse, long ldlse, char* lds) {
  const int tid = opaque_tid(), lane = tid & 63, r32 = lane & 31, hi = lane >> 5; const int wid = __builtin_amdgcn_readfirstlane(tid >> 6);
  const int hw = wid >> 2, wq = wid & 3;
  char* V_lds = lds + OFF_V; char* K_lds = lds + OFF_K;
  float* ws = (float*)(lds + OFF_WS) + wid * 64; float* li_l = ws; float* al_l = ws + 32;
  float* tab = (float*)(lds + OFF_TAB);
  bf16x8 qr[8];
  { const bf16_t* Qw = Qb + hw * D + (long)(wq * QBLK + r32) * ldq + hi * 8;
#pragma unroll
    for (int d0 = 0; d0 < 8; ++d0) qr[d0] = *reinterpret_cast<const bf16x8*>(Qw + d0 * 16); }
  if (TAB) { for (int i = tid; i < 2 * 512; i += NW * 64) tab[i] = ((i & 511) < tablen) ? tabg[i] : 0.f; }
  const int sr = tid >> 4, sc = (tid & 15) * 8, vst0 = v_st(sr, sc), vst1 = v_st(32 + sr, sc);
  const int vb0 = (int)(uintptr_t)V_lds + v_rd_base(lane);
  bf16x8 vs0, vs1, ks0, ks1;
#define SLOAD(k0) do { vs0 = *reinterpret_cast<const bf16x8*>(&Vh[(long)((k0) + sr) * ldk + sc]); vs1 = *reinterpret_cast<const bf16x8*>(&Vh[(long)((k0) + 32 + sr) * ldk + sc]); \
    ks0 = *reinterpret_cast<const bf16x8*>(&Kh[(long)((k0) + sr) * ldk + sc]); ks1 = *reinterpret_cast<const bf16x8*>(&Kh[(long)((k0) + 32 + sr) * ldk + sc]); } while (0)
#define SWRITE(b) do { *(bf16x8*)(V_lds + (b) * SHM_V + vst0) = vs0; *(bf16x8*)(V_lds + (b) * SHM_V + vst1) = vs1; const int kc = sc * 2; \
    *(bf16x8*)(K_lds + (b) * SHM_K + KSWZ(sr, kc)) = ks0; *(bf16x8*)(K_lds + (b) * SHM_K + KSWZ(32 + sr, kc)) = ks1; } while (0)
  float m_reg = hw ? m_init1 : m_init0, l_reg = l_init; f32x16 o[4] = {};
  const int qw0 = qpos0 + wq * QBLK;
  SLOAD(t_lo * KVBLK); SWRITE(0); __syncthreads();
  for (int t = t_lo; t < t_hi; ++t) {
    const int b = (t - t_lo) & 1; const bool more = (t + 1 < t_hi);
    if (more) SLOAD((t + 1) * KVBLK);
    const bool active = !TAB || (KVBLK * t + KVBLK - 1 >= qw0 - W && KVBLK * t <= qw0 + QBLK - 1 + W);
    if (active) {
      f32x16 p0, p1; qkt(p0, p1, K_lds + b * SHM_K, qr, r32, hi);
      if (TAB) { const float* tl = tab + hw * 512 + (KVBLK * t - qw0 - r32 + 4 * hi + W + 96);
#pragma unroll
        for (int r = 0; r < 16; ++r) { const int ix = (r & 3) + 8 * (r >> 2); p0[r] = fmaf(p0[r], C, tl[ix]); p1[r] = fmaf(p1[r], C, tl[ix + 32]); } }
      else {
#pragma unroll
        for (int r = 0; r < 16; ++r) { p0[r] *= C; p1[r] *= C; } }
      float pmax = p0[0];
#pragma unroll
      for (int r = 1; r < 16; ++r) pmax = fmaxf(pmax, p0[r]);
#pragma unroll
      for (int r = 0; r < 16; ++r) pmax = fmaxf(pmax, p1[r]);
      { auto rr = __builtin_amdgcn_permlane32_swap(__float_as_uint(pmax), __float_as_uint(pmax), false, false);
        pmax = fmaxf(__uint_as_float(rr[0]), __uint_as_float(rr[1])); }
      if (!__all(pmax - m_reg <= THR2)) {
        const float mn = fmaxf(m_reg, pmax); const float alpha = __builtin_amdgcn_exp2f(m_reg - mn); m_reg = mn; l_reg *= alpha;
        if (hi == 0) al_l[r32] = alpha; asm volatile("s_waitcnt lgkmcnt(0)" ::: "memory");
#pragma unroll
        for (int d = 0; d < 4; ++d)
#pragma unroll
          for (int r = 0; r < 16; ++r) o[d][r] *= al_l[crow(r, hi)];
      }
#pragma unroll
      for (int r = 0; r < 16; ++r) { p0[r] = __builtin_amdgcn_exp2f(p0[r] - m_reg); p1[r] = __builtin_amdgcn_exp2f(p1[r] - m_reg); }
      float ps = 0.f;
#pragma unroll
      for (int r = 0; r < 16; ++r) ps += p0[r];
#pragma unroll
      for (int r = 0; r < 16; ++r) ps += p1[r];
      { auto rr = __builtin_amdgcn_permlane32_swap(__float_as_uint(ps), __float_as_uint(ps), false, false);
        ps = __uint_as_float(rr[0]) + __uint_as_float(rr[1]); }
      l_reg += ps;
      bf16x8 pa0, pa1, pa2, pa3;
#define PK4(P, BASE, OUT) do { unsigned a0 = cvt_pk_bf16(P[BASE + 0], P[BASE + 1]), a1 = cvt_pk_bf16(P[BASE + 2], P[BASE + 3]);   \
    unsigned b0 = cvt_pk_bf16(P[BASE + 4], P[BASE + 5]), b1 = cvt_pk_bf16(P[BASE + 6], P[BASE + 7]);                              \
    auto r0 = __builtin_amdgcn_permlane32_swap(a0, b0, false, false); auto r1 = __builtin_amdgcn_permlane32_swap(a1, b1, false, false); \
    u32x4 w = {r0[0], r1[0], r0[1], r1[1]}; OUT = *reinterpret_cast<bf16x8*>(&w); } while (0)
      PK4(p0, 0, pa0); PK4(p0, 8, pa1); PK4(p1, 0, pa2); PK4(p1, 8, pa3);
#undef PK4
      SBAR();
      pv_d0(o, vb0 + b * SHM_V, pa0, pa1, pa2, pa3);
    }
    if (more) SWRITE(b ^ 1);
    __syncthreads();
  }
  if (hi == 0) li_l[r32] = l_reg; asm volatile("s_waitcnt lgkmcnt(0)" ::: "memory");
  float rli[16];
#pragma unroll
  for (int r = 0; r < 16; ++r) rli[r] = __builtin_amdgcn_rcpf(li_l[crow(r, hi)]);
  bf16_t* stg = (bf16_t*)(lds + wid * 8192);
#pragma unroll
  for (int r = 0; r < 16; ++r) { const int orow = crow(r, hi);
#pragma unroll
    for (int d0 = 0; d0 < 4; ++d0) { const unsigned w = cvt_pk_bf16(o[d0][r] * rli[r], 0.f); stg[orow * 128 + d0 * 32 + r32] = (bf16_t)(w & 0xffffu); } }
  asm volatile("s_waitcnt lgkmcnt(0)" ::: "memory");
#pragma unroll
  for (int i = 0; i < 8; ++i) { const int row = i * 4 + (lane >> 4), ch = lane & 15; const u32x4 v = *(const u32x4*)(stg + row * 128 + ch * 8);
    *(u32x4*)(Ob + hw * D + (long)(wq * QBLK + row) * ldo + ch * 8) = v; }
  if (lse != nullptr && hi == 0) lse[hw + (long)(wq * QBLK + r32) * ldlse] = (m_reg + __builtin_amdgcn_logf(l_reg)) * LN2;
  __syncthreads();
#undef SLOAD
#undef SWRITE
}
template <bool PRE>
__device__ __forceinline__ void partialSM(f32x16& p0, f32x16& p1, float& m_reg, float& mn, float& alpha) {
  constexpr float cs = PRE ? 1.0f : C;
  float pmax = p0[0];
#pragma unroll
  for (int r = 1; r < 16; ++r) pmax = fmaxf(pmax, p0[r]);
#pragma unroll
  for (int r = 0; r < 16; ++r) pmax = fmaxf(pmax, p1[r]);
  { auto rr = __builtin_amdgcn_permlane32_swap(__float_as_uint(pmax), __float_as_uint(pmax), false, false);
    pmax = fmaxf(__uint_as_float(rr[0]), __uint_as_float(rr[1])); }
  if (__builtin_expect(__all((pmax - m_reg) * cs <= THR2), 1)) { mn = m_reg; alpha = 1.f; }
  else { mn = fmaxf(m_reg, pmax); alpha = __builtin_amdgcn_exp2f((m_reg - mn) * cs); m_reg = mn; }
  const float mnC = -mn * cs;
#pragma unroll
  for (int r = 0; r < 16; ++r) p0[r] = fmaf(p0[r], cs, mnC);
#pragma unroll
  for (int r = 0; r < 16; ++r) p1[r] = fmaf(p1[r], cs, mnC);
#pragma unroll
  for (int r = 0; r < 16; ++r) p0[r] = __builtin_amdgcn_exp2f(p0[r]);
}
__device__ __forceinline__ void partialSM_fixed(f32x16& p0) {
#pragma unroll
  for (int r = 0; r < 16; ++r) p0[r] = __builtin_amdgcn_exp2f(p0[r]);
}
__device__ __forceinline__ void finishSM(f32x16& p0, f32x16& p1, float alpha, float& l_reg, bf16x8& pa0, bf16x8& pa1, bf16x8& pa2, bf16x8& pa3) {
#pragma unroll
  for (int r = 0; r < 16; ++r) p1[r] = __builtin_amdgcn_exp2f(p1[r]);
  float ps = 0;
#pragma unroll
  for (int r = 0; r < 16; ++r) ps += p0[r];
#pragma unroll
  for (int r = 0; r < 16; ++r) ps += p1[r];
  { auto rr = __builtin_amdgcn_permlane32_swap(__float_as_uint(ps), __float_as_uint(ps), false, false);
    ps = __uint_as_float(rr[0]) + __uint_as_float(rr[1]); }
  l_reg = l_reg * alpha + ps;
#define PK4(P, BASE, OUT) do { unsigned a0 = cvt_pk_bf16(P[BASE + 0], P[BASE + 1]), a1 = cvt_pk_bf16(P[BASE + 2], P[BASE + 3]);   \
    unsigned b0 = cvt_pk_bf16(P[BASE + 4], P[BASE + 5]), b1 = cvt_pk_bf16(P[BASE + 6], P[BASE + 7]);                              \
    auto r0 = __builtin_amdgcn_permlane32_swap(a0, b0, false, false); auto r1 = __builtin_amdgcn_permlane32_swap(a1, b1, false, false); \
    u32x4 w = {r0[0], r1[0], r0[1], r1[1]}; OUT = *reinterpret_cast<bf16x8*>(&w); } while (0)
  PK4(p0, 0, pa0); PK4(p0, 8, pa1); PK4(p1, 0, pa2); PK4(p1, 8, pa3);
#undef PK4
}
template <bool PRE>
__device__ __forceinline__ void attn_unit_dense(const bf16_t* __restrict__ Qb, long ldq, const bf16_t* __restrict__ Kh, const bf16_t* __restrict__ Vh, long ldk,
                                                bf16_t* __restrict__ Ob, long ldo, int ntile, float mfix2, char* lds) {
  const int tid = opaque_tid(), lane = tid & 63, r32 = lane & 31, hi = lane >> 5; const int wid = __builtin_amdgcn_readfirstlane(tid >> 6);
  float* ws = (float*)(lds + OFF_WS) + wid * 64; float* li_l = ws; float* al_l = ws + 32;
  const bool fixm = PRE && mfix2 >= 0.f;
  float m_reg = -1e30f, l_reg = 0; f32x16 o[4] = {}; bf16x8 qr[8];
  { const bf16_t* Qw = Qb + (long)(wid * QBLK + r32) * ldq + hi * 8;
#pragma unroll
    for (int d0 = 0; d0 < 8; ++d0) qr[d0] = *reinterpret_cast<const bf16x8*>(Qw + d0 * 16); }
  const int sr = tid >> 4, sc = (tid & 15) * 8, vst0 = v_st(sr, sc), vst1 = v_st(32 + sr, sc);
  const int vb0 = (int)(uintptr_t)lds + v_rd_base(lane);
  bf16x8 vsE0, vsE1, ksE0, ksE1, vsO0, vsO1, ksO0, ksO1;
#define SLOAD_E(k0) do { vsE0 = *reinterpret_cast<const bf16x8*>(&Vh[(long)((k0) + sr) * ldk + sc]); vsE1 = *reinterpret_cast<const bf16x8*>(&Vh[(long)((k0) + 32 + sr) * ldk + sc]); \
    ksE0 = *reinterpret_cast<const bf16x8*>(&Kh[(long)((k0) + sr) * ldk + sc]); ksE1 = *reinterpret_cast<const bf16x8*>(&Kh[(long)((k0) + 32 + sr) * ldk + sc]); } while (0)
#define SLOAD_O(k0) do { vsO0 = *reinterpret_cast<const bf16x8*>(&Vh[(long)((k0) + sr) * ldk + sc]); vsO1 = *reinterpret_cast<const bf16x8*>(&Vh[(long)((k0) + 32 + sr) * ldk + sc]); \
    ksO0 = *reinterpret_cast<const bf16x8*>(&Kh[(long)((k0) + sr) * ldk + sc]); ksO1 = *reinterpret_cast<const bf16x8*>(&Kh[(long)((k0) + 32 + sr) * ldk + sc]); } while (0)
#define SWRITE_E(bo) do { char* B_ = lds + (bo); *(bf16x8*)(B_ + vst0) = vsE0; *(bf16x8*)(B_ + vst1) = vsE1; const int kc = sc * 2; \
    *(bf16x8*)(B_ + SHM_V + KSWZ(sr, kc)) = ksE0; *(bf16x8*)(B_ + SHM_V + KSWZ(32 + sr, kc)) = ksE1; } while (0)
#define SWRITE_O(bo) do { char* B_ = lds + (bo); *(bf16x8*)(B_ + vst0) = vsO0; *(bf16x8*)(B_ + vst1) = vsO1; const int kc = sc * 2; \
    *(bf16x8*)(B_ + SHM_V + KSWZ(sr, kc)) = ksO0; *(bf16x8*)(B_ + SHM_V + KSWZ(32 + sr, kc)) = ksO1; } while (0)
#define SWAIT() asm volatile("s_waitcnt vmcnt(4)" ::: "memory")
#define PSM(P0, P1, MN, AL) do { if (fixm) { partialSM_fixed(P0); AL = 1.f; MN = 0.f; } else partialSM<PRE>(P0, P1, m_reg, MN, AL); } while (0)
#define RESC(a) do { if (!fixm) if (__any((a) < 1.f)) { if (hi == 0) al_l[r32] = (a); asm volatile("s_waitcnt lgkmcnt(0)" ::: "memory"); \
    _Pragma("unroll") for (int d = 0; d < 4; ++d) _Pragma("unroll") for (int r = 0; r < 16; ++r) o[d][r] *= al_l[crow(r, hi)]; } } while (0)
#define ROT3() do { const int t_ = bV; bV = bK; bK = bW; bW = t_; } while (0)
  f32x16 pA0, pA1, pB0, pB1; float mnA, mnB, alA, alB; bf16x8 pa0, pa1, pa2, pa3; const int NT = ntile;
  int bV = 0, bK = 0, bW = BUF3;
  SLOAD_E(0); SLOAD_O(KVBLK); asm volatile("s_waitcnt vmcnt(4)" ::: "memory"); SWRITE_E(0); SLOAD_E(2 * KVBLK);
  __syncthreads();
  SWAIT(); SWRITE_O(bW);
  qkt(pA0, pA1, lds + bK + SHM_V, qr, r32, hi); PSM(pA0, pA1, mnA, alA);
  if (3 < NT) SLOAD_O(3 * KVBLK);
  bV = 0; bK = BUF3; bW = 2 * BUF3;
  for (int j = 1; j + 1 < NT; j += 2) {
    __syncthreads(); SWAIT(); SWRITE_E(bW);
    SBAR(); qkt(pB0, pB1, lds + bK + SHM_V, qr, r32, hi);
    finishSM(pA0, pA1, alA, l_reg, pa0, pa1, pa2, pa3); SBAR();
    if (j + 3 < NT) SLOAD_E((j + 3) * KVBLK); SBAR();
    pv_d0(o, vb0 + bV, pa0, pa1, pa2, pa3); PSM(pB0, pB1, mnB, alB);
    RESC(alB); ROT3();
    __syncthreads(); SWAIT(); SWRITE_O(bW);
    SBAR(); qkt(pA0, pA1, lds + bK + SHM_V, qr, r32, hi);
    finishSM(pB0, pB1, alB, l_reg, pa0, pa1, pa2, pa3); SBAR();
    if (j + 4 < NT) SLOAD_O((j + 4) * KVBLK); SBAR();
    pv_d0(o, vb0 + bV, pa0, pa1, pa2, pa3); PSM(pA0, pA1, mnA, alA);
    RESC(alA); ROT3();
  }
  __syncthreads();
  SBAR(); qkt(pB0, pB1, lds + bK + SHM_V, qr, r32, hi);
  finishSM(pA0, pA1, alA, l_reg, pa0, pa1, pa2, pa3); SBAR();
  pv_d0(o, vb0 + bV, pa0, pa1, pa2, pa3); PSM(pB0, pB1, mnB, alB);
  RESC(alB); ROT3();
  finishSM(pB0, pB1, alB, l_reg, pa0, pa1, pa2, pa3); SBAR();
  pv_d0(o, vb0 + bV, pa0, pa1, pa2, pa3);
#undef ROT3
  if (hi == 0) li_l[r32] = l_reg; asm volatile("s_waitcnt lgkmcnt(0)" ::: "memory");
  float rli[16];
#pragma unroll
  for (int r = 0; r < 16; ++r) rli[r] = __builtin_amdgcn_rcpf(li_l[crow(r, hi)]);
  __syncthreads();
  bf16_t* stg = (bf16_t*)(lds + wid * 8192);
#pragma unroll
  for (int r = 0; r < 16; ++r) { const int orow = crow(r, hi);
#pragma unroll
    for (int d0 = 0; d0 < 4; ++d0) { const unsigned w = cvt_pk_bf16(o[d0][r] * rli[r], 0.f); stg[orow * 128 + d0 * 32 + r32] = (bf16_t)(w & 0xffffu); } }
  asm volatile("s_waitcnt lgkmcnt(0)" ::: "memory");
#pragma unroll
  for (int i = 0; i < 8; ++i) { const int row = i * 4 + (lane >> 4), ch = lane & 15; const u32x4 v = *(const u32x4*)(stg + row * 128 + ch * 8);
    *(u32x4*)(Ob + (long)(wid * QBLK + row) * ldo + ch * 8) = v; }
  __syncthreads();
#undef PSM
#undef SLOAD_E
#undef SLOAD_O
#undef SWRITE_E
#undef SWRITE_O
#undef SWAIT
#undef RESC
}
#undef SBAR
}

#define XB_TMO      128
#define XB_XCNT(j)  (256  + 64 * (j))
#define XB_XSUB(j)  (1280 + 64 * (j))
#define XB_XGEN(j)  (2304 + 64 * (j))
#define XB_TOP      3328
#define XB_TOPGEN   3392
#define XCD_BAR_WORDS 3456
#define XB_SPIN_CAP (1u << 18)
__device__ __forceinline__ unsigned xb_ld(unsigned* p)              { return __hip_atomic_load(p, __ATOMIC_RELAXED, __HIP_MEMORY_SCOPE_AGENT); }
__device__ __forceinline__ unsigned xb_add(unsigned* p, unsigned v) { return __hip_atomic_fetch_add(p, v, __ATOMIC_RELAXED, __HIP_MEMORY_SCOPE_AGENT); }
__device__ __forceinline__ unsigned xb_xcc_id() { return (unsigned)__builtin_amdgcn_s_getreg((3 << 11) | 20) & 0xFu; }
#define XB_SPIN(cond, bar) do { unsigned _sp = 0; while (cond) { __builtin_amdgcn_s_sleep(1); \
    if ((++_sp & 255u) == 0u) { if (xb_ld(&(bar)[XB_TMO])) break; if (_sp > XB_SPIN_CAP) { atomicAdd(&(bar)[XB_TMO], 1u); break; } } } } while (0)
struct XcdBarrier { unsigned* bar; unsigned x; volatile LAS unsigned* st; };
__device__ __forceinline__ XcdBarrier xcd_barrier_post(unsigned* bar, volatile LAS unsigned* st) {
    XcdBarrier b; b.bar = bar; b.x = xb_xcc_id(); b.st = st;
    if (threadIdx.x == 0) (void)xb_add(&bar[XB_XCNT(b.x)], 1u);
    return b;
}
__device__ __forceinline__ void xcd_barrier_complete(unsigned* bar, unsigned x, unsigned& nloc, unsigned& nx) {
    const unsigned G = gridDim.x * gridDim.y * gridDim.z;
    unsigned sum, cnt, mine, sp = 0u;
    for (;;) {
        sum = 0u; cnt = 0u; mine = 0u;
#pragma unroll
        for (unsigned j = 0; j < 16; ++j) { const unsigned c = xb_ld(&bar[XB_XCNT(j)]); sum += c; cnt += (c > 0u) ? 1u : 0u; mine = (j == x) ? c : mine; }
        if (sum == G) break;
        __builtin_amdgcn_s_sleep(1);
        if ((++sp & 255u) == 0u) { if (xb_ld(&bar[XB_TMO])) break; if (sp > XB_SPIN_CAP) { atomicAdd(&bar[XB_TMO], 1u); break; } }
    }
    nloc = mine > 0u ? mine : 1u; nx = cnt > 0u ? cnt : 1u;
}
__device__ __forceinline__ void xcd_barrier(const XcdBarrier& b) {
    asm volatile("s_waitcnt vmcnt(0)" ::: "memory");
    __syncthreads();
    if (threadIdx.x == 0) {
        unsigned* bar = b.bar;
        __builtin_amdgcn_s_waitcnt(0);
        unsigned nloc = b.st[0], nx = b.st[1];
        if (nloc == 0u) { xcd_barrier_complete(bar, b.x, nloc, nx); b.st[0] = nloc; b.st[1] = nx; }
        const unsigned old = xb_add(&bar[XB_XSUB(b.x)], 1u);
        const unsigned gen = old / nloc;
        if (old + 1u == (gen + 1u) * nloc) {
            __builtin_amdgcn_fence(__ATOMIC_RELEASE, "agent");
            asm volatile("s_waitcnt vmcnt(0)" ::: "memory");
            const unsigned og = xb_add(&bar[XB_TOP], 1u);
            const unsigned tg = og / nx;
            if (og + 1u == (tg + 1u) * nx) xb_add(&bar[XB_TOPGEN], 1u);
            else XB_SPIN(xb_ld(&bar[XB_TOPGEN]) == tg, bar);
            __builtin_amdgcn_fence(__ATOMIC_ACQUIRE, "agent");
            xb_add(&bar[XB_XGEN(b.x)], 1u);
            asm volatile("s_waitcnt vmcnt(0)" ::: "memory");
        } else {
            XB_SPIN(xb_ld(&bar[XB_XGEN(b.x)]) == gen, bar);
            __builtin_amdgcn_fence(__ATOMIC_ACQUIRE, "agent");
            asm volatile("s_waitcnt vmcnt(0)" ::: "memory");
        }
    }
    __syncthreads();
}

constexpr int NWAVES = 8;
constexpr int RING_BYTES = 131072, LDSCTL_OFF = RING_BYTES, MISC_OFF = LDSCTL_OFF + 320, LDS_BYTES = 147456;
static_assert(att::LDS_BYTES <= RING_BYTES, "attention scratch inside the ring region");

struct Args {
    const float* in[20]; float* out; unsigned char* ws; int ph_lo, ph_hi;
};

__device__ __forceinline__ float wave_sum(float v) {
#pragma unroll
    for (int o = 1; o < 64; o <<= 1) v += __shfl_xor(v, o);
    return v;
}
__device__ __forceinline__ unsigned f2bf(float f) { unsigned u = __builtin_bit_cast(unsigned, f); return (u + 0x7fffu + ((u >> 16) & 1u)) >> 16; }
__device__ __forceinline__ unsigned pk2(float lo, float hi) { return f2bf(lo) | (f2bf(hi) << 16); }

__device__ __forceinline__ void transpose_item(const float* W, const float* gain, int K, int N, bf16_t* WT, int k0, int n0, int drow0, LAS float* scr, int lane) {
    const int kr = lane >> 3, nq = lane & 7;
    f32x4 v[8]; float gk[8];
#pragma unroll
    for (int i = 0; i < 8; ++i) { v[i] = *(const GAS f32x4*)(W + (size_t)(k0 + kr + 8 * i) * N + n0 + 4 * nq); gk[i] = gain ? gain[k0 + kr + 8 * i] : 1.0f; }
#pragma unroll
    for (int i = 0; i < 8; ++i) { LAS float* d = scr + (kr + 8 * i) * 33 + 4 * nq; d[0] = v[i].x * gk[i]; d[1] = v[i].y * gk[i]; d[2] = v[i].z * gk[i]; d[3] = v[i].w * gk[i]; }
    asm volatile("s_waitcnt lgkmcnt(0)" ::: "memory");
    const int c = lane & 7;
#pragma unroll
    for (int j = 0; j < 4; ++j) { const int n = (lane >> 3) + 8 * j; const LAS float* s = scr + (8 * c) * 33 + n;
        u32x4 o; o.x = pk2(s[0 * 33], s[1 * 33]); o.y = pk2(s[2 * 33], s[3 * 33]); o.z = pk2(s[4 * 33], s[5 * 33]); o.w = pk2(s[6 * 33], s[7 * 33]);
        *(GAS u32x4*)(WT + (size_t)(drow0 + n) * K + k0 + 8 * c) = o; }
    asm volatile("s_waitcnt lgkmcnt(0)" ::: "memory");
}

__device__ __forceinline__ int t5_bucket(int rel) {
    const int n = rel < 0 ? -rel : rel; int b;
    if (n < 8) b = n; else { b = 8 + (n >= 15) + (n >= 27) + (n >= 50) + (n >= 91) + (n >= 166) + (n >= 305) + (n >= 559); if (b > 15) b = 15; }
    return b + (rel > 0 ? 16 : 0);
}
__device__ __forceinline__ void sincos_d(double a, double& s, double& c) {
    const double k = __builtin_rint(a * 0.63661977236758134308);
    const double r = (a - k * 1.57079632679489655800) - k * 6.12323399573676603587e-17;
    const double r2 = r * r;
    double ps = 1.0 / 6227020800.0;
    ps = ps * r2 - 1.0 / 39916800.0; ps = ps * r2 + 1.0 / 362880.0; ps = ps * r2 - 1.0 / 5040.0; ps = ps * r2 + 1.0 / 120.0; ps = ps * r2 - 1.0 / 6.0; ps = ps * r2 + 1.0;
    const double sr = r * ps;
    double pc = -1.0 / 87178291200.0;
    pc = pc * r2 + 1.0 / 479001600.0; pc = pc * r2 - 1.0 / 3628800.0; pc = pc * r2 + 1.0 / 40320.0; pc = pc * r2 - 1.0 / 720.0; pc = pc * r2 + 1.0 / 24.0; pc = pc * r2 - 0.5; pc = pc * r2 + 1.0;
    const int q = ((int)k) & 3;
    s = (q == 0) ? sr : (q == 1) ? pc : (q == 2) ? -sr : -pc;
    c = (q == 0) ? pc : (q == 1) ? -sr : (q == 2) ? -pc : sr;
}

__device__ __forceinline__ float row_to_bf16(const float* xrow, bf16_t* orow, int lane) {
    const GAS f32x4* xr = (const GAS f32x4*)xrow + lane;
    f32x4 v[8]; float s = 0.f;
#pragma unroll
    for (int j = 0; j < 8; ++j) { v[j] = xr[64 * j]; s += (v[j].x * v[j].x + v[j].y * v[j].y) + (v[j].z * v[j].z + v[j].w * v[j].w); }
    GAS u32x2* o8 = (GAS u32x2*)orow + lane;
#pragma unroll
    for (int j = 0; j < 8; ++j) { u32x2 w; w.x = cvt_pk_bf16(v[j].x, v[j].y); w.y = cvt_pk_bf16(v[j].z, v[j].w); o8[64 * j] = w; }
    return wave_sum(s);
}
__device__ __forceinline__ void rms_row_out(const bf16_t* xrow, float* orow, const float* g, float rstd, int lane) {
    const GAS u32x2* xr = (const GAS u32x2*)xrow + lane; GAS f32x4* o = (GAS f32x4*)orow + lane; const GAS f32x4* gr = (const GAS f32x4*)g + lane;
#pragma unroll
    for (int j = 0; j < 8; ++j) { const u32x2 w = xr[64 * j]; const f32x4 gg = gr[64 * j]; f32x4 v = {bflo(w.x), bfhi(w.x), bflo(w.y), bfhi(w.y)}; o[64 * j] = v * rstd * gg; }
}

__device__ __forceinline__ void qknorm_rows(bf16_t* qkv, const float* ropec, const float* ropes, const float* qg, const float* kg, int row_base, int tid) {
    const int lane = tid & 63, wave = tid >> 6;
    const int head = lane >> 3, q8 = lane & 7, hf = q8 >> 2, a = q8 & 3;
    const float* gp = (head < 6) ? qg : kg;
    const float osc = (head < 6) ? 0.088388347648318440f * 1.4426950408889634f : 1.0f;
    float g1[8], g2[8];
#pragma unroll
    for (int e = 0; e < 8; ++e) { g1[e] = gp[hf * 64 + 8 * a + e]; g2[e] = gp[hf * 64 + 32 + 8 * a + e]; }
    for (int t0 = 0; t0 < 32; t0 += 4) {
        u32x4 w1[4], w2[4]; f32x4 cs[4][4];
#pragma unroll
        for (int i = 0; i < 4; ++i) { const int m = row_base + wave + 8 * (t0 + i);
            const int s = (m < NPROMPT) ? (m & (SEQ_P - 1)) : ((m - NPROMPT) & (SEQ_S - 1)); const int n = hf ? (s & 63) : (s >> 6);
            const bf16_t* p1 = qkv + (size_t)m * PROJ + head * HD + hf * 64 + 8 * a;
            w1[i] = *(const GAS u32x4*)p1; w2[i] = *(const GAS u32x4*)(p1 + 32);
            cs[i][0] = *(const GAS f32x4*)(ropec + n * 32 + 8 * a); cs[i][1] = *(const GAS f32x4*)(ropec + n * 32 + 8 * a + 4);
            cs[i][2] = *(const GAS f32x4*)(ropes + n * 32 + 8 * a); cs[i][3] = *(const GAS f32x4*)(ropes + n * 32 + 8 * a + 4); }
#pragma unroll
        for (int i = 0; i < 4; ++i) { const int m = row_base + wave + 8 * (t0 + i);
            bf16_t* p1 = qkv + (size_t)m * PROJ + head * HD + hf * 64 + 8 * a;
            float x1[8], x2[8];
#pragma unroll
            for (int e = 0; e < 4; ++e) { x1[2 * e] = bflo(w1[i][e]); x1[2 * e + 1] = bfhi(w1[i][e]); x2[2 * e] = bflo(w2[i][e]); x2[2 * e + 1] = bfhi(w2[i][e]); }
            float ss = 0.f;
#pragma unroll
            for (int e = 0; e < 8; ++e) ss += x1[e] * x1[e] + x2[e] * x2[e];
            ss += __shfl_xor(ss, 1); ss += __shfl_xor(ss, 2); ss += __shfl_xor(ss, 4);
            const float rstd = 1.0f / sqrtf(ss * (1.f / HD) + RMS_EPS);
            float o1[8], o2[8];
#pragma unroll
            for (int e = 0; e < 8; ++e) { const float cc = e < 4 ? cs[i][0][e & 3] : cs[i][1][e & 3], sn = e < 4 ? cs[i][2][e & 3] : cs[i][3][e & 3];
                const float y1 = x1[e] * rstd * g1[e], y2 = x2[e] * rstd * g2[e]; o1[e] = (y1 * cc - y2 * sn) * osc; o2[e] = (y1 * sn + y2 * cc) * osc; }
            u32x4 r1, r2;
#pragma unroll
            for (int e = 0; e < 4; ++e) { r1[e] = cvt_pk_bf16(o1[2 * e], o1[2 * e + 1]); r2[e] = cvt_pk_bf16(o2[2 * e], o2[2 * e + 1]); }
            *(GAS u32x4*)p1 = r1; *(GAS u32x4*)(p1 + 32) = r2; }
    }
}
__device__ __forceinline__ void crescale_rows(bf16_t* mix, const float* lsebuf, int row_base, int tid) {
    const int lane = tid & 63, wave = tid >> 6;
    for (int t0 = 0; t0 < 32; t0 += 4) {
        float ls[4][6]; u32x2 w[4][3];
#pragma unroll
        for (int i = 0; i < 4; ++i) { const int m = row_base + wave + 8 * (t0 + i);
#pragma unroll
            for (int k = 0; k < 6; ++k) ls[i][k] = lsebuf[(size_t)m * 6 + k];
            const GAS u32x2* p = (const GAS u32x2*)(mix + (size_t)m * MIXW + 1280) + lane;
#pragma unroll
            for (int j = 0; j < 3; ++j) w[i][j] = p[64 * j]; }
#pragma unroll
        for (int i = 0; i < 4; ++i) { const int m = row_base + wave + 8 * (t0 + i);
            float al[6];
#pragma unroll
            for (int j = 0; j < 2; ++j) { const float mx = fmaxf(fmaxf(ls[i][j], ls[i][2 + j]), ls[i][4 + j]);
                const float e0 = __expf(ls[i][j] - mx), e1 = __expf(ls[i][2 + j] - mx), e2 = __expf(ls[i][4 + j] - mx); const float inv = 1.0f / (e0 + e1 + e2);
                al[j] = e0 * inv; al[2 + j] = e1 * inv; al[4 + j] = e2 * inv; }
            GAS u32x2* p = (GAS u32x2*)(mix + (size_t)m * MIXW + 1280) + lane;
#pragma unroll
            for (int j = 0; j < 3; ++j) { const int hc = (4 * lane + 256 * j) >> 7; const float a = (hc == 0) ? al[0] : (hc == 1) ? al[1] : (hc == 2) ? al[2] : (hc == 3) ? al[3] : (hc == 4) ? al[4] : al[5];
                u32x2 v = w[i][j]; v.x = cvt_pk_bf16(bflo(v.x) * a, bfhi(v.x) * a); v.y = cvt_pk_bf16(bflo(v.y) * a, bfhi(v.y) * a); p[64 * j] = v; } }
    }
}

__global__ void __launch_bounds__(NWAVES * 64, 2) fwd(Args args) {
    extern __shared__ __attribute__((aligned(16))) unsigned char lds[];
    LAS unsigned char* ldsl = (LAS unsigned char*)lds;
    volatile LAS unsigned* MISC = (volatile LAS unsigned*)(ldsl + MISC_OFF);
    const int G = gridDim.x;
    unsigned char* ws = args.ws;
    gu32* ctl = (gu32*)(ws + WS_CTL);
    { const int tid0 = threadIdx.x; for (int u = tid0; u < (LDS_BYTES - LDSCTL_OFF) / 4; u += NWAVES * 64) ((LAS unsigned*)(ldsl + LDSCTL_OFF))[u] = 0u; }
    __syncthreads();
    XcdBarrier bar; bar.bar = (unsigned*)ctl + CW_BAR; bar.x = 0; bar.st = nullptr;
    if (ONE_LAUNCH) bar = xcd_barrier_post((unsigned*)ctl + CW_BAR, MISC + 8);
    int bx = blockIdx.x;
    if (ONE_LAUNCH) {
        if (threadIdx.x == 0) { const unsigned xcc = xb_xcc_id(); const unsigned rk = __hip_atomic_fetch_add(ctl + CW_XRANK + 64 * (xcc & 15u), 1u, __ATOMIC_RELAXED, __HIP_MEMORY_SCOPE_AGENT); MISC[12] = rk * 8u + xcc; }
        xcd_barrier(bar);
        if (threadIdx.x == 0) { bool ok = (G % 8 == 0);
            for (unsigned j = 0; j < 16; ++j) { const unsigned cnt = __hip_atomic_load(ctl + CW_XRANK + 64 * j, __ATOMIC_RELAXED, __HIP_MEMORY_SCOPE_AGENT); ok = ok && (cnt == (j < 8 ? (unsigned)G / 8u : 0u)); }
            if (!ok) MISC[12] = blockIdx.x; }
        __syncthreads();
        bx = __builtin_amdgcn_readfirstlane((int)MISC[12]);
    }
    const int lo = args.ph_lo, hi = args.ph_hi;
#ifndef PHMASK
#define PHMASK 0xffff
#endif
#define IN(k) (lo <= (k) && (k) < hi)
#define EN(b) ((PHMASK >> (b)) & 1)
#ifndef PROBE_DUP
#define PROBE_DUP 0
#endif
#define NREP(b) (1 + ((PROBE_DUP >> (b)) & 1))
#define REPSEAM(b) do { if (ONE_LAUNCH && NREP(b) > 1 && rep == 0) xcd_barrier(bar); } while (0)
#define SEAM(k) do { if (ONE_LAUNCH && IN(k) && IN((k) + 1)) xcd_barrier(bar); } while (0)
#define LANE_ID() const int tid = opaque_tid(), lane = tid & 63, wave = __builtin_amdgcn_readfirstlane(tid >> 6); const int vcu = (G % 8 == 0) ? (bx % 8) * (G / 8) + bx / 8 : bx; const int gw = vcu * NWAVES + wave, NGW = G * NWAVES; (void)lane; (void)gw; (void)NGW
#define ROPEC ((float*)(ws + WS_TAB))
#define ROPES (ROPEC + 128 * 32)
#define TABB (ROPES + 128 * 32)
#define TABC (TABB + 4 * 512)
#define LSEBUF ((float*)(ws + WS_LSE))
#define XB ((bf16_t*)(ws + WS_XB))
#define MB ((bf16_t*)(ws + WS_MB))
#define SSBUF ((pg8::ss_t*)(ws + WS_SS))
#define RSM ((pg8::ss_t*)(ws + WS_RSM))
#define QKV ((bf16_t*)(ws + WS_QKV))
#define MIX ((bf16_t*)(ws + WS_MIX))
#define HID ((bf16_t*)(ws + WS_HID))
#define QX ((bf16_t*)(ws + WS_QX))
#define OX ((bf16_t*)(ws + WS_OX))
#define KVX ((bf16_t*)(ws + WS_KVX))
    float* out = args.out;

    if (EN(13) && IN(0)) {
        LANE_ID();
        float* ropec = ROPEC; float* ropes = ROPES; float* tabB = TABB; float* tabC = TABC;
        LAS float* scr = (LAS float*)(ldsl + wave * 16384);
        constexpr int I_IN = 32 * 120, I_OUT = 32 * 64, I_CQ = 32 * 16, I_CKV = 32 * 32, I_CO = 8 * 64, I_FI = 32 * 352, I_FO = 88 * 64;
        constexpr int I_LAYER = I_IN + I_OUT + I_CQ + I_CKV + I_CO + I_FI + I_FO;
        for (int it = gw; it < DEPTH * I_LAYER; it += NGW) {
            const int l = it / I_LAYER; int r = it % I_LAYER;
            const float* W; bf16_t* WT; int K, N; const float* gain = nullptr;
            if (r < I_IN) { gain = args.in[4] + (size_t)l * DM; W = args.in[5] + (size_t)l * DM * PROJ; WT = (bf16_t*)(ws + WS_WIN) + (size_t)l * PROJ * DM; K = DM; N = PROJ; }
            else if ((r -= I_IN) < I_OUT) { W = args.in[10] + (size_t)l * MIXW * DM; WT = (bf16_t*)(ws + WS_WOUT) + (size_t)l * DM * MIXW; K = MIXW; N = DM; }
            else if ((r -= I_OUT) < I_CQ) { gain = args.in[11] + (size_t)l * DM; W = args.in[13] + (size_t)l * DM * XW; WT = (bf16_t*)(ws + WS_WCQ) + (size_t)l * XW * DM; K = DM; N = XW; }
            else if ((r -= I_CQ) < I_CKV) { gain = args.in[12] + (size_t)l * DM; W = args.in[14] + (size_t)l * DM * 2 * XW; WT = (bf16_t*)(ws + WS_WCKV) + (size_t)l * 2 * XW * DM; K = DM; N = 2 * XW; }
            else if ((r -= I_CKV) < I_CO) { W = args.in[15] + (size_t)l * XW * DM; WT = (bf16_t*)(ws + WS_WCO) + (size_t)l * DM * XW; K = XW; N = DM; }
            else if ((r -= I_CO) < I_FI) { gain = args.in[16] + (size_t)l * DM; W = args.in[17] + (size_t)l * DM * 2 * DFF; WT = (bf16_t*)(ws + WS_WFI) + (size_t)l * 2 * DFF * DM; K = DM; N = 2 * DFF; }
            else { r -= I_FI; W = args.in[18] + (size_t)l * DFF * DM; WT = (bf16_t*)(ws + WS_WFO) + (size_t)l * DM * DFF; K = DFF; N = DM; }
            const int nblk = N / 32, kb = r / nblk, nb = r % nblk, n0 = 32 * nb;
            int drow0 = n0;
            if (N == 2 * DFF) drow0 = (n0 < DFF) ? 256 * (n0 / 128) + (n0 % 128) : 256 * ((n0 - DFF) / 128) + 128 + ((n0 - DFF) % 128);
            transpose_item(W, gain, K, N, WT, 64 * kb, n0, drow0, scr, lane);
        }
        { bf16_t* xb = XB; pg8::ss_t* ss0 = SSBUF; bf16_t* mb = MB; pg8::ss_t* rsm = RSM;
          for (int m = gw; m < NTOK; m += NGW) { const float* xr = (m < NPROMPT) ? args.in[0] + (size_t)m * DM : args.in[1] + (size_t)(m - NPROMPT) * DM;
              const float q = row_to_bf16(xr, xb + (size_t)m * DM, lane); if (lane == 0) ss0[m] = (pg8::ss_t)(q * pg8::SS_SCALE); }
          for (int m = gw; m < MEMROWS; m += NGW) { const float* mr = (m < 2 * MEMLEN) ? args.in[2] + (size_t)m * DM : args.in[3] + (size_t)(m - 2 * MEMLEN) * DM;
              const float q = row_to_bf16(mr, mb + (size_t)m * DM, lane); if (lane == 0) rsm[m] = (pg8::ss_t)(q * pg8::SS_SCALE); } }
        const int gt = vcu * (NWAVES * 64) + tid, NGT = G * NWAVES * 64;
        const float* rel_bias = args.in[9];
        for (int e = gt; e < 4096 + 2048 + 3072; e += NGT) {
            if (e < 4096) { const int n = e >> 5, i = e & 31;
                double invd = 1.0; for (int q = 0; q < i; ++q) invd *= 0.7498942093324559;
                const float inv = (float)invd;
                const float ang = (float)n * inv; double s, c; sincos_d((double)ang, s, c); ropec[e] = (float)c; ropes[e] = (float)s; }
            else if (e < 4096 + 2048) { const int t = e - 4096, h = t >> 9, i = t & 511; const int rel = i - 96 - 128;
                float v = -INFINITY; if (rel >= -128 && rel <= 128) v = rel_bias[t5_bucket(rel) * 10 + h] * att::LOG2E;
                tabB[t] = v; }
            else { const int t = e - 6144, hc = t >> 9, i = t & 511; const int off = i - 96 - 64; const int d = (hc < 2) ? 1 : (hc < 4) ? 4 : 16;
                float v = -INFINITY; if (off >= -64 && off <= 64) v = rel_bias[t5_bucket(off * d) * 10 + 4 + hc] * att::LOG2E;
                tabC[t] = v; }
        }
    }
    SEAM(0);

    for (int l = 0; l < DEPTH; ++l) {
        const int pb = 1 + PPL * l;
#define XS0 ((l == 0) ? args.in[0] : (const float*)out)
#define XS1 ((l == 0) ? args.in[1] : (const float*)out + (size_t)NPROMPT * DM)
        if (EN(0) && IN(pb + 0)) for (int rep = 0; rep < NREP(0); ++rep) {
            { const bf16_t* Win = (const bf16_t*)(ws + WS_WIN) + (size_t)l * PROJ * DM; const bool tail = (G == 256) && l > 0;
              pg8::Gemm g{XB, Win, NTOK, PROJ, DM}; pg8::StaticOrder S; S.init(NTOK, PROJ, G, bx, 0, tail ? 11 : (1 << 30));
              pg8::EpiBf16 E{QKV, PROJ, SSBUF + (size_t)(3 * l) * NTOK};
              pg8::gemm_phase<pg8::EpiBf16, pg8::StaticOrder, true, true>(ldsl, g, S, E);
              if (tail) { pg8::TailHalfOrder T; T.init(NTOK, PROJ, G, bx, 11); pg8::EpiBf16H EH{QKV, PROJ, SSBUF + (size_t)(3 * l) * NTOK};
                  pg8::gemm_phase<pg8::EpiBf16H, pg8::TailHalfOrder, true, true, true>(ldsl, g, T, EH); } }
            if (l == 0) {
              pg8::Gemm g{MB, (const bf16_t*)(ws + WS_WCKV), MEMROWS, 4 * 2 * XW, DM}; pg8::StaticOrder S; S.init(MEMROWS, 4 * 2 * XW, G, (bx + G - 64) % G);
              pg8::EpiBf16 E{KVX, 4 * 2 * XW, RSM};
              pg8::gemm_phase<pg8::EpiBf16, pg8::StaticOrder, true, true>(ldsl, g, S, E); }
            REPSEAM(0);
        }
        SEAM(pb + 0);
        if (EN(1) && IN(pb + 1)) {
            const int tid = opaque_tid(); const float* tabC = TABC; float* lsebuf = LSEBUF;
            gu32* qhead = ctl + CW_QUEUE + 64 * (2 * l);
            volatile LAS unsigned* uidw = (volatile LAS unsigned*)(ldsl + att::OFF_UID);
            for (;;) {
                if (tid == 0) uidw[0] = __hip_atomic_fetch_add(qhead, 1u, __ATOMIC_RELAXED, __HIP_MEMORY_SCOPE_AGENT);
                __syncthreads();
                const int u = (int)uidw[0];
                __syncthreads();
                if (u >= 1344) break;
                if (u < 960 && u % 5 == 4) {
                    qknorm_rows(QKV, ROPEC, ROPES, args.in[6] + (size_t)l * HD, args.in[7] + (size_t)l * HD, (u / 5) * 256, tid);
                } else { const int v0 = (u < 960) ? u - u / 5 : u - 192;
                {
                    const int v = v0, gi = v % 3, idx = v / 3; const int d = (gi == 0) ? 1 : (gi == 1) ? 4 : 16;
                    long row0; int j, L;
                    if (idx < 128) { row0 = (long)(idx / 64) * SEQ_P; j = idx % 64; L = SEQ_P; } else { const int i2 = idx - 128; row0 = NPROMPT + (long)(i2 / 32) * SEQ_S; j = i2 % 32; L = SEQ_S; }
                    const int res = j % d, qbr = j / d, p0 = qbr * 128, Lr = L / d;
                    int tlo = p0 / 64 - 1, thi = p0 / 64 + 3; if (tlo < 0) tlo = 0; if (thi > Lr / 64) thi = Lr / 64;
                    const long rq = row0 + (long)p0 * d + res, rk = row0 + res; const int hc = 2 * gi;
                    att::attn_unit<true>(QKV + rq * PROJ + COL_QC + hc * HD, (long)d * PROJ, QKV + rk * PROJ + COL_KC + gi * HD, QKV + rk * PROJ + COL_VC + gi * HD, (long)d * PROJ,
                                         MIX + rq * MIXW + 1280 + hc * HD, (long)d * MIXW, tlo, thi, p0, 64, tabC + hc * 512, 321, -1e30f, -1e30f, 0.f, lsebuf + rq * 6 + hc, (long)d * 6, (char*)lds);
                } }
            }
        }
        SEAM(pb + 1);
        if (EN(2) && IN(pb + 2)) for (int rep = 0; rep < NREP(2); ++rep) {
            const int tid = opaque_tid(); const float* tabB = TABB;
            float mfix2;
            { const float* qg = args.in[6] + (size_t)l * HD; const float* kg = args.in[7] + (size_t)l * HD; const int ln = tid & 63;
              float a = fmaxf(fabsf(qg[ln]), fabsf(qg[ln + 64])), b = fmaxf(fabsf(kg[ln]), fabsf(kg[ln + 64]));
#pragma unroll
              for (int o = 1; o < 64; o <<= 1) { a = fmaxf(a, __shfl_xor(a, o)); b = fmaxf(b, __shfl_xor(b, o)); }
              mfix2 = __builtin_amdgcn_readfirstlane(128.f * a * b * 1.02f * att::C); if (!(mfix2 <= 40.f)) mfix2 = -1.f; }
            gu32* qhead = ctl + CW_QUEUE + 64 * (2 * l + 1 + 8 * rep);
            volatile LAS unsigned* uidw = (volatile LAS unsigned*)(ldsl + att::OFF_UID);
            const float* sink = args.in[8] + (size_t)l * 4;
            for (;;) {
                if (tid == 0) uidw[0] = __hip_atomic_fetch_add(qhead, 1u, __ATOMIC_RELAXED, __HIP_MEMORY_SCOPE_AGENT);
                __syncthreads();
                const int u = (int)uidw[0];
                __syncthreads();
                if (u >= 1152 + 192 + 768) break;
                if (u < 1152) {
                    int seq, kvh, qb, gi, L;
                    if (u < 384) { seq = u / 192; const int r = u % 192; kvh = r / 96; const int r2 = r % 96; qb = r2 / 3; gi = r2 % 3; L = SEQ_P; }
                    else { const int v = u - 384; seq = 2 + v / 96; const int r = v % 96; kvh = r / 48; const int r2 = r % 48; qb = r2 / 3; gi = r2 % 3; L = SEQ_S; }
                    const long row0 = (seq < 2) ? (long)seq * SEQ_P : (long)NPROMPT + (long)(seq - 2) * SEQ_S;
                    const int h = kvh * 3 + gi;
                    att::attn_unit_dense<true>(QKV + (row0 + qb * 256) * PROJ + COL_QA + h * HD, PROJ, QKV + row0 * PROJ + COL_KA + kvh * HD, QKV + row0 * PROJ + COL_VA + kvh * HD, PROJ,
                                         MIX + (row0 + qb * 256) * MIXW + h * HD, MIXW, L / 64, mfix2, (char*)lds);
                } else if (u < 1344) { if (rep == 0) crescale_rows(MIX, LSEBUF, (u - 1152) * 256, tid); }
                else {
                    const int v = u - 1344, qbg = v >> 1, kvh = v & 1; const long rowq = (long)qbg * 128;
                    long row0; int pos0, L;
                    if (rowq < NPROMPT) { row0 = (rowq / SEQ_P) * SEQ_P; pos0 = (int)(rowq % SEQ_P); L = SEQ_P; } else { const long rr = rowq - NPROMPT; row0 = NPROMPT + (rr / SEQ_S) * SEQ_S; pos0 = (int)(rr % SEQ_S); L = SEQ_S; }
                    int tlo = pos0 / 64 - 2, thi = pos0 / 64 + 4; if (tlo < 0) tlo = 0; if (thi > L / 64) thi = L / 64;
                    const int h = 2 * kvh;
                    att::attn_unit<true>(QKV + rowq * PROJ + COL_QB + h * HD, PROJ, QKV + row0 * PROJ + COL_KB + kvh * HD, QKV + row0 * PROJ + COL_VB + kvh * HD, PROJ,
                                         MIX + rowq * MIXW + 768 + h * HD, MIXW, tlo, thi, pos0, 128, tabB + h * 512, 449, sink[h] * att::LOG2E, sink[h + 1] * att::LOG2E, 1.0f, nullptr, 0, (char*)lds);
                }
            }
            REPSEAM(2);
        }
        SEAM(pb + 2);
        if (EN(3) && IN(pb + 3)) for (int rep = 0; rep < NREP(3); ++rep) {
            const bf16_t* Wout = (const bf16_t*)(ws + WS_WOUT) + (size_t)l * DM * MIXW;
            pg8::Gemm g{MIX, Wout, NTOK, DM, MIXW}; pg8::StaticOrder S; S.init(NTOK, DM, G, bx);
            pg8::EpiRes E{XB, SSBUF + (size_t)(rep ? NNORM : 3 * l + 1) * NTOK, rep ? 0.f : 1.f};
            pg8::gemm_phase<pg8::EpiRes, pg8::StaticOrder, true, true>(ldsl, g, S, E);
            REPSEAM(3);
        }
        SEAM(pb + 3);
        if (EN(4) && IN(pb + 4)) for (int rep = 0; rep < NREP(4); ++rep) {
            const bf16_t* Wcq = (const bf16_t*)(ws + WS_WCQ) + (size_t)l * XW * DM;
            const bool tail = (G == 256);
            pg8::Gemm g{XB, Wcq, NTOK, XW, DM}; pg8::StaticOrder S; S.init(NTOK, XW, G, bx, 0, tail ? 1 : (1 << 30)); pg8::EpiBf16 E{QX, XW, SSBUF + (size_t)(3 * l + 1) * NTOK};
            pg8::gemm_phase<pg8::EpiBf16, pg8::StaticOrder, true, true>(ldsl, g, S, E);
            if (tail) { pg8::TailHalfOrder T; T.init(NTOK, XW, G, bx, 1); pg8::EpiBf16H EH{QX, XW, SSBUF + (size_t)(3 * l + 1) * NTOK};
                pg8::gemm_phase<pg8::EpiBf16H, pg8::TailHalfOrder, true, true, true>(ldsl, g, T, EH); }
            REPSEAM(4);
        }
        SEAM(pb + 4);
        if (EN(5) && IN(pb + 5)) for (int rep = 0; rep < NREP(5); ++rep) {
            for (int u = bx; u < 768; u += G) {
                const int qbg = u >> 2, h = u & 3; const long rowq = (long)qbg * 256;
                const int seq = (rowq < NPROMPT) ? (int)(rowq / SEQ_P) : 2 + (int)((rowq - NPROMPT) / SEQ_S);
                const bf16_t* kb = KVX + (size_t)seq * MEMLEN * (4 * 2 * XW) + l * (2 * XW) + h * HD;
                att::attn_unit_dense<false>(QX + rowq * XW + h * HD, XW, kb, kb + XW, 4 * 2 * XW, OX + rowq * XW + h * HD, XW, MEMLEN / 64, -1.f, (char*)lds);
            }
            REPSEAM(5);
        }
        SEAM(pb + 5);
        if (EN(6) && IN(pb + 6)) for (int rep = 0; rep < NREP(6); ++rep) {
            const bf16_t* Wco = (const bf16_t*)(ws + WS_WCO) + (size_t)l * DM * XW;
            pg8::Gemm g{OX, Wco, NTOK, DM, XW}; pg8::StaticOrder S; S.init(NTOK, DM, G, bx);
            pg8::EpiRes E{XB, SSBUF + (size_t)(rep ? NNORM : 3 * l + 2) * NTOK, rep ? 0.f : 1.f};
            pg8::gemm_phase<pg8::EpiRes, pg8::StaticOrder, true, true>(ldsl, g, S, E);
            REPSEAM(6);
        }
        SEAM(pb + 6);
        if (EN(7) && IN(pb + 7)) for (int rep = 0; rep < NREP(7); ++rep) {
            const bf16_t* Wfi = (const bf16_t*)(ws + WS_WFI) + (size_t)l * 2 * DFF * DM;
            pg8::Gemm g{XB, Wfi, NTOK, 2 * DFF, DM}; pg8::StaticOrder S; S.init(NTOK, 2 * DFF, G, bx);
            pg8::EpiSwiglu E{HID, DFF, SSBUF + (size_t)(3 * l + 2) * NTOK};
            pg8::gemm_phase<pg8::EpiSwiglu, pg8::StaticOrder, true, true>(ldsl, g, S, E);
            REPSEAM(7);
        }
        SEAM(pb + 7);
        if (EN(8) && IN(pb + 8)) for (int rep = 0; rep < NREP(8); ++rep) {
            const bf16_t* Wfo = (const bf16_t*)(ws + WS_WFO) + (size_t)l * DM * DFF;
            pg8::Gemm g{HID, Wfo, NTOK, DM, DFF}; pg8::StaticOrder S; S.init(NTOK, DM, G, bx);
            pg8::EpiRes E{XB, SSBUF + (size_t)(rep ? NNORM : 3 * l + 3) * NTOK, rep ? 0.f : 1.f};
            pg8::gemm_phase<pg8::EpiRes, pg8::StaticOrder, true, true>(ldsl, g, S, E);
            REPSEAM(8);
        }
        SEAM(pb + 8);
    }
    if (EN(14) && IN(NPHASE - 1)) {
        LANE_ID();
        const float* g = args.in[19]; const pg8::ss_t* ssl = SSBUF + (size_t)(NNORM - 1) * NTOK;
        f32x4 gg[8];
#pragma unroll
        for (int j = 0; j < 8; ++j) gg[j] = ((const GAS f32x4*)g)[lane + 64 * j];
        for (int m = gw; m < NTOK; m += 4 * NGW) {
            u32x2 w[4][8]; float rstd[4];
#pragma unroll
            for (int i = 0; i < 4; ++i) { const int mi = m + i * NGW; const int mc = mi < NTOK ? mi : m;
                rstd[i] = __builtin_amdgcn_rsqf((float)ssl[mc] * pg8::SS_INV_MEAN + RMS_EPS);
#pragma unroll
                for (int j = 0; j < 8; ++j) w[i][j] = ((const GAS u32x2*)(XB + (size_t)mc * DM))[lane + 64 * j]; }
#pragma unroll
            for (int i = 0; i < 4; ++i) { const int mi = m + i * NGW; if (mi < NTOK) { GAS f32x4* o = (GAS f32x4*)(out + (size_t)mi * DM) + lane;
#pragma unroll
                for (int j = 0; j < 8; ++j) { const f32x4 v = {bflo(w[i][j].x), bfhi(w[i][j].x), bflo(w[i][j].y), bfhi(w[i][j].y)}; o[64 * j] = v * rstd[i] * gg[j]; } } }
        }
    }
#undef IN
#undef SEAM
}

extern "C" void kernel_launch(void* const* d_in, const int* in_sizes, int n_in, void* d_out, int out_size, void* d_ws, size_t ws_size, hipStream_t stream) {
    static int grid = 0;
    if (grid == 0) {
        if (n_in != 20 || out_size != NTOK * DM || ws_size < WS_END) { fprintf(stderr, "kernel_launch: unexpected shapes: n_in %d out %d ws %zu (need %zu)\n", n_in, out_size, ws_size, (size_t)WS_END); grid = -1; return; }
        int dev = 0, cus = 0, per_cu = 0;
        if (hipGetDevice(&dev) != hipSuccess || hipDeviceGetAttribute(&cus, hipDeviceAttributeMultiprocessorCount, dev) != hipSuccess) { grid = -1; return; }
        if (hipFuncSetAttribute((const void*)fwd, hipFuncAttributeMaxDynamicSharedMemorySize, LDS_BYTES) != hipSuccess) { fprintf(stderr, "kernel_launch: hipFuncSetAttribute failed\n"); grid = -1; return; }
        if (hipOccupancyMaxActiveBlocksPerMultiprocessor(&per_cu, (const void*)fwd, NWAVES * 64, LDS_BYTES) != hipSuccess || per_cu < 1) { fprintf(stderr, "kernel_launch: occupancy query says %d\n", per_cu); }
        (void)hipGetLastError();
        grid = cus;
    }
    if (grid < 0) return;
    (void)hipMemsetAsync((char*)d_ws + WS_CTL, 0, CTL_ZERO_BYTES, stream);
    Args a{};
    for (int i = 0; i < 20; ++i) a.in[i] = (const float*)d_in[i];
    a.out = (float*)d_out; a.ws = (unsigned char*)d_ws;
#if ONE_LAUNCH
    a.ph_lo = 0; a.ph_hi = NPHASE;
    hipLaunchKernelGGL(fwd, dim3(grid), dim3(NWAVES * 64), LDS_BYTES, stream, a);
#else
    for (int p = 0; p < NPHASE; ++p) { a.ph_lo = p; a.ph_hi = p + 1; hipLaunchKernelGGL(fwd, dim3(grid), dim3(NWAVES * 64), LDS_BYTES, stream, a); }
#endif
    const hipError_t le = hipPeekAtLastError();
    if (le != hipSuccess) fprintf(stderr, "kernel_launch: launch failed: %s\n", hipGetErrorName(le));
}
```

```cpp
#include <hip/hip_runtime.h>
#include <cstdio>
#include <cstdint>

#ifndef ONE_LAUNCH
#define ONE_LAUNCH 1
#endif

constexpr int DM = 2048, NTOK = 49152, NPROMPT = 16384, SEQ_P = 8192, SEQ_S = 4096, DEPTH = 4;
constexpr int PROJ = 3840, MIXW = 2048, XW = 512, DFF = 5632, MEMLEN = 256, MEMROWS = 2560, HD = 128;
constexpr int COL_QA = 0, COL_KA = 768, COL_VA = 1024, COL_QB = 1280, COL_KB = 1792, COL_VB = 2048, COL_QC = 2304, COL_KC = 3072, COL_VC = 3456;
constexpr float RMS_EPS = 1e-6f;
constexpr int PPL = 9;
constexpr int NPHASE = 2 + PPL * DEPTH;
constexpr int NNORM = 3 * DEPTH + 1;

constexpr size_t MiB = 1u << 20;
constexpr size_t WS_CTL = 0;
constexpr size_t WS_SS = 1 * MiB;
constexpr size_t CTL_ZERO_BYTES = 6 * MiB + 512 * 1024;
static_assert(WS_SS + (size_t)(NNORM + 1) * NTOK * 8 <= CTL_ZERO_BYTES, "ss inside the memset region");
constexpr size_t WS_TAB = 6 * MiB + 512 * 1024;
constexpr size_t WS_RSM = 7 * MiB;
constexpr size_t WS_LSE = 618 * MiB;
constexpr size_t WS_WIN = 8 * MiB, WS_WOUT = 68 * MiB, WS_WCQ = 100 * MiB, WS_WCKV = 108 * MiB, WS_WCO = 124 * MiB, WS_WFI = 132 * MiB, WS_WFO = 308 * MiB;
constexpr size_t WS_XB = 396 * MiB;
constexpr size_t WS_MB = 588 * MiB;
constexpr size_t WS_KVX = 598 * MiB;
constexpr size_t WS_QKV = 620 * MiB;
constexpr size_t WS_MIX = 980 * MiB;
constexpr size_t WS_HID = 620 * MiB;
constexpr size_t WS_QX = 620 * MiB, WS_OX = 668 * MiB;
constexpr size_t WS_END = 1172 * MiB;
constexpr int CW_BAR = 4096;
constexpr int CW_XRANK = 12288;
constexpr int CW_TAIL = 24576;
constexpr int CW_QUEUE = 16384;

#define GAS __attribute__((address_space(1)))
#define LAS __attribute__((address_space(3)))
typedef unsigned short bf16_t;
typedef short bf16x8 __attribute__((ext_vector_type(8)));
typedef short s16x4 __attribute__((ext_vector_type(4)));
typedef float f32x4 __attribute__((ext_vector_type(4)));
typedef float f32x16 __attribute__((ext_vector_type(16)));
typedef unsigned u32x4 __attribute__((ext_vector_type(4)));
typedef unsigned u32x2 __attribute__((ext_vector_type(2)));
typedef GAS unsigned gu32;

__device__ __forceinline__ int opaque_tid() { int t = threadIdx.x; asm volatile("" : "+v"(t)); return t; }
__device__ __forceinline__ unsigned cvt_pk_bf16(float lo, float hi) { unsigned r; asm volatile("v_cvt_pk_bf16_f32 %0, %1, %2" : "=v"(r) : "v"(lo), "v"(hi)); return r; }
__device__ __forceinline__ float bf2f(unsigned short b) { return __builtin_bit_cast(float, (unsigned)b << 16); }
__device__ __forceinline__ float bflo(unsigned w) { return __builtin_bit_cast(float, w << 16); }
__device__ __forceinline__ float bfhi(unsigned w) { return __builtin_bit_cast(float, w & 0xffff0000u); }

namespace pg8 {
#define PG8_LAS __attribute__((address_space(3)))
constexpr int BM = 256, BK = 64, HALF = 128, HTB = HALF * BK * 2, STAGE_BYTES = 8 * HTB, NXCD = 8, WGM = 4;
__host__ __device__ __forceinline__ int lds_byte(int r, int c) { const int st = (r >> 4) * 2 + (c >> 5), rr = r & 15, cc = c & 31, ob = rr * 64 + cc * 2; return st * 1024 + (ob ^ (((ob >> 9) & 1) << 5)); }
__host__ __device__ __forceinline__ void stage_rc(int b, int& R, int& C) { const int st = b / 1024, sb = b % 1024, swz = sb ^ (((sb >> 9) & 1) << 5); R = (st >> 1) * 16 + swz / 64; C = (st & 1) * 32 + (swz % 64) / 2; }
__host__ __device__ __forceinline__ int perm32(int rho) { const int n = rho >> 4, i = rho & 15; return 8 * (i >> 2) + 4 * n + (i & 3); }

struct Unit { int pm, pn; };
struct Gemm { const bf16_t* A; const bf16_t* Bt; int M, N, K; };

struct StaticOrder {
    int nM, nN, nwg, G, c, i_lo, i_hi, wgm = WGM;
    __host__ __device__ void init(int M, int N, int G_, int c_, int lo_ = 0, int hi_ = 1 << 30) { nM = M / BM; nN = N / BM; nwg = nM * nN; G = G_; c = c_; i_lo = lo_; i_hi = hi_; }
    __host__ __device__ bool next(int i, Unit& u) const {
        i += i_lo; if (i >= i_hi) return false;
        const long L = (long)i * G + c; if (L >= nwg) return false;
        int wgid = (int)L; { const int q = nwg / NXCD, r = nwg % NXCD, xcd = wgid % NXCD, off = wgid / NXCD; wgid = (xcd < r ? xcd * (q + 1) : r * (q + 1) + (xcd - r) * q) + off; }
        const int nig = wgm * nN, gid = wgid / nig, fm = gid * wgm, gsz = (nM - fm) < wgm ? (nM - fm) : wgm;
        u.pm = fm + ((wgid % nig) % gsz); u.pn = (wgid % nig) / gsz; return true;
    }
    __device__ __forceinline__ void a_ready(const Unit&) const {}
    __device__ __forceinline__ void done(const Unit&) const {}
};

struct TailHalfOrder {
    StaticOrder F; int c;
    __host__ __device__ void init(int M, int N, int G_, int c_, int round) { F.init(M, N, G_, c_ >> 1, round, round + 1); c = c_; }
    __host__ __device__ bool next(int i, Unit& u) const { if (i != 0) return false; Unit f; if (!F.next(0, f)) return false; u.pm = f.pm; u.pn = 2 * f.pn + (c & 1); return true; }
    __device__ __forceinline__ void a_ready(const Unit&) const {}
    __device__ __forceinline__ void done(const Unit&) const {}
};

typedef unsigned long long ss_t;
constexpr float SS_SCALE = 16777216.0f, SS_INV_MEAN = 1.0f / (16777216.0f * 2048.0f);
struct PreSS { ss_t v[2][4]; };
struct PreNone {};
__device__ __forceinline__ unsigned lane_perm(int src4, unsigned v) { return (unsigned)__builtin_amdgcn_ds_bpermute(src4, (int)v); }
__device__ __forceinline__ void ss_prefetch(PreSS& p, const ss_t* ss, int row0) {
#pragma unroll
    for (int ai = 0; ai < 2; ++ai)
#pragma unroll
        for (int m = 0; m < 4; ++m) p.v[ai][m] = ss[row0 + ai * HALF + m * 16];
}
__device__ __forceinline__ void row_rstd(const PreSS& p, float (&rs)[2][4]) {
#pragma unroll
    for (int ai = 0; ai < 2; ++ai)
#pragma unroll
        for (int m = 0; m < 4; ++m) {
            const ss_t v = p.v[ai][m]; const float f = (float)(unsigned)(v >> 32) * 4294967296.0f + (float)(unsigned)v;
            rs[ai][m] = __builtin_amdgcn_rsqf(f * SS_INV_MEAN + 1e-6f); }
}
template <int NBJ>
struct EpiBf16T {
    static constexpr bool PERM = true, AFTER_DRAIN = false;
    bf16_t* O; int ldc; const ss_t* ss;
    typedef PreSS Pre;
    __device__ __forceinline__ void prefetch(Pre& p, const Unit& u, int wr, int fr) const { ss_prefetch(p, ss, u.pm * BM + wr * 64 + fr); }
    __device__ __forceinline__ void operator()(const f32x4 (&acc)[2][2][4][2], const Unit& u, int wr, int wc, int fr, int fq, const Pre& pre) const {
        const int row0 = u.pm * BM + wr * 64 + fr; const int col0 = u.pn * (NBJ * HALF) + wc * 32 + 8 * fq;
        float rs[2][4]; row_rstd(pre, rs);
#pragma unroll
        for (int ai = 0; ai < 2; ++ai)
#pragma unroll
            for (int m = 0; m < 4; ++m) { bf16_t* rowp = O + (size_t)(row0 + ai * HALF + m * 16) * ldc + col0; const float r = rs[ai][m];
#pragma unroll
                for (int bj = 0; bj < NBJ; ++bj) { const f32x4 v0 = acc[ai][bj][m][0] * r, v1 = acc[ai][bj][m][1] * r;
                    u32x4 w; w.x = cvt_pk_bf16(v0[0], v0[1]); w.y = cvt_pk_bf16(v0[2], v0[3]); w.z = cvt_pk_bf16(v1[0], v1[1]); w.w = cvt_pk_bf16(v1[2], v1[3]);
                    *(u32x4*)(rowp + bj * HALF) = w; } }
    }
};
typedef EpiBf16T<2> EpiBf16; typedef EpiBf16T<1> EpiBf16H;
struct EpiRes {
    static constexpr bool PERM = true, AFTER_DRAIN = false;
    bf16_t* xb; ss_t* ssout; float scale;
    typedef PreNone Pre;
    __device__ __forceinline__ void prefetch(Pre&, const Unit&, int, int) const {}
    __device__ __forceinline__ void operator()(const f32x4 (&acc)[2][2][4][2], const Unit& u, int wr, int wc, int fr, int fq, const Pre&) const {
        const int row0 = u.pm * BM + wr * 64 + fr; const int col0 = u.pn * BM + wc * 32 + 8 * fq;
        bf16_t* xbase = xb + (size_t)row0 * DM + col0;
        const int pl = fq * 16 + fr, psrc = (4 * fr + fq) * 4;
        const bf16_t* xload = xb + (size_t)(u.pm * BM + wr * 64 + (pl >> 2)) * DM + u.pn * BM + wc * 32 + 8 * (pl & 3);
#pragma unroll
        for (int ai = 0; ai < 2; ++ai) { float sq[4];
            u32x4 xv[4][2];
#pragma unroll
            for (int m = 0; m < 4; ++m)
#pragma unroll
                for (int bj = 0; bj < 2; ++bj) xv[m][bj] = *(const u32x4*)(xload + (size_t)(ai * HALF + m * 16) * DM + bj * HALF);
#pragma unroll
            for (int m = 0; m < 4; ++m) { bf16_t* bp = xbase + (size_t)(ai * HALF + m * 16) * DM;
                float q = 0.f;
#pragma unroll
                for (int bj = 0; bj < 2; ++bj) { const u32x4 xq = xv[m][bj]; u32x4 xw; xw.x = lane_perm(psrc, xq.x); xw.y = lane_perm(psrc, xq.y); xw.z = lane_perm(psrc, xq.z); xw.w = lane_perm(psrc, xq.w);
                    const f32x4 d0 = acc[ai][bj][m][0] * scale, d1 = acc[ai][bj][m][1] * scale;
                    u32x4 w; w.x = cvt_pk_bf16(bflo(xw.x) + d0[0], bfhi(xw.x) + d0[1]); w.y = cvt_pk_bf16(bflo(xw.y) + d0[2], bfhi(xw.y) + d0[3]);
                    w.z = cvt_pk_bf16(bflo(xw.z) + d1[0], bfhi(xw.z) + d1[1]); w.w = cvt_pk_bf16(bflo(xw.w) + d1[2], bfhi(xw.w) + d1[3]);
                    *(u32x4*)(bp + bj * HALF) = w;
                    const float e0 = bflo(w.x), e1 = bfhi(w.x), e2 = bflo(w.y), e3 = bfhi(w.y), e4 = bflo(w.z), e5 = bfhi(w.z), e6 = bflo(w.w), e7 = bfhi(w.w);
                    q += (e0 * e0 + e1 * e1) + (e2 * e2 + e3 * e3) + (e4 * e4 + e5 * e5) + (e6 * e6 + e7 * e7); }
                sq[m] = q; }
            asm volatile("" ::: "memory");
            const bool b0 = fq & 1, b1 = fq & 2;
            const float w0 = (b0 ? sq[1] : sq[0]) + __shfl_xor(b0 ? sq[0] : sq[1], 16), w1 = (b0 ? sq[3] : sq[2]) + __shfl_xor(b0 ? sq[2] : sq[3], 16);
            const float tot = (b1 ? w1 : w0) + __shfl_xor(b1 ? w0 : w1, 32);
            __hip_atomic_fetch_add(ssout + u.pm * BM + ai * HALF + wr * 64 + fq * 16 + fr, (ss_t)(tot * SS_SCALE), __ATOMIC_RELAXED, __HIP_MEMORY_SCOPE_AGENT); }
    }
};
struct EpiSwiglu {
    static constexpr bool PERM = true, AFTER_DRAIN = false;
    bf16_t* O; int ldc; const ss_t* ss;
    typedef PreSS Pre;
    __device__ __forceinline__ void prefetch(Pre& p, const Unit& u, int wr, int fr) const { ss_prefetch(p, ss, u.pm * BM + wr * 64 + fr); }
    __device__ __forceinline__ void operator()(const f32x4 (&acc)[2][2][4][2], const Unit& u, int wr, int wc, int fr, int fq, const Pre& pre) const {
        const int row0 = u.pm * BM + wr * 64 + fr; const int col0 = u.pn * HALF + wc * 32 + 8 * fq;
        float rs[2][4]; row_rstd(pre, rs);
#pragma unroll
        for (int ai = 0; ai < 2; ++ai)
#pragma unroll
            for (int m = 0; m < 4; ++m) {
                const float r = rs[ai][m], c = -1.4426950408889634f * r, r2 = r * r;
                const f32x4 g0 = acc[ai][0][m][0], g1 = acc[ai][0][m][1], u0 = acc[ai][1][m][0], u1 = acc[ai][1][m][1];
                const f32x4 t0 = g0 * c, t1 = g1 * c;
                f32x4 e0, e1;
#pragma unroll
                for (int i = 0; i < 4; ++i) { e0[i] = __builtin_amdgcn_exp2f(t0[i]); e1[i] = __builtin_amdgcn_exp2f(t1[i]); }
                const f32x4 d0 = e0 + 1.0f, d1 = e1 + 1.0f;
                f32x4 q0, q1;
#pragma unroll
                for (int i = 0; i < 4; ++i) { q0[i] = __builtin_amdgcn_rcpf(d0[i]); q1[i] = __builtin_amdgcn_rcpf(d1[i]); }
                const f32x4 h0 = (g0 * u0) * (q0 * r2), h1 = (g1 * u1) * (q1 * r2);
                u32x4 w; w.x = cvt_pk_bf16(h0[0], h0[1]); w.y = cvt_pk_bf16(h0[2], h0[3]); w.z = cvt_pk_bf16(h1[0], h1[1]); w.w = cvt_pk_bf16(h1[2], h1[3]);
                *(u32x4*)(O + (size_t)(row0 + ai * HALF + m * 16) * ldc + col0) = w; }
    }
};

template <class Epi, class Sched, bool ALIGN_EPI = false, bool SP2 = false, bool HALFN = false>
__device__ __forceinline__ void gemm_phase(PG8_LAS unsigned char* lds, const Gemm g, const Sched& S, const Epi& E) {
    const int tid = opaque_tid(), wid = __builtin_amdgcn_readfirstlane(tid >> 6), lane = tid & 63, wr = wid >> 2, wc = wid & 3, fr = lane & 15, fq = lane >> 4;
    const int K = g.K, nt = K / BK;
    unsigned voffA[2], voffB[2];
#pragma unroll
    for (int i = 0; i < 2; ++i) { int R, C; stage_rc(tid * 16 + i * 8192, R, C); const int Rb = Epi::PERM ? ((R & ~31) + perm32(R & 31)) : R;
        voffA[i] = (unsigned)(R * K + C) * 2u; voffB[i] = (unsigned)(Rb * K + C) * 2u; }
    const size_t kstep = (size_t)(BK * 2);
    const size_t hstep = (size_t)HALF * K * 2;
    const size_t tstep = 2 * hstep;
    const size_t bstep = HALFN ? hstep : tstep;
    const unsigned ldsw = (unsigned)wid * 1024u;
    const int aoff = lds_byte(wr * 64 + fr, fq * 8), boff = lds_byte(wc * 32 + fr, fq * 8);
#define PG8_SA(b, h) (((b) * 2 + (h)) * HTB)
#define PG8_SB(b, h) ((4 + (b) * 2 + (h)) * HTB)
#define PG8_STAGE(bufoff, gbase, voff) do { _Pragma("unroll") for (int _i = 0; _i < 2; ++_i) \
        __builtin_amdgcn_global_load_lds((const unsigned*)((const char*)(gbase) + (voff)[_i]), (PG8_LAS unsigned*)(lds + (bufoff) + ldsw + _i * 8192), 16, 0, 0); } while (0)
#define PG8_LDA(dst, b, h) do { _Pragma("unroll") for (int m = 0; m < 4; ++m) _Pragma("unroll") for (int k = 0; k < 2; ++k) dst[m][k] = *(const PG8_LAS bf16x8*)(lds + PG8_SA(b, h) + aoff + m * 2048 + k * 1024); } while (0)
#define PG8_LDB(dst, b, h) do { _Pragma("unroll") for (int n = 0; n < 2; ++n) _Pragma("unroll") for (int k = 0; k < 2; ++k) dst[n][k] = *(const PG8_LAS bf16x8*)(lds + PG8_SB(b, h) + boff + n * 2048 + k * 1024); } while (0)
#define PG8_MMA(ai, bj, At, Bt) do { __builtin_amdgcn_s_setprio(1); _Pragma("unroll") for (int m = 0; m < 4; ++m) _Pragma("unroll") for (int n = 0; n < 2; ++n) _Pragma("unroll") for (int k = 0; k < 2; ++k) \
        acc[ai][bj][m][n] = __builtin_amdgcn_mfma_f32_16x16x32_bf16(Bt[n][k], At[m][k], acc[ai][bj][m][n], 0, 0, 0); __builtin_amdgcn_s_setprio(0); } while (0)
#define PG8_WAIT_V(n) asm volatile("s_waitcnt vmcnt(" #n ")" ::: "memory")
#define PG8_WAIT_L(n) asm volatile("s_waitcnt lgkmcnt(" #n ")" ::: "memory")
#define PG8_BAR __builtin_amdgcn_s_barrier()
#define PG8_SCHED __builtin_amdgcn_sched_barrier(0)
    Unit cur, nxt; int ui = 0;
    if (!S.next(0, cur)) return;
    f32x4 acc[2][2][4][2];
#pragma unroll
    for (int a = 0; a < 2; ++a)
#pragma unroll
        for (int b = 0; b < 2; ++b)
#pragma unroll
            for (int m = 0; m < 4; ++m)
#pragma unroll
                for (int n = 0; n < 2; ++n) acc[a][b][m][n] = (f32x4){0.f, 0.f, 0.f, 0.f};
    bf16x8 At[4][2], B0[2][2], B1[2][2];
    typename Epi::Pre pre;
    const char* cA = (const char*)g.A + (size_t)cur.pm * tstep; const char* cB = (const char*)g.Bt + (size_t)cur.pn * bstep;
    S.a_ready(cur);
    if constexpr (SP2 && HALFN) {
        PG8_STAGE(PG8_SB(0, 0), cB, voffB); PG8_STAGE(PG8_SA(0, 0), cA, voffA); PG8_STAGE(PG8_SA(0, 1), cA + hstep, voffA);
        if (wr == 1) PG8_BAR;
        PG8_WAIT_V(2); PG8_BAR;
        PG8_STAGE(PG8_SB(1, 0), cB + kstep, voffB); PG8_STAGE(PG8_SA(1, 0), cA + kstep, voffA);
        PG8_WAIT_V(4); PG8_BAR;
    } else if constexpr (SP2) {
        PG8_STAGE(PG8_SB(0, 0), cB, voffB); PG8_STAGE(PG8_SB(0, 1), cB + hstep, voffB); PG8_STAGE(PG8_SA(0, 0), cA, voffA); PG8_STAGE(PG8_SA(0, 1), cA + hstep, voffA);
        if (wr == 1) PG8_BAR;
        PG8_WAIT_V(2); PG8_BAR;
        PG8_STAGE(PG8_SB(1, 0), cB + kstep, voffB); PG8_STAGE(PG8_SA(1, 0), cA + kstep, voffA); PG8_STAGE(PG8_SB(1, 1), cB + hstep + kstep, voffB);
        PG8_WAIT_V(6); PG8_BAR;
    } else {
        PG8_STAGE(PG8_SB(0, 0), cB, voffB); PG8_STAGE(PG8_SA(0, 0), cA, voffA); PG8_STAGE(PG8_SB(0, 1), cB + hstep, voffB); PG8_STAGE(PG8_SA(0, 1), cA + hstep, voffA);
        if (wr == 1) PG8_BAR;
        PG8_WAIT_V(4); PG8_BAR;
        PG8_STAGE(PG8_SB(1, 0), cB + kstep, voffB); PG8_STAGE(PG8_SA(1, 0), cA + kstep, voffA); PG8_STAGE(PG8_SB(1, 1), cB + hstep + kstep, voffB);
        PG8_WAIT_V(6); PG8_BAR;
    }
    for (;;) {
        const bool has_next = S.next(ui + 1, nxt);
        const char* nA = has_next ? (const char*)g.A + (size_t)nxt.pm * tstep : cA; const char* nB = has_next ? (const char*)g.Bt + (size_t)nxt.pn * bstep : cB;
        for (int t = 0; t < nt; t += 2) {
            const bool last = (t == nt - 2);
            const char* a1 = cA + (size_t)(t + 1) * kstep;
            const char* a2 = last ? nA : cA + (size_t)(t + 2) * kstep; const char* b2 = last ? nB : cB + (size_t)(t + 2) * kstep;
            const char* a3 = a2 + kstep; const char* b3 = b2 + kstep;
            if (last && has_next) S.a_ready(nxt);
            if (last) E.prefetch(pre, cur, wr, fr);
            if constexpr (SP2 && HALFN) {
            PG8_LDB(B0, 0, 0); PG8_SCHED; PG8_LDA(At, 0, 0); PG8_STAGE(PG8_SA(1, 1), a1 + hstep, voffA);
            PG8_WAIT_V(6); PG8_WAIT_L(0); PG8_BAR; PG8_MMA(0, 0, At, B0); PG8_BAR; PG8_SCHED;
            PG8_LDA(At, 0, 1); PG8_STAGE(PG8_SB(0, 0), b2, voffB); PG8_STAGE(PG8_SA(0, 0), a2, voffA);
            PG8_WAIT_V(6); PG8_WAIT_L(0); PG8_BAR; PG8_MMA(1, 0, At, B0); PG8_BAR; PG8_SCHED;
            PG8_LDB(B0, 1, 0); PG8_SCHED; PG8_LDA(At, 1, 0); PG8_STAGE(PG8_SA(0, 1), a2 + hstep, voffA);
            PG8_WAIT_V(6); PG8_WAIT_L(0); PG8_BAR; PG8_MMA(0, 0, At, B0); PG8_BAR; PG8_SCHED;
            PG8_LDA(At, 1, 1); PG8_STAGE(PG8_SB(1, 0), b3, voffB); PG8_STAGE(PG8_SA(1, 0), a3, voffA);
            PG8_WAIT_V(6); PG8_WAIT_L(0); PG8_BAR; PG8_MMA(1, 0, At, B0); PG8_BAR; PG8_SCHED;
            } else if constexpr (SP2) {
            PG8_LDB(B0, 0, 0); PG8_LDB(B1, 0, 1); PG8_SCHED; PG8_LDA(At, 0, 0); PG8_STAGE(PG8_SA(1, 1), a1 + hstep, voffA);
            PG8_WAIT_V(8); PG8_WAIT_L(0); PG8_BAR; PG8_MMA(0, 0, At, B0); PG8_MMA(0, 1, At, B1); PG8_BAR; PG8_SCHED;
            PG8_LDA(At, 0, 1); PG8_STAGE(PG8_SB(0, 0), b2, voffB); PG8_STAGE(PG8_SB(0, 1), b2 + hstep, voffB); PG8_STAGE(PG8_SA(0, 0), a2, voffA);
            PG8_WAIT_V(8); PG8_WAIT_L(0); PG8_BAR; PG8_MMA(1, 0, At, B0); PG8_MMA(1, 1, At, B1); PG8_BAR; PG8_SCHED;
            PG8_LDB(B0, 1, 0); PG8_LDB(B1, 1, 1); PG8_SCHED; PG8_LDA(At, 1, 0); PG8_STAGE(PG8_SA(0, 1), a2 + hstep, voffA);
            PG8_WAIT_V(8); PG8_WAIT_L(0); PG8_BAR; PG8_MMA(0, 0, At, B0); PG8_MMA(0, 1, At, B1); PG8_BAR; PG8_SCHED;
            PG8_LDA(At, 1, 1); PG8_STAGE(PG8_SB(1, 0), b3, voffB); PG8_STAGE(PG8_SB(1, 1), b3 + hstep, voffB); PG8_STAGE(PG8_SA(1, 0), a3, voffA);
            PG8_WAIT_V(8); PG8_WAIT_L(0); PG8_BAR; PG8_MMA(1, 0, At, B0); PG8_MMA(1, 1, At, B1); PG8_BAR; PG8_SCHED;
            } else {
            PG8_LDB(B0, 0, 0); PG8_SCHED; PG8_LDA(At, 0, 0); PG8_STAGE(PG8_SA(1, 1), a1 + hstep, voffA);
            PG8_WAIT_L(8); PG8_BAR; PG8_WAIT_L(0); PG8_MMA(0, 0, At, B0); PG8_BAR; PG8_SCHED;
            PG8_LDB(B1, 0, 1); PG8_STAGE(PG8_SB(0, 0), b2, voffB);
            PG8_BAR; PG8_WAIT_L(0); PG8_MMA(0, 1, At, B1); PG8_BAR;
            PG8_LDA(At, 0, 1); PG8_STAGE(PG8_SA(0, 0), a2, voffA);
            PG8_BAR; PG8_WAIT_L(0); PG8_MMA(1, 0, At, B0); PG8_BAR; PG8_SCHED;
            PG8_STAGE(PG8_SB(0, 1), b2 + hstep, voffB);
            PG8_WAIT_V(6); PG8_BAR; PG8_MMA(1, 1, At, B1); PG8_BAR;
            PG8_LDB(B0, 1, 0); PG8_SCHED; PG8_LDA(At, 1, 0); PG8_STAGE(PG8_SA(0, 1), a2 + hstep, voffA);
            PG8_WAIT_L(8); PG8_BAR; PG8_WAIT_L(0); PG8_MMA(0, 0, At, B0); PG8_BAR; PG8_SCHED;
            PG8_LDB(B1, 1, 1); PG8_STAGE(PG8_SB(1, 0), b3, voffB);
            PG8_BAR; PG8_WAIT_L(0); PG8_MMA(0, 1, At, B1); PG8_BAR;
            PG8_LDA(At, 1, 1); PG8_STAGE(PG8_SA(1, 0), a3, voffA);
            PG8_BAR; PG8_WAIT_L(0); PG8_MMA(1, 0, At, B0); PG8_BAR; PG8_SCHED;
            PG8_STAGE(PG8_SB(1, 1), b3 + hstep, voffB);
            PG8_WAIT_V(6); PG8_BAR; PG8_MMA(1, 1, At, B1); PG8_BAR;
            }
        }
        if constexpr (ALIGN_EPI) { if (wr == 0) PG8_BAR; }
        if constexpr (!Epi::AFTER_DRAIN) { E(acc, cur, wr, wc, fr, fq, pre); S.done(cur); }
        if (!has_next) break;
#pragma unroll
        for (int a = 0; a < 2; ++a)
#pragma unroll
            for (int b = 0; b < 2; ++b)
#pragma unroll
                for (int m = 0; m < 4; ++m)
#pragma unroll
                    for (int n = 0; n < 2; ++n) acc[a][b][m][n] = (f32x4){0.f, 0.f, 0.f, 0.f};
        cur = nxt; cA = nA; cB = nB; ++ui;
        if constexpr (ALIGN_EPI) { if (wr == 1) PG8_BAR; }
    }
    PG8_WAIT_V(0);
    if constexpr (!ALIGN_EPI) { if (wr == 0) PG8_BAR; }
    PG8_BAR;
#undef PG8_SA
#undef PG8_SB
#undef PG8_STAGE
#undef PG8_LDA
#undef PG8_LDB
#undef PG8_MMA
#undef PG8_WAIT_V
#undef PG8_WAIT_L
#undef PG8_BAR
#undef PG8_SCHED
}
}

namespace att {
constexpr int D = 128, NW = 8, QBLK = 32, KVBLK = 64;
constexpr float SCALE = 0.088388347648318440f, LOG2E = 1.4426950408889634f, LN2 = 0.6931471805599453f;
constexpr float C = SCALE * LOG2E;
constexpr float THR2 = 8.f * LOG2E;
constexpr int SHM_V = KVBLK * D * 2, SHM_K = KVBLK * D * 2;
constexpr int OFF_V = 0, OFF_K = 2 * SHM_V, BUF3 = SHM_V + SHM_K  , OFF_WS = 3 * BUF3, OFF_TAB = OFF_WS + NW * 64 * 4, TAB_FLOATS = 1024, OFF_UID = OFF_TAB + TAB_FLOATS * 4, LDS_BYTES = OFF_UID + 64;
#define KSWZ(row, colB) ((row) * 256 + ((colB) ^ (((row) & 7) << 4)))
#define SBAR() __builtin_amdgcn_sched_barrier(0)
__device__ __forceinline__ int crow(int r, int hi) { return (r & 3) + 8 * (r >> 2) + 4 * hi; }
__device__ __forceinline__ void qkt(f32x16& p0, f32x16& p1, const char* Ks, const bf16x8* qr, int r32, int hi) {
  p0 = f32x16{}; p1 = f32x16{};
#pragma unroll
  for (int d0 = 0; d0 < 8; ++d0) { const int cb = (d0 * 16 + hi * 8) * 2;
    const bf16x8 b0 = *reinterpret_cast<const bf16x8*>(Ks + KSWZ(r32, cb));
    const bf16x8 b1 = *reinterpret_cast<const bf16x8*>(Ks + KSWZ(32 + r32, cb));
    p0 = __builtin_amdgcn_mfma_f32_32x32x16_bf16(b0, qr[d0], p0, 0, 0, 0);
    p1 = __builtin_amdgcn_mfma_f32_32x32x16_bf16(b1, qr[d0], p1, 0, 0, 0); }
}
__device__ __forceinline__ int v_st(int k, int c) { const int kk = (k & ~0xC) | ((k & 4) << 1) | ((k & 8) >> 1); return ((kk >> 3) * 4 + (c >> 5)) * 512 + ((kk & 7) * 32 + (c & 31)) * 2; }
__device__ __forceinline__ int v_rd_base(int lane) { return ((lane & 3) << 3) | (((lane >> 2) & 3) << 6) | (((lane >> 4) & 1) << 5) | (((lane >> 5) & 1) << 8); }
constexpr int v_rd_off(int d0, int ks, int half) { return d0 * 512 + ks * 4096 + half * 2048; }
template <int OFF> __device__ __forceinline__ s16x4 tr_read(int vb) {
  s16x4 r; asm volatile("ds_read_b64_tr_b16 %0, %1 offset:%2" : "=&v"(r) : "v"(vb), "i"(OFF) : "memory"); return r;
}
template <int D0> __device__ __forceinline__ void pv_one(f32x16& od, int vb, bf16x8 pa0, bf16x8 pa1, bf16x8 pa2, bf16x8 pa3) {
  const s16x4 l0 = tr_read<v_rd_off(D0, 0, 0)>(vb), h0 = tr_read<v_rd_off(D0, 0, 1)>(vb), l1 = tr_read<v_rd_off(D0, 1, 0)>(vb), h1 = tr_read<v_rd_off(D0, 1, 1)>(vb);
  const s16x4 l2 = tr_read<v_rd_off(D0, 2, 0)>(vb), h2 = tr_read<v_rd_off(D0, 2, 1)>(vb), l3 = tr_read<v_rd_off(D0, 3, 0)>(vb), h3 = tr_read<v_rd_off(D0, 3, 1)>(vb);
  asm volatile("s_waitcnt lgkmcnt(0)" ::: "memory"); SBAR();
#define PK(L, H) (bf16x8){L[0], L[1], L[2], L[3], H[0], H[1], H[2], H[3]}
  od = __builtin_amdgcn_mfma_f32_32x32x16_bf16(pa0, PK(l0, h0), od, 0, 0, 0);
  od = __builtin_amdgcn_mfma_f32_32x32x16_bf16(pa1, PK(l1, h1), od, 0, 0, 0);
  od = __builtin_amdgcn_mfma_f32_32x32x16_bf16(pa2, PK(l2, h2), od, 0, 0, 0);
  od = __builtin_amdgcn_mfma_f32_32x32x16_bf16(pa3, PK(l3, h3), od, 0, 0, 0);
#undef PK
}
__device__ __forceinline__ void pv_d0(f32x16* o, int vb, bf16x8 pa0, bf16x8 pa1, bf16x8 pa2, bf16x8 pa3) {
  pv_one<0>(o[0], vb, pa0, pa1, pa2, pa3); pv_one<1>(o[1], vb, pa0, pa1, pa2, pa3); pv_one<2>(o[2], vb, pa0, pa1, pa2, pa3); pv_one<3>(o[3], vb, pa0, pa1, pa2, pa3);
}

template <bool TAB>
__device__ __forceinline__ void attn_unit(const bf16_t* __restrict__ Qb, long ldq, const bf16_t* __restrict__ Kh, const bf16_t* __restrict__ Vh, long ldk,
                                          bf16_t* __restrict__ Ob, long ldo, int t_lo, int t_hi, int qpos0, int W, const float* __restrict__ tabg, int tablen,
                                          float m_init0, float m_init1, float l_init, float* __restrict__ lse, long ldlse, char* lds) {
  const int tid = opaque_tid(), lane = tid & 63, r32 = lane & 31, hi = lane >> 5; const int wid = __builtin_amdgcn_readfirstlane(tid >> 6);
  const int hw = wid >> 2, wq = wid & 3;
  char* V_lds = lds + OFF_V; char* K_lds = lds + OFF_K;
  float* ws = (float*)(lds + OFF_WS) + wid * 64; float* li_l = ws; float* al_l = ws + 32;
  float* tab = (float*)(lds + OFF_TAB);
  bf16x8 qr[8];
  { const bf16_t* Qw = Qb + hw * D + (long)(wq * QBLK + r32) * ldq + hi * 8;
#pragma unroll
    for (int d0 = 0; d0 < 8; ++d0) qr[d0] = *reinterpret_cast<const bf16x8*>(Qw + d0 * 16); }
  if (TAB) { for (int i = tid; i < 2 * 512; i += NW * 64) tab[i] = ((i & 511) < tablen) ? tabg[i] : 0.f; }
  const int sr = tid >> 4, sc = (tid & 15) * 8, vst0 = v_st(sr, sc), vst1 = v_st(32 + sr, sc);
  const int vb0 = (int)(uintptr_t)V_lds + v_rd_base(lane);
  bf16x8 vs0, vs1, ks0, ks1;
#define SLOAD(k0) do { vs0 = *reinterpret_cast<const bf16x8*>(&Vh[(long)((k0) + sr) * ldk + sc]); vs1 = *reinterpret_cast<const bf16x8*>(&Vh[(long)((k0) + 32 + sr) * ldk + sc]); \
    ks0 = *reinterpret_cast<const bf16x8*>(&Kh[(long)((k0) + sr) * ldk + sc]); ks1 = *reinterpret_cast<const bf16x8*>(&Kh[(long)((k0) + 32 + sr) * ldk + sc]); } while (0)
#define SWRITE(b) do { *(bf16x8*)(V_lds + (b) * SHM_V + vst0) = vs0; *(bf16x8*)(V_lds + (b) * SHM_V + vst1) = vs1; const int kc = sc * 2; \
    *(bf16x8*)(K_lds + (b) * SHM_K + KSWZ(sr, kc)) = ks0; *(bf16x8*)(K_lds + (b) * SHM_K + KSWZ(32 + sr, kc)) = ks1; } while (0)
  float m_reg = hw ? m_init1 : m_init0, l_reg = l_init; f32x16 o[4] = {};
  const int qw0 = qpos0 + wq * QBLK;
  SLOAD(t_lo * KVBLK); SWRITE(0); __syncthreads();
  for (int t = t_lo; t < t_hi; ++t) {
    const int b = (t - t_lo) & 1; const bool more = (t + 1 < t_hi);
    if (more) SLOAD((t + 1) * KVBLK);
    const bool active = !TAB || (KVBLK * t + KVBLK - 1 >= qw0 - W && KVBLK * t <= qw0 + QBLK - 1 + W);
    if (active) {
      f32x16 p0, p1; qkt(p0, p1, K_lds + b * SHM_K, qr, r32, hi);
      if (TAB) { const float* tl = tab + hw * 512 + (KVBLK * t - qw0 - r32 + 4 * hi + W + 96);
#pragma unroll
        for (int r = 0; r < 16; ++r) { const int ix = (r & 3) + 8 * (r >> 2); p0[r] = fmaf(p0[r], C, tl[ix]); p1[r] = fmaf(p1[r], C, tl[ix + 32]); } }
      else {
#pragma unroll
        for (int r = 0; r < 16; ++r) { p0[r] *= C; p1[r] *= C; } }
      float pmax = p0[0];
#pragma unroll
      for (int r = 1; r < 16; ++r) pmax = fmaxf(pmax, p0[r]);
#pragma unroll
      for (int r = 0; r < 16; ++r) pmax = fmaxf(pmax, p1[r]);
      { auto rr = __builtin_amdgcn_permlane32_swap(__float_as_uint(pmax), __float_as_uint(pmax), false, false);
        pmax = fmaxf(__uint_as_float(rr[0]), __uint_as_float(rr[1])); }
      if (!__all(pmax - m_reg <= THR2)) {
        const float mn = fmaxf(m_reg, pmax); const float alpha = __builtin_amdgcn_exp2f(m_reg - mn); m_reg = mn; l_reg *= alpha;
        if (hi == 0) al_l[r32] = alpha; asm volatile("s_waitcnt lgkmcnt(0)" ::: "memory");
#pragma unroll
        for (int d = 0; d < 4; ++d)
#pragma unroll
          for (int r = 0; r < 16; ++r) o[d][r] *= al_l[crow(r, hi)];
      }
#pragma unroll
      for (int r = 0; r < 16; ++r) { p0[r] = __builtin_amdgcn_exp2f(p0[r] - m_reg); p1[r] = __builtin_amdgcn_exp2f(p1[r] - m_reg); }
      float ps = 0.f;
#pragma unroll
      for (int r = 0; r < 16; ++r) ps += p0[r];
#pragma unroll
      for (int r = 0; r < 16; ++r) ps += p1[r];
      { auto rr = __builtin_amdgcn_permlane32_swap(__float_as_uint(ps), __float_as_uint(ps), false, false);
        ps = __uint_as_float(rr[0]) + __uint_as_float(rr[1]); }
      l_reg += ps;
      bf16x8 pa0, pa1, pa2, pa3;
#define PK4(P, BASE, OUT) do { unsigned a0 = cvt_pk_bf16(P[BASE + 0], P[BASE + 1]), a1 = cvt_pk_bf16(P[BASE + 2], P[BASE + 3]);   \
    unsigned b0 = cvt_pk_bf16(P[BASE + 4], P[BASE + 5]), b1 = cvt_pk_bf16(P[BASE + 6], P[BASE + 7]);                              \
    auto r0 = __builtin_amdgcn_permlane32_swap(a0, b0, false, false); auto r1 = __builtin_amdgcn_permlane32_swap(a1, b1, false, false); \
    u32x4 w = {r0[0], r1[0], r0[1], r1[1]}; OUT = *reinterpret_cast<bf16x8*>(&w); } while (0)
      PK4(p0, 0, pa0); PK4(p0, 8, pa1); PK4(p1, 0, pa2); PK4(p1, 8, pa3);
#undef PK4
      SBAR();
      pv_d0(o, vb0 + b * SHM_V, pa0, pa1, pa2, pa3);
    }
    if (more) SWRITE(b ^ 1);
    __syncthreads();
  }
  if (hi == 0) li_l[r32] = l_reg; asm volatile("s_waitcnt lgkmcnt(0)" ::: "memory");
  float rli[16];
#pragma unroll
  for (int r = 0; r < 16; ++r) rli[r] = __builtin_amdgcn_rcpf(li_l[crow(r, hi)]);
  bf16_t* stg = (bf16_t*)(lds + wid * 8192);
#pragma unroll
  for (int r = 0; r < 16; ++r) { const int orow = crow(r, hi);
#pragma unroll
    for (int d0 = 0; d0 < 4; ++d0) { const unsigned w = cvt_pk_bf16(o[d0][r] * rli[r], 0.f); stg[orow * 128 + d0 * 32 + r32] = (bf16_t)(w & 0xffffu); } }
  asm volatile("s_waitcnt lgkmcnt(0)" ::: "memory");
#pragma unroll
  for (int i = 0; i < 8; ++i) { const int row = i * 4 + (lane >> 4), ch = lane & 15; const u32x4 v = *(const u32x4*)(stg + row * 128 + ch * 8);
    *(u32x4*)(Ob + hw * D + (long)(wq * QBLK + row) * ldo + ch * 8) = v; }
  if (lse != nullptr && hi == 0) lse[hw + (long)(wq * QBLK + r32) * ldlse] = (m_reg + __builtin_amdgcn_logf(l_reg)) * LN2;
  __syncthreads();
#undef SLOAD
#undef SWRITE
}
template <bool PRE>
__device__ __forceinline__ void partialSM(f32x16& p0, f32x16& p1, float& m_reg, float& mn, float& alpha) {
  constexpr float cs = PRE ? 1.0f : C;
  float pmax = p0[0];
#pragma unroll
  for (int r = 1; r < 16; ++r) pmax = fmaxf(pmax, p0[r]);
#pragma unroll
  for (int r = 0; r < 16; ++r) pmax = fmaxf(pmax, p1[r]);
  { auto rr = __builtin_amdgcn_permlane32_swap(__float_as_uint(pmax), __float_as_uint(pmax), false, false);
    pmax = fmaxf(__uint_as_float(rr[0]), __uint_as_float(rr[1])); }
  if (__builtin_expect(__all((pmax - m_reg) * cs <= THR2), 1)) { mn = m_reg; alpha = 1.f; }
  else { mn = fmaxf(m_reg, pmax); alpha = __builtin_amdgcn_exp2f((m_reg - mn) * cs); m_reg = mn; }
  const float mnC = -mn * cs;
#pragma unroll
  for (int r = 0; r < 16; ++r) p0[r] = fmaf(p0[r], cs, mnC);
#pragma unroll
  for (int r = 0; r < 16; ++r) p1[r] = fmaf(p1[r], cs, mnC);
#pragma unroll
  for (int r = 0; r < 16; ++r) p0[r] = __builtin_amdgcn_exp2f(p0[r]);
}
__device__ __forceinline__ void partialSM_fixed(f32x16& p0) {
#pragma unroll
  for (int r = 0; r < 16; ++r) p0[r] = __builtin_amdgcn_exp2f(p0[r]);
}
__device__ __forceinline__ void finishSM(f32x16& p0, f32x16& p1, float alpha, float& l_reg, bf16x8& pa0, bf16x8& pa1, bf16x8& pa2, bf16x8& pa3) {
#pragma unroll
  for (int r = 0; r < 16; ++r) p1[r] = __builtin_amdgcn_exp2f(p1[r]);
  float ps = 0;
#pragma unroll
  for (int r = 0; r < 16; ++r) ps += p0[r];
#pragma unroll
  for (int r = 0; r < 16; ++r) ps += p1[r];
  { auto rr = __builtin_amdgcn_permlane32_swap(__float_as_uint(ps), __float_as_uint(ps), false, false);
    ps = __uint_as_float(rr[0]) + __uint_as_float(rr[1]); }
  l_reg = l_reg * alpha + ps;
#define PK4(P, BASE, OUT) do { unsigned a0 = cvt_pk_bf16(P[BASE + 0], P[BASE + 1]), a1 = cvt_pk_bf16(P[BASE + 2], P[BASE + 3]);   \
    unsigned b0 = cvt_pk_bf16(P[BASE + 4], P[BASE + 5]), b1 = cvt_pk_bf16(P[BASE + 6], P[BASE + 7]);                              \
    auto r0 = __builtin_amdgcn_permlane32_swap(a0, b0, false, false); auto r1 = __builtin_amdgcn_permlane32_swap(a1, b1, false, false); \
    u32x4 w = {r0[0], r1[0], r0[1], r1[1]}; OUT = *reinterpret_cast<bf16x8*>(&w); } while (0)
  PK4(p0, 0, pa0); PK4(p0, 8, pa1); PK4(p1, 0, pa2); PK4(p1, 8, pa3);
#undef PK4
}
template <bool PRE>
__device__ __forceinline__ void attn_unit_dense(const bf16_t* __restrict__ Qb, long ldq, const bf16_t* __restrict__ Kh, const bf16_t* __restrict__ Vh, long ldk,
                                                bf16_t* __restrict__ Ob, long ldo, int ntile, float mfix2, char* lds) {
  const int tid = opaque_tid(), lane = tid & 63, r32 = lane & 31, hi = lane >> 5; const int wid = __builtin_amdgcn_readfirstlane(tid >> 6);
  float* ws = (float*)(lds + OFF_WS) + wid * 64; float* li_l = ws; float* al_l = ws + 32;
  const bool fixm = PRE && mfix2 >= 0.f;
  float m_reg = -1e30f, l_reg = 0; f32x16 o[4] = {}; bf16x8 qr[8];
  { const bf16_t* Qw = Qb + (long)(wid * QBLK + r32) * ldq + hi * 8;
#pragma unroll
    for (int d0 = 0; d0 < 8; ++d0) qr[d0] = *reinterpret_cast<const bf16x8*>(Qw + d0 * 16); }
  const int sr = tid >> 4, sc = (tid & 15) * 8, vst0 = v_st(sr, sc), vst1 = v_st(32 + sr, sc);
  const int vb0 = (int)(uintptr_t)lds + v_rd_base(lane);
  bf16x8 vsE0, vsE1, ksE0, ksE1, vsO0, vsO1, ksO0, ksO1;
#define SLOAD_E(k0) do { vsE0 = *reinterpret_cast<const bf16x8*>(&Vh[(long)((k0) + sr) * ldk + sc]); vsE1 = *reinterpret_cast<const bf16x8*>(&Vh[(long)((k0) + 32 + sr) * ldk + sc]); \
    ksE0 = *reinterpret_cast<const bf16x8*>(&Kh[(long)((k0) + sr) * ldk + sc]); ksE1 = *reinterpret_cast<const bf16x8*>(&Kh[(long)((k0) + 32 + sr) * ldk + sc]); } while (0)
#define SLOAD_O(k0) do { vsO0 = *reinterpret_cast<const bf16x8*>(&Vh[(long)((k0) + sr) * ldk + sc]); vsO1 = *reinterpret_cast<const bf16x8*>(&Vh[(long)((k0) + 32 + sr) * ldk + sc]); \
    ksO0 = *reinterpret_cast<const bf16x8*>(&Kh[(long)((k0) + sr) * ldk + sc]); ksO1 = *reinterpret_cast<const bf16x8*>(&Kh[(long)((k0) + 32 + sr) * ldk + sc]); } while (0)
#define SWRITE_E(bo) do { char* B_ = lds + (bo); *(bf16x8*)(B_ + vst0) = vsE0; *(bf16x8*)(B_ + vst1) = vsE1; const int kc = sc * 2; \
    *(bf16x8*)(B_ + SHM_V + KSWZ(sr, kc)) = ksE0; *(bf16x8*)(B_ + SHM_V + KSWZ(32 + sr, kc)) = ksE1; } while (0)
#define SWRITE_O(bo) do { char* B_ = lds + (bo); *(bf16x8*)(B_ + vst0) = vsO0; *(bf16x8*)(B_ + vst1) = vsO1; const int kc = sc * 2; \
    *(bf16x8*)(B_ + SHM_V + KSWZ(sr, kc)) = ksO0; *(bf16x8*)(B_ + SHM_V + KSWZ(32 + sr, kc)) = ksO1; } while (0)
#define SWAIT() asm volatile("s_waitcnt vmcnt(4)" ::: "memory")
#define PSM(P0, P1, MN, AL) do { if (fixm) { partialSM_fixed(P0); AL = 1.f; MN = 0.f; } else partialSM<PRE>(P0, P1, m_reg, MN, AL); } while (0)
#define RESC(a) do { if (!fixm) if (__any((a) < 1.f)) { if (hi == 0) al_l[r32] = (a); asm volatile("s_waitcnt lgkmcnt(0)" ::: "memory"); \
    _Pragma("unroll") for (int d = 0; d < 4; ++d) _Pragma("unroll") for (int r = 0; r < 16; ++r) o[d][r] *= al_l[crow(r, hi)]; } } while (0)
#define ROT3() do { const int t_ = bV; bV = bK; bK = bW; bW = t_; } while (0)
  f32x16 pA0, pA1, pB0, pB1; float mnA, mnB, alA, alB; bf16x8 pa0, pa1, pa2, pa3; const int NT = ntile;
  int bV = 0, bK = 0, bW = BUF3;
  SLOAD_E(0); SLOAD_O(KVBLK); asm volatile("s_waitcnt vmcnt(4)" ::: "memory"); SWRITE_E(0); SLOAD_E(2 * KVBLK);
  __syncthreads();
  SWAIT(); SWRITE_O(bW);
  qkt(pA0, pA1, lds + bK + SHM_V, qr, r32, hi); PSM(pA0, pA1, mnA, alA);
  if (3 < NT) SLOAD_O(3 * KVBLK);
  bV = 0; bK = BUF3; bW = 2 * BUF3;
  for (int j = 1; j + 1 < NT; j += 2) {
    __syncthreads(); SWAIT(); SWRITE_E(bW);
    SBAR(); qkt(pB0, pB1, lds + bK + SHM_V, qr, r32, hi);
    finishSM(pA0, pA1, alA, l_reg, pa0, pa1, pa2, pa3); SBAR();
    if (j + 3 < NT) SLOAD_E((j + 3) * KVBLK); SBAR();
    pv_d0(o, vb0 + bV, pa0, pa1, pa2, pa3); PSM(pB0, pB1, mnB, alB);
    RESC(alB); ROT3();
    __syncthreads(); SWAIT(); SWRITE_O(bW);
    SBAR(); qkt(pA0, pA1, lds + bK + SHM_V, qr, r32, hi);
    finishSM(pB0, pB1, alB, l_reg, pa0, pa1, pa2, pa3); SBAR();
    if (j + 4 < NT) SLOAD_O((j + 4) * KVBLK); SBAR();
    pv_d0(o, vb0 + bV, pa0, pa1, pa2, pa3); PSM(pA0, pA1, mnA, alA);
    RESC(alA); ROT3();
  }
  __syncthreads();
  SBAR(); qkt(pB0, pB1, lds + bK + SHM_V, qr, r32, hi);
  finishSM(pA0, pA1, alA, l_reg, pa0, pa1, pa2, pa3); SBAR();
  pv_d0(o, vb0 + bV, pa0, pa1, pa2, pa3); PSM(pB0, pB1, mnB, alB);
  RESC(alB); ROT3();
  finishSM(pB0, pB1, alB, l_reg, pa0, pa1, pa2, pa3); SBAR();
  pv_d0(o, vb0 + bV, pa0, pa1, pa2, pa3);
#undef ROT3
  if (hi == 0) li_l[r32] = l_reg; asm volatile("s_waitcnt lgkmcnt(0)" ::: "memory");
  float rli[16];
#pragma unroll
  for (int r = 0; r < 16; ++r) rli[r] = __builtin_amdgcn_rcpf(li_l[crow(r, hi)]);
  __syncthreads();
  bf16_t* stg = (bf16_t*)(lds + wid * 8192);
#pragma unroll
  for (int r = 0; r < 16; ++r) { const int orow = crow(r, hi);
#pragma unroll
    for (int d0 = 0; d0 < 4; ++d0) { const unsigned w = cvt_pk_bf16(o[d0][r] * rli[r], 0.f); stg[orow * 128 + d0 * 32 + r32] = (bf16_t)(w & 0xffffu); } }
  asm volatile("s_waitcnt lgkmcnt(0)" ::: "memory");
#pragma unroll
  for (int i = 0; i < 8; ++i) { const int row = i * 4 + (lane >> 4), ch = lane & 15; const u32x4 v = *(const u32x4*)(stg + row * 128 + ch * 8);
    *(u32x4*)(Ob + (long)(wid * QBLK + row) * ldo + ch * 8) = v; }
  __syncthreads();
#undef PSM
#undef SLOAD_E
#undef SLOAD_O
#undef SWRITE_E
#undef SWRITE_O
#undef SWAIT
#undef RESC
}
#undef SBAR
}

#define XB_TMO      128
#define XB_XCNT(j)  (256  + 64 * (j))
#define XB_XSUB(j)  (1280 + 64 * (j))
#define XB_XGEN(j)  (2304 + 64 * (j))
#define XB_TOP      3328
#define XB_TOPGEN   3392
#define XCD_BAR_WORDS 3456
#define XB_SPIN_CAP (1u << 18)
__device__ __forceinline__ unsigned xb_ld(unsigned* p)              { return __hip_atomic_load(p, __ATOMIC_RELAXED, __HIP_MEMORY_SCOPE_AGENT); }
__device__ __forceinline__ unsigned xb_add(unsigned* p, unsigned v) { return __hip_atomic_fetch_add(p, v, __ATOMIC_RELAXED, __HIP_MEMORY_SCOPE_AGENT); }
__device__ __forceinline__ unsigned xb_xcc_id() { return (unsigned)__builtin_amdgcn_s_getreg((3 << 11) | 20) & 0xFu; }
#define XB_SPIN(cond, bar) do { unsigned _sp = 0; while (cond) { __builtin_amdgcn_s_sleep(1); \
    if ((++_sp & 255u) == 0u) { if (xb_ld(&(bar)[XB_TMO])) break; if (_sp > XB_SPIN_CAP) { atomicAdd(&(bar)[XB_TMO], 1u); break; } } } } while (0)
struct XcdBarrier { unsigned* bar; unsigned x; volatile LAS unsigned* st; };
__device__ __forceinline__ XcdBarrier xcd_barrier_post(unsigned* bar, volatile LAS unsigned* st) {
    XcdBarrier b; b.bar = bar; b.x = xb_xcc_id(); b.st = st;
    if (threadIdx.x == 0) (void)xb_add(&bar[XB_XCNT(b.x)], 1u);
    return b;
}
__device__ __forceinline__ void xcd_barrier_complete(unsigned* bar, unsigned x, unsigned& nloc, unsigned& nx) {
    const unsigned G = gridDim.x * gridDim.y * gridDim.z;
    unsigned sum, cnt, mine, sp = 0u;
    for (;;) {
        sum = 0u; cnt = 0u; mine = 0u;
#pragma unroll
        for (unsigned j = 0; j < 16; ++j) { const unsigned c = xb_ld(&bar[XB_XCNT(j)]); sum += c; cnt += (c > 0u) ? 1u : 0u; mine = (j == x) ? c : mine; }
        if (sum == G) break;
        __builtin_amdgcn_s_sleep(1);
        if ((++sp & 255u) == 0u) { if (xb_ld(&bar[XB_TMO])) break; if (sp > XB_SPIN_CAP) { atomicAdd(&bar[XB_TMO], 1u); break; } }
    }
    nloc = mine > 0u ? mine : 1u; nx = cnt > 0u ? cnt : 1u;
}
__device__ __forceinline__ void xcd_barrier(const XcdBarrier& b) {
    asm volatile("s_waitcnt vmcnt(0)" ::: "memory");
    __syncthreads();
    if (threadIdx.x == 0) {
        unsigned* bar = b.bar;
        __builtin_amdgcn_s_waitcnt(0);
        unsigned nloc = b.st[0], nx = b.st[1];
        if (nloc == 0u) { xcd_barrier_complete(bar, b.x, nloc, nx); b.st[0] = nloc; b.st[1] = nx; }
        const unsigned old = xb_add(&bar[XB_XSUB(b.x)], 1u);
        const unsigned gen = old / nloc;
        if (old + 1u == (gen + 1u) * nloc) {
            __builtin_amdgcn_fence(__ATOMIC_RELEASE, "agent");
            asm volatile("s_waitcnt vmcnt(0)" ::: "memory");
            const unsigned og = xb_add(&bar[XB_TOP], 1u);
            const unsigned tg = og / nx;
            if (og + 1u == (tg + 1u) * nx) xb_add(&bar[XB_TOPGEN], 1u);
            else XB_SPIN(xb_ld(&bar[XB_TOPGEN]) == tg, bar);
            __builtin_amdgcn_fence(__ATOMIC_ACQUIRE, "agent");
            xb_add(&bar[XB_XGEN(b.x)], 1u);
            asm volatile("s_waitcnt vmcnt(0)" ::: "memory");
        } else {
            XB_SPIN(xb_ld(&bar[XB_XGEN(b.x)]) == gen, bar);
            __builtin_amdgcn_fence(__ATOMIC_ACQUIRE, "agent");
            asm volatile("s_waitcnt vmcnt(0)" ::: "memory");
        }
    }
    __syncthreads();
}

constexpr int NWAVES = 8;
constexpr int RING_BYTES = 131072, LDSCTL_OFF = RING_BYTES, MISC_OFF = LDSCTL_OFF + 320, LDS_BYTES = 147456;
static_assert(att::LDS_BYTES <= RING_BYTES, "attention scratch inside the ring region");

struct Args {
    const float* in[20]; float* out; unsigned char* ws; int ph_lo, ph_hi;
};

__device__ __forceinline__ float wave_sum(float v) {
#pragma unroll
    for (int o = 1; o < 64; o <<= 1) v += __shfl_xor(v, o);
    return v;
}
__device__ __forceinline__ unsigned f2bf(float f) { unsigned u = __builtin_bit_cast(unsigned, f); return (u + 0x7fffu + ((u >> 16) & 1u)) >> 16; }
__device__ __forceinline__ unsigned pk2(float lo, float hi) { return f2bf(lo) | (f2bf(hi) << 16); }

__device__ __forceinline__ void transpose_item(const float* W, const float* gain, int K, int N, bf16_t* WT, int k0, int n0, int drow0, LAS float* scr, int lane) {
    const int kr = lane >> 3, nq = lane & 7;
    f32x4 v[8]; float gk[8];
#pragma unroll
    for (int i = 0; i < 8; ++i) { v[i] = *(const GAS f32x4*)(W + (size_t)(k0 + kr + 8 * i) * N + n0 + 4 * nq); gk[i] = gain ? gain[k0 + kr + 8 * i] : 1.0f; }
#pragma unroll
    for (int i = 0; i < 8; ++i) { LAS float* d = scr + (kr + 8 * i) * 33 + 4 * nq; d[0] = v[i].x * gk[i]; d[1] = v[i].y * gk[i]; d[2] = v[i].z * gk[i]; d[3] = v[i].w * gk[i]; }
    asm volatile("s_waitcnt lgkmcnt(0)" ::: "memory");
    const int c = lane & 7;
#pragma unroll
    for (int j = 0; j < 4; ++j) { const int n = (lane >> 3) + 8 * j; const LAS float* s = scr + (8 * c) * 33 + n;
        u32x4 o; o.x = pk2(s[0 * 33], s[1 * 33]); o.y = pk2(s[2 * 33], s[3 * 33]); o.z = pk2(s[4 * 33], s[5 * 33]); o.w = pk2(s[6 * 33], s[7 * 33]);
        *(GAS u32x4*)(WT + (size_t)(drow0 + n) * K + k0 + 8 * c) = o; }
    asm volatile("s_waitcnt lgkmcnt(0)" ::: "memory");
}

__device__ __forceinline__ int t5_bucket(int rel) {
    const int n = rel < 0 ? -rel : rel; int b;
    if (n < 8) b = n; else { b = 8 + (n >= 15) + (n >= 27) + (n >= 50) + (n >= 91) + (n >= 166) + (n >= 305) + (n >= 559); if (b > 15) b = 15; }
    return b + (rel > 0 ? 16 : 0);
}
__device__ __forceinline__ void sincos_d(double a, double& s, double& c) {
    const double k = __builtin_rint(a * 0.63661977236758134308);
    const double r = (a - k * 1.57079632679489655800) - k * 6.12323399573676603587e-17;
    const double r2 = r * r;
    double ps = 1.0 / 6227020800.0;
    ps = ps * r2 - 1.0 / 39916800.0; ps = ps * r2 + 1.0 / 362880.0; ps = ps * r2 - 1.0 / 5040.0; ps = ps * r2 + 1.0 / 120.0; ps = ps * r2 - 1.0 / 6.0; ps = ps * r2 + 1.0;
    const double sr = r * ps;
    double pc = -1.0 / 87178291200.0;
    pc = pc * r2 + 1.0 / 479001600.0; pc = pc * r2 - 1.0 / 3628800.0; pc = pc * r2 + 1.0 / 40320.0; pc = pc * r2 - 1.0 / 720.0; pc = pc * r2 + 1.0 / 24.0; pc = pc * r2 - 0.5; pc = pc * r2 + 1.0;
    const int q = ((int)k) & 3;
    s = (q == 0) ? sr : (q == 1) ? pc : (q == 2) ? -sr : -pc;
    c = (q == 0) ? pc : (q == 1) ? -sr : (q == 2) ? -pc : sr;
}

__device__ __forceinline__ float row_to_bf16(const float* xrow, bf16_t* orow, int lane) {
    const GAS f32x4* xr = (const GAS f32x4*)xrow + lane;
    f32x4 v[8]; float s = 0.f;
#pragma unroll
    for (int j = 0; j < 8; ++j) { v[j] = xr[64 * j]; s += (v[j].x * v[j].x + v[j].y * v[j].y) + (v[j].z * v[j].z + v[j].w * v[j].w); }
    GAS u32x2* o8 = (GAS u32x2*)orow + lane;
#pragma unroll
    for (int j = 0; j < 8; ++j) { u32x2 w; w.x = cvt_pk_bf16(v[j].x, v[j].y); w.y = cvt_pk_bf16(v[j].z, v[j].w); o8[64 * j] = w; }
    return wave_sum(s);
}
__device__ __forceinline__ void rms_row_out(const bf16_t* xrow, float* orow, const float* g, float rstd, int lane) {
    const GAS u32x2* xr = (const GAS u32x2*)xrow + lane; GAS f32x4* o = (GAS f32x4*)orow + lane; const GAS f32x4* gr = (const GAS f32x4*)g + lane;
#pragma unroll
    for (int j = 0; j < 8; ++j) { const u32x2 w = xr[64 * j]; const f32x4 gg = gr[64 * j]; f32x4 v = {bflo(w.x), bfhi(w.x), bflo(w.y), bfhi(w.y)}; o[64 * j] = v * rstd * gg; }
}

__device__ __forceinline__ void qknorm_rows(bf16_t* qkv, const float* ropec, const float* ropes, const float* qg, const float* kg, int row_base, int tid) {
    const int lane = tid & 63, wave = tid >> 6;
    const int head = lane >> 3, q8 = lane & 7, hf = q8 >> 2, a = q8 & 3;
    const float* gp = (head < 6) ? qg : kg;
    const float osc = (head < 6) ? 0.088388347648318440f * 1.4426950408889634f : 1.0f;
    float g1[8], g2[8];
#pragma unroll
    for (int e = 0; e < 8; ++e) { g1[e] = gp[hf * 64 + 8 * a + e]; g2[e] = gp[hf * 64 + 32 + 8 * a + e]; }
    for (int t0 = 0; t0 < 32; t0 += 4) {
        u32x4 w1[4], w2[4]; f32x4 cs[4][4];
#pragma unroll
        for (int i = 0; i < 4; ++i) { const int m = row_base + wave + 8 * (t0 + i);
            const int s = (m < NPROMPT) ? (m & (SEQ_P - 1)) : ((m - NPROMPT) & (SEQ_S - 1)); const int n = hf ? (s & 63) : (s >> 6);
            const bf16_t* p1 = qkv + (size_t)m * PROJ + head * HD + hf * 64 + 8 * a;
            w1[i] = *(const GAS u32x4*)p1; w2[i] = *(const GAS u32x4*)(p1 + 32);
            cs[i][0] = *(const GAS f32x4*)(ropec + n * 32 + 8 * a); cs[i][1] = *(const GAS f32x4*)(ropec + n * 32 + 8 * a + 4);
            cs[i][2] = *(const GAS f32x4*)(ropes + n * 32 + 8 * a); cs[i][3] = *(const GAS f32x4*)(ropes + n * 32 + 8 * a + 4); }
#pragma unroll
        for (int i = 0; i < 4; ++i) { const int m = row_base + wave + 8 * (t0 + i);
            bf16_t* p1 = qkv + (size_t)m * PROJ + head * HD + hf * 64 + 8 * a;
            float x1[8], x2[8];
#pragma unroll
            for (int e = 0; e < 4; ++e) { x1[2 * e] = bflo(w1[i][e]); x1[2 * e + 1] = bfhi(w1[i][e]); x2[2 * e] = bflo(w2[i][e]); x2[2 * e + 1] = bfhi(w2[i][e]); }
            float ss = 0.f;
#pragma unroll
            for (int e = 0; e < 8; ++e) ss += x1[e] * x1[e] + x2[e] * x2[e];
            ss += __shfl_xor(ss, 1); ss += __shfl_xor(ss, 2); ss += __shfl_xor(ss, 4);
            const float rstd = 1.0f / sqrtf(ss * (1.f / HD) + RMS_EPS);
            float o1[8], o2[8];
#pragma unroll
            for (int e = 0; e < 8; ++e) { const float cc = e < 4 ? cs[i][0][e & 3] : cs[i][1][e & 3], sn = e < 4 ? cs[i][2][e & 3] : cs[i][3][e & 3];
                const float y1 = x1[e] * rstd * g1[e], y2 = x2[e] * rstd * g2[e]; o1[e] = (y1 * cc - y2 * sn) * osc; o2[e] = (y1 * sn + y2 * cc) * osc; }
            u32x4 r1, r2;
#pragma unroll
            for (int e = 0; e < 4; ++e) { r1[e] = cvt_pk_bf16(o1[2 * e], o1[2 * e + 1]); r2[e] = cvt_pk_bf16(o2[2 * e], o2[2 * e + 1]); }
            *(GAS u32x4*)p1 = r1; *(GAS u32x4*)(p1 + 32) = r2; }
    }
}
__device__ __forceinline__ void crescale_rows(bf16_t* mix, const float* lsebuf, int row_base, int tid) {
    const int lane = tid & 63, wave = tid >> 6;
    for (int t0 = 0; t0 < 32; t0 += 4) {
        float ls[4][6]; u32x2 w[4][3];
#pragma unroll
        for (int i = 0; i < 4; ++i) { const int m = row_base + wave + 8 * (t0 + i);
#pragma unroll
            for (int k = 0; k < 6; ++k) ls[i][k] = lsebuf[(size_t)m * 6 + k];
            const GAS u32x2* p = (const GAS u32x2*)(mix + (size_t)m * MIXW + 1280) + lane;
#pragma unroll
            for (int j = 0; j < 3; ++j) w[i][j] = p[64 * j]; }
#pragma unroll
        for (int i = 0; i < 4; ++i) { const int m = row_base + wave + 8 * (t0 + i);
            float al[6];
#pragma unroll
            for (int j = 0; j < 2; ++j) { const float mx = fmaxf(fmaxf(ls[i][j], ls[i][2 + j]), ls[i][4 + j]);
                const float e0 = __expf(ls[i][j] - mx), e1 = __expf(ls[i][2 + j] - mx), e2 = __expf(ls[i][4 + j] - mx); const float inv = 1.0f / (e0 + e1 + e2);
                al[j] = e0 * inv; al[2 + j] = e1 * inv; al[4 + j] = e2 * inv; }
            GAS u32x2* p = (GAS u32x2*)(mix + (size_t)m * MIXW + 1280) + lane;
#pragma unroll
            for (int j = 0; j < 3; ++j) { const int hc = (4 * lane + 256 * j) >> 7; const float a = (hc == 0) ? al[0] : (hc == 1) ? al[1] : (hc == 2) ? al[2] : (hc == 3) ? al[3] : (hc == 4) ? al[4] : al[5];
                u32x2 v = w[i][j]; v.x = cvt_pk_bf16(bflo(v.x) * a, bfhi(v.x) * a); v.y = cvt_pk_bf16(bflo(v.y) * a, bfhi(v.y) * a); p[64 * j] = v; } }
    }
}

__global__ void __launch_bounds__(NWAVES * 64, 2) fwd(Args args) {
    extern __shared__ __attribute__((aligned(16))) unsigned char lds[];
    LAS unsigned char* ldsl = (LAS unsigned char*)lds;
    volatile LAS unsigned* MISC = (volatile LAS unsigned*)(ldsl + MISC_OFF);
    const int G = gridDim.x;
    unsigned char* ws = args.ws;
    gu32* ctl = (gu32*)(ws + WS_CTL);
    { const int tid0 = threadIdx.x; for (int u = tid0; u < (LDS_BYTES - LDSCTL_OFF) / 4; u += NWAVES * 64) ((LAS unsigned*)(ldsl + LDSCTL_OFF))[u] = 0u; }
    __syncthreads();
    XcdBarrier bar; bar.bar = (unsigned*)ctl + CW_BAR; bar.x = 0; bar.st = nullptr;
    if (ONE_LAUNCH) bar = xcd_barrier_post((unsigned*)ctl + CW_BAR, MISC + 8);
    int bx = blockIdx.x;
    if (ONE_LAUNCH) {
        if (threadIdx.x == 0) { const unsigned xcc = xb_xcc_id(); const unsigned rk = __hip_atomic_fetch_add(ctl + CW_XRANK + 64 * (xcc & 15u), 1u, __ATOMIC_RELAXED, __HIP_MEMORY_SCOPE_AGENT); MISC[12] = rk * 8u + xcc; }
        xcd_barrier(bar);
        if (threadIdx.x == 0) { bool ok = (G % 8 == 0);
            for (unsigned j = 0; j < 16; ++j) { const unsigned cnt = __hip_atomic_load(ctl + CW_XRANK + 64 * j, __ATOMIC_RELAXED, __HIP_MEMORY_SCOPE_AGENT); ok = ok && (cnt == (j < 8 ? (unsigned)G / 8u : 0u)); }
            if (!ok) MISC[12] = blockIdx.x; }
        __syncthreads();
        bx = __builtin_amdgcn_readfirstlane((int)MISC[12]);
    }
    const int lo = args.ph_lo, hi = args.ph_hi;
#ifndef PHMASK
#define PHMASK 0xffff
#endif
#define IN(k) (lo <= (k) && (k) < hi)
#define EN(b) ((PHMASK >> (b)) & 1)
#ifndef PROBE_DUP
#define PROBE_DUP 0
#endif
#define NREP(b) (1 + ((PROBE_DUP >> (b)) & 1))
#define REPSEAM(b) do { if (ONE_LAUNCH && NREP(b) > 1 && rep == 0) xcd_barrier(bar); } while (0)
#define SEAM(k) do { if (ONE_LAUNCH && IN(k) && IN((k) + 1)) xcd_barrier(bar); } while (0)
#define LANE_ID() const int tid = opaque_tid(), lane = tid & 63, wave = __builtin_amdgcn_readfirstlane(tid >> 6); const int vcu = (G % 8 == 0) ? (bx % 8) * (G / 8) + bx / 8 : bx; const int gw = vcu * NWAVES + wave, NGW = G * NWAVES; (void)lane; (void)gw; (void)NGW
#define ROPEC ((float*)(ws + WS_TAB))
#define ROPES (ROPEC + 128 * 32)
#define TABB (ROPES + 128 * 32)
#define TABC (TABB + 4 * 512)
#define LSEBUF ((float*)(ws + WS_LSE))
#define XB ((bf16_t*)(ws + WS_XB))
#define MB ((bf16_t*)(ws + WS_MB))
#define SSBUF ((pg8::ss_t*)(ws + WS_SS))
#define RSM ((pg8::ss_t*)(ws + WS_RSM))
#define QKV ((bf16_t*)(ws + WS_QKV))
#define MIX ((bf16_t*)(ws + WS_MIX))
#define HID ((bf16_t*)(ws + WS_HID))
#define QX ((bf16_t*)(ws + WS_QX))
#define OX ((bf16_t*)(ws + WS_OX))
#define KVX ((bf16_t*)(ws + WS_KVX))
    float* out = args.out;

    if (EN(13) && IN(0)) {
        LANE_ID();
        float* ropec = ROPEC; float* ropes = ROPES; float* tabB = TABB; float* tabC = TABC;
        LAS float* scr = (LAS float*)(ldsl + wave * 16384);
        constexpr int I_IN = 32 * 120, I_OUT = 32 * 64, I_CQ = 32 * 16, I_CKV = 32 * 32, I_CO = 8 * 64, I_FI = 32 * 352, I_FO = 88 * 64;
        constexpr int I_LAYER = I_IN + I_OUT + I_CQ + I_CKV + I_CO + I_FI + I_FO;
        for (int it = gw; it < DEPTH * I_LAYER; it += NGW) {
            const int l = it / I_LAYER; int r = it % I_LAYER;
            const float* W; bf16_t* WT; int K, N; const float* gain = nullptr;
            if (r < I_IN) { gain = args.in[4] + (size_t)l * DM; W = args.in[5] + (size_t)l * DM * PROJ; WT = (bf16_t*)(ws + WS_WIN) + (size_t)l * PROJ * DM; K = DM; N = PROJ; }
            else if ((r -= I_IN) < I_OUT) { W = args.in[10] + (size_t)l * MIXW * DM; WT = (bf16_t*)(ws + WS_WOUT) + (size_t)l * DM * MIXW; K = MIXW; N = DM; }
            else if ((r -= I_OUT) < I_CQ) { gain = args.in[11] + (size_t)l * DM; W = args.in[13] + (size_t)l * DM * XW; WT = (bf16_t*)(ws + WS_WCQ) + (size_t)l * XW * DM; K = DM; N = XW; }
            else if ((r -= I_CQ) < I_CKV) { gain = args.in[12] + (size_t)l * DM; W = args.in[14] + (size_t)l * DM * 2 * XW; WT = (bf16_t*)(ws + WS_WCKV) + (size_t)l * 2 * XW * DM; K = DM; N = 2 * XW; }
            else if ((r -= I_CKV) < I_CO) { W = args.in[15] + (size_t)l * XW * DM; WT = (bf16_t*)(ws + WS_WCO) + (size_t)l * DM * XW; K = XW; N = DM; }
            else if ((r -= I_CO) < I_FI) { gain = args.in[16] + (size_t)l * DM; W = args.in[17] + (size_t)l * DM * 2 * DFF; WT = (bf16_t*)(ws + WS_WFI) + (size_t)l * 2 * DFF * DM; K = DM; N = 2 * DFF; }
            else { r -= I_FI; W = args.in[18] + (size_t)l * DFF * DM; WT = (bf16_t*)(ws + WS_WFO) + (size_t)l * DM * DFF; K = DFF; N = DM; }
            const int nblk = N / 32, kb = r / nblk, nb = r % nblk, n0 = 32 * nb;
            int drow0 = n0;
            if (N == 2 * DFF) drow0 = (n0 < DFF) ? 256 * (n0 / 128) + (n0 % 128) : 256 * ((n0 - DFF) / 128) + 128 + ((n0 - DFF) % 128);
            transpose_item(W, gain, K, N, WT, 64 * kb, n0, drow0, scr, lane);
        }
        { bf16_t* xb = XB; pg8::ss_t* ss0 = SSBUF; bf16_t* mb = MB; pg8::ss_t* rsm = RSM;
          for (int m = gw; m < NTOK; m += NGW) { const float* xr = (m < NPROMPT) ? args.in[0] + (size_t)m * DM : args.in[1] + (size_t)(m - NPROMPT) * DM;
              const float q = row_to_bf16(xr, xb + (size_t)m * DM, lane); if (lane == 0) ss0[m] = (pg8::ss_t)(q * pg8::SS_SCALE); }
          for (int m = gw; m < MEMROWS; m += NGW) { const float* mr = (m < 2 * MEMLEN) ? args.in[2] + (size_t)m * DM : args.in[3] + (size_t)(m - 2 * MEMLEN) * DM;
              const float q = row_to_bf16(mr, mb + (size_t)m * DM, lane); if (lane == 0) rsm[m] = (pg8::ss_t)(q * pg8::SS_SCALE); } }
        const int gt = vcu * (NWAVES * 64) + tid, NGT = G * NWAVES * 64;
        const float* rel_bias = args.in[9];
        for (int e = gt; e < 4096 + 2048 + 3072; e += NGT) {
            if (e < 4096) { const int n = e >> 5, i = e & 31;
                double invd = 1.0; for (int q = 0; q < i; ++q) invd *= 0.7498942093324559;
                const float inv = (float)invd;
                const float ang = (float)n * inv; double s, c; sincos_d((double)ang, s, c); ropec[e] = (float)c; ropes[e] = (float)s; }
            else if (e < 4096 + 2048) { const int t = e - 4096, h = t >> 9, i = t & 511; const int rel = i - 96 - 128;
                float v = -INFINITY; if (rel >= -128 && rel <= 128) v = rel_bias[t5_bucket(rel) * 10 + h] * att::LOG2E;
                tabB[t] = v; }
            else { const int t = e - 6144, hc = t >> 9, i = t & 511; const int off = i - 96 - 64; const int d = (hc < 2) ? 1 : (hc < 4) ? 4 : 16;
                float v = -INFINITY; if (off >= -64 && off <= 64) v = rel_bias[t5_bucket(off * d) * 10 + 4 + hc] * att::LOG2E;
                tabC[t] = v; }
        }
    }
    SEAM(0);

    for (int l = 0; l < DEPTH; ++l) {
        const int pb = 1 + PPL * l;
#define XS0 ((l == 0) ? args.in[0] : (const float*)out)
#define XS1 ((l == 0) ? args.in[1] : (const float*)out + (size_t)NPROMPT * DM)
        if (EN(0) && IN(pb + 0)) for (int rep = 0; rep < NREP(0); ++rep) {
            { const bf16_t* Win = (const bf16_t*)(ws + WS_WIN) + (size_t)l * PROJ * DM; const bool tail = (G == 256) && l > 0;
              pg8::Gemm g{XB, Win, NTOK, PROJ, DM}; pg8::StaticOrder S; S.init(NTOK, PROJ, G, bx, 0, tail ? 11 : (1 << 30));
              pg8::EpiBf16 E{QKV, PROJ, SSBUF + (size_t)(3 * l) * NTOK};
              pg8::gemm_phase<pg8::EpiBf16, pg8::StaticOrder, true, true>(ldsl, g, S, E);
              if (tail) {
                  if (threadIdx.x == 0) MISC[13] = __hip_atomic_fetch_add(ctl + CW_TAIL + 64 * l, 1u, __ATOMIC_RELAXED, __HIP_MEMORY_SCOPE_AGENT);
                  __syncthreads(); const int slot = __builtin_amdgcn_readfirstlane((int)MISC[13]); __syncthreads();
                  pg8::TailHalfOrder T; T.init(NTOK, PROJ, G, slot, 11); pg8::EpiBf16H EH{QKV, PROJ, SSBUF + (size_t)(3 * l) * NTOK};
                  pg8::gemm_phase<pg8::EpiBf16H, pg8::TailHalfOrder, true, true, true>(ldsl, g, T, EH); } }
            if (l == 0) {
              pg8::Gemm g{MB, (const bf16_t*)(ws + WS_WCKV), MEMROWS, 4 * 2 * XW, DM}; pg8::StaticOrder S; S.init(MEMROWS, 4 * 2 * XW, G, (bx + G - 64) % G);
              pg8::EpiBf16 E{KVX, 4 * 2 * XW, RSM};
              pg8::gemm_phase<pg8::EpiBf16, pg8::StaticOrder, true, true>(ldsl, g, S, E); }
            REPSEAM(0);
        }
        SEAM(pb + 0);
        if (EN(1) && IN(pb + 1)) {
            const int tid = opaque_tid(); const float* tabC = TABC; float* lsebuf = LSEBUF;
            gu32* qhead = ctl + CW_QUEUE + 64 * (2 * l);
            volatile LAS unsigned* uidw = (volatile LAS unsigned*)(ldsl + att::OFF_UID);
            for (;;) {
                if (tid == 0) uidw[0] = __hip_atomic_fetch_add(qhead, 1u, __ATOMIC_RELAXED, __HIP_MEMORY_SCOPE_AGENT);
                __syncthreads();
                const int u = (int)uidw[0];
                __syncthreads();
                if (u >= 1344) break;
                if (u < 960 && u % 5 == 4) {
                    qknorm_rows(QKV, ROPEC, ROPES, args.in[6] + (size_t)l * HD, args.in[7] + (size_t)l * HD, (u / 5) * 256, tid);
                } else { const int v0 = (u < 960) ? u - u / 5 : u - 192;
                {
                    const int v = v0, gi = v % 3, idx = v / 3; const int d = (gi == 0) ? 1 : (gi == 1) ? 4 : 16;
                    long row0; int j, L;
                    if (idx < 128) { row0 = (long)(idx / 64) * SEQ_P; j = idx % 64; L = SEQ_P; } else { const int i2 = idx - 128; row0 = NPROMPT + (long)(i2 / 32) * SEQ_S; j = i2 % 32; L = SEQ_S; }
                    const int res = j % d, qbr = j / d, p0 = qbr * 128, Lr = L / d;
                    int tlo = p0 / 64 - 1, thi = p0 / 64 + 3; if (tlo < 0) tlo = 0; if (thi > Lr / 64) thi = Lr / 64;
                    const long rq = row0 + (long)p0 * d + res, rk = row0 + res; const int hc = 2 * gi;
                    att::attn_unit<true>(QKV + rq * PROJ + COL_QC + hc * HD, (long)d * PROJ, QKV + rk * PROJ + COL_KC + gi * HD, QKV + rk * PROJ + COL_VC + gi * HD, (long)d * PROJ,
                                         MIX + rq * MIXW + 1280 + hc * HD, (long)d * MIXW, tlo, thi, p0, 64, tabC + hc * 512, 321, -1e30f, -1e30f, 0.f, lsebuf + rq * 6 + hc, (long)d * 6, (char*)lds);
                } }
            }
        }
        SEAM(pb + 1);
        if (EN(2) && IN(pb + 2)) for (int rep = 0; rep < NREP(2); ++rep) {
            const int tid = opaque_tid(); const float* tabB = TABB;
            float mfix2;
            { const float* qg = args.in[6] + (size_t)l * HD; const float* kg = args.in[7] + (size_t)l * HD; const int ln = tid & 63;
              float a = fmaxf(fabsf(qg[ln]), fabsf(qg[ln + 64])), b = fmaxf(fabsf(kg[ln]), fabsf(kg[ln + 64]));
#pragma unroll
              for (int o = 1; o < 64; o <<= 1) { a = fmaxf(a, __shfl_xor(a, o)); b = fmaxf(b, __shfl_xor(b, o)); }
              mfix2 = __builtin_amdgcn_readfirstlane(128.f * a * b * 1.02f * att::C); if (!(mfix2 <= 40.f)) mfix2 = -1.f; }
            gu32* qhead = ctl + CW_QUEUE + 64 * (2 * l + 1 + 8 * rep);
            volatile LAS unsigned* uidw = (volatile LAS unsigned*)(ldsl + att::OFF_UID);
            const float* sink = args.in[8] + (size_t)l * 4;
            for (;;) {
                if (tid == 0) uidw[0] = __hip_atomic_fetch_add(qhead, 1u, __ATOMIC_RELAXED, __HIP_MEMORY_SCOPE_AGENT);
                __syncthreads();
                const int u = (int)uidw[0];
                __syncthreads();
                if (u >= 1152 + 192 + 768) break;
                if (u < 1152) {
                    int seq, kvh, qb, gi, L;
                    if (u < 384) { seq = u / 192; const int r = u % 192; kvh = r / 96; const int r2 = r % 96; qb = r2 / 3; gi = r2 % 3; L = SEQ_P; }
                    else { const int v = u - 384; seq = 2 + v / 96; const int r = v % 96; kvh = r / 48; const int r2 = r % 48; qb = r2 / 3; gi = r2 % 3; L = SEQ_S; }
                    const long row0 = (seq < 2) ? (long)seq * SEQ_P : (long)NPROMPT + (long)(seq - 2) * SEQ_S;
                    const int h = kvh * 3 + gi;
                    att::attn_unit_dense<true>(QKV + (row0 + qb * 256) * PROJ + COL_QA + h * HD, PROJ, QKV + row0 * PROJ + COL_KA + kvh * HD, QKV + row0 * PROJ + COL_VA + kvh * HD, PROJ,
                                         MIX + (row0 + qb * 256) * MIXW + h * HD, MIXW, L / 64, mfix2, (char*)lds);
                } else if (u < 1344) { if (rep == 0) crescale_rows(MIX, LSEBUF, (u - 1152) * 256, tid); }
                else {
                    const int v = u - 1344, qbg = v >> 1, kvh = v & 1; const long rowq = (long)qbg * 128;
                    long row0; int pos0, L;
                    if (rowq < NPROMPT) { row0 = (rowq / SEQ_P) * SEQ_P; pos0 = (int)(rowq % SEQ_P); L = SEQ_P; } else { const long rr = rowq - NPROMPT; row0 = NPROMPT + (rr / SEQ_S) * SEQ_S; pos0 = (int)(rr % SEQ_S); L = SEQ_S; }
                    int tlo = pos0 / 64 - 2, thi = pos0 / 64 + 4; if (tlo < 0) tlo = 0; if (thi > L / 64) thi = L / 64;
                    const int h = 2 * kvh;
                    att::attn_unit<true>(QKV + rowq * PROJ + COL_QB + h * HD, PROJ, QKV + row0 * PROJ + COL_KB + kvh * HD, QKV + row0 * PROJ + COL_VB + kvh * HD, PROJ,
                                         MIX + rowq * MIXW + 768 + h * HD, MIXW, tlo, thi, pos0, 128, tabB + h * 512, 449, sink[h] * att::LOG2E, sink[h + 1] * att::LOG2E, 1.0f, nullptr, 0, (char*)lds);
                }
            }
            REPSEAM(2);
        }
        SEAM(pb + 2);
        if (EN(3) && IN(pb + 3)) for (int rep = 0; rep < NREP(3); ++rep) {
            const bf16_t* Wout = (const bf16_t*)(ws + WS_WOUT) + (size_t)l * DM * MIXW;
            pg8::Gemm g{MIX, Wout, NTOK, DM, MIXW}; pg8::StaticOrder S; S.init(NTOK, DM, G, bx);
            pg8::EpiRes E{XB, SSBUF + (size_t)(rep ? NNORM : 3 * l + 1) * NTOK, rep ? 0.f : 1.f};
            pg8::gemm_phase<pg8::EpiRes, pg8::StaticOrder, true, true>(ldsl, g, S, E);
            REPSEAM(3);
        }
        SEAM(pb + 3);
        if (EN(4) && IN(pb + 4)) for (int rep = 0; rep < NREP(4); ++rep) {
            const bf16_t* Wcq = (const bf16_t*)(ws + WS_WCQ) + (size_t)l * XW * DM;
            const bool tail = (G == 256);
            pg8::Gemm g{XB, Wcq, NTOK, XW, DM}; pg8::StaticOrder S; S.init(NTOK, XW, G, bx, 0, tail ? 1 : (1 << 30)); pg8::EpiBf16 E{QX, XW, SSBUF + (size_t)(3 * l + 1) * NTOK};
            pg8::gemm_phase<pg8::EpiBf16, pg8::StaticOrder, true, true>(ldsl, g, S, E);
            if (tail) { pg8::TailHalfOrder T; T.init(NTOK, XW, G, bx, 1); pg8::EpiBf16H EH{QX, XW, SSBUF + (size_t)(3 * l + 1) * NTOK};
                pg8::gemm_phase<pg8::EpiBf16H, pg8::TailHalfOrder, true, true, true>(ldsl, g, T, EH); }
            REPSEAM(4);
        }
        SEAM(pb + 4);
        if (EN(5) && IN(pb + 5)) for (int rep = 0; rep < NREP(5); ++rep) {
            for (int u = bx; u < 768; u += G) {
                const int qbg = u >> 2, h = u & 3; const long rowq = (long)qbg * 256;
                const int seq = (rowq < NPROMPT) ? (int)(rowq / SEQ_P) : 2 + (int)((rowq - NPROMPT) / SEQ_S);
                const bf16_t* kb = KVX + (size_t)seq * MEMLEN * (4 * 2 * XW) + l * (2 * XW) + h * HD;
                att::attn_unit_dense<false>(QX + rowq * XW + h * HD, XW, kb, kb + XW, 4 * 2 * XW, OX + rowq * XW + h * HD, XW, MEMLEN / 64, -1.f, (char*)lds);
            }
            REPSEAM(5);
        }
        SEAM(pb + 5);
        if (EN(6) && IN(pb + 6)) for (int rep = 0; rep < NREP(6); ++rep) {
            const bf16_t* Wco = (const bf16_t*)(ws + WS_WCO) + (size_t)l * DM * XW;
            pg8::Gemm g{OX, Wco, NTOK, DM, XW}; pg8::StaticOrder S; S.init(NTOK, DM, G, bx);
            pg8::EpiRes E{XB, SSBUF + (size_t)(rep ? NNORM : 3 * l + 2) * NTOK, rep ? 0.f : 1.f};
            pg8::gemm_phase<pg8::EpiRes, pg8::StaticOrder, true, true>(ldsl, g, S, E);
            REPSEAM(6);
        }
        SEAM(pb + 6);
        if (EN(7) && IN(pb + 7)) for (int rep = 0; rep < NREP(7); ++rep) {
            const bf16_t* Wfi = (const bf16_t*)(ws + WS_WFI) + (size_t)l * 2 * DFF * DM;
            pg8::Gemm g{XB, Wfi, NTOK, 2 * DFF, DM}; pg8::StaticOrder S; S.init(NTOK, 2 * DFF, G, bx);
            pg8::EpiSwiglu E{HID, DFF, SSBUF + (size_t)(3 * l + 2) * NTOK};
            pg8::gemm_phase<pg8::EpiSwiglu, pg8::StaticOrder, true, true>(ldsl, g, S, E);
            REPSEAM(7);
        }
        SEAM(pb + 7);
        if (EN(8) && IN(pb + 8)) for (int rep = 0; rep < NREP(8); ++rep) {
            const bf16_t* Wfo = (const bf16_t*)(ws + WS_WFO) + (size_t)l * DM * DFF;
            pg8::Gemm g{HID, Wfo, NTOK, DM, DFF}; pg8::StaticOrder S; S.init(NTOK, DM, G, bx);
            pg8::EpiRes E{XB, SSBUF + (size_t)(rep ? NNORM : 3 * l + 3) * NTOK, rep ? 0.f : 1.f};
            pg8::gemm_phase<pg8::EpiRes, pg8::StaticOrder, true, true>(ldsl, g, S, E);
            REPSEAM(8);
        }
        SEAM(pb + 8);
    }
    if (EN(14) && IN(NPHASE - 1)) {
        LANE_ID();
        const float* g = args.in[19]; const pg8::ss_t* ssl = SSBUF + (size_t)(NNORM - 1) * NTOK;
        f32x4 gg[8];
#pragma unroll
        for (int j = 0; j < 8; ++j) gg[j] = ((const GAS f32x4*)g)[lane + 64 * j];
        for (int m = gw; m < NTOK; m += 4 * NGW) {
            u32x2 w[4][8]; float rstd[4];
#pragma unroll
            for (int i = 0; i < 4; ++i) { const int mi = m + i * NGW; const int mc = mi < NTOK ? mi : m;
                rstd[i] = __builtin_amdgcn_rsqf((float)ssl[mc] * pg8::SS_INV_MEAN + RMS_EPS);
#pragma unroll
                for (int j = 0; j < 8; ++j) w[i][j] = ((const GAS u32x2*)(XB + (size_t)mc * DM))[lane + 64 * j]; }
#pragma unroll
            for (int i = 0; i < 4; ++i) { const int mi = m + i * NGW; if (mi < NTOK) { GAS f32x4* o = (GAS f32x4*)(out + (size_t)mi * DM) + lane;
#pragma unroll
                for (int j = 0; j < 8; ++j) { const f32x4 v = {bflo(w[i][j].x), bfhi(w[i][j].x), bflo(w[i][j].y), bfhi(w[i][j].y)}; o[64 * j] = v * rstd[i] * gg[j]; } } }
        }
    }
#undef IN
#undef SEAM
}

extern "C" void kernel_launch(void* const* d_in, const int* in_sizes, int n_in, void* d_out, int out_size, void* d_ws, size_t ws_size, hipStream_t stream) {
    static int grid = 0;
    if (grid == 0) {
        if (n_in != 20 || out_size != NTOK * DM || ws_size < WS_END) { fprintf(stderr, "kernel_launch: unexpected shapes: n_in %d out %d ws %zu (need %zu)\n", n_in, out_size, ws_size, (size_t)WS_END); grid = -1; return; }
        int dev = 0, cus = 0, per_cu = 0;
        if (hipGetDevice(&dev) != hipSuccess || hipDeviceGetAttribute(&cus, hipDeviceAttributeMultiprocessorCount, dev) != hipSuccess) { grid = -1; return; }
        if (hipFuncSetAttribute((const void*)fwd, hipFuncAttributeMaxDynamicSharedMemorySize, LDS_BYTES) != hipSuccess) { fprintf(stderr, "kernel_launch: hipFuncSetAttribute failed\n"); grid = -1; return; }
        if (hipOccupancyMaxActiveBlocksPerMultiprocessor(&per_cu, (const void*)fwd, NWAVES * 64, LDS_BYTES) != hipSuccess || per_cu < 1) { fprintf(stderr, "kernel_launch: occupancy query says %d\n", per_cu); }
        (void)hipGetLastError();
        grid = cus;
    }
    if (grid < 0) return;
    (void)hipMemsetAsync((char*)d_ws + WS_CTL, 0, CTL_ZERO_BYTES, stream);
    Args a{};
    for (int i = 0; i < 20; ++i) a.in[i] = (const float*)d_in[i];
    a.out = (float*)d_out; a.ws = (unsigned char*)d_ws;
#if ONE_LAUNCH
    a.ph_lo = 0; a.ph_hi = NPHASE;
    hipLaunchKernelGGL(fwd, dim3(grid), dim3(NWAVES * 64), LDS_BYTES, stream, a);
#else
    for (int p = 0; p < NPHASE; ++p) { a.ph_lo = p; a.ph_hi = p + 1; hipLaunchKernelGGL(fwd, dim3(grid), dim3(NWAVES * 64), LDS_BYTES, stream, a); }
#endif
    const hipError_t le = hipPeekAtLastError();
    if (le != hipSuccess) fprintf(stderr, "kernel_launch: launch failed: %s\n", hipGetErrorName(le));
}
```

```cpp
#include <hip/hip_runtime.h>
#include <cstdio>
#include <cstdint>

#ifndef ONE_LAUNCH
#define ONE_LAUNCH 1
#endif

constexpr int DM = 2048, NTOK = 49152, NPROMPT = 16384, SEQ_P = 8192, SEQ_S = 4096, DEPTH = 4;
constexpr int PROJ = 3840, MIXW = 2048, XW = 512, DFF = 5632, MEMLEN = 256, MEMROWS = 2560, HD = 128;
constexpr int COL_QA = 0, COL_KA = 768, COL_VA = 1024, COL_QB = 1280, COL_KB = 1792, COL_VB = 2048, COL_QC = 2304, COL_KC = 3072, COL_VC = 3456;
constexpr float RMS_EPS = 1e-6f;
constexpr int PPL = 9;
constexpr int NPHASE = 2 + PPL * DEPTH;
constexpr int NNORM = 3 * DEPTH + 1;

constexpr size_t MiB = 1u << 20;
constexpr size_t WS_CTL = 0;
constexpr size_t WS_SS = 1 * MiB;
constexpr size_t CTL_ZERO_BYTES = 6 * MiB + 512 * 1024;
static_assert(WS_SS + (size_t)(NNORM + 1) * NTOK * 8 <= CTL_ZERO_BYTES, "ss inside the memset region");
constexpr size_t WS_TAB = 6 * MiB + 512 * 1024;
constexpr size_t WS_RSM = 7 * MiB;
constexpr size_t WS_LSE = 618 * MiB;
constexpr size_t WS_WIN = 8 * MiB, WS_WOUT = 68 * MiB, WS_WCQ = 100 * MiB, WS_WCKV = 108 * MiB, WS_WCO = 124 * MiB, WS_WFI = 132 * MiB, WS_WFO = 308 * MiB;
constexpr size_t WS_XB = 396 * MiB;
constexpr size_t WS_MB = 588 * MiB;
constexpr size_t WS_KVX = 598 * MiB;
constexpr size_t WS_QKV = 620 * MiB;
constexpr size_t WS_MIX = 980 * MiB;
constexpr size_t WS_HID = 620 * MiB;
constexpr size_t WS_QX = 620 * MiB, WS_OX = 668 * MiB;
constexpr size_t WS_END = 1172 * MiB;
constexpr int CW_BAR = 4096;
constexpr int CW_XRANK = 12288;
constexpr int CW_TAIL = 24576;
constexpr int CW_QUEUE = 16384;

#define GAS __attribute__((address_space(1)))
#define LAS __attribute__((address_space(3)))
typedef unsigned short bf16_t;
typedef short bf16x8 __attribute__((ext_vector_type(8)));
typedef short s16x4 __attribute__((ext_vector_type(4)));
typedef float f32x4 __attribute__((ext_vector_type(4)));
typedef float f32x16 __attribute__((ext_vector_type(16)));
typedef unsigned u32x4 __attribute__((ext_vector_type(4)));
typedef unsigned u32x2 __attribute__((ext_vector_type(2)));
typedef GAS unsigned gu32;

__device__ __forceinline__ int opaque_tid() { int t = threadIdx.x; asm volatile("" : "+v"(t)); return t; }
__device__ __forceinline__ unsigned cvt_pk_bf16(float lo, float hi) { unsigned r; asm volatile("v_cvt_pk_bf16_f32 %0, %1, %2" : "=v"(r) : "v"(lo), "v"(hi)); return r; }
__device__ __forceinline__ float bf2f(unsigned short b) { return __builtin_bit_cast(float, (unsigned)b << 16); }
__device__ __forceinline__ float bflo(unsigned w) { return __builtin_bit_cast(float, w << 16); }
__device__ __forceinline__ float bfhi(unsigned w) { return __builtin_bit_cast(float, w & 0xffff0000u); }

namespace pg8 {
#define PG8_LAS __attribute__((address_space(3)))
constexpr int BM = 256, BK = 64, HALF = 128, HTB = HALF * BK * 2, STAGE_BYTES = 8 * HTB, NXCD = 8, WGM = 4;
__host__ __device__ __forceinline__ int lds_byte(int r, int c) { const int st = (r >> 4) * 2 + (c >> 5), rr = r & 15, cc = c & 31, ob = rr * 64 + cc * 2; return st * 1024 + (ob ^ (((ob >> 9) & 1) << 5)); }
__host__ __device__ __forceinline__ void stage_rc(int b, int& R, int& C) { const int st = b / 1024, sb = b % 1024, swz = sb ^ (((sb >> 9) & 1) << 5); R = (st >> 1) * 16 + swz / 64; C = (st & 1) * 32 + (swz % 64) / 2; }
__host__ __device__ __forceinline__ int perm32(int rho) { const int n = rho >> 4, i = rho & 15; return 8 * (i >> 2) + 4 * n + (i & 3); }

struct Unit { int pm, pn; };
struct Gemm { const bf16_t* A; const bf16_t* Bt; int M, N, K; };

struct StaticOrder {
    int nM, nN, nwg, G, c, i_lo, i_hi, wgm = WGM;
    __host__ __device__ void init(int M, int N, int G_, int c_, int lo_ = 0, int hi_ = 1 << 30) { nM = M / BM; nN = N / BM; nwg = nM * nN; G = G_; c = c_; i_lo = lo_; i_hi = hi_; }
    __host__ __device__ bool next(int i, Unit& u) const {
        i += i_lo; if (i >= i_hi) return false;
        const long L = (long)i * G + c; if (L >= nwg) return false;
        int wgid = (int)L; { const int q = nwg / NXCD, r = nwg % NXCD, xcd = wgid % NXCD, off = wgid / NXCD; wgid = (xcd < r ? xcd * (q + 1) : r * (q + 1) + (xcd - r) * q) + off; }
        const int nig = wgm * nN, gid = wgid / nig, fm = gid * wgm, gsz = (nM - fm) < wgm ? (nM - fm) : wgm;
        u.pm = fm + ((wgid % nig) % gsz); u.pn = (wgid % nig) / gsz; return true;
    }
    __device__ __forceinline__ void a_ready(const Unit&) const {}
    __device__ __forceinline__ void done(const Unit&) const {}
};

struct TailHalfOrder {
    StaticOrder F; int c;
    __host__ __device__ void init(int M, int N, int G_, int c_, int round) { F.init(M, N, G_, c_ >> 1, round, round + 1); c = c_; }
    __host__ __device__ bool next(int i, Unit& u) const { if (i != 0) return false; Unit f; if (!F.next(0, f)) return false; u.pm = f.pm; u.pn = 2 * f.pn + (c & 1); return true; }
    __device__ __forceinline__ void a_ready(const Unit&) const {}
    __device__ __forceinline__ void done(const Unit&) const {}
};

typedef unsigned long long ss_t;
constexpr float SS_SCALE = 16777216.0f, SS_INV_MEAN = 1.0f / (16777216.0f * 2048.0f);
struct PreSS { ss_t v[2][4]; };
struct PreNone {};
__device__ __forceinline__ unsigned lane_perm(int src4, unsigned v) { return (unsigned)__builtin_amdgcn_ds_bpermute(src4, (int)v); }
__device__ __forceinline__ void ss_prefetch(PreSS& p, const ss_t* ss, int row0) {
#pragma unroll
    for (int ai = 0; ai < 2; ++ai)
#pragma unroll
        for (int m = 0; m < 4; ++m) p.v[ai][m] = ss[row0 + ai * HALF + m * 16];
}
__device__ __forceinline__ void row_rstd(const PreSS& p, float (&rs)[2][4]) {
#pragma unroll
    for (int ai = 0; ai < 2; ++ai)
#pragma unroll
        for (int m = 0; m < 4; ++m) {
            const ss_t v = p.v[ai][m]; const float f = (float)(unsigned)(v >> 32) * 4294967296.0f + (float)(unsigned)v;
            rs[ai][m] = __builtin_amdgcn_rsqf(f * SS_INV_MEAN + 1e-6f); }
}
template <int NBJ>
struct EpiBf16T {
    static constexpr bool PERM = true, AFTER_DRAIN = false;
    bf16_t* O; int ldc; const ss_t* ss;
    typedef PreSS Pre;
    __device__ __forceinline__ void prefetch(Pre& p, const Unit& u, int wr, int fr) const { ss_prefetch(p, ss, u.pm * BM + wr * 64 + fr); }
    __device__ __forceinline__ void operator()(const f32x4 (&acc)[2][2][4][2], const Unit& u, int wr, int wc, int fr, int fq, const Pre& pre) const {
        const int row0 = u.pm * BM + wr * 64 + fr; const int col0 = u.pn * (NBJ * HALF) + wc * 32 + 8 * fq;
        float rs[2][4]; row_rstd(pre, rs);
#pragma unroll
        for (int ai = 0; ai < 2; ++ai)
#pragma unroll
            for (int m = 0; m < 4; ++m) { bf16_t* rowp = O + (size_t)(row0 + ai * HALF + m * 16) * ldc + col0; const float r = rs[ai][m];
#pragma unroll
                for (int bj = 0; bj < NBJ; ++bj) { const f32x4 v0 = acc[ai][bj][m][0] * r, v1 = acc[ai][bj][m][1] * r;
                    u32x4 w; w.x = cvt_pk_bf16(v0[0], v0[1]); w.y = cvt_pk_bf16(v0[2], v0[3]); w.z = cvt_pk_bf16(v1[0], v1[1]); w.w = cvt_pk_bf16(v1[2], v1[3]);
                    *(u32x4*)(rowp + bj * HALF) = w; } }
    }
};
typedef EpiBf16T<2> EpiBf16; typedef EpiBf16T<1> EpiBf16H;
struct EpiRes {
    static constexpr bool PERM = true, AFTER_DRAIN = false;
    bf16_t* xb; ss_t* ssout; float scale;
    typedef PreNone Pre;
    __device__ __forceinline__ void prefetch(Pre&, const Unit&, int, int) const {}
    __device__ __forceinline__ void operator()(const f32x4 (&acc)[2][2][4][2], const Unit& u, int wr, int wc, int fr, int fq, const Pre&) const {
        const int row0 = u.pm * BM + wr * 64 + fr; const int col0 = u.pn * BM + wc * 32 + 8 * fq;
        bf16_t* xbase = xb + (size_t)row0 * DM + col0;
        const int pl = fq * 16 + fr, psrc = (4 * fr + fq) * 4;
        const bf16_t* xload = xb + (size_t)(u.pm * BM + wr * 64 + (pl >> 2)) * DM + u.pn * BM + wc * 32 + 8 * (pl & 3);
#pragma unroll
        for (int ai = 0; ai < 2; ++ai) { float sq[4];
            u32x4 xv[4][2];
#pragma unroll
            for (int m = 0; m < 4; ++m)
#pragma unroll
                for (int bj = 0; bj < 2; ++bj) xv[m][bj] = *(const u32x4*)(xload + (size_t)(ai * HALF + m * 16) * DM + bj * HALF);
#pragma unroll
            for (int m = 0; m < 4; ++m) { bf16_t* bp = xbase + (size_t)(ai * HALF + m * 16) * DM;
                float q = 0.f;
#pragma unroll
                for (int bj = 0; bj < 2; ++bj) { const u32x4 xq = xv[m][bj]; u32x4 xw; xw.x = lane_perm(psrc, xq.x); xw.y = lane_perm(psrc, xq.y); xw.z = lane_perm(psrc, xq.z); xw.w = lane_perm(psrc, xq.w);
                    const f32x4 d0 = acc[ai][bj][m][0] * scale, d1 = acc[ai][bj][m][1] * scale;
                    u32x4 w; w.x = cvt_pk_bf16(bflo(xw.x) + d0[0], bfhi(xw.x) + d0[1]); w.y = cvt_pk_bf16(bflo(xw.y) + d0[2], bfhi(xw.y) + d0[3]);
                    w.z = cvt_pk_bf16(bflo(xw.z) + d1[0], bfhi(xw.z) + d1[1]); w.w = cvt_pk_bf16(bflo(xw.w) + d1[2], bfhi(xw.w) + d1[3]);
                    *(u32x4*)(bp + bj * HALF) = w;
                    const float e0 = bflo(w.x), e1 = bfhi(w.x), e2 = bflo(w.y), e3 = bfhi(w.y), e4 = bflo(w.z), e5 = bfhi(w.z), e6 = bflo(w.w), e7 = bfhi(w.w);
                    q += (e0 * e0 + e1 * e1) + (e2 * e2 + e3 * e3) + (e4 * e4 + e5 * e5) + (e6 * e6 + e7 * e7); }
                sq[m] = q; }
            asm volatile("" ::: "memory");
            const bool b0 = fq & 1, b1 = fq & 2;
            const float w0 = (b0 ? sq[1] : sq[0]) + __shfl_xor(b0 ? sq[0] : sq[1], 16), w1 = (b0 ? sq[3] : sq[2]) + __shfl_xor(b0 ? sq[2] : sq[3], 16);
            const float tot = (b1 ? w1 : w0) + __shfl_xor(b1 ? w0 : w1, 32);
            __hip_atomic_fetch_add(ssout + u.pm * BM + ai * HALF + wr * 64 + fq * 16 + fr, (ss_t)(tot * SS_SCALE), __ATOMIC_RELAXED, __HIP_MEMORY_SCOPE_AGENT); }
    }
};
struct EpiSwiglu {
    static constexpr bool PERM = true, AFTER_DRAIN = false;
    bf16_t* O; int ldc; const ss_t* ss;
    typedef PreSS Pre;
    __device__ __forceinline__ void prefetch(Pre& p, const Unit& u, int wr, int fr) const { ss_prefetch(p, ss, u.pm * BM + wr * 64 + fr); }
    __device__ __forceinline__ void operator()(const f32x4 (&acc)[2][2][4][2], const Unit& u, int wr, int wc, int fr, int fq, const Pre& pre) const {
        const int row0 = u.pm * BM + wr * 64 + fr; const int col0 = u.pn * HALF + wc * 32 + 8 * fq;
        float rs[2][4]; row_rstd(pre, rs);
#pragma unroll
        for (int ai = 0; ai < 2; ++ai)
#pragma unroll
            for (int m = 0; m < 4; ++m) {
                const float r = rs[ai][m], c = -1.4426950408889634f * r, r2 = r * r;
                const f32x4 g0 = acc[ai][0][m][0], g1 = acc[ai][0][m][1], u0 = acc[ai][1][m][0], u1 = acc[ai][1][m][1];
                const f32x4 t0 = g0 * c, t1 = g1 * c;
                f32x4 e0, e1;
#pragma unroll
                for (int i = 0; i < 4; ++i) { e0[i] = __builtin_amdgcn_exp2f(t0[i]); e1[i] = __builtin_amdgcn_exp2f(t1[i]); }
                const f32x4 d0 = e0 + 1.0f, d1 = e1 + 1.0f;
                f32x4 q0, q1;
#pragma unroll
                for (int i = 0; i < 4; ++i) { q0[i] = __builtin_amdgcn_rcpf(d0[i]); q1[i] = __builtin_amdgcn_rcpf(d1[i]); }
                const f32x4 h0 = (g0 * u0) * (q0 * r2), h1 = (g1 * u1) * (q1 * r2);
                u32x4 w; w.x = cvt_pk_bf16(h0[0], h0[1]); w.y = cvt_pk_bf16(h0[2], h0[3]); w.z = cvt_pk_bf16(h1[0], h1[1]); w.w = cvt_pk_bf16(h1[2], h1[3]);
                *(u32x4*)(O + (size_t)(row0 + ai * HALF + m * 16) * ldc + col0) = w; }
    }
};

template <class Epi, class Sched, bool ALIGN_EPI = false, bool SP2 = false, bool HALFN = false>
__device__ __forceinline__ void gemm_phase(PG8_LAS unsigned char* lds, const Gemm g, const Sched& S, const Epi& E) {
    const int tid = opaque_tid(), wid = __builtin_amdgcn_readfirstlane(tid >> 6), lane = tid & 63, wr = wid >> 2, wc = wid & 3, fr = lane & 15, fq = lane >> 4;
    const int K = g.K, nt = K / BK;
    unsigned voffA[2], voffB[2];
#pragma unroll
    for (int i = 0; i < 2; ++i) { int R, C; stage_rc(tid * 16 + i * 8192, R, C); const int Rb = Epi::PERM ? ((R & ~31) + perm32(R & 31)) : R;
        voffA[i] = (unsigned)(R * K + C) * 2u; voffB[i] = (unsigned)(Rb * K + C) * 2u; }
    const size_t kstep = (size_t)(BK * 2);
    const size_t hstep = (size_t)HALF * K * 2;
    const size_t tstep = 2 * hstep;
    const size_t bstep = HALFN ? hstep : tstep;
    const unsigned ldsw = (unsigned)wid * 1024u;
    const int aoff = lds_byte(wr * 64 + fr, fq * 8), boff = lds_byte(wc * 32 + fr, fq * 8);
#define PG8_SA(b, h) (((b) * 2 + (h)) * HTB)
#define PG8_SB(b, h) ((4 + (b) * 2 + (h)) * HTB)
#define PG8_STAGE(bufoff, gbase, voff) do { _Pragma("unroll") for (int _i = 0; _i < 2; ++_i) \
        __builtin_amdgcn_global_load_lds((const unsigned*)((const char*)(gbase) + (voff)[_i]), (PG8_LAS unsigned*)(lds + (bufoff) + ldsw + _i * 8192), 16, 0, 0); } while (0)
#define PG8_LDA(dst, b, h) do { _Pragma("unroll") for (int m = 0; m < 4; ++m) _Pragma("unroll") for (int k = 0; k < 2; ++k) dst[m][k] = *(const PG8_LAS bf16x8*)(lds + PG8_SA(b, h) + aoff + m * 2048 + k * 1024); } while (0)
#define PG8_LDB(dst, b, h) do { _Pragma("unroll") for (int n = 0; n < 2; ++n) _Pragma("unroll") for (int k = 0; k < 2; ++k) dst[n][k] = *(const PG8_LAS bf16x8*)(lds + PG8_SB(b, h) + boff + n * 2048 + k * 1024); } while (0)
#define PG8_MMA(ai, bj, At, Bt) do { __builtin_amdgcn_s_setprio(1); _Pragma("unroll") for (int m = 0; m < 4; ++m) _Pragma("unroll") for (int n = 0; n < 2; ++n) _Pragma("unroll") for (int k = 0; k < 2; ++k) \
        acc[ai][bj][m][n] = __builtin_amdgcn_mfma_f32_16x16x32_bf16(Bt[n][k], At[m][k], acc[ai][bj][m][n], 0, 0, 0); __builtin_amdgcn_s_setprio(0); } while (0)
#define PG8_WAIT_V(n) asm volatile("s_waitcnt vmcnt(" #n ")" ::: "memory")
#define PG8_WAIT_L(n) asm volatile("s_waitcnt lgkmcnt(" #n ")" ::: "memory")
#define PG8_BAR __builtin_amdgcn_s_barrier()
#define PG8_SCHED __builtin_amdgcn_sched_barrier(0)
    Unit cur, nxt; int ui = 0;
    if (!S.next(0, cur)) return;
    f32x4 acc[2][2][4][2];
#pragma unroll
    for (int a = 0; a < 2; ++a)
#pragma unroll
        for (int b = 0; b < 2; ++b)
#pragma unroll
            for (int m = 0; m < 4; ++m)
#pragma unroll
                for (int n = 0; n < 2; ++n) acc[a][b][m][n] = (f32x4){0.f, 0.f, 0.f, 0.f};
    bf16x8 At[4][2], B0[2][2], B1[2][2];
    typename Epi::Pre pre;
    const char* cA = (const char*)g.A + (size_t)cur.pm * tstep; const char* cB = (const char*)g.Bt + (size_t)cur.pn * bstep;
    S.a_ready(cur);
    if constexpr (SP2 && HALFN) {
        PG8_STAGE(PG8_SB(0, 0), cB, voffB); PG8_STAGE(PG8_SA(0, 0), cA, voffA); PG8_STAGE(PG8_SA(0, 1), cA + hstep, voffA);
        if (wr == 1) PG8_BAR;
        PG8_WAIT_V(2); PG8_BAR;
        PG8_STAGE(PG8_SB(1, 0), cB + kstep, voffB); PG8_STAGE(PG8_SA(1, 0), cA + kstep, voffA);
        PG8_WAIT_V(4); PG8_BAR;
    } else if constexpr (SP2) {
        PG8_STAGE(PG8_SB(0, 0), cB, voffB); PG8_STAGE(PG8_SB(0, 1), cB + hstep, voffB); PG8_STAGE(PG8_SA(0, 0), cA, voffA); PG8_STAGE(PG8_SA(0, 1), cA + hstep, voffA);
        if (wr == 1) PG8_BAR;
        PG8_WAIT_V(2); PG8_BAR;
        PG8_STAGE(PG8_SB(1, 0), cB + kstep, voffB); PG8_STAGE(PG8_SA(1, 0), cA + kstep, voffA); PG8_STAGE(PG8_SB(1, 1), cB + hstep + kstep, voffB);
        PG8_WAIT_V(6); PG8_BAR;
    } else {
        PG8_STAGE(PG8_SB(0, 0), cB, voffB); PG8_STAGE(PG8_SA(0, 0), cA, voffA); PG8_STAGE(PG8_SB(0, 1), cB + hstep, voffB); PG8_STAGE(PG8_SA(0, 1), cA + hstep, voffA);
        if (wr == 1) PG8_BAR;
        PG8_WAIT_V(4); PG8_BAR;
        PG8_STAGE(PG8_SB(1, 0), cB + kstep, voffB); PG8_STAGE(PG8_SA(1, 0), cA + kstep, voffA); PG8_STAGE(PG8_SB(1, 1), cB + hstep + kstep, voffB);
        PG8_WAIT_V(6); PG8_BAR;
    }
    for (;;) {
        const bool has_next = S.next(ui + 1, nxt);
        const char* nA = has_next ? (const char*)g.A + (size_t)nxt.pm * tstep : cA; const char* nB = has_next ? (const char*)g.Bt + (size_t)nxt.pn * bstep : cB;
        for (int t = 0; t < nt; t += 2) {
            const bool last = (t == nt - 2);
            const char* a1 = cA + (size_t)(t + 1) * kstep;
            const char* a2 = last ? nA : cA + (size_t)(t + 2) * kstep; const char* b2 = last ? nB : cB + (size_t)(t + 2) * kstep;
            const char* a3 = a2 + kstep; const char* b3 = b2 + kstep;
            if (last && has_next) S.a_ready(nxt);
            if (last) E.prefetch(pre, cur, wr, fr);
            if constexpr (SP2 && HALFN) {
            PG8_LDB(B0, 0, 0); PG8_SCHED; PG8_LDA(At, 0, 0); PG8_STAGE(PG8_SA(1, 1), a1 + hstep, voffA);
            PG8_WAIT_V(6); PG8_WAIT_L(0); PG8_BAR; PG8_MMA(0, 0, At, B0); PG8_BAR; PG8_SCHED;
            PG8_LDA(At, 0, 1); PG8_STAGE(PG8_SB(0, 0), b2, voffB); PG8_STAGE(PG8_SA(0, 0), a2, voffA);
            PG8_WAIT_V(6); PG8_WAIT_L(0); PG8_BAR; PG8_MMA(1, 0, At, B0); PG8_BAR; PG8_SCHED;
            PG8_LDB(B0, 1, 0); PG8_SCHED; PG8_LDA(At, 1, 0); PG8_STAGE(PG8_SA(0, 1), a2 + hstep, voffA);
            PG8_WAIT_V(6); PG8_WAIT_L(0); PG8_BAR; PG8_MMA(0, 0, At, B0); PG8_BAR; PG8_SCHED;
            PG8_LDA(At, 1, 1); PG8_STAGE(PG8_SB(1, 0), b3, voffB); PG8_STAGE(PG8_SA(1, 0), a3, voffA);
            PG8_WAIT_V(6); PG8_WAIT_L(0); PG8_BAR; PG8_MMA(1, 0, At, B0); PG8_BAR; PG8_SCHED;
            } else if constexpr (SP2) {
            PG8_LDB(B0, 0, 0); PG8_LDB(B1, 0, 1); PG8_SCHED; PG8_LDA(At, 0, 0); PG8_STAGE(PG8_SA(1, 1), a1 + hstep, voffA);
            PG8_WAIT_V(8); PG8_WAIT_L(0); PG8_BAR; PG8_MMA(0, 0, At, B0); PG8_MMA(0, 1, At, B1); PG8_BAR; PG8_SCHED;
            PG8_LDA(At, 0, 1); PG8_STAGE(PG8_SB(0, 0), b2, voffB); PG8_STAGE(PG8_SB(0, 1), b2 + hstep, voffB); PG8_STAGE(PG8_SA(0, 0), a2, voffA);
            PG8_WAIT_V(8); PG8_WAIT_L(0); PG8_BAR; PG8_MMA(1, 0, At, B0); PG8_MMA(1, 1, At, B1); PG8_BAR; PG8_SCHED;
            PG8_LDB(B0, 1, 0); PG8_LDB(B1, 1, 1); PG8_SCHED; PG8_LDA(At, 1, 0); PG8_STAGE(PG8_SA(0, 1), a2 + hstep, voffA);
            PG8_WAIT_V(8); PG8_WAIT_L(0); PG8_BAR; PG8_MMA(0, 0, At, B0); PG8_MMA(0, 1, At, B1); PG8_BAR; PG8_SCHED;
            PG8_LDA(At, 1, 1); PG8_STAGE(PG8_SB(1, 0), b3, voffB); PG8_STAGE(PG8_SB(1, 1), b3 + hstep, voffB); PG8_STAGE(PG8_SA(1, 0), a3, voffA);
            PG8_WAIT_V(8); PG8_WAIT_L(0); PG8_BAR; PG8_MMA(1, 0, At, B0); PG8_MMA(1, 1, At, B1); PG8_BAR; PG8_SCHED;
            } else {
            PG8_LDB(B0, 0, 0); PG8_SCHED; PG8_LDA(At, 0, 0); PG8_STAGE(PG8_SA(1, 1), a1 + hstep, voffA);
            PG8_WAIT_L(8); PG8_BAR; PG8_WAIT_L(0); PG8_MMA(0, 0, At, B0); PG8_BAR; PG8_SCHED;
            PG8_LDB(B1, 0, 1); PG8_STAGE(PG8_SB(0, 0), b2, voffB);
            PG8_BAR; PG8_WAIT_L(0); PG8_MMA(0, 1, At, B1); PG8_BAR;
            PG8_LDA(At, 0, 1); PG8_STAGE(PG8_SA(0, 0), a2, voffA);
            PG8_BAR; PG8_WAIT_L(0); PG8_MMA(1, 0, At, B0); PG8_BAR; PG8_SCHED;
            PG8_STAGE(PG8_SB(0, 1), b2 + hstep, voffB);
            PG8_WAIT_V(6); PG8_BAR; PG8_MMA(1, 1, At, B1); PG8_BAR;
            PG8_LDB(B0, 1, 0); PG8_SCHED; PG8_LDA(At, 1, 0); PG8_STAGE(PG8_SA(0, 1), a2 + hstep, voffA);
            PG8_WAIT_L(8); PG8_BAR; PG8_WAIT_L(0); PG8_MMA(0, 0, At, B0); PG8_BAR; PG8_SCHED;
            PG8_LDB(B1, 1, 1); PG8_STAGE(PG8_SB(1, 0), b3, voffB);
            PG8_BAR; PG8_WAIT_L(0); PG8_MMA(0, 1, At, B1); PG8_BAR;
            PG8_LDA(At, 1, 1); PG8_STAGE(PG8_SA(1, 0), a3, voffA);
            PG8_BAR; PG8_WAIT_L(0); PG8_MMA(1, 0, At, B0); PG8_BAR; PG8_SCHED;
            PG8_STAGE(PG8_SB(1, 1), b3 + hstep, voffB);
            PG8_WAIT_V(6); PG8_BAR; PG8_MMA(1, 1, At, B1); PG8_BAR;
            }
        }
        if constexpr (ALIGN_EPI) { if (wr == 0) PG8_BAR; }
        if constexpr (!Epi::AFTER_DRAIN) { E(acc, cur, wr, wc, fr, fq, pre); S.done(cur); }
        if (!has_next) break;
#pragma unroll
        for (int a = 0; a < 2; ++a)
#pragma unroll
            for (int b = 0; b < 2; ++b)
#pragma unroll
                for (int m = 0; m < 4; ++m)
#pragma unroll
                    for (int n = 0; n < 2; ++n) acc[a][b][m][n] = (f32x4){0.f, 0.f, 0.f, 0.f};
        cur = nxt; cA = nA; cB = nB; ++ui;
        if constexpr (ALIGN_EPI) { if (wr == 1) PG8_BAR; }
    }
    PG8_WAIT_V(0);
    if constexpr (!ALIGN_EPI) { if (wr == 0) PG8_BAR; }
    PG8_BAR;
#undef PG8_SA
#undef PG8_SB
#undef PG8_STAGE
#undef PG8_LDA
#undef PG8_LDB
#undef PG8_MMA
#undef PG8_WAIT_V
#undef PG8_WAIT_L
#undef PG8_BAR
#undef PG8_SCHED
}
}

namespace att {
constexpr int D = 128, NW = 8, QBLK = 32, KVBLK = 64;
constexpr float SCALE = 0.088388347648318440f, LOG2E = 1.4426950408889634f, LN2 = 0.6931471805599453f;
constexpr float C = SCALE * LOG2E;
constexpr float THR2 = 8.f * LOG2E;
constexpr int SHM_V = KVBLK * D * 2, SHM_K = KVBLK * D * 2;
constexpr int OFF_V = 0, OFF_K = 2 * SHM_V, BUF3 = SHM_V + SHM_K  , OFF_WS = 3 * BUF3, OFF_TAB = OFF_WS + NW * 64 * 4, TAB_FLOATS = 1024, OFF_UID = OFF_TAB + TAB_FLOATS * 4, LDS_BYTES = OFF_UID + 64;
#define KSWZ(row, colB) ((row) * 256 + ((colB) ^ (((row) & 7) << 4)))
#define SBAR() __builtin_amdgcn_sched_barrier(0)
__device__ __forceinline__ int crow(int r, int hi) { return (r & 3) + 8 * (r >> 2) + 4 * hi; }
__device__ __forceinline__ void qkt(f32x16& p0, f32x16& p1, const char* Ks, const bf16x8* qr, int r32, int hi) {
  p0 = f32x16{}; p1 = f32x16{};
#pragma unroll
  for (int d0 = 0; d0 < 8; ++d0) { const int cb = (d0 * 16 + hi * 8) * 2;
    const bf16x8 b0 = *reinterpret_cast<const bf16x8*>(Ks + KSWZ(r32, cb));
    const bf16x8 b1 = *reinterpret_cast<const bf16x8*>(Ks + KSWZ(32 + r32, cb));
    p0 = __builtin_amdgcn_mfma_f32_32x32x16_bf16(b0, qr[d0], p0, 0, 0, 0);
    p1 = __builtin_amdgcn_mfma_f32_32x32x16_bf16(b1, qr[d0], p1, 0, 0, 0); }
}
__device__ __forceinline__ int v_st(int k, int c) { const int kk = (k & ~0xC) | ((k & 4) << 1) | ((k & 8) >> 1); return ((kk >> 3) * 4 + (c >> 5)) * 512 + ((kk & 7) * 32 + (c & 31)) * 2; }
__device__ __forceinline__ int v_rd_base(int lane) { return ((lane & 3) << 3) | (((lane >> 2) & 3) << 6) | (((lane >> 4) & 1) << 5) | (((lane >> 5) & 1) << 8); }
constexpr int v_rd_off(int d0, int ks, int half) { return d0 * 512 + ks * 4096 + half * 2048; }
template <int OFF> __device__ __forceinline__ s16x4 tr_read(int vb) {
  s16x4 r; asm volatile("ds_read_b64_tr_b16 %0, %1 offset:%2" : "=&v"(r) : "v"(vb), "i"(OFF) : "memory"); return r;
}
template <int D0> __device__ __forceinline__ void pv_one(f32x16& od, int vb, bf16x8 pa0, bf16x8 pa1, bf16x8 pa2, bf16x8 pa3) {
  const s16x4 l0 = tr_read<v_rd_off(D0, 0, 0)>(vb), h0 = tr_read<v_rd_off(D0, 0, 1)>(vb), l1 = tr_read<v_rd_off(D0, 1, 0)>(vb), h1 = tr_read<v_rd_off(D0, 1, 1)>(vb);
  const s16x4 l2 = tr_read<v_rd_off(D0, 2, 0)>(vb), h2 = tr_read<v_rd_off(D0, 2, 1)>(vb), l3 = tr_read<v_rd_off(D0, 3, 0)>(vb), h3 = tr_read<v_rd_off(D0, 3, 1)>(vb);
  asm volatile("s_waitcnt lgkmcnt(0)" ::: "memory"); SBAR();
#define PK(L, H) (bf16x8){L[0], L[1], L[2], L[3], H[0], H[1], H[2], H[3]}
  od = __builtin_amdgcn_mfma_f32_32x32x16_bf16(pa0, PK(l0, h0), od, 0, 0, 0);
  od = __builtin_amdgcn_mfma_f32_32x32x16_bf16(pa1, PK(l1, h1), od, 0, 0, 0);
  od = __builtin_amdgcn_mfma_f32_32x32x16_bf16(pa2, PK(l2, h2), od, 0, 0, 0);
  od = __builtin_amdgcn_mfma_f32_32x32x16_bf16(pa3, PK(l3, h3), od, 0, 0, 0);
#undef PK
}
__device__ __forceinline__ void pv_d0(f32x16* o, int vb, bf16x8 pa0, bf16x8 pa1, bf16x8 pa2, bf16x8 pa3) {
  pv_one<0>(o[0], vb, pa0, pa1, pa2, pa3); pv_one<1>(o[1], vb, pa0, pa1, pa2, pa3); pv_one<2>(o[2], vb, pa0, pa1, pa2, pa3); pv_one<3>(o[3], vb, pa0, pa1, pa2, pa3);
}

template <bool TAB>
__device__ __forceinline__ void attn_unit(const bf16_t* __restrict__ Qb, long ldq, const bf16_t* __restrict__ Kh, const bf16_t* __restrict__ Vh, long ldk,
                                          bf16_t* __restrict__ Ob, long ldo, int t_lo, int t_hi, int qpos0, int W, const float* __restrict__ tabg, int tablen,
                                          float m_init0, float m_init1, float l_init, float* __restrict__ lse, long ldlse, char* lds) {
  const int tid = opaque_tid(), lane = tid & 63, r32 = lane & 31, hi = lane >> 5; const int wid = __builtin_amdgcn_readfirstlane(tid >> 6);
  const int hw = wid >> 2, wq = wid & 3;
  char* V_lds = lds + OFF_V; char* K_lds = lds + OFF_K;
  float* ws = (float*)(lds + OFF_WS) + wid * 64; float* li_l = ws; float* al_l = ws + 32;
  float* tab = (float*)(lds + OFF_TAB);
  bf16x8 qr[8];
  { const bf16_t* Qw = Qb + hw * D + (long)(wq * QBLK + r32) * ldq + hi * 8;
#pragma unroll
    for (int d0 = 0; d0 < 8; ++d0) qr[d0] = *reinterpret_cast<const bf16x8*>(Qw + d0 * 16); }
  if (TAB) { for (int i = tid; i < 2 * 512; i += NW * 64) tab[i] = ((i & 511) < tablen) ? tabg[i] : 0.f; }
  const int sr = tid >> 4, sc = (tid & 15) * 8, vst0 = v_st(sr, sc), vst1 = v_st(32 + sr, sc);
  const int vb0 = (int)(uintptr_t)V_lds + v_rd_base(lane);
  bf16x8 vs0, vs1, ks0, ks1;
#define SLOAD(k0) do { vs0 = *reinterpret_cast<const bf16x8*>(&Vh[(long)((k0) + sr) * ldk + sc]); vs1 = *reinterpret_cast<const bf16x8*>(&Vh[(long)((k0) + 32 + sr) * ldk + sc]); \
    ks0 = *reinterpret_cast<const bf16x8*>(&Kh[(long)((k0) + sr) * ldk + sc]); ks1 = *reinterpret_cast<const bf16x8*>(&Kh[(long)((k0) + 32 + sr) * ldk + sc]); } while (0)
#define SWRITE(b) do { *(bf16x8*)(V_lds + (b) * SHM_V + vst0) = vs0; *(bf16x8*)(V_lds + (b) * SHM_V + vst1) = vs1; const int kc = sc * 2; \
    *(bf16x8*)(K_lds + (b) * SHM_K + KSWZ(sr, kc)) = ks0; *(bf16x8*)(K_lds + (b) * SHM_K + KSWZ(32 + sr, kc)) = ks1; } while (0)
  float m_reg = hw ? m_init1 : m_init0, l_reg = l_init; f32x16 o[4] = {};
  const int qw0 = qpos0 + wq * QBLK;
  SLOAD(t_lo * KVBLK); SWRITE(0); __syncthreads();
  for (int t = t_lo; t < t_hi; ++t) {
    const int b = (t - t_lo) & 1; const bool more = (t + 1 < t_hi);
    if (more) SLOAD((t + 1) * KVBLK);
    const bool active = !TAB || (KVBLK * t + KVBLK - 1 >= qw0 - W && KVBLK * t <= qw0 + QBLK - 1 + W);
    if (active) {
      f32x16 p0, p1; qkt(p0, p1, K_lds + b * SHM_K, qr, r32, hi);
      if (TAB) { const float* tl = tab + hw * 512 + (KVBLK * t - qw0 - r32 + 4 * hi + W + 96);
#pragma unroll
        for (int r = 0; r < 16; ++r) { const int ix = (r & 3) + 8 * (r >> 2); p0[r] = fmaf(p0[r], C, tl[ix]); p1[r] = fmaf(p1[r], C, tl[ix + 32]); } }
      else {
#pragma unroll
        for (int r = 0; r < 16; ++r) { p0[r] *= C; p1[r] *= C; } }
      float pmax = p0[0];
#pragma unroll
      for (int r = 1; r < 16; ++r) pmax = fmaxf(pmax, p0[r]);
#pragma unroll
      for (int r = 0; r < 16; ++r) pmax = fmaxf(pmax, p1[r]);
      { auto rr = __builtin_amdgcn_permlane32_swap(__float_as_uint(pmax), __float_as_uint(pmax), false, false);
        pmax = fmaxf(__uint_as_float(rr[0]), __uint_as_float(rr[1])); }
      if (!__all(pmax - m_reg <= THR2)) {
        const float mn = fmaxf(m_reg, pmax); const float alpha = __builtin_amdgcn_exp2f(m_reg - mn); m_reg = mn; l_reg *= alpha;
        if (hi == 0) al_l[r32] = alpha; asm volatile("s_waitcnt lgkmcnt(0)" ::: "memory");
#pragma unroll
        for (int d = 0; d < 4; ++d)
#pragma unroll
          for (int r = 0; r < 16; ++r) o[d][r] *= al_l[crow(r, hi)];
      }
#pragma unroll
      for (int r = 0; r < 16; ++r) { p0[r] = __builtin_amdgcn_exp2f(p0[r] - m_reg); p1[r] = __builtin_amdgcn_exp2f(p1[r] - m_reg); }
      float ps = 0.f;
#pragma unroll
      for (int r = 0; r < 16; ++r) ps += p0[r];
#pragma unroll
      for (int r = 0; r < 16; ++r) ps += p1[r];
      { auto rr = __builtin_amdgcn_permlane32_swap(__float_as_uint(ps), __float_as_uint(ps), false, false);
        ps = __uint_as_float(rr[0]) + __uint_as_float(rr[1]); }
      l_reg += ps;
      bf16x8 pa0, pa1, pa2, pa3;
#define PK4(P, BASE, OUT) do { unsigned a0 = cvt_pk_bf16(P[BASE + 0], P[BASE + 1]), a1 = cvt_pk_bf16(P[BASE + 2], P[BASE + 3]);   \
    unsigned b0 = cvt_pk_bf16(P[BASE + 4], P[BASE + 5]), b1 = cvt_pk_bf16(P[BASE + 6], P[BASE + 7]);                              \
    auto r0 = __builtin_amdgcn_permlane32_swap(a0, b0, false, false); auto r1 = __builtin_amdgcn_permlane32_swap(a1, b1, false, false); \
    u32x4 w = {r0[0], r1[0], r0[1], r1[1]}; OUT = *reinterpret_cast<bf16x8*>(&w); } while (0)
      PK4(p0, 0, pa0); PK4(p0, 8, pa1); PK4(p1, 0, pa2); PK4(p1, 8, pa3);
#undef PK4
      SBAR();
      pv_d0(o, vb0 + b * SHM_V, pa0, pa1, pa2, pa3);
    }
    if (more) SWRITE(b ^ 1);
    __syncthreads();
  }
  if (hi == 0) li_l[r32] = l_reg; asm volatile("s_waitcnt lgkmcnt(0)" ::: "memory");
  float rli[16];
#pragma unroll
  for (int r = 0; r < 16; ++r) rli[r] = __builtin_amdgcn_rcpf(li_l[crow(r, hi)]);
  bf16_t* stg = (bf16_t*)(lds + wid * 8192);
#pragma unroll
  for (int r = 0; r < 16; ++r) { const int orow = crow(r, hi);
#pragma unroll
    for (int d0 = 0; d0 < 4; ++d0) { const unsigned w = cvt_pk_bf16(o[d0][r] * rli[r], 0.f); stg[orow * 128 + d0 * 32 + r32] = (bf16_t)(w & 0xffffu); } }
  asm volatile("s_waitcnt lgkmcnt(0)" ::: "memory");
#pragma unroll
  for (int i = 0; i < 8; ++i) { const int row = i * 4 + (lane >> 4), ch = lane & 15; const u32x4 v = *(const u32x4*)(stg + row * 128 + ch * 8);
    *(u32x4*)(Ob + hw * D + (long)(wq * QBLK + row) * ldo + ch * 8) = v; }
  if (lse != nullptr && hi == 0) lse[hw + (long)(wq * QBLK + r32) * ldlse] = (m_reg + __builtin_amdgcn_logf(l_reg)) * LN2;
  __syncthreads();
#undef SLOAD
#undef SWRITE
}
template <bool PRE>
__device__ __forceinline__ void partialSM(f32x16& p0, f32x16& p1, float& m_reg, float& mn, float& alpha) {
  constexpr float cs = PRE ? 1.0f : C;
  float pmax = p0[0];
#pragma unroll
  for (int r = 1; r < 16; ++r) pmax = fmaxf(pmax, p0[r]);
#pragma unroll
  for (int r = 0; r < 16; ++r) pmax = fmaxf(pmax, p1[r]);
  { auto rr = __builtin_amdgcn_permlane32_swap(__float_as_uint(pmax), __float_as_uint(pmax), false, false);
    pmax = fmaxf(__uint_as_float(rr[0]), __uint_as_float(rr[1])); }
  if (__builtin_expect(__all((pmax - m_reg) * cs <= THR2), 1)) { mn = m_reg; alpha = 1.f; }
  else { mn = fmaxf(m_reg, pmax); alpha = __builtin_amdgcn_exp2f((m_reg - mn) * cs); m_reg = mn; }
  const float mnC = -mn * cs;
#pragma unroll
  for (int r = 0; r < 16; ++r) p0[r] = fmaf(p0[r], cs, mnC);
#pragma unroll
  for (int r = 0; r < 16; ++r) p1[r] = fmaf(p1[r], cs, mnC);
#pragma unroll
  for (int r = 0; r < 16; ++r) p0[r] = __builtin_amdgcn_exp2f(p0[r]);
}
__device__ __forceinline__ void partialSM_fixed(f32x16& p0) {
#pragma unroll
  for (int r = 0; r < 16; ++r) p0[r] = __builtin_amdgcn_exp2f(p0[r]);
}
__device__ __forceinline__ void finishSM(f32x16& p0, f32x16& p1, float alpha, float& l_reg, bf16x8& pa0, bf16x8& pa1, bf16x8& pa2, bf16x8& pa3) {
#pragma unroll
  for (int r = 0; r < 16; ++r) p1[r] = __builtin_amdgcn_exp2f(p1[r]);
  float ps = 0;
#pragma unroll
  for (int r = 0; r < 16; ++r) ps += p0[r];
#pragma unroll
  for (int r = 0; r < 16; ++r) ps += p1[r];
  { auto rr = __builtin_amdgcn_permlane32_swap(__float_as_uint(ps), __float_as_uint(ps), false, false);
    ps = __uint_as_float(rr[0]) + __uint_as_float(rr[1]); }
  l_reg = l_reg * alpha + ps;
#define PK4(P, BASE, OUT) do { unsigned a0 = cvt_pk_bf16(P[BASE + 0], P[BASE + 1]), a1 = cvt_pk_bf16(P[BASE + 2], P[BASE + 3]);   \
    unsigned b0 = cvt_pk_bf16(P[BASE + 4], P[BASE + 5]), b1 = cvt_pk_bf16(P[BASE + 6], P[BASE + 7]);                              \
    auto r0 = __builtin_amdgcn_permlane32_swap(a0, b0, false, false); auto r1 = __builtin_amdgcn_permlane32_swap(a1, b1, false, false); \
    u32x4 w = {r0[0], r1[0], r0[1], r1[1]}; OUT = *reinterpret_cast<bf16x8*>(&w); } while (0)
  PK4(p0, 0, pa0); PK4(p0, 8, pa1); PK4(p1, 0, pa2); PK4(p1, 8, pa3);
#undef PK4
}
template <bool PRE>
__device__ __forceinline__ void attn_unit_dense(const bf16_t* __restrict__ Qb, long ldq, const bf16_t* __restrict__ Kh, const bf16_t* __restrict__ Vh, long ldk,
                                                bf16_t* __restrict__ Ob, long ldo, int ntile, float mfix2, char* lds) {
  const int tid = opaque_tid(), lane = tid & 63, r32 = lane & 31, hi = lane >> 5; const int wid = __builtin_amdgcn_readfirstlane(tid >> 6);
  float* ws = (float*)(lds + OFF_WS) + wid * 64; float* li_l = ws; float* al_l = ws + 32;
  const bool fixm = PRE && mfix2 >= 0.f;
  float m_reg = -1e30f, l_reg = 0; f32x16 o[4] = {}; bf16x8 qr[8];
  { const bf16_t* Qw = Qb + (long)(wid * QBLK + r32) * ldq + hi * 8;
#pragma unroll
    for (int d0 = 0; d0 < 8; ++d0) qr[d0] = *reinterpret_cast<const bf16x8*>(Qw + d0 * 16); }
  const int sr = tid >> 4, sc = (tid & 15) * 8, vst0 = v_st(sr, sc), vst1 = v_st(32 + sr, sc);
  const int vb0 = (int)(uintptr_t)lds + v_rd_base(lane);
  bf16x8 vsE0, vsE1, ksE0, ksE1, vsO0, vsO1, ksO0, ksO1;
#define SLOAD_E(k0) do { vsE0 = *reinterpret_cast<const bf16x8*>(&Vh[(long)((k0) + sr) * ldk + sc]); vsE1 = *reinterpret_cast<const bf16x8*>(&Vh[(long)((k0) + 32 + sr) * ldk + sc]); \
    ksE0 = *reinterpret_cast<const bf16x8*>(&Kh[(long)((k0) + sr) * ldk + sc]); ksE1 = *reinterpret_cast<const bf16x8*>(&Kh[(long)((k0) + 32 + sr) * ldk + sc]); } while (0)
#define SLOAD_O(k0) do { vsO0 = *reinterpret_cast<const bf16x8*>(&Vh[(long)((k0) + sr) * ldk + sc]); vsO1 = *reinterpret_cast<const bf16x8*>(&Vh[(long)((k0) + 32 + sr) * ldk + sc]); \
    ksO0 = *reinterpret_cast<const bf16x8*>(&Kh[(long)((k0) + sr) * ldk + sc]); ksO1 = *reinterpret_cast<const bf16x8*>(&Kh[(long)((k0) + 32 + sr) * ldk + sc]); } while (0)
#define SWRITE_E(bo) do { char* B_ = lds + (bo); *(bf16x8*)(B_ + vst0) = vsE0; *(bf16x8*)(B_ + vst1) = vsE1; const int kc = sc * 2; \
    *(bf16x8*)(B_ + SHM_V + KSWZ(sr, kc)) = ksE0; *(bf16x8*)(B_ + SHM_V + KSWZ(32 + sr, kc)) = ksE1; } while (0)
#define SWRITE_O(bo) do { char* B_ = lds + (bo); *(bf16x8*)(B_ + vst0) = vsO0; *(bf16x8*)(B_ + vst1) = vsO1; const int kc = sc * 2; \
    *(bf16x8*)(B_ + SHM_V + KSWZ(sr, kc)) = ksO0; *(bf16x8*)(B_ + SHM_V + KSWZ(32 + sr, kc)) = ksO1; } while (0)
#define SWAIT() asm volatile("s_waitcnt vmcnt(4)" ::: "memory")
#define PSM(P0, P1, MN, AL) do { if (fixm) { partialSM_fixed(P0); AL = 1.f; MN = 0.f; } else partialSM<PRE>(P0, P1, m_reg, MN, AL); } while (0)
#define RESC(a) do { if (!fixm) if (__any((a) < 1.f)) { if (hi == 0) al_l[r32] = (a); asm volatile("s_waitcnt lgkmcnt(0)" ::: "memory"); \
    _Pragma("unroll") for (int d = 0; d < 4; ++d) _Pragma("unroll") for (int r = 0; r < 16; ++r) o[d][r] *= al_l[crow(r, hi)]; } } while (0)
#define ROT3() do { const int t_ = bV; bV = bK; bK = bW; bW = t_; } while (0)
  f32x16 pA0, pA1, pB0, pB1; float mnA, mnB, alA, alB; bf16x8 pa0, pa1, pa2, pa3; const int NT = ntile;
  int bV = 0, bK = 0, bW = BUF3;
  SLOAD_E(0); SLOAD_O(KVBLK); asm volatile("s_waitcnt vmcnt(4)" ::: "memory"); SWRITE_E(0); SLOAD_E(2 * KVBLK);
  __syncthreads();
  SWAIT(); SWRITE_O(bW);
  qkt(pA0, pA1, lds + bK + SHM_V, qr, r32, hi); PSM(pA0, pA1, mnA, alA);
  if (3 < NT) SLOAD_O(3 * KVBLK);
  bV = 0; bK = BUF3; bW = 2 * BUF3;
  for (int j = 1; j + 1 < NT; j += 2) {
    __syncthreads(); SWAIT(); SWRITE_E(bW);
    SBAR(); qkt(pB0, pB1, lds + bK + SHM_V, qr, r32, hi);
    finishSM(pA0, pA1, alA, l_reg, pa0, pa1, pa2, pa3); SBAR();
    if (j + 3 < NT) SLOAD_E((j + 3) * KVBLK); SBAR();
    pv_d0(o, vb0 + bV, pa0, pa1, pa2, pa3); PSM(pB0, pB1, mnB, alB);
    RESC(alB); ROT3();
    __syncthreads(); SWAIT(); SWRITE_O(bW);
    SBAR(); qkt(pA0, pA1, lds + bK + SHM_V, qr, r32, hi);
    finishSM(pB0, pB1, alB, l_reg, pa0, pa1, pa2, pa3); SBAR();
    if (j + 4 < NT) SLOAD_O((j + 4) * KVBLK); SBAR();
    pv_d0(o, vb0 + bV, pa0, pa1, pa2, pa3); PSM(pA0, pA1, mnA, alA);
    RESC(alA); ROT3();
  }
  __syncthreads();
  SBAR(); qkt(pB0, pB1, lds + bK + SHM_V, qr, r32, hi);
  finishSM(pA0, pA1, alA, l_reg, pa0, pa1, pa2, pa3); SBAR();
  pv_d0(o, vb0 + bV, pa0, pa1, pa2, pa3); PSM(pB0, pB1, mnB, alB);
  RESC(alB); ROT3();
  finishSM(pB0, pB1, alB, l_reg, pa0, pa1, pa2, pa3); SBAR();
  pv_d0(o, vb0 + bV, pa0, pa1, pa2, pa3);
#undef ROT3
  if (hi == 0) li_l[r32] = l_reg; asm volatile("s_waitcnt lgkmcnt(0)" ::: "memory");
  float rli[16];
#pragma unroll
  for (int r = 0; r < 16; ++r) rli[r] = __builtin_amdgcn_rcpf(li_l[crow(r, hi)]);
  __syncthreads();
  bf16_t* stg = (bf16_t*)(lds + wid * 8192);
#pragma unroll
  for (int r = 0; r < 16; ++r) { const int orow = crow(r, hi);
#pragma unroll
    for (int d0 = 0; d0 < 4; ++d0) { const unsigned w = cvt_pk_bf16(o[d0][r] * rli[r], 0.f); stg[orow * 128 + d0 * 32 + r32] = (bf16_t)(w & 0xffffu); } }
  asm volatile("s_waitcnt lgkmcnt(0)" ::: "memory");
#pragma unroll
  for (int i = 0; i < 8; ++i) { const int row = i * 4 + (lane >> 4), ch = lane & 15; const u32x4 v = *(const u32x4*)(stg + row * 128 + ch * 8);
    *(u32x4*)(Ob + (long)(wid * QBLK + row) * ldo + ch * 8) = v; }
  __syncthreads();
#undef PSM
#undef SLOAD_E
#undef SLOAD_O
#undef SWRITE_E
#undef SWRITE_O
#undef SWAIT
#undef RESC
}
#undef SBAR
}

#define XB_TMO      128
#define XB_XCNT(j)  (256  + 64 * (j))
#define XB_XSUB(j)  (1280 + 64 * (j))
#define XB_XGEN(j)  (2304 + 64 * (j))
#define XB_TOP      3328
#define XB_TOPGEN   3392
#define XCD_BAR_WORDS 3456
#define XB_SPIN_CAP (1u << 18)
__device__ __forceinline__ unsigned xb_ld(unsigned* p)              { return __hip_atomic_load(p, __ATOMIC_RELAXED, __HIP_MEMORY_SCOPE_AGENT); }
__device__ __forceinline__ unsigned xb_add(unsigned* p, unsigned v) { return __hip_atomic_fetch_add(p, v, __ATOMIC_RELAXED, __HIP_MEMORY_SCOPE_AGENT); }
__device__ __forceinline__ unsigned xb_xcc_id() { return (unsigned)__builtin_amdgcn_s_getreg((3 << 11) | 20) & 0xFu; }
#define XB_SPIN(cond, bar) do { unsigned _sp = 0; while (cond) { __builtin_amdgcn_s_sleep(1); \
    if ((++_sp & 255u) == 0u) { if (xb_ld(&(bar)[XB_TMO])) break; if (_sp > XB_SPIN_CAP) { atomicAdd(&(bar)[XB_TMO], 1u); break; } } } } while (0)
struct XcdBarrier { unsigned* bar; unsigned x; volatile LAS unsigned* st; };
__device__ __forceinline__ XcdBarrier xcd_barrier_post(unsigned* bar, volatile LAS unsigned* st) {
    XcdBarrier b; b.bar = bar; b.x = xb_xcc_id(); b.st = st;
    if (threadIdx.x == 0) (void)xb_add(&bar[XB_XCNT(b.x)], 1u);
    return b;
}
__device__ __forceinline__ void xcd_barrier_complete(unsigned* bar, unsigned x, unsigned& nloc, unsigned& nx) {
    const unsigned G = gridDim.x * gridDim.y * gridDim.z;
    unsigned sum, cnt, mine, sp = 0u;
    for (;;) {
        sum = 0u; cnt = 0u; mine = 0u;
#pragma unroll
        for (unsigned j = 0; j < 16; ++j) { const unsigned c = xb_ld(&bar[XB_XCNT(j)]); sum += c; cnt += (c > 0u) ? 1u : 0u; mine = (j == x) ? c : mine; }
        if (sum == G) break;
        __builtin_amdgcn_s_sleep(1);
        if ((++sp & 255u) == 0u) { if (xb_ld(&bar[XB_TMO])) break; if (sp > XB_SPIN_CAP) { atomicAdd(&bar[XB_TMO], 1u); break; } }
    }
    nloc = mine > 0u ? mine : 1u; nx = cnt > 0u ? cnt : 1u;
}
__device__ __forceinline__ void xcd_barrier(const XcdBarrier& b) {
    asm volatile("s_waitcnt vmcnt(0)" ::: "memory");
    __syncthreads();
    if (threadIdx.x == 0) {
        unsigned* bar = b.bar;
        __builtin_amdgcn_s_waitcnt(0);
        unsigned nloc = b.st[0], nx = b.st[1];
        if (nloc == 0u) { xcd_barrier_complete(bar, b.x, nloc, nx); b.st[0] = nloc; b.st[1] = nx; }
        const unsigned old = xb_add(&bar[XB_XSUB(b.x)], 1u);
        const unsigned gen = old / nloc;
        if (old + 1u == (gen + 1u) * nloc) {
            __builtin_amdgcn_fence(__ATOMIC_RELEASE, "agent");
            asm volatile("s_waitcnt vmcnt(0)" ::: "memory");
            const unsigned og = xb_add(&bar[XB_TOP], 1u);
            const unsigned tg = og / nx;
            if (og + 1u == (tg + 1u) * nx) xb_add(&bar[XB_TOPGEN], 1u);
            else XB_SPIN(xb_ld(&bar[XB_TOPGEN]) == tg, bar);
            __builtin_amdgcn_fence(__ATOMIC_ACQUIRE, "agent");
            xb_add(&bar[XB_XGEN(b.x)], 1u);
            asm volatile("s_waitcnt vmcnt(0)" ::: "memory");
        } else {
            XB_SPIN(xb_ld(&bar[XB_XGEN(b.x)]) == gen, bar);
            __builtin_amdgcn_fence(__ATOMIC_ACQUIRE, "agent");
            asm volatile("s_waitcnt vmcnt(0)" ::: "memory");
        }
    }
    __syncthreads();
}

constexpr int NWAVES = 8;
constexpr int RING_BYTES = 131072, LDSCTL_OFF = RING_BYTES, MISC_OFF = LDSCTL_OFF + 320, LDS_BYTES = 147456;
static_assert(att::LDS_BYTES <= RING_BYTES, "attention scratch inside the ring region");

struct Args {
    const float* in[20]; float* out; unsigned char* ws; int ph_lo, ph_hi;
};

__device__ __forceinline__ float wave_sum(float v) {
#pragma unroll
    for (int o = 1; o < 64; o <<= 1) v += __shfl_xor(v, o);
    return v;
}
__device__ __forceinline__ unsigned f2bf(float f) { unsigned u = __builtin_bit_cast(unsigned, f); return (u + 0x7fffu + ((u >> 16) & 1u)) >> 16; }
__device__ __forceinline__ unsigned pk2(float lo, float hi) { return f2bf(lo) | (f2bf(hi) << 16); }

__device__ __forceinline__ void transpose_item(const float* W, const float* gain, int K, int N, bf16_t* WT, int k0, int n0, int drow0, LAS float* scr, int lane) {
    const int kr = lane >> 3, nq = lane & 7;
    f32x4 v[8]; float gk[8];
#pragma unroll
    for (int i = 0; i < 8; ++i) { v[i] = *(const GAS f32x4*)(W + (size_t)(k0 + kr + 8 * i) * N + n0 + 4 * nq); gk[i] = gain ? gain[k0 + kr + 8 * i] : 1.0f; }
#pragma unroll
    for (int i = 0; i < 8; ++i) { LAS float* d = scr + (kr + 8 * i) * 33 + 4 * nq; d[0] = v[i].x * gk[i]; d[1] = v[i].y * gk[i]; d[2] = v[i].z * gk[i]; d[3] = v[i].w * gk[i]; }
    asm volatile("s_waitcnt lgkmcnt(0)" ::: "memory");
    const int c = lane & 7;
#pragma unroll
    for (int j = 0; j < 4; ++j) { const int n = (lane >> 3) + 8 * j; const LAS float* s = scr + (8 * c) * 33 + n;
        u32x4 o; o.x = pk2(s[0 * 33], s[1 * 33]); o.y = pk2(s[2 * 33], s[3 * 33]); o.z = pk2(s[4 * 33], s[5 * 33]); o.w = pk2(s[6 * 33], s[7 * 33]);
        *(GAS u32x4*)(WT + (size_t)(drow0 + n) * K + k0 + 8 * c) = o; }
    asm volatile("s_waitcnt lgkmcnt(0)" ::: "memory");
}

__device__ __forceinline__ int t5_bucket(int rel) {
    const int n = rel < 0 ? -rel : rel; int b;
    if (n < 8) b = n; else { b = 8 + (n >= 15) + (n >= 27) + (n >= 50) + (n >= 91) + (n >= 166) + (n >= 305) + (n >= 559); if (b > 15) b = 15; }
    return b + (rel > 0 ? 16 : 0);
}
__device__ __forceinline__ void sincos_d(double a, double& s, double& c) {
    const double k = __builtin_rint(a * 0.63661977236758134308);
    const double r = (a - k * 1.57079632679489655800) - k * 6.12323399573676603587e-17;
    const double r2 = r * r;
    double ps = 1.0 / 6227020800.0;
    ps = ps * r2 - 1.0 / 39916800.0; ps = ps * r2 + 1.0 / 362880.0; ps = ps * r2 - 1.0 / 5040.0; ps = ps * r2 + 1.0 / 120.0; ps = ps * r2 - 1.0 / 6.0; ps = ps * r2 + 1.0;
    const double sr = r * ps;
    double pc = -1.0 / 87178291200.0;
    pc = pc * r2 + 1.0 / 479001600.0; pc = pc * r2 - 1.0 / 3628800.0; pc = pc * r2 + 1.0 / 40320.0; pc = pc * r2 - 1.0 / 720.0; pc = pc * r2 + 1.0 / 24.0; pc = pc * r2 - 0.5; pc = pc * r2 + 1.0;
    const int q = ((int)k) & 3;
    s = (q == 0) ? sr : (q == 1) ? pc : (q == 2) ? -sr : -pc;
    c = (q == 0) ? pc : (q == 1) ? -sr : (q == 2) ? -pc : sr;
}

__device__ __forceinline__ float row_to_bf16(const float* xrow, bf16_t* orow, int lane) {
    const GAS f32x4* xr = (const GAS f32x4*)xrow + lane;
    f32x4 v[8]; float s = 0.f;
#pragma unroll
    for (int j = 0; j < 8; ++j) { v[j] = xr[64 * j]; s += (v[j].x * v[j].x + v[j].y * v[j].y) + (v[j].z * v[j].z + v[j].w * v[j].w); }
    GAS u32x2* o8 = (GAS u32x2*)orow + lane;
#pragma unroll
    for (int j = 0; j < 8; ++j) { u32x2 w; w.x = cvt_pk_bf16(v[j].x, v[j].y); w.y = cvt_pk_bf16(v[j].z, v[j].w); o8[64 * j] = w; }
    return wave_sum(s);
}
__device__ __forceinline__ void rms_row_out(const bf16_t* xrow, float* orow, const float* g, float rstd, int lane) {
    const GAS u32x2* xr = (const GAS u32x2*)xrow + lane; GAS f32x4* o = (GAS f32x4*)orow + lane; const GAS f32x4* gr = (const GAS f32x4*)g + lane;
#pragma unroll
    for (int j = 0; j < 8; ++j) { const u32x2 w = xr[64 * j]; const f32x4 gg = gr[64 * j]; f32x4 v = {bflo(w.x), bfhi(w.x), bflo(w.y), bfhi(w.y)}; o[64 * j] = v * rstd * gg; }
}

__device__ __forceinline__ void qknorm_rows(bf16_t* qkv, const float* ropec, const float* ropes, const float* qg, const float* kg, int row_base, int tid) {
    const int lane = tid & 63, wave = tid >> 6;
    const int head = lane >> 3, q8 = lane & 7, hf = q8 >> 2, a = q8 & 3;
    const float* gp = (head < 6) ? qg : kg;
    const float osc = (head < 6) ? 0.088388347648318440f * 1.4426950408889634f : 1.0f;
    float g1[8], g2[8];
#pragma unroll
    for (int e = 0; e < 8; ++e) { g1[e] = gp[hf * 64 + 8 * a + e]; g2[e] = gp[hf * 64 + 32 + 8 * a + e]; }
    for (int t0 = 0; t0 < 32; t0 += 4) {
        u32x4 w1[4], w2[4]; f32x4 cs[4][4];
#pragma unroll
        for (int i = 0; i < 4; ++i) { const int m = row_base + wave + 8 * (t0 + i);
            const int s = (m < NPROMPT) ? (m & (SEQ_P - 1)) : ((m - NPROMPT) & (SEQ_S - 1)); const int n = hf ? (s & 63) : (s >> 6);
            const bf16_t* p1 = qkv + (size_t)m * PROJ + head * HD + hf * 64 + 8 * a;
            w1[i] = *(const GAS u32x4*)p1; w2[i] = *(const GAS u32x4*)(p1 + 32);
            cs[i][0] = *(const GAS f32x4*)(ropec + n * 32 + 8 * a); cs[i][1] = *(const GAS f32x4*)(ropec + n * 32 + 8 * a + 4);
            cs[i][2] = *(const GAS f32x4*)(ropes + n * 32 + 8 * a); cs[i][3] = *(const GAS f32x4*)(ropes + n * 32 + 8 * a + 4); }
#pragma unroll
        for (int i = 0; i < 4; ++i) { const int m = row_base + wave + 8 * (t0 + i);
            bf16_t* p1 = qkv + (size_t)m * PROJ + head * HD + hf * 64 + 8 * a;
            float x1[8], x2[8];
#pragma unroll
            for (int e = 0; e < 4; ++e) { x1[2 * e] = bflo(w1[i][e]); x1[2 * e + 1] = bfhi(w1[i][e]); x2[2 * e] = bflo(w2[i][e]); x2[2 * e + 1] = bfhi(w2[i][e]); }
            float ss = 0.f;
#pragma unroll
            for (int e = 0; e < 8; ++e) ss += x1[e] * x1[e] + x2[e] * x2[e];
            ss += __shfl_xor(ss, 1); ss += __shfl_xor(ss, 2); ss += __shfl_xor(ss, 4);
            const float rstd = 1.0f / sqrtf(ss * (1.f / HD) + RMS_EPS);
            float o1[8], o2[8];
#pragma unroll
            for (int e = 0; e < 8; ++e) { const float cc = e < 4 ? cs[i][0][e & 3] : cs[i][1][e & 3], sn = e < 4 ? cs[i][2][e & 3] : cs[i][3][e & 3];
                const float y1 = x1[e] * rstd * g1[e], y2 = x2[e] * rstd * g2[e]; o1[e] = (y1 * cc - y2 * sn) * osc; o2[e] = (y1 * sn + y2 * cc) * osc; }
            u32x4 r1, r2;
#pragma unroll
            for (int e = 0; e < 4; ++e) { r1[e] = cvt_pk_bf16(o1[2 * e], o1[2 * e + 1]); r2[e] = cvt_pk_bf16(o2[2 * e], o2[2 * e + 1]); }
            *(GAS u32x4*)p1 = r1; *(GAS u32x4*)(p1 + 32) = r2; }
    }
}
__device__ __forceinline__ void crescale_rows(bf16_t* mix, const float* lsebuf, int row_base, int tid) {
    const int lane = tid & 63, wave = tid >> 6;
    for (int t0 = 0; t0 < 32; t0 += 4) {
        float ls[4][6]; u32x2 w[4][3];
#pragma unroll
        for (int i = 0; i < 4; ++i) { const int m = row_base + wave + 8 * (t0 + i);
#pragma unroll
            for (int k = 0; k < 6; ++k) ls[i][k] = lsebuf[(size_t)m * 6 + k];
            const GAS u32x2* p = (const GAS u32x2*)(mix + (size_t)m * MIXW + 1280) + lane;
#pragma unroll
            for (int j = 0; j < 3; ++j) w[i][j] = p[64 * j]; }
#pragma unroll
        for (int i = 0; i < 4; ++i) { const int m = row_base + wave + 8 * (t0 + i);
            float al[6];
#pragma unroll
            for (int j = 0; j < 2; ++j) { const float mx = fmaxf(fmaxf(ls[i][j], ls[i][2 + j]), ls[i][4 + j]);
                const float e0 = __expf(ls[i][j] - mx), e1 = __expf(ls[i][2 + j] - mx), e2 = __expf(ls[i][4 + j] - mx); const float inv = 1.0f / (e0 + e1 + e2);
                al[j] = e0 * inv; al[2 + j] = e1 * inv; al[4 + j] = e2 * inv; }
            GAS u32x2* p = (GAS u32x2*)(mix + (size_t)m * MIXW + 1280) + lane;
#pragma unroll
            for (int j = 0; j < 3; ++j) { const int hc = (4 * lane + 256 * j) >> 7; const float a = (hc == 0) ? al[0] : (hc == 1) ? al[1] : (hc == 2) ? al[2] : (hc == 3) ? al[3] : (hc == 4) ? al[4] : al[5];
                u32x2 v = w[i][j]; v.x = cvt_pk_bf16(bflo(v.x) * a, bfhi(v.x) * a); v.y = cvt_pk_bf16(bflo(v.y) * a, bfhi(v.y) * a); p[64 * j] = v; } }
    }
}

__global__ void __launch_bounds__(NWAVES * 64, 2) fwd(Args args) {
    extern __shared__ __attribute__((aligned(16))) unsigned char lds[];
    LAS unsigned char* ldsl = (LAS unsigned char*)lds;
    volatile LAS unsigned* MISC = (volatile LAS unsigned*)(ldsl + MISC_OFF);
    const int G = gridDim.x;
    unsigned char* ws = args.ws;
    gu32* ctl = (gu32*)(ws + WS_CTL);
    { const int tid0 = threadIdx.x; for (int u = tid0; u < (LDS_BYTES - LDSCTL_OFF) / 4; u += NWAVES * 64) ((LAS unsigned*)(ldsl + LDSCTL_OFF))[u] = 0u; }
    __syncthreads();
    XcdBarrier bar; bar.bar = (unsigned*)ctl + CW_BAR; bar.x = 0; bar.st = nullptr;
    if (ONE_LAUNCH) bar = xcd_barrier_post((unsigned*)ctl + CW_BAR, MISC + 8);
    int bx = blockIdx.x;
    if (ONE_LAUNCH) {
        if (threadIdx.x == 0) { const unsigned xcc = xb_xcc_id(); const unsigned rk = __hip_atomic_fetch_add(ctl + CW_XRANK + 64 * (xcc & 15u), 1u, __ATOMIC_RELAXED, __HIP_MEMORY_SCOPE_AGENT); MISC[12] = rk * 8u + xcc; }
        xcd_barrier(bar);
        if (threadIdx.x == 0) { bool ok = (G % 8 == 0);
            for (unsigned j = 0; j < 16; ++j) { const unsigned cnt = __hip_atomic_load(ctl + CW_XRANK + 64 * j, __ATOMIC_RELAXED, __HIP_MEMORY_SCOPE_AGENT); ok = ok && (cnt == (j < 8 ? (unsigned)G / 8u : 0u)); }
            if (!ok) MISC[12] = blockIdx.x; }
        __syncthreads();
        bx = __builtin_amdgcn_readfirstlane((int)MISC[12]);
    }
    const int lo = args.ph_lo, hi = args.ph_hi;
#ifndef PHMASK
#define PHMASK 0xffff
#endif
#define IN(k) (lo <= (k) && (k) < hi)
#define EN(b) ((PHMASK >> (b)) & 1)
#ifndef PROBE_DUP
#define PROBE_DUP 0
#endif
#define NREP(b) (1 + ((PROBE_DUP >> (b)) & 1))
#define REPSEAM(b) do { if (ONE_LAUNCH && NREP(b) > 1 && rep == 0) xcd_barrier(bar); } while (0)
#define SEAM(k) do { if (ONE_LAUNCH && IN(k) && IN((k) + 1)) xcd_barrier(bar); } while (0)
#define LANE_ID() const int tid = opaque_tid(), lane = tid & 63, wave = __builtin_amdgcn_readfirstlane(tid >> 6); const int vcu = (G % 8 == 0) ? (bx % 8) * (G / 8) + bx / 8 : bx; const int gw = vcu * NWAVES + wave, NGW = G * NWAVES; (void)lane; (void)gw; (void)NGW
#define ROPEC ((float*)(ws + WS_TAB))
#define ROPES (ROPEC + 128 * 32)
#define TABB (ROPES + 128 * 32)
#define TABC (TABB + 4 * 512)
#define LSEBUF ((float*)(ws + WS_LSE))
#define XB ((bf16_t*)(ws + WS_XB))
#define MB ((bf16_t*)(ws + WS_MB))
#define SSBUF ((pg8::ss_t*)(ws + WS_SS))
#define RSM ((pg8::ss_t*)(ws + WS_RSM))
#define QKV ((bf16_t*)(ws + WS_QKV))
#define MIX ((bf16_t*)(ws + WS_MIX))
#define HID ((bf16_t*)(ws + WS_HID))
#define QX ((bf16_t*)(ws + WS_QX))
#define OX ((bf16_t*)(ws + WS_OX))
#define KVX ((bf16_t*)(ws + WS_KVX))
    float* out = args.out;

    if (EN(13) && IN(0)) {
        LANE_ID();
        float* ropec = ROPEC; float* ropes = ROPES; float* tabB = TABB; float* tabC = TABC;
        LAS float* scr = (LAS float*)(ldsl + wave * 16384);
        constexpr int I_IN = 32 * 120, I_OUT = 32 * 64, I_CQ = 32 * 16, I_CKV = 32 * 32, I_CO = 8 * 64, I_FI = 32 * 352, I_FO = 88 * 64;
        constexpr int I_LAYER = I_IN + I_OUT + I_CQ + I_CKV + I_CO + I_FI + I_FO;
        for (int it = gw; it < DEPTH * I_LAYER; it += NGW) {
            const int l = it / I_LAYER; int r = it % I_LAYER;
            const float* W; bf16_t* WT; int K, N; const float* gain = nullptr;
            if (r < I_IN) { gain = args.in[4] + (size_t)l * DM; W = args.in[5] + (size_t)l * DM * PROJ; WT = (bf16_t*)(ws + WS_WIN) + (size_t)l * PROJ * DM; K = DM; N = PROJ; }
            else if ((r -= I_IN) < I_OUT) { W = args.in[10] + (size_t)l * MIXW * DM; WT = (bf16_t*)(ws + WS_WOUT) + (size_t)l * DM * MIXW; K = MIXW; N = DM; }
            else if ((r -= I_OUT) < I_CQ) { gain = args.in[11] + (size_t)l * DM; W = args.in[13] + (size_t)l * DM * XW; WT = (bf16_t*)(ws + WS_WCQ) + (size_t)l * XW * DM; K = DM; N = XW; }
            else if ((r -= I_CQ) < I_CKV) { gain = args.in[12] + (size_t)l * DM; W = args.in[14] + (size_t)l * DM * 2 * XW; WT = (bf16_t*)(ws + WS_WCKV) + (size_t)l * 2 * XW * DM; K = DM; N = 2 * XW; }
            else if ((r -= I_CKV) < I_CO) { W = args.in[15] + (size_t)l * XW * DM; WT = (bf16_t*)(ws + WS_WCO) + (size_t)l * DM * XW; K = XW; N = DM; }
            else if ((r -= I_CO) < I_FI) { gain = args.in[16] + (size_t)l * DM; W = args.in[17] + (size_t)l * DM * 2 * DFF; WT = (bf16_t*)(ws + WS_WFI) + (size_t)l * 2 * DFF * DM; K = DM; N = 2 * DFF; }
            else { r -= I_FI; W = args.in[18] + (size_t)l * DFF * DM; WT = (bf16_t*)(ws + WS_WFO) + (size_t)l * DM * DFF; K = DFF; N = DM; }
            const int nblk = N / 32, kb = r / nblk, nb = r % nblk, n0 = 32 * nb;
            int drow0 = n0;
            if (N == 2 * DFF) drow0 = (n0 < DFF) ? 256 * (n0 / 128) + (n0 % 128) : 256 * ((n0 - DFF) / 128) + 128 + ((n0 - DFF) % 128);
            transpose_item(W, gain, K, N, WT, 64 * kb, n0, drow0, scr, lane);
        }
        { bf16_t* xb = XB; pg8::ss_t* ss0 = SSBUF; bf16_t* mb = MB; pg8::ss_t* rsm = RSM;
          for (int m = gw; m < NTOK; m += NGW) { const float* xr = (m < NPROMPT) ? args.in[0] + (size_t)m * DM : args.in[1] + (size_t)(m - NPROMPT) * DM;
              const float q = row_to_bf16(xr, xb + (size_t)m * DM, lane); if (lane == 0) ss0[m] = (pg8::ss_t)(q * pg8::SS_SCALE); }
          for (int m = gw; m < MEMROWS; m += NGW) { const float* mr = (m < 2 * MEMLEN) ? args.in[2] + (size_t)m * DM : args.in[3] + (size_t)(m - 2 * MEMLEN) * DM;
              const float q = row_to_bf16(mr, mb + (size_t)m * DM, lane); if (lane == 0) rsm[m] = (pg8::ss_t)(q * pg8::SS_SCALE); } }
        const int gt = vcu * (NWAVES * 64) + tid, NGT = G * NWAVES * 64;
        const float* rel_bias = args.in[9];
        for (int e = gt; e < 4096 + 2048 + 3072; e += NGT) {
            if (e < 4096) { const int n = e >> 5, i = e & 31;
                double invd = 1.0; for (int q = 0; q < i; ++q) invd *= 0.7498942093324559;
                const float inv = (float)invd;
                const float ang = (float)n * inv; double s, c; sincos_d((double)ang, s, c); ropec[e] = (float)c; ropes[e] = (float)s; }
            else if (e < 4096 + 2048) { const int t = e - 4096, h = t >> 9, i = t & 511; const int rel = i - 96 - 128;
                float v = -INFINITY; if (rel >= -128 && rel <= 128) v = rel_bias[t5_bucket(rel) * 10 + h] * att::LOG2E;
                tabB[t] = v; }
            else { const int t = e - 6144, hc = t >> 9, i = t & 511; const int off = i - 96 - 64; const int d = (hc < 2) ? 1 : (hc < 4) ? 4 : 16;
                float v = -INFINITY; if (off >= -64 && off <= 64) v = rel_bias[t5_bucket(off * d) * 10 + 4 + hc] * att::LOG2E;
                tabC[t] = v; }
        }
    }
    SEAM(0);

    for (int l = 0; l < DEPTH; ++l) {
        const int pb = 1 + PPL * l;
#define XS0 ((l == 0) ? args.in[0] : (const float*)out)
#define XS1 ((l == 0) ? args.in[1] : (const float*)out + (size_t)NPROMPT * DM)
        if (EN(0) && IN(pb + 0)) for (int rep = 0; rep < NREP(0); ++rep) {
            { const bf16_t* Win = (const bf16_t*)(ws + WS_WIN) + (size_t)l * PROJ * DM; const bool tail = (G == 256) && l > 0;
              pg8::Gemm g{XB, Win, NTOK, PROJ, DM}; pg8::StaticOrder S; S.init(NTOK, PROJ, G, bx, 0, tail ? 11 : (1 << 30));
              pg8::EpiBf16 E{QKV, PROJ, SSBUF + (size_t)(3 * l) * NTOK};
              pg8::gemm_phase<pg8::EpiBf16, pg8::StaticOrder, true, true>(ldsl, g, S, E);
              if (tail) {
                  if (threadIdx.x == 0) MISC[13] = __hip_atomic_fetch_add(ctl + CW_TAIL + 64 * l, 1u, __ATOMIC_RELAXED, __HIP_MEMORY_SCOPE_AGENT);
                  __syncthreads(); const int slot = __builtin_amdgcn_readfirstlane((int)MISC[13]); __syncthreads();
                  pg8::TailHalfOrder T; T.init(NTOK, PROJ, G, slot, 11); pg8::EpiBf16H EH{QKV, PROJ, SSBUF + (size_t)(3 * l) * NTOK};
                  pg8::gemm_phase<pg8::EpiBf16H, pg8::TailHalfOrder, true, true, true>(ldsl, g, T, EH); } }
            if (l == 0) {
              pg8::Gemm g{MB, (const bf16_t*)(ws + WS_WCKV), MEMROWS, 4 * 2 * XW, DM}; pg8::StaticOrder S; S.init(MEMROWS, 4 * 2 * XW, G, (bx + G - 64) % G);
              pg8::EpiBf16 E{KVX, 4 * 2 * XW, RSM};
              pg8::gemm_phase<pg8::EpiBf16, pg8::StaticOrder, true, true>(ldsl, g, S, E); }
            REPSEAM(0);
        }
        SEAM(pb + 0);
        if (EN(1) && IN(pb + 1)) {
            const int tid = opaque_tid(); const float* tabC = TABC; float* lsebuf = LSEBUF;
            gu32* qhead = ctl + CW_QUEUE + 64 * (2 * l);
            volatile LAS unsigned* uidw = (volatile LAS unsigned*)(ldsl + att::OFF_UID);
            for (;;) {
                if (tid == 0) uidw[0] = __hip_atomic_fetch_add(qhead, 1u, __ATOMIC_RELAXED, __HIP_MEMORY_SCOPE_AGENT);
                __syncthreads();
                const int u = (int)uidw[0];
                __syncthreads();
                if (u >= 1344) break;
                if (u < 960 && u % 5 == 4) {
                    qknorm_rows(QKV, ROPEC, ROPES, args.in[6] + (size_t)l * HD, args.in[7] + (size_t)l * HD, (u / 5) * 256, tid);
                } else { const int v0 = (u < 960) ? u - u / 5 : u - 192;
                {
                    const int v = v0, gi = v % 3, idx = v / 3; const int d = (gi == 0) ? 1 : (gi == 1) ? 4 : 16;
                    long row0; int j, L;
                    if (idx < 128) { row0 = (long)(idx / 64) * SEQ_P; j = idx % 64; L = SEQ_P; } else { const int i2 = idx - 128; row0 = NPROMPT + (long)(i2 / 32) * SEQ_S; j = i2 % 32; L = SEQ_S; }
                    const int res = j % d, qbr = j / d, p0 = qbr * 128, Lr = L / d;
                    int tlo = p0 / 64 - 1, thi = p0 / 64 + 3; if (tlo < 0) tlo = 0; if (thi > Lr / 64) thi = Lr / 64;
                    const long rq = row0 + (long)p0 * d + res, rk = row0 + res; const int hc = 2 * gi;
                    att::attn_unit<true>(QKV + rq * PROJ + COL_QC + hc * HD, (long)d * PROJ, QKV + rk * PROJ + COL_KC + gi * HD, QKV + rk * PROJ + COL_VC + gi * HD, (long)d * PROJ,
                                         MIX + rq * MIXW + 1280 + hc * HD, (long)d * MIXW, tlo, thi, p0, 64, tabC + hc * 512, 321, -1e30f, -1e30f, 0.f, lsebuf + rq * 6 + hc, (long)d * 6, (char*)lds);
                } }
            }
        }
        SEAM(pb + 1);
        if (EN(2) && IN(pb + 2)) for (int rep = 0; rep < NREP(2); ++rep) {
            const int tid = opaque_tid(); const float* tabB = TABB;
            float mfix2;
            { const float* qg = args.in[6] + (size_t)l * HD; const float* kg = args.in[7] + (size_t)l * HD; const int ln = tid & 63;
              float a = fmaxf(fabsf(qg[ln]), fabsf(qg[ln + 64])), b = fmaxf(fabsf(kg[ln]), fabsf(kg[ln + 64]));
#pragma unroll
              for (int o = 1; o < 64; o <<= 1) { a = fmaxf(a, __shfl_xor(a, o)); b = fmaxf(b, __shfl_xor(b, o)); }
              mfix2 = __builtin_amdgcn_readfirstlane(128.f * a * b * 1.02f * att::C); if (!(mfix2 <= 40.f)) mfix2 = -1.f; }
            gu32* qhead = ctl + CW_QUEUE + 64 * (2 * l + 1 + 8 * rep);
            volatile LAS unsigned* uidw = (volatile LAS unsigned*)(ldsl + att::OFF_UID);
            const float* sink = args.in[8] + (size_t)l * 4;
            for (;;) {
                if (tid == 0) uidw[0] = __hip_atomic_fetch_add(qhead, 1u, __ATOMIC_RELAXED, __HIP_MEMORY_SCOPE_AGENT);
                __syncthreads();
                const int u = (int)uidw[0];
                __syncthreads();
                if (u >= 1152 + 192 + 768) break;
                if (u < 1152) {
                    int seq, kvh, qb, gi, L;
                    if (u < 384) { seq = u / 192; const int r = u % 192; kvh = r / 96; const int r2 = r % 96; qb = r2 / 3; gi = r2 % 3; L = SEQ_P; }
                    else { const int v = u - 384; seq = 2 + v / 96; const int r = v % 96; kvh = r / 48; const int r2 = r % 48; qb = r2 / 3; gi = r2 % 3; L = SEQ_S; }
                    const long row0 = (seq < 2) ? (long)seq * SEQ_P : (long)NPROMPT + (long)(seq - 2) * SEQ_S;
                    const int h = kvh * 3 + gi;
                    att::attn_unit_dense<true>(QKV + (row0 + qb * 256) * PROJ + COL_QA + h * HD, PROJ, QKV + row0 * PROJ + COL_KA + kvh * HD, QKV + row0 * PROJ + COL_VA + kvh * HD, PROJ,
                                         MIX + (row0 + qb * 256) * MIXW + h * HD, MIXW, L / 64, mfix2, (char*)lds);
                } else if (u < 1344) { if (rep == 0) crescale_rows(MIX, LSEBUF, (u - 1152) * 256, tid); }
                else {
                    const int v = u - 1344, qbg = v >> 1, kvh = v & 1; const long rowq = (long)qbg * 128;
                    long row0; int pos0, L;
                    if (rowq < NPROMPT) { row0 = (rowq / SEQ_P) * SEQ_P; pos0 = (int)(rowq % SEQ_P); L = SEQ_P; } else { const long rr = rowq - NPROMPT; row0 = NPROMPT + (rr / SEQ_S) * SEQ_S; pos0 = (int)(rr % SEQ_S); L = SEQ_S; }
                    int tlo = pos0 / 64 - 2, thi = pos0 / 64 + 4; if (tlo < 0) tlo = 0; if (thi > L / 64) thi = L / 64;
                    const int h = 2 * kvh;
                    att::attn_unit<true>(QKV + rowq * PROJ + COL_QB + h * HD, PROJ, QKV + row0 * PROJ + COL_KB + kvh * HD, QKV + row0 * PROJ + COL_VB + kvh * HD, PROJ,
                                         MIX + rowq * MIXW + 768 + h * HD, MIXW, tlo, thi, pos0, 128, tabB + h * 512, 449, sink[h] * att::LOG2E, sink[h + 1] * att::LOG2E, 1.0f, nullptr, 0, (char*)lds);
                }
            }
            REPSEAM(2);
        }
        SEAM(pb + 2);
        if (EN(3) && IN(pb + 3)) for (int rep = 0; rep < NREP(3); ++rep) {
            const bf16_t* Wout = (const bf16_t*)(ws + WS_WOUT) + (size_t)l * DM * MIXW;
            pg8::Gemm g{MIX, Wout, NTOK, DM, MIXW}; pg8::StaticOrder S; S.init(NTOK, DM, G, bx);
            pg8::EpiRes E{XB, SSBUF + (size_t)(rep ? NNORM : 3 * l + 1) * NTOK, rep ? 0.f : 1.f};
            pg8::gemm_phase<pg8::EpiRes, pg8::StaticOrder, true, true>(ldsl, g, S, E);
            REPSEAM(3);
        }
        SEAM(pb + 3);
        if (EN(4) && IN(pb + 4)) for (int rep = 0; rep < NREP(4); ++rep) {
            const bf16_t* Wcq = (const bf16_t*)(ws + WS_WCQ) + (size_t)l * XW * DM;
            const bool tail = (G == 256);
            pg8::Gemm g{XB, Wcq, NTOK, XW, DM}; pg8::StaticOrder S; S.init(NTOK, XW, G, bx, 0, tail ? 1 : (1 << 30)); pg8::EpiBf16 E{QX, XW, SSBUF + (size_t)(3 * l + 1) * NTOK};
            pg8::gemm_phase<pg8::EpiBf16, pg8::StaticOrder, true, true>(ldsl, g, S, E);
            if (tail) { pg8::TailHalfOrder T; T.init(NTOK, XW, G, bx, 1); pg8::EpiBf16H EH{QX, XW, SSBUF + (size_t)(3 * l + 1) * NTOK};
                pg8::gemm_phase<pg8::EpiBf16H, pg8::TailHalfOrder, true, true, true>(ldsl, g, T, EH); }
            REPSEAM(4);
        }
        SEAM(pb + 4);
        if (EN(5) && IN(pb + 5)) for (int rep = 0; rep < NREP(5); ++rep) {
            for (int u = bx; u < 768; u += G) {
                const int qbg = u >> 2, h = u & 3; const long rowq = (long)qbg * 256;
                const int seq = (rowq < NPROMPT) ? (int)(rowq / SEQ_P) : 2 + (int)((rowq - NPROMPT) / SEQ_S);
                const bf16_t* kb = KVX + (size_t)seq * MEMLEN * (4 * 2 * XW) + l * (2 * XW) + h * HD;
                att::attn_unit_dense<false>(QX + rowq * XW + h * HD, XW, kb, kb + XW, 4 * 2 * XW, OX + rowq * XW + h * HD, XW, MEMLEN / 64, -1.f, (char*)lds);
            }
            REPSEAM(5);
        }
        SEAM(pb + 5);
        if (EN(6) && IN(pb + 6)) for (int rep = 0; rep < NREP(6); ++rep) {
            const bf16_t* Wco = (const bf16_t*)(ws + WS_WCO) + (size_t)l * DM * XW;
            pg8::Gemm g{OX, Wco, NTOK, DM, XW}; pg8::StaticOrder S; S.init(NTOK, DM, G, bx);
            pg8::EpiRes E{XB, SSBUF + (size_t)(rep ? NNORM : 3 * l + 2) * NTOK, rep ? 0.f : 1.f};
            pg8::gemm_phase<pg8::EpiRes, pg8::StaticOrder, true, true>(ldsl, g, S, E);
            REPSEAM(6);
        }
        SEAM(pb + 6);
        if (EN(7) && IN(pb + 7)) for (int rep = 0; rep < NREP(7); ++rep) {
            const bf16_t* Wfi = (const bf16_t*)(ws + WS_WFI) + (size_t)l * 2 * DFF * DM;
            const bool dyn = (G == 256) && NREP(7) == 1;
            pg8::Gemm g{XB, Wfi, NTOK, 2 * DFF, DM}; pg8::StaticOrder S; S.init(NTOK, 2 * DFF, G, bx, 0, dyn ? 32 : (1 << 30));
            pg8::EpiSwiglu E{HID, DFF, SSBUF + (size_t)(3 * l + 2) * NTOK};
            pg8::gemm_phase<pg8::EpiSwiglu, pg8::StaticOrder, true, true>(ldsl, g, S, E);
            if (dyn) {
                if (threadIdx.x == 0) MISC[13] = __hip_atomic_fetch_add(ctl + CW_TAIL + 64 * (4 + l), 1u, __ATOMIC_RELAXED, __HIP_MEMORY_SCOPE_AGENT);
                __syncthreads(); const int slot1 = __builtin_amdgcn_readfirstlane((int)MISC[13]); __syncthreads();
                if (slot1 < G) { pg8::StaticOrder S1; S1.init(NTOK, 2 * DFF, G, slot1, 32, 33);
                    pg8::gemm_phase<pg8::EpiSwiglu, pg8::StaticOrder, true, true>(ldsl, g, S1, E);
                    if (threadIdx.x == 0) MISC[13] = __hip_atomic_fetch_add(ctl + CW_TAIL + 64 * (4 + l), 1u, __ATOMIC_RELAXED, __HIP_MEMORY_SCOPE_AGENT);
                    __syncthreads(); const int slot2 = __builtin_amdgcn_readfirstlane((int)MISC[13]); __syncthreads();
                    if (slot2 < G) { pg8::StaticOrder S2; S2.init(NTOK, 2 * DFF, G, slot2, 32, 33);
                        pg8::gemm_phase<pg8::EpiSwiglu, pg8::StaticOrder, true, true>(ldsl, g, S2, E); } } }
            REPSEAM(7);
        }
        SEAM(pb + 7);
        if (EN(8) && IN(pb + 8)) for (int rep = 0; rep < NREP(8); ++rep) {
            const bf16_t* Wfo = (const bf16_t*)(ws + WS_WFO) + (size_t)l * DM * DFF;
            pg8::Gemm g{HID, Wfo, NTOK, DM, DFF}; pg8::StaticOrder S; S.init(NTOK, DM, G, bx);
            pg8::EpiRes E{XB, SSBUF + (size_t)(rep ? NNORM : 3 * l + 3) * NTOK, rep ? 0.f : 1.f};
            pg8::gemm_phase<pg8::EpiRes, pg8::StaticOrder, true, true>(ldsl, g, S, E);
            REPSEAM(8);
        }
        SEAM(pb + 8);
    }
    if (EN(14) && IN(NPHASE - 1)) {
        LANE_ID();
        const float* g = args.in[19]; const pg8::ss_t* ssl = SSBUF + (size_t)(NNORM - 1) * NTOK;
        f32x4 gg[8];
#pragma unroll
        for (int j = 0; j < 8; ++j) gg[j] = ((const GAS f32x4*)g)[lane + 64 * j];
        for (int m = gw; m < NTOK; m += 4 * NGW) {
            u32x2 w[4][8]; float rstd[4];
#pragma unroll
            for (int i = 0; i < 4; ++i) { const int mi = m + i * NGW; const int mc = mi < NTOK ? mi : m;
                rstd[i] = __builtin_amdgcn_rsqf((float)ssl[mc] * pg8::SS_INV_MEAN + RMS_EPS);
#pragma unroll
                for (int j = 0; j < 8; ++j) w[i][j] = ((const GAS u32x2*)(XB + (size_t)mc * DM))[lane + 64 * j]; }
#pragma unroll
            for (int i = 0; i < 4; ++i) { const int mi = m + i * NGW; if (mi < NTOK) { GAS f32x4* o = (GAS f32x4*)(out + (size_t)mi * DM) + lane;
#pragma unroll
                for (int j = 0; j < 8; ++j) { const f32x4 v = {bflo(w[i][j].x), bfhi(w[i][j].x), bflo(w[i][j].y), bfhi(w[i][j].y)}; o[64 * j] = v * rstd[i] * gg[j]; } } }
        }
    }
#undef IN
#undef SEAM
}

extern "C" void kernel_launch(void* const* d_in, const int* in_sizes, int n_in, void* d_out, int out_size, void* d_ws, size_t ws_size, hipStream_t stream) {
    static int grid = 0;
    if (grid == 0) {
        if (n_in != 20 || out_size != NTOK * DM || ws_size < WS_END) { fprintf(stderr, "kernel_launch: unexpected shapes: n_in %d out %d ws %zu (need %zu)\n", n_in, out_size, ws_size, (size_t)WS_END); grid = -1; return; }
        int dev = 0, cus = 0, per_cu = 0;
        if (hipGetDevice(&dev) != hipSuccess || hipDeviceGetAttribute(&cus, hipDeviceAttributeMultiprocessorCount, dev) != hipSuccess) { grid = -1; return; }
        if (hipFuncSetAttribute((const void*)fwd, hipFuncAttributeMaxDynamicSharedMemorySize, LDS_BYTES) != hipSuccess) { fprintf(stderr, "kernel_launch: hipFuncSetAttribute failed\n"); grid = -1; return; }
        if (hipOccupancyMaxActiveBlocksPerMultiprocessor(&per_cu, (const void*)fwd, NWAVES * 64, LDS_BYTES) != hipSuccess || per_cu < 1) { fprintf(stderr, "kernel_launch: occupancy query says %d\n", per_cu); }
        (void)hipGetLastError();
        grid = cus;
    }
    if (grid < 0) return;
    (void)hipMemsetAsync((char*)d_ws + WS_CTL, 0, CTL_ZERO_BYTES, stream);
    Args a{};
    for (int i = 0; i < 20; ++i) a.in[i] = (const float*)d_in[i];
    a.out = (float*)d_out; a.ws = (unsigned char*)d_ws;
#if ONE_LAUNCH
    a.ph_lo = 0; a.ph_hi = NPHASE;
    hipLaunchKernelGGL(fwd, dim3(grid), dim3(NWAVES * 64), LDS_BYTES, stream, a);
#else
    for (int p = 0; p < NPHASE; ++p) { a.ph_lo = p; a.ph_hi = p + 1; hipLaunchKernelGGL(fwd, dim3(grid), dim3(NWAVES * 64), LDS_BYTES, stream, a); }
#endif
    const hipError_t le = hipPeekAtLastError();
    if (le != hipSuccess) fprintf(stderr, "kernel_launch: launch failed: %s\n", hipGetErrorName(le));
}
```

```cpp
#include <hip/hip_runtime.h>
#include <cstdio>
#include <cstdint>

#ifndef ONE_LAUNCH
#define ONE_LAUNCH 1
#endif

constexpr int DM = 2048, NTOK = 49152, NPROMPT = 16384, SEQ_P = 8192, SEQ_S = 4096, DEPTH = 4;
constexpr int PROJ = 3840, MIXW = 2048, XW = 512, DFF = 5632, MEMLEN = 256, MEMROWS = 2560, HD = 128;
constexpr int COL_QA = 0, COL_KA = 768, COL_VA = 1024, COL_QB = 1280, COL_KB = 1792, COL_VB = 2048, COL_QC = 2304, COL_KC = 3072, COL_VC = 3456;
constexpr float RMS_EPS = 1e-6f;
constexpr int PPL = 9;
constexpr int NPHASE = 2 + PPL * DEPTH;
constexpr int NNORM = 3 * DEPTH + 1;

constexpr size_t MiB = 1u << 20;
constexpr size_t WS_CTL = 0;
constexpr size_t WS_SS = 1 * MiB;
constexpr size_t CTL_ZERO_BYTES = 6 * MiB + 512 * 1024;
static_assert(WS_SS + (size_t)(NNORM + 1) * NTOK * 8 <= CTL_ZERO_BYTES, "ss inside the memset region");
constexpr size_t WS_TAB = 6 * MiB + 512 * 1024;
constexpr size_t WS_RSM = 7 * MiB;
constexpr size_t WS_LSE = 618 * MiB;
constexpr size_t WS_WIN = 8 * MiB, WS_WOUT = 68 * MiB, WS_WCQ = 100 * MiB, WS_WCKV = 108 * MiB, WS_WCO = 124 * MiB, WS_WFI = 132 * MiB, WS_WFO = 308 * MiB;
constexpr size_t WS_XB = 396 * MiB;
constexpr size_t WS_MB = 588 * MiB;
constexpr size_t WS_KVX = 598 * MiB;
constexpr size_t WS_QKV = 620 * MiB;
constexpr size_t WS_MIX = 980 * MiB;
constexpr size_t WS_HID = 620 * MiB;
constexpr size_t WS_QX = 620 * MiB, WS_OX = 668 * MiB;
constexpr size_t WS_END = 1172 * MiB;
constexpr int CW_BAR = 4096;
constexpr int CW_XRANK = 12288;
constexpr int CW_TAIL = 24576;
constexpr int CW_QUEUE = 16384;

#define GAS __attribute__((address_space(1)))
#define LAS __attribute__((address_space(3)))
typedef unsigned short bf16_t;
typedef short bf16x8 __attribute__((ext_vector_type(8)));
typedef short s16x4 __attribute__((ext_vector_type(4)));
typedef float f32x4 __attribute__((ext_vector_type(4)));
typedef float f32x16 __attribute__((ext_vector_type(16)));
typedef unsigned u32x4 __attribute__((ext_vector_type(4)));
typedef unsigned u32x2 __attribute__((ext_vector_type(2)));
typedef GAS unsigned gu32;

__device__ __forceinline__ int opaque_tid() { int t = threadIdx.x; asm volatile("" : "+v"(t)); return t; }
__device__ __forceinline__ unsigned cvt_pk_bf16(float lo, float hi) { unsigned r; asm volatile("v_cvt_pk_bf16_f32 %0, %1, %2" : "=v"(r) : "v"(lo), "v"(hi)); return r; }
__device__ __forceinline__ float bf2f(unsigned short b) { return __builtin_bit_cast(float, (unsigned)b << 16); }
__device__ __forceinline__ float bflo(unsigned w) { return __builtin_bit_cast(float, w << 16); }
__device__ __forceinline__ float bfhi(unsigned w) { return __builtin_bit_cast(float, w & 0xffff0000u); }

namespace pg8 {
#define PG8_LAS __attribute__((address_space(3)))
constexpr int BM = 256, BK = 64, HALF = 128, HTB = HALF * BK * 2, STAGE_BYTES = 8 * HTB, NXCD = 8, WGM = 4;
__host__ __device__ __forceinline__ int lds_byte(int r, int c) { const int st = (r >> 4) * 2 + (c >> 5), rr = r & 15, cc = c & 31, ob = rr * 64 + cc * 2; return st * 1024 + (ob ^ (((ob >> 9) & 1) << 5)); }
__host__ __device__ __forceinline__ void stage_rc(int b, int& R, int& C) { const int st = b / 1024, sb = b % 1024, swz = sb ^ (((sb >> 9) & 1) << 5); R = (st >> 1) * 16 + swz / 64; C = (st & 1) * 32 + (swz % 64) / 2; }
__host__ __device__ __forceinline__ int perm32(int rho) { const int n = rho >> 4, i = rho & 15; return 8 * (i >> 2) + 4 * n + (i & 3); }

struct Unit { int pm, pn; };
struct Gemm { const bf16_t* A; const bf16_t* Bt; int M, N, K; };

struct StaticOrder {
    int nM, nN, nwg, G, c, i_lo, i_hi, wgm = WGM;
    __host__ __device__ void init(int M, int N, int G_, int c_, int lo_ = 0, int hi_ = 1 << 30) { nM = M / BM; nN = N / BM; nwg = nM * nN; G = G_; c = c_; i_lo = lo_; i_hi = hi_; }
    __host__ __device__ bool next(int i, Unit& u) const {
        i += i_lo; if (i >= i_hi) return false;
        const long L = (long)i * G + c; if (L >= nwg) return false;
        int wgid = (int)L; { const int q = nwg / NXCD, r = nwg % NXCD, xcd = wgid % NXCD, off = wgid / NXCD; wgid = (xcd < r ? xcd * (q + 1) : r * (q + 1) + (xcd - r) * q) + off; }
        const int nig = wgm * nN, gid = wgid / nig, fm = gid * wgm, gsz = (nM - fm) < wgm ? (nM - fm) : wgm;
        u.pm = fm + ((wgid % nig) % gsz); u.pn = (wgid % nig) / gsz; return true;
    }
    __device__ __forceinline__ void a_ready(const Unit&) const {}
    __device__ __forceinline__ void done(const Unit&) const {}
};

struct TailHalfOrder {
    StaticOrder F; int c;
    __host__ __device__ void init(int M, int N, int G_, int c_, int round) { F.init(M, N, G_, c_ >> 1, round, round + 1); c = c_; }
    __host__ __device__ bool next(int i, Unit& u) const { if (i != 0) return false; Unit f; if (!F.next(0, f)) return false; u.pm = f.pm; u.pn = 2 * f.pn + (c & 1); return true; }
    __device__ __forceinline__ void a_ready(const Unit&) const {}
    __device__ __forceinline__ void done(const Unit&) const {}
};

typedef unsigned long long ss_t;
constexpr float SS_SCALE = 16777216.0f, SS_INV_MEAN = 1.0f / (16777216.0f * 2048.0f);
struct PreSS { ss_t v[2][4]; };
struct PreNone {};
__device__ __forceinline__ unsigned lane_perm(int src4, unsigned v) { return (unsigned)__builtin_amdgcn_ds_bpermute(src4, (int)v); }
__device__ __forceinline__ void ss_prefetch(PreSS& p, const ss_t* ss, int row0) {
#pragma unroll
    for (int ai = 0; ai < 2; ++ai)
#pragma unroll
        for (int m = 0; m < 4; ++m) p.v[ai][m] = ss[row0 + ai * HALF + m * 16];
}
__device__ __forceinline__ void row_rstd(const PreSS& p, float (&rs)[2][4]) {
#pragma unroll
    for (int ai = 0; ai < 2; ++ai)
#pragma unroll
        for (int m = 0; m < 4; ++m) {
            const ss_t v = p.v[ai][m]; const float f = (float)(unsigned)(v >> 32) * 4294967296.0f + (float)(unsigned)v;
            rs[ai][m] = __builtin_amdgcn_rsqf(f * SS_INV_MEAN + 1e-6f); }
}
template <int NBJ>
struct EpiBf16T {
    static constexpr bool PERM = true, AFTER_DRAIN = false;
    bf16_t* O; int ldc; const ss_t* ss;
    typedef PreSS Pre;
    __device__ __forceinline__ void prefetch(Pre& p, const Unit& u, int wr, int fr) const { ss_prefetch(p, ss, u.pm * BM + wr * 64 + fr); }
    __device__ __forceinline__ void operator()(const f32x4 (&acc)[2][2][4][2], const Unit& u, int wr, int wc, int fr, int fq, const Pre& pre) const {
        const int row0 = u.pm * BM + wr * 64 + fr; const int col0 = u.pn * (NBJ * HALF) + wc * 32 + 8 * fq;
        float rs[2][4]; row_rstd(pre, rs);
#pragma unroll
        for (int ai = 0; ai < 2; ++ai)
#pragma unroll
            for (int m = 0; m < 4; ++m) { bf16_t* rowp = O + (size_t)(row0 + ai * HALF + m * 16) * ldc + col0; const float r = rs[ai][m];
#pragma unroll
                for (int bj = 0; bj < NBJ; ++bj) { const f32x4 v0 = acc[ai][bj][m][0] * r, v1 = acc[ai][bj][m][1] * r;
                    u32x4 w; w.x = cvt_pk_bf16(v0[0], v0[1]); w.y = cvt_pk_bf16(v0[2], v0[3]); w.z = cvt_pk_bf16(v1[0], v1[1]); w.w = cvt_pk_bf16(v1[2], v1[3]);
                    *(u32x4*)(rowp + bj * HALF) = w; } }
    }
};
typedef EpiBf16T<2> EpiBf16; typedef EpiBf16T<1> EpiBf16H;
struct EpiRes {
    static constexpr bool PERM = true, AFTER_DRAIN = false;
    bf16_t* xb; ss_t* ssout; float scale;
    typedef PreNone Pre;
    __device__ __forceinline__ void prefetch(Pre&, const Unit&, int, int) const {}
    __device__ __forceinline__ void operator()(const f32x4 (&acc)[2][2][4][2], const Unit& u, int wr, int wc, int fr, int fq, const Pre&) const {
        const int row0 = u.pm * BM + wr * 64 + fr; const int col0 = u.pn * BM + wc * 32 + 8 * fq;
        bf16_t* xbase = xb + (size_t)row0 * DM + col0;
        const int pl = fq * 16 + fr, psrc = (4 * fr + fq) * 4;
        const bf16_t* xload = xb + (size_t)(u.pm * BM + wr * 64 + (pl >> 2)) * DM + u.pn * BM + wc * 32 + 8 * (pl & 3);
#pragma unroll
        for (int ai = 0; ai < 2; ++ai) { float sq[4];
            u32x4 xv[4][2];
#pragma unroll
            for (int m = 0; m < 4; ++m)
#pragma unroll
                for (int bj = 0; bj < 2; ++bj) xv[m][bj] = *(const u32x4*)(xload + (size_t)(ai * HALF + m * 16) * DM + bj * HALF);
#pragma unroll
            for (int m = 0; m < 4; ++m) { bf16_t* bp = xbase + (size_t)(ai * HALF + m * 16) * DM;
                float q = 0.f;
#pragma unroll
                for (int bj = 0; bj < 2; ++bj) { const u32x4 xq = xv[m][bj]; u32x4 xw; xw.x = lane_perm(psrc, xq.x); xw.y = lane_perm(psrc, xq.y); xw.z = lane_perm(psrc, xq.z); xw.w = lane_perm(psrc, xq.w);
                    const f32x4 d0 = acc[ai][bj][m][0] * scale, d1 = acc[ai][bj][m][1] * scale;
                    u32x4 w; w.x = cvt_pk_bf16(bflo(xw.x) + d0[0], bfhi(xw.x) + d0[1]); w.y = cvt_pk_bf16(bflo(xw.y) + d0[2], bfhi(xw.y) + d0[3]);
                    w.z = cvt_pk_bf16(bflo(xw.z) + d1[0], bfhi(xw.z) + d1[1]); w.w = cvt_pk_bf16(bflo(xw.w) + d1[2], bfhi(xw.w) + d1[3]);
                    *(u32x4*)(bp + bj * HALF) = w;
                    const float e0 = bflo(w.x), e1 = bfhi(w.x), e2 = bflo(w.y), e3 = bfhi(w.y), e4 = bflo(w.z), e5 = bfhi(w.z), e6 = bflo(w.w), e7 = bfhi(w.w);
                    q += (e0 * e0 + e1 * e1) + (e2 * e2 + e3 * e3) + (e4 * e4 + e5 * e5) + (e6 * e6 + e7 * e7); }
                sq[m] = q; }
            asm volatile("" ::: "memory");
            const bool b0 = fq & 1, b1 = fq & 2;
            const float w0 = (b0 ? sq[1] : sq[0]) + __shfl_xor(b0 ? sq[0] : sq[1], 16), w1 = (b0 ? sq[3] : sq[2]) + __shfl_xor(b0 ? sq[2] : sq[3], 16);
            const float tot = (b1 ? w1 : w0) + __shfl_xor(b1 ? w0 : w1, 32);
            __hip_atomic_fetch_add(ssout + u.pm * BM + ai * HALF + wr * 64 + fq * 16 + fr, (ss_t)(tot * SS_SCALE), __ATOMIC_RELAXED, __HIP_MEMORY_SCOPE_AGENT); }
    }
};
struct EpiSwiglu {
    static constexpr bool PERM = true, AFTER_DRAIN = false;
    bf16_t* O; int ldc; const ss_t* ss;
    typedef PreSS Pre;
    __device__ __forceinline__ void prefetch(Pre& p, const Unit& u, int wr, int fr) const { ss_prefetch(p, ss, u.pm * BM + wr * 64 + fr); }
    __device__ __forceinline__ void operator()(const f32x4 (&acc)[2][2][4][2], const Unit& u, int wr, int wc, int fr, int fq, const Pre& pre) const {
        const int row0 = u.pm * BM + wr * 64 + fr; const int col0 = u.pn * HALF + wc * 32 + 8 * fq;
        float rs[2][4]; row_rstd(pre, rs);
#pragma unroll
        for (int ai = 0; ai < 2; ++ai)
#pragma unroll
            for (int m = 0; m < 4; ++m) {
                const float r = rs[ai][m], c = -1.4426950408889634f * r, r2 = r * r;
                const f32x4 g0 = acc[ai][0][m][0], g1 = acc[ai][0][m][1], u0 = acc[ai][1][m][0], u1 = acc[ai][1][m][1];
                const f32x4 t0 = g0 * c, t1 = g1 * c;
                f32x4 e0, e1;
#pragma unroll
                for (int i = 0; i < 4; ++i) { e0[i] = __builtin_amdgcn_exp2f(t0[i]); e1[i] = __builtin_amdgcn_exp2f(t1[i]); }
                const f32x4 d0 = e0 + 1.0f, d1 = e1 + 1.0f;
                f32x4 q0, q1;
#pragma unroll
                for (int i = 0; i < 4; ++i) { q0[i] = __builtin_amdgcn_rcpf(d0[i]); q1[i] = __builtin_amdgcn_rcpf(d1[i]); }
                const f32x4 h0 = (g0 * u0) * (q0 * r2), h1 = (g1 * u1) * (q1 * r2);
                u32x4 w; w.x = cvt_pk_bf16(h0[0], h0[1]); w.y = cvt_pk_bf16(h0[2], h0[3]); w.z = cvt_pk_bf16(h1[0], h1[1]); w.w = cvt_pk_bf16(h1[2], h1[3]);
                *(u32x4*)(O + (size_t)(row0 + ai * HALF + m * 16) * ldc + col0) = w; }
    }
};

template <class Epi, class Sched, bool ALIGN_EPI = false, bool SP2 = false, bool HALFN = false>
__device__ __forceinline__ void gemm_phase(PG8_LAS unsigned char* lds, const Gemm g, const Sched& S, const Epi& E) {
    const int tid = opaque_tid(), wid = __builtin_amdgcn_readfirstlane(tid >> 6), lane = tid & 63, wr = wid >> 2, wc = wid & 3, fr = lane & 15, fq = lane >> 4;
    const int K = g.K, nt = K / BK;
    unsigned voffA[2], voffB[2];
#pragma unroll
    for (int i = 0; i < 2; ++i) { int R, C; stage_rc(tid * 16 + i * 8192, R, C); const int Rb = Epi::PERM ? ((R & ~31) + perm32(R & 31)) : R;
        voffA[i] = (unsigned)(R * K + C) * 2u; voffB[i] = (unsigned)(Rb * K + C) * 2u; }
    const size_t kstep = (size_t)(BK * 2);
    const size_t hstep = (size_t)HALF * K * 2;
    const size_t tstep = 2 * hstep;
    const size_t bstep = HALFN ? hstep : tstep;
    const unsigned ldsw = (unsigned)wid * 1024u;
    const int aoff = lds_byte(wr * 64 + fr, fq * 8), boff = lds_byte(wc * 32 + fr, fq * 8);
#define PG8_SA(b, h) (((b) * 2 + (h)) * HTB)
#define PG8_SB(b, h) ((4 + (b) * 2 + (h)) * HTB)
#define PG8_STAGE(bufoff, gbase, voff) do { _Pragma("unroll") for (int _i = 0; _i < 2; ++_i) \
        __builtin_amdgcn_global_load_lds((const unsigned*)((const char*)(gbase) + (voff)[_i]), (PG8_LAS unsigned*)(lds + (bufoff) + ldsw + _i * 8192), 16, 0, 0); } while (0)
#define PG8_LDA(dst, b, h) do { _Pragma("unroll") for (int m = 0; m < 4; ++m) _Pragma("unroll") for (int k = 0; k < 2; ++k) dst[m][k] = *(const PG8_LAS bf16x8*)(lds + PG8_SA(b, h) + aoff + m * 2048 + k * 1024); } while (0)
#define PG8_LDB(dst, b, h) do { _Pragma("unroll") for (int n = 0; n < 2; ++n) _Pragma("unroll") for (int k = 0; k < 2; ++k) dst[n][k] = *(const PG8_LAS bf16x8*)(lds + PG8_SB(b, h) + boff + n * 2048 + k * 1024); } while (0)
#define PG8_MMA(ai, bj, At, Bt) do { __builtin_amdgcn_s_setprio(1); _Pragma("unroll") for (int m = 0; m < 4; ++m) _Pragma("unroll") for (int n = 0; n < 2; ++n) _Pragma("unroll") for (int k = 0; k < 2; ++k) \
        acc[ai][bj][m][n] = __builtin_amdgcn_mfma_f32_16x16x32_bf16(Bt[n][k], At[m][k], acc[ai][bj][m][n], 0, 0, 0); __builtin_amdgcn_s_setprio(0); } while (0)
#define PG8_WAIT_V(n) asm volatile("s_waitcnt vmcnt(" #n ")" ::: "memory")
#define PG8_WAIT_L(n) asm volatile("s_waitcnt lgkmcnt(" #n ")" ::: "memory")
#define PG8_BAR __builtin_amdgcn_s_barrier()
#define PG8_SCHED __builtin_amdgcn_sched_barrier(0)
    Unit cur, nxt; int ui = 0;
    if (!S.next(0, cur)) return;
    f32x4 acc[2][2][4][2];
#pragma unroll
    for (int a = 0; a < 2; ++a)
#pragma unroll
        for (int b = 0; b < 2; ++b)
#pragma unroll
            for (int m = 0; m < 4; ++m)
#pragma unroll
                for (int n = 0; n < 2; ++n) acc[a][b][m][n] = (f32x4){0.f, 0.f, 0.f, 0.f};
    bf16x8 At[4][2], B0[2][2], B1[2][2];
    typename Epi::Pre pre;
    const char* cA = (const char*)g.A + (size_t)cur.pm * tstep; const char* cB = (const char*)g.Bt + (size_t)cur.pn * bstep;
    S.a_ready(cur);
    if constexpr (SP2 && HALFN) {
        PG8_STAGE(PG8_SB(0, 0), cB, voffB); PG8_STAGE(PG8_SA(0, 0), cA, voffA); PG8_STAGE(PG8_SA(0, 1), cA + hstep, voffA);
        if (wr == 1) PG8_BAR;
        PG8_WAIT_V(2); PG8_BAR;
        PG8_STAGE(PG8_SB(1, 0), cB + kstep, voffB); PG8_STAGE(PG8_SA(1, 0), cA + kstep, voffA);
        PG8_WAIT_V(4); PG8_BAR;
    } else if constexpr (SP2) {
        PG8_STAGE(PG8_SB(0, 0), cB, voffB); PG8_STAGE(PG8_SB(0, 1), cB + hstep, voffB); PG8_STAGE(PG8_SA(0, 0), cA, voffA); PG8_STAGE(PG8_SA(0, 1), cA + hstep, voffA);
        if (wr == 1) PG8_BAR;
        PG8_WAIT_V(2); PG8_BAR;
        PG8_STAGE(PG8_SB(1, 0), cB + kstep, voffB); PG8_STAGE(PG8_SA(1, 0), cA + kstep, voffA); PG8_STAGE(PG8_SB(1, 1), cB + hstep + kstep, voffB);
        PG8_WAIT_V(6); PG8_BAR;
    } else {
        PG8_STAGE(PG8_SB(0, 0), cB, voffB); PG8_STAGE(PG8_SA(0, 0), cA, voffA); PG8_STAGE(PG8_SB(0, 1), cB + hstep, voffB); PG8_STAGE(PG8_SA(0, 1), cA + hstep, voffA);
        if (wr == 1) PG8_BAR;
        PG8_WAIT_V(4); PG8_BAR;
        PG8_STAGE(PG8_SB(1, 0), cB + kstep, voffB); PG8_STAGE(PG8_SA(1, 0), cA + kstep, voffA); PG8_STAGE(PG8_SB(1, 1), cB + hstep + kstep, voffB);
        PG8_WAIT_V(6); PG8_BAR;
    }
    for (;;) {
        const bool has_next = S.next(ui + 1, nxt);
        const char* nA = has_next ? (const char*)g.A + (size_t)nxt.pm * tstep : cA; const char* nB = has_next ? (const char*)g.Bt + (size_t)nxt.pn * bstep : cB;
        for (int t = 0; t < nt; t += 2) {
            const bool last = (t == nt - 2);
            const char* a1 = cA + (size_t)(t + 1) * kstep;
            const char* a2 = last ? nA : cA + (size_t)(t + 2) * kstep; const char* b2 = last ? nB : cB + (size_t)(t + 2) * kstep;
            const char* a3 = a2 + kstep; const char* b3 = b2 + kstep;
            if (last && has_next) S.a_ready(nxt);
            if (last) E.prefetch(pre, cur, wr, fr);
            if constexpr (SP2 && HALFN) {
            PG8_LDB(B0, 0, 0); PG8_SCHED; PG8_LDA(At, 0, 0); PG8_STAGE(PG8_SA(1, 1), a1 + hstep, voffA);
            PG8_WAIT_V(6); PG8_WAIT_L(0); PG8_BAR; PG8_MMA(0, 0, At, B0); PG8_BAR; PG8_SCHED;
            PG8_LDA(At, 0, 1); PG8_STAGE(PG8_SB(0, 0), b2, voffB); PG8_STAGE(PG8_SA(0, 0), a2, voffA);
            PG8_WAIT_V(6); PG8_WAIT_L(0); PG8_BAR; PG8_MMA(1, 0, At, B0); PG8_BAR; PG8_SCHED;
            PG8_LDB(B0, 1, 0); PG8_SCHED; PG8_LDA(At, 1, 0); PG8_STAGE(PG8_SA(0, 1), a2 + hstep, voffA);
            PG8_WAIT_V(6); PG8_WAIT_L(0); PG8_BAR; PG8_MMA(0, 0, At, B0); PG8_BAR; PG8_SCHED;
            PG8_LDA(At, 1, 1); PG8_STAGE(PG8_SB(1, 0), b3, voffB); PG8_STAGE(PG8_SA(1, 0), a3, voffA);
            PG8_WAIT_V(6); PG8_WAIT_L(0); PG8_BAR; PG8_MMA(1, 0, At, B0); PG8_BAR; PG8_SCHED;
            } else if constexpr (SP2) {
            PG8_LDB(B0, 0, 0); PG8_LDB(B1, 0, 1); PG8_SCHED; PG8_LDA(At, 0, 0); PG8_STAGE(PG8_SA(1, 1), a1 + hstep, voffA);
            PG8_WAIT_V(8); PG8_WAIT_L(0); PG8_BAR; PG8_MMA(0, 0, At, B0); PG8_MMA(0, 1, At, B1); PG8_BAR; PG8_SCHED;
            PG8_LDA(At, 0, 1); PG8_STAGE(PG8_SB(0, 0), b2, voffB); PG8_STAGE(PG8_SB(0, 1), b2 + hstep, voffB); PG8_STAGE(PG8_SA(0, 0), a2, voffA);
            PG8_WAIT_V(8); PG8_WAIT_L(0); PG8_BAR; PG8_MMA(1, 0, At, B0); PG8_MMA(1, 1, At, B1); PG8_BAR; PG8_SCHED;
            PG8_LDB(B0, 1, 0); PG8_LDB(B1, 1, 1); PG8_SCHED; PG8_LDA(At, 1, 0); PG8_STAGE(PG8_SA(0, 1), a2 + hstep, voffA);
            PG8_WAIT_V(8); PG8_WAIT_L(0); PG8_BAR; PG8_MMA(0, 0, At, B0); PG8_MMA(0, 1, At, B1); PG8_BAR; PG8_SCHED;
            PG8_LDA(At, 1, 1); PG8_STAGE(PG8_SB(1, 0), b3, voffB); PG8_STAGE(PG8_SB(1, 1), b3 + hstep, voffB); PG8_STAGE(PG8_SA(1, 0), a3, voffA);
            PG8_WAIT_V(8); PG8_WAIT_L(0); PG8_BAR; PG8_MMA(1, 0, At, B0); PG8_MMA(1, 1, At, B1); PG8_BAR; PG8_SCHED;
            } else {
            PG8_LDB(B0, 0, 0); PG8_SCHED; PG8_LDA(At, 0, 0); PG8_STAGE(PG8_SA(1, 1), a1 + hstep, voffA);
            PG8_WAIT_L(8); PG8_BAR; PG8_WAIT_L(0); PG8_MMA(0, 0, At, B0); PG8_BAR; PG8_SCHED;
            PG8_LDB(B1, 0, 1); PG8_STAGE(PG8_SB(0, 0), b2, voffB);
            PG8_BAR; PG8_WAIT_L(0); PG8_MMA(0, 1, At, B1); PG8_BAR;
            PG8_LDA(At, 0, 1); PG8_STAGE(PG8_SA(0, 0), a2, voffA);
            PG8_BAR; PG8_WAIT_L(0); PG8_MMA(1, 0, At, B0); PG8_BAR; PG8_SCHED;
            PG8_STAGE(PG8_SB(0, 1), b2 + hstep, voffB);
            PG8_WAIT_V(6); PG8_BAR; PG8_MMA(1, 1, At, B1); PG8_BAR;
            PG8_LDB(B0, 1, 0); PG8_SCHED; PG8_LDA(At, 1, 0); PG8_STAGE(PG8_SA(0, 1), a2 + hstep, voffA);
            PG8_WAIT_L(8); PG8_BAR; PG8_WAIT_L(0); PG8_MMA(0, 0, At, B0); PG8_BAR; PG8_SCHED;
            PG8_LDB(B1, 1, 1); PG8_STAGE(PG8_SB(1, 0), b3, voffB);
            PG8_BAR; PG8_WAIT_L(0); PG8_MMA(0, 1, At, B1); PG8_BAR;
            PG8_LDA(At, 1, 1); PG8_STAGE(PG8_SA(1, 0), a3, voffA);
            PG8_BAR; PG8_WAIT_L(0); PG8_MMA(1, 0, At, B0); PG8_BAR; PG8_SCHED;
            PG8_STAGE(PG8_SB(1, 1), b3 + hstep, voffB);
            PG8_WAIT_V(6); PG8_BAR; PG8_MMA(1, 1, At, B1); PG8_BAR;
            }
        }
        if constexpr (ALIGN_EPI) { if (wr == 0) PG8_BAR; }
        if constexpr (!Epi::AFTER_DRAIN) { E(acc, cur, wr, wc, fr, fq, pre); S.done(cur); }
        if (!has_next) break;
#pragma unroll
        for (int a = 0; a < 2; ++a)
#pragma unroll
            for (int b = 0; b < 2; ++b)
#pragma unroll
                for (int m = 0; m < 4; ++m)
#pragma unroll
                    for (int n = 0; n < 2; ++n) acc[a][b][m][n] = (f32x4){0.f, 0.f, 0.f, 0.f};
        cur = nxt; cA = nA; cB = nB; ++ui;
        if constexpr (ALIGN_EPI) { if (wr == 1) PG8_BAR; }
    }
    PG8_WAIT_V(0);
    if constexpr (!ALIGN_EPI) { if (wr == 0) PG8_BAR; }
    PG8_BAR;
#undef PG8_SA
#undef PG8_SB
#undef PG8_STAGE
#undef PG8_LDA
#undef PG8_LDB
#undef PG8_MMA
#undef PG8_WAIT_V
#undef PG8_WAIT_L
#undef PG8_BAR
#undef PG8_SCHED
}
}

namespace att {
constexpr int D = 128, NW = 8, QBLK = 32, KVBLK = 64;
constexpr float SCALE = 0.088388347648318440f, LOG2E = 1.4426950408889634f, LN2 = 0.6931471805599453f;
constexpr float C = SCALE * LOG2E;
constexpr float THR2 = 8.f * LOG2E;
constexpr int SHM_V = KVBLK * D * 2, SHM_K = KVBLK * D * 2;
constexpr int OFF_V = 0, OFF_K = 2 * SHM_V, BUF3 = SHM_V + SHM_K  , OFF_WS = 3 * BUF3, OFF_TAB = OFF_WS + NW * 64 * 4, TAB_FLOATS = 1024, OFF_UID = OFF_TAB + TAB_FLOATS * 4, LDS_BYTES = OFF_UID + 64;
#define KSWZ(row, colB) ((row) * 256 + ((colB) ^ (((row) & 7) << 4)))
#define SBAR() __builtin_amdgcn_sched_barrier(0)
__device__ __forceinline__ int crow(int r, int hi) { return (r & 3) + 8 * (r >> 2) + 4 * hi; }
__device__ __forceinline__ void qkt(f32x16& p0, f32x16& p1, const char* Ks, const bf16x8* qr, int r32, int hi) {
  p0 = f32x16{}; p1 = f32x16{};
#pragma unroll
  for (int d0 = 0; d0 < 8; ++d0) { const int cb = (d0 * 16 + hi * 8) * 2;
    const bf16x8 b0 = *reinterpret_cast<const bf16x8*>(Ks + KSWZ(r32, cb));
    const bf16x8 b1 = *reinterpret_cast<const bf16x8*>(Ks + KSWZ(32 + r32, cb));
    p0 = __builtin_amdgcn_mfma_f32_32x32x16_bf16(b0, qr[d0], p0, 0, 0, 0);
    p1 = __builtin_amdgcn_mfma_f32_32x32x16_bf16(b1, qr[d0], p1, 0, 0, 0); }
}
__device__ __forceinline__ int v_st(int k, int c) { const int kk = (k & ~0xC) | ((k & 4) << 1) | ((k & 8) >> 1); return ((kk >> 3) * 4 + (c >> 5)) * 512 + ((kk & 7) * 32 + (c & 31)) * 2; }
__device__ __forceinline__ int v_rd_base(int lane) { return ((lane & 3) << 3) | (((lane >> 2) & 3) << 6) | (((lane >> 4) & 1) << 5) | (((lane >> 5) & 1) << 8); }
constexpr int v_rd_off(int d0, int ks, int half) { return d0 * 512 + ks * 4096 + half * 2048; }
template <int OFF> __device__ __forceinline__ s16x4 tr_read(int vb) {
  s16x4 r; asm volatile("ds_read_b64_tr_b16 %0, %1 offset:%2" : "=&v"(r) : "v"(vb), "i"(OFF) : "memory"); return r;
}
template <int D0> __device__ __forceinline__ void pv_one(f32x16& od, int vb, bf16x8 pa0, bf16x8 pa1, bf16x8 pa2, bf16x8 pa3) {
  const s16x4 l0 = tr_read<v_rd_off(D0, 0, 0)>(vb), h0 = tr_read<v_rd_off(D0, 0, 1)>(vb), l1 = tr_read<v_rd_off(D0, 1, 0)>(vb), h1 = tr_read<v_rd_off(D0, 1, 1)>(vb);
  const s16x4 l2 = tr_read<v_rd_off(D0, 2, 0)>(vb), h2 = tr_read<v_rd_off(D0, 2, 1)>(vb), l3 = tr_read<v_rd_off(D0, 3, 0)>(vb), h3 = tr_read<v_rd_off(D0, 3, 1)>(vb);
  asm volatile("s_waitcnt lgkmcnt(0)" ::: "memory"); SBAR();
#define PK(L, H) (bf16x8){L[0], L[1], L[2], L[3], H[0], H[1], H[2], H[3]}
  od = __builtin_amdgcn_mfma_f32_32x32x16_bf16(pa0, PK(l0, h0), od, 0, 0, 0);
  od = __builtin_amdgcn_mfma_f32_32x32x16_bf16(pa1, PK(l1, h1), od, 0, 0, 0);
  od = __builtin_amdgcn_mfma_f32_32x32x16_bf16(pa2, PK(l2, h2), od, 0, 0, 0);
  od = __builtin_amdgcn_mfma_f32_32x32x16_bf16(pa3, PK(l3, h3), od, 0, 0, 0);
#undef PK
}
__device__ __forceinline__ void pv_d0(f32x16* o, int vb, bf16x8 pa0, bf16x8 pa1, bf16x8 pa2, bf16x8 pa3) {
  pv_one<0>(o[0], vb, pa0, pa1, pa2, pa3); pv_one<1>(o[1], vb, pa0, pa1, pa2, pa3); pv_one<2>(o[2], vb, pa0, pa1, pa2, pa3); pv_one<3>(o[3], vb, pa0, pa1, pa2, pa3);
}

template <bool TAB>
__device__ __forceinline__ void attn_unit(const bf16_t* __restrict__ Qb, long ldq, const bf16_t* __restrict__ Kh, const bf16_t* __restrict__ Vh, long ldk,
                                          bf16_t* __restrict__ Ob, long ldo, int t_lo, int t_hi, int qpos0, int W, const float* __restrict__ tabg, int tablen,
                                          float m_init0, float m_init1, float l_init, float* __restrict__ lse, long ldlse, char* lds) {
  const int tid = opaque_tid(), lane = tid & 63, r32 = lane & 31, hi = lane >> 5; const int wid = __builtin_amdgcn_readfirstlane(tid >> 6);
  const int hw = wid >> 2, wq = wid & 3;
  char* V_lds = lds + OFF_V; char* K_lds = lds + OFF_K;
  float* ws = (float*)(lds + OFF_WS) + wid * 64; float* li_l = ws; float* al_l = ws + 32;
  float* tab = (float*)(lds + OFF_TAB);
  bf16x8 qr[8];
  { const bf16_t* Qw = Qb + hw * D + (long)(wq * QBLK + r32) * ldq + hi * 8;
#pragma unroll
    for (int d0 = 0; d0 < 8; ++d0) qr[d0] = *reinterpret_cast<const bf16x8*>(Qw + d0 * 16); }
  if (TAB) { for (int i = tid; i < 2 * 512; i += NW * 64) tab[i] = ((i & 511) < tablen) ? tabg[i] : 0.f; }
  const int sr = tid >> 4, sc = (tid & 15) * 8, vst0 = v_st(sr, sc), vst1 = v_st(32 + sr, sc);
  const int vb0 = (int)(uintptr_t)V_lds + v_rd_base(lane);
  bf16x8 vs0, vs1, ks0, ks1;
#define SLOAD(k0) do { vs0 = *reinterpret_cast<const bf16x8*>(&Vh[(long)((k0) + sr) * ldk + sc]); vs1 = *reinterpret_cast<const bf16x8*>(&Vh[(long)((k0) + 32 + sr) * ldk + sc]); \
    ks0 = *reinterpret_cast<const bf16x8*>(&Kh[(long)((k0) + sr) * ldk + sc]); ks1 = *reinterpret_cast<const bf16x8*>(&Kh[(long)((k0) + 32 + sr) * ldk + sc]); } while (0)
#define SWRITE(b) do { *(bf16x8*)(V_lds + (b) * SHM_V + vst0) = vs0; *(bf16x8*)(V_lds + (b) * SHM_V + vst1) = vs1; const int kc = sc * 2; \
    *(bf16x8*)(K_lds + (b) * SHM_K + KSWZ(sr, kc)) = ks0; *(bf16x8*)(K_lds + (b) * SHM_K + KSWZ(32 + sr, kc)) = ks1; } while (0)
  float m_reg = hw ? m_init1 : m_init0, l_reg = l_init; f32x16 o[4] = {};
  const int qw0 = qpos0 + wq * QBLK;
  SLOAD(t_lo * KVBLK); SWRITE(0); __syncthreads();
  for (int t = t_lo; t < t_hi; ++t) {
    const int b = (t - t_lo) & 1; const bool more = (t + 1 < t_hi);
    if (more) SLOAD((t + 1) * KVBLK);
    const bool active = !TAB || (KVBLK * t + KVBLK - 1 >= qw0 - W && KVBLK * t <= qw0 + QBLK - 1 + W);
    if (active) {
      f32x16 p0, p1; qkt(p0, p1, K_lds + b * SHM_K, qr, r32, hi);
      if (TAB) { const float* tl = tab + hw * 512 + (KVBLK * t - qw0 - r32 + 4 * hi + W + 96);
#pragma unroll
        for (int r = 0; r < 16; ++r) { const int ix = (r & 3) + 8 * (r >> 2); p0[r] = fmaf(p0[r], C, tl[ix]); p1[r] = fmaf(p1[r], C, tl[ix + 32]); } }
      else {
#pragma unroll
        for (int r = 0; r < 16; ++r) { p0[r] *= C; p1[r] *= C; } }
      float pmax = p0[0];
#pragma unroll
      for (int r = 1; r < 16; ++r) pmax = fmaxf(pmax, p0[r]);
#pragma unroll
      for (int r = 0; r < 16; ++r) pmax = fmaxf(pmax, p1[r]);
      { auto rr = __builtin_amdgcn_permlane32_swap(__float_as_uint(pmax), __float_as_uint(pmax), false, false);
        pmax = fmaxf(__uint_as_float(rr[0]), __uint_as_float(rr[1])); }
      if (!__all(pmax - m_reg <= THR2)) {
        const float mn = fmaxf(m_reg, pmax); const float alpha = __builtin_amdgcn_exp2f(m_reg - mn); m_reg = mn; l_reg *= alpha;
        if (hi == 0) al_l[r32] = alpha; asm volatile("s_waitcnt lgkmcnt(0)" ::: "memory");
#pragma unroll
        for (int d = 0; d < 4; ++d)
#pragma unroll
          for (int r = 0; r < 16; ++r) o[d][r] *= al_l[crow(r, hi)];
      }
#pragma unroll
      for (int r = 0; r < 16; ++r) { p0[r] = __builtin_amdgcn_exp2f(p0[r] - m_reg); p1[r] = __builtin_amdgcn_exp2f(p1[r] - m_reg); }
      float ps = 0.f;
#pragma unroll
      for (int r = 0; r < 16; ++r) ps += p0[r];
#pragma unroll
      for (int r = 0; r < 16; ++r) ps += p1[r];
      { auto rr = __builtin_amdgcn_permlane32_swap(__float_as_uint(ps), __float_as_uint(ps), false, false);
        ps = __uint_as_float(rr[0]) + __uint_as_float(rr[1]); }
      l_reg += ps;
      bf16x8 pa0, pa1, pa2, pa3;
#define PK4(P, BASE, OUT) do { unsigned a0 = cvt_pk_bf16(P[BASE + 0], P[BASE + 1]), a1 = cvt_pk_bf16(P[BASE + 2], P[BASE + 3]);   \
    unsigned b0 = cvt_pk_bf16(P[BASE + 4], P[BASE + 5]), b1 = cvt_pk_bf16(P[BASE + 6], P[BASE + 7]);                              \
    auto r0 = __builtin_amdgcn_permlane32_swap(a0, b0, false, false); auto r1 = __builtin_amdgcn_permlane32_swap(a1, b1, false, false); \
    u32x4 w = {r0[0], r1[0], r0[1], r1[1]}; OUT = *reinterpret_cast<bf16x8*>(&w); } while (0)
      PK4(p0, 0, pa0); PK4(p0, 8, pa1); PK4(p1, 0, pa2); PK4(p1, 8, pa3);
#undef PK4
      SBAR();
      pv_d0(o, vb0 + b * SHM_V, pa0, pa1, pa2, pa3);
    }
    if (more) SWRITE(b ^ 1);
    __syncthreads();
  }
  if (hi == 0) li_l[r32] = l_reg; asm volatile("s_waitcnt lgkmcnt(0)" ::: "memory");
  float rli[16];
#pragma unroll
  for (int r = 0; r < 16; ++r) rli[r] = __builtin_amdgcn_rcpf(li_l[crow(r, hi)]);
  bf16_t* stg = (bf16_t*)(lds + wid * 8192);
#pragma unroll
  for (int r = 0; r < 16; ++r) { const int orow = crow(r, hi);
#pragma unroll
    for (int d0 = 0; d0 < 4; ++d0) { const unsigned w = cvt_pk_bf16(o[d0][r] * rli[r], 0.f); stg[orow * 128 + d0 * 32 + r32] = (bf16_t)(w & 0xffffu); } }
  asm volatile("s_waitcnt lgkmcnt(0)" ::: "memory");
#pragma unroll
  for (int i = 0; i < 8; ++i) { const int row = i * 4 + (lane >> 4), ch = lane & 15; const u32x4 v = *(const u32x4*)(stg + row * 128 + ch * 8);
    *(u32x4*)(Ob + hw * D + (long)(wq * QBLK + row) * ldo + ch * 8) = v; }
  if (lse != nullptr && hi == 0) lse[hw + (long)(wq * QBLK + r32) * ldlse] = (m_reg + __builtin_amdgcn_logf(l_reg)) * LN2;
  __syncthreads();
#undef SLOAD
#undef SWRITE
}
template <bool PRE>
__device__ __forceinline__ void partialSM(f32x16& p0, f32x16& p1, float& m_reg, float& mn, float& alpha) {
  constexpr float cs = PRE ? 1.0f : C;
  float pmax = p0[0];
#pragma unroll
  for (int r = 1; r < 16; ++r) pmax = fmaxf(pmax, p0[r]);
#pragma unroll
  for (int r = 0; r < 16; ++r) pmax = fmaxf(pmax, p1[r]);
  { auto rr = __builtin_amdgcn_permlane32_swap(__float_as_uint(pmax), __float_as_uint(pmax), false, false);
    pmax = fmaxf(__uint_as_float(rr[0]), __uint_as_float(rr[1])); }
  if (__builtin_expect(__all((pmax - m_reg) * cs <= THR2), 1)) { mn = m_reg; alpha = 1.f; }
  else { mn = fmaxf(m_reg, pmax); alpha = __builtin_amdgcn_exp2f((m_reg - mn) * cs); m_reg = mn; }
  const float mnC = -mn * cs;
#pragma unroll
  for (int r = 0; r < 16; ++r) p0[r] = fmaf(p0[r], cs, mnC);
#pragma unroll
  for (int r = 0; r < 16; ++r) p1[r] = fmaf(p1[r], cs, mnC);
#pragma unroll
  for (int r = 0; r < 16; ++r) p0[r] = __builtin_amdgcn_exp2f(p0[r]);
}
__device__ __forceinline__ void partialSM_fixed(f32x16& p0) {
#pragma unroll
  for (int r = 0; r < 16; ++r) p0[r] = __builtin_amdgcn_exp2f(p0[r]);
}
__device__ __forceinline__ void finishSM(f32x16& p0, f32x16& p1, float alpha, float& l_reg, bf16x8& pa0, bf16x8& pa1, bf16x8& pa2, bf16x8& pa3) {
#pragma unroll
  for (int r = 0; r < 16; ++r) p1[r] = __builtin_amdgcn_exp2f(p1[r]);
  float ps = 0;
#pragma unroll
  for (int r = 0; r < 16; ++r) ps += p0[r];
#pragma unroll
  for (int r = 0; r < 16; ++r) ps += p1[r];
  { auto rr = __builtin_amdgcn_permlane32_swap(__float_as_uint(ps), __float_as_uint(ps), false, false);
    ps = __uint_as_float(rr[0]) + __uint_as_float(rr[1]); }
  l_reg = l_reg * alpha + ps;
#define PK4(P, BASE, OUT) do { unsigned a0 = cvt_pk_bf16(P[BASE + 0], P[BASE + 1]), a1 = cvt_pk_bf16(P[BASE + 2], P[BASE + 3]);   \
    unsigned b0 = cvt_pk_bf16(P[BASE + 4], P[BASE + 5]), b1 = cvt_pk_bf16(P[BASE + 6], P[BASE + 7]);                              \
    auto r0 = __builtin_amdgcn_permlane32_swap(a0, b0, false, false); auto r1 = __builtin_amdgcn_permlane32_swap(a1, b1, false, false); \
    u32x4 w = {r0[0], r1[0], r0[1], r1[1]}; OUT = *reinterpret_cast<bf16x8*>(&w); } while (0)
  PK4(p0, 0, pa0); PK4(p0, 8, pa1); PK4(p1, 0, pa2); PK4(p1, 8, pa3);
#undef PK4
}
template <bool PRE>
__device__ __forceinline__ void attn_unit_dense(const bf16_t* __restrict__ Qb, long ldq, const bf16_t* __restrict__ Kh, const bf16_t* __restrict__ Vh, long ldk,
                                                bf16_t* __restrict__ Ob, long ldo, int ntile, float mfix2, char* lds) {
  const int tid = opaque_tid(), lane = tid & 63, r32 = lane & 31, hi = lane >> 5; const int wid = __builtin_amdgcn_readfirstlane(tid >> 6);
  float* ws = (float*)(lds + OFF_WS) + wid * 64; float* li_l = ws; float* al_l = ws + 32;
  const bool fixm = PRE && mfix2 >= 0.f;
  float m_reg = -1e30f, l_reg = 0; f32x16 o[4] = {}; bf16x8 qr[8];
  { const bf16_t* Qw = Qb + (long)(wid * QBLK + r32) * ldq + hi * 8;
#pragma unroll
    for (int d0 = 0; d0 < 8; ++d0) qr[d0] = *reinterpret_cast<const bf16x8*>(Qw + d0 * 16); }
  const int sr = tid >> 4, sc = (tid & 15) * 8, vst0 = v_st(sr, sc), vst1 = v_st(32 + sr, sc);
  const int vb0 = (int)(uintptr_t)lds + v_rd_base(lane);
  bf16x8 vsE0, vsE1, ksE0, ksE1, vsO0, vsO1, ksO0, ksO1;
#define SLOAD_E(k0) do { vsE0 = *reinterpret_cast<const bf16x8*>(&Vh[(long)((k0) + sr) * ldk + sc]); vsE1 = *reinterpret_cast<const bf16x8*>(&Vh[(long)((k0) + 32 + sr) * ldk + sc]); \
    ksE0 = *reinterpret_cast<const bf16x8*>(&Kh[(long)((k0) + sr) * ldk + sc]); ksE1 = *reinterpret_cast<const bf16x8*>(&Kh[(long)((k0) + 32 + sr) * ldk + sc]); } while (0)
#define SLOAD_O(k0) do { vsO0 = *reinterpret_cast<const bf16x8*>(&Vh[(long)((k0) + sr) * ldk + sc]); vsO1 = *reinterpret_cast<const bf16x8*>(&Vh[(long)((k0) + 32 + sr) * ldk + sc]); \
    ksO0 = *reinterpret_cast<const bf16x8*>(&Kh[(long)((k0) + sr) * ldk + sc]); ksO1 = *reinterpret_cast<const bf16x8*>(&Kh[(long)((k0) + 32 + sr) * ldk + sc]); } while (0)
#define SWRITE_E(bo) do { char* B_ = lds + (bo); *(bf16x8*)(B_ + vst0) = vsE0; *(bf16x8*)(B_ + vst1) = vsE1; const int kc = sc * 2; \
    *(bf16x8*)(B_ + SHM_V + KSWZ(sr, kc)) = ksE0; *(bf16x8*)(B_ + SHM_V + KSWZ(32 + sr, kc)) = ksE1; } while (0)
#define SWRITE_O(bo) do { char* B_ = lds + (bo); *(bf16x8*)(B_ + vst0) = vsO0; *(bf16x8*)(B_ + vst1) = vsO1; const int kc = sc * 2; \
    *(bf16x8*)(B_ + SHM_V + KSWZ(sr, kc)) = ksO0; *(bf16x8*)(B_ + SHM_V + KSWZ(32 + sr, kc)) = ksO1; } while (0)
#define SWAIT() asm volatile("s_waitcnt vmcnt(4)" ::: "memory")
#define PSM(P0, P1, MN, AL) do { if (fixm) { partialSM_fixed(P0); AL = 1.f; MN = 0.f; } else partialSM<PRE>(P0, P1, m_reg, MN, AL); } while (0)
#define RESC(a) do { if (!fixm) if (__any((a) < 1.f)) { if (hi == 0) al_l[r32] = (a); asm volatile("s_waitcnt lgkmcnt(0)" ::: "memory"); \
    _Pragma("unroll") for (int d = 0; d < 4; ++d) _Pragma("unroll") for (int r = 0; r < 16; ++r) o[d][r] *= al_l[crow(r, hi)]; } } while (0)
#define ROT3() do { const int t_ = bV; bV = bK; bK = bW; bW = t_; } while (0)
  f32x16 pA0, pA1, pB0, pB1; float mnA, mnB, alA, alB; bf16x8 pa0, pa1, pa2, pa3; const int NT = ntile;
  int bV = 0, bK = 0, bW = BUF3;
  SLOAD_E(0); SLOAD_O(KVBLK); asm volatile("s_waitcnt vmcnt(4)" ::: "memory"); SWRITE_E(0); SLOAD_E(2 * KVBLK);
  __syncthreads();
  SWAIT(); SWRITE_O(bW);
  qkt(pA0, pA1, lds + bK + SHM_V, qr, r32, hi); PSM(pA0, pA1, mnA, alA);
  if (3 < NT) SLOAD_O(3 * KVBLK);
  bV = 0; bK = BUF3; bW = 2 * BUF3;
  for (int j = 1; j + 1 < NT; j += 2) {
    __syncthreads(); SWAIT(); SWRITE_E(bW);
    SBAR(); qkt(pB0, pB1, lds + bK + SHM_V, qr, r32, hi);
    finishSM(pA0, pA1, alA, l_reg, pa0, pa1, pa2, pa3); SBAR();
    if (j + 3 < NT) SLOAD_E((j + 3) * KVBLK); SBAR();
    pv_d0(o, vb0 + bV, pa0, pa1, pa2, pa3); PSM(pB0, pB1, mnB, alB);
    RESC(alB); ROT3();
    __syncthreads(); SWAIT(); SWRITE_O(bW);
    SBAR(); qkt(pA0, pA1, lds + bK + SHM_V, qr, r32, hi);
    finishSM(pB0, pB1, alB, l_reg, pa0, pa1, pa2, pa3); SBAR();
    if (j + 4 < NT) SLOAD_O((j + 4) * KVBLK); SBAR();
    pv_d0(o, vb0 + bV, pa0, pa1, pa2, pa3); PSM(pA0, pA1, mnA, alA);
    RESC(alA); ROT3();
  }
  __syncthreads();
  SBAR(); qkt(pB0, pB1, lds + bK + SHM_V, qr, r32, hi);
  finishSM(pA0, pA1, alA, l_reg, pa0, pa1, pa2, pa3); SBAR();
  pv_d0(o, vb0 + bV, pa0, pa1, pa2, pa3); PSM(pB0, pB1, mnB, alB);
  RESC(alB); ROT3();
  finishSM(pB0, pB1, alB, l_reg, pa0, pa1, pa2, pa3); SBAR();
  pv_d0(o, vb0 + bV, pa0, pa1, pa2, pa3);
#undef ROT3
  if (hi == 0) li_l[r32] = l_reg; asm volatile("s_waitcnt lgkmcnt(0)" ::: "memory");
  float rli[16];
#pragma unroll
  for (int r = 0; r < 16; ++r) rli[r] = __builtin_amdgcn_rcpf(li_l[crow(r, hi)]);
  __syncthreads();
  bf16_t* stg = (bf16_t*)(lds + wid * 8192);
#pragma unroll
  for (int r = 0; r < 16; ++r) { const int orow = crow(r, hi);
#pragma unroll
    for (int d0 = 0; d0 < 4; ++d0) { const unsigned w = cvt_pk_bf16(o[d0][r] * rli[r], 0.f); stg[orow * 128 + d0 * 32 + r32] = (bf16_t)(w & 0xffffu); } }
  asm volatile("s_waitcnt lgkmcnt(0)" ::: "memory");
#pragma unroll
  for (int i = 0; i < 8; ++i) { const int row = i * 4 + (lane >> 4), ch = lane & 15; const u32x4 v = *(const u32x4*)(stg + row * 128 + ch * 8);
    *(u32x4*)(Ob + (long)(wid * QBLK + row) * ldo + ch * 8) = v; }
  __syncthreads();
#undef PSM
#undef SLOAD_E
#undef SLOAD_O
#undef SWRITE_E
#undef SWRITE_O
#undef SWAIT
#undef RESC
}
#undef SBAR
}

#define XB_TMO      128
#define XB_XCNT(j)  (256  + 64 * (j))
#define XB_XSUB(j)  (1280 + 64 * (j))
#define XB_XGEN(j)  (2304 + 64 * (j))
#define XB_TOP      3328
#define XB_TOPGEN   3392
#define XCD_BAR_WORDS 3456
#define XB_SPIN_CAP (1u << 18)
__device__ __forceinline__ unsigned xb_ld(unsigned* p)              { return __hip_atomic_load(p, __ATOMIC_RELAXED, __HIP_MEMORY_SCOPE_AGENT); }
__device__ __forceinline__ unsigned xb_add(unsigned* p, unsigned v) { return __hip_atomic_fetch_add(p, v, __ATOMIC_RELAXED, __HIP_MEMORY_SCOPE_AGENT); }
__device__ __forceinline__ unsigned xb_xcc_id() { return (unsigned)__builtin_amdgcn_s_getreg((3 << 11) | 20) & 0xFu; }
#define XB_SPIN(cond, bar) do { unsigned _sp = 0; while (cond) { __builtin_amdgcn_s_sleep(1); \
    if ((++_sp & 255u) == 0u) { if (xb_ld(&(bar)[XB_TMO])) break; if (_sp > XB_SPIN_CAP) { atomicAdd(&(bar)[XB_TMO], 1u); break; } } } } while (0)
struct XcdBarrier { unsigned* bar; unsigned x; volatile LAS unsigned* st; };
__device__ __forceinline__ XcdBarrier xcd_barrier_post(unsigned* bar, volatile LAS unsigned* st) {
    XcdBarrier b; b.bar = bar; b.x = xb_xcc_id(); b.st = st;
    if (threadIdx.x == 0) (void)xb_add(&bar[XB_XCNT(b.x)], 1u);
    return b;
}
__device__ __forceinline__ void xcd_barrier_complete(unsigned* bar, unsigned x, unsigned& nloc, unsigned& nx) {
    const unsigned G = gridDim.x * gridDim.y * gridDim.z;
    unsigned sum, cnt, mine, sp = 0u;
    for (;;) {
        sum = 0u; cnt = 0u; mine = 0u;
#pragma unroll
        for (unsigned j = 0; j < 16; ++j) { const unsigned c = xb_ld(&bar[XB_XCNT(j)]); sum += c; cnt += (c > 0u) ? 1u : 0u; mine = (j == x) ? c : mine; }
        if (sum == G) break;
        __builtin_amdgcn_s_sleep(1);
        if ((++sp & 255u) == 0u) { if (xb_ld(&bar[XB_TMO])) break; if (sp > XB_SPIN_CAP) { atomicAdd(&bar[XB_TMO], 1u); break; } }
    }
    nloc = mine > 0u ? mine : 1u; nx = cnt > 0u ? cnt : 1u;
}
__device__ __forceinline__ void xcd_barrier(const XcdBarrier& b) {
    asm volatile("s_waitcnt vmcnt(0)" ::: "memory");
    __syncthreads();
    if (threadIdx.x == 0) {
        unsigned* bar = b.bar;
        __builtin_amdgcn_s_waitcnt(0);
        unsigned nloc = b.st[0], nx = b.st[1];
        if (nloc == 0u) { xcd_barrier_complete(bar, b.x, nloc, nx); b.st[0] = nloc; b.st[1] = nx; }
        const unsigned old = xb_add(&bar[XB_XSUB(b.x)], 1u);
        const unsigned gen = old / nloc;
        if (old + 1u == (gen + 1u) * nloc) {
            __builtin_amdgcn_fence(__ATOMIC_RELEASE, "agent");
            asm volatile("s_waitcnt vmcnt(0)" ::: "memory");
            const unsigned og = xb_add(&bar[XB_TOP], 1u);
            const unsigned tg = og / nx;
            if (og + 1u == (tg + 1u) * nx) xb_add(&bar[XB_TOPGEN], 1u);
            else XB_SPIN(xb_ld(&bar[XB_TOPGEN]) == tg, bar);
            __builtin_amdgcn_fence(__ATOMIC_ACQUIRE, "agent");
            xb_add(&bar[XB_XGEN(b.x)], 1u);
            asm volatile("s_waitcnt vmcnt(0)" ::: "memory");
        } else {
            XB_SPIN(xb_ld(&bar[XB_XGEN(b.x)]) == gen, bar);
            __builtin_amdgcn_fence(__ATOMIC_ACQUIRE, "agent");
            asm volatile("s_waitcnt vmcnt(0)" ::: "memory");
        }
    }
    __syncthreads();
}

constexpr int NWAVES = 8;
constexpr int RING_BYTES = 131072, LDSCTL_OFF = RING_BYTES, MISC_OFF = LDSCTL_OFF + 320, LDS_BYTES = 147456;
static_assert(att::LDS_BYTES <= RING_BYTES, "attention scratch inside the ring region");

struct Args {
    const float* in[20]; float* out; unsigned char* ws; int ph_lo, ph_hi;
};

__device__ __forceinline__ float wave_sum(float v) {
#pragma unroll
    for (int o = 1; o < 64; o <<= 1) v += __shfl_xor(v, o);
    return v;
}
__device__ __forceinline__ unsigned f2bf(float f) { unsigned u = __builtin_bit_cast(unsigned, f); return (u + 0x7fffu + ((u >> 16) & 1u)) >> 16; }
__device__ __forceinline__ unsigned pk2(float lo, float hi) { return f2bf(lo) | (f2bf(hi) << 16); }

__device__ __forceinline__ void transpose_item(const float* W, const float* gain, int K, int N, bf16_t* WT, int k0, int n0, int drow0, LAS float* scr, int lane) {
    const int kr = lane >> 3, nq = lane & 7;
    f32x4 v[8]; float gk[8];
#pragma unroll
    for (int i = 0; i < 8; ++i) { v[i] = *(const GAS f32x4*)(W + (size_t)(k0 + kr + 8 * i) * N + n0 + 4 * nq); gk[i] = gain ? gain[k0 + kr + 8 * i] : 1.0f; }
#pragma unroll
    for (int i = 0; i < 8; ++i) { LAS float* d = scr + (kr + 8 * i) * 33 + 4 * nq; d[0] = v[i].x * gk[i]; d[1] = v[i].y * gk[i]; d[2] = v[i].z * gk[i]; d[3] = v[i].w * gk[i]; }
    asm volatile("s_waitcnt lgkmcnt(0)" ::: "memory");
    const int c = lane & 7;
#pragma unroll
    for (int j = 0; j < 4; ++j) { const int n = (lane >> 3) + 8 * j; const LAS float* s = scr + (8 * c) * 33 + n;
        u32x4 o; o.x = pk2(s[0 * 33], s[1 * 33]); o.y = pk2(s[2 * 33], s[3 * 33]); o.z = pk2(s[4 * 33], s[5 * 33]); o.w = pk2(s[6 * 33], s[7 * 33]);
        *(GAS u32x4*)(WT + (size_t)(drow0 + n) * K + k0 + 8 * c) = o; }
    asm volatile("s_waitcnt lgkmcnt(0)" ::: "memory");
}

__device__ __forceinline__ int t5_bucket(int rel) {
    const int n = rel < 0 ? -rel : rel; int b;
    if (n < 8) b = n; else { b = 8 + (n >= 15) + (n >= 27) + (n >= 50) + (n >= 91) + (n >= 166) + (n >= 305) + (n >= 559); if (b > 15) b = 15; }
    return b + (rel > 0 ? 16 : 0);
}
__device__ __forceinline__ void sincos_d(double a, double& s, double& c) {
    const double k = __builtin_rint(a * 0.63661977236758134308);
    const double r = (a - k * 1.57079632679489655800) - k * 6.12323399573676603587e-17;
    const double r2 = r * r;
    double ps = 1.0 / 6227020800.0;
    ps = ps * r2 - 1.0 / 39916800.0; ps = ps * r2 + 1.0 / 362880.0; ps = ps * r2 - 1.0 / 5040.0; ps = ps * r2 + 1.0 / 120.0; ps = ps * r2 - 1.0 / 6.0; ps = ps * r2 + 1.0;
    const double sr = r * ps;
    double pc = -1.0 / 87178291200.0;
    pc = pc * r2 + 1.0 / 479001600.0; pc = pc * r2 - 1.0 / 3628800.0; pc = pc * r2 + 1.0 / 40320.0; pc = pc * r2 - 1.0 / 720.0; pc = pc * r2 + 1.0 / 24.0; pc = pc * r2 - 0.5; pc = pc * r2 + 1.0;
    const int q = ((int)k) & 3;
    s = (q == 0) ? sr : (q == 1) ? pc : (q == 2) ? -sr : -pc;
    c = (q == 0) ? pc : (q == 1) ? -sr : (q == 2) ? -pc : sr;
}

__device__ __forceinline__ float row_to_bf16(const float* xrow, bf16_t* orow, int lane) {
    const GAS f32x4* xr = (const GAS f32x4*)xrow + lane;
    f32x4 v[8]; float s = 0.f;
#pragma unroll
    for (int j = 0; j < 8; ++j) { v[j] = xr[64 * j]; s += (v[j].x * v[j].x + v[j].y * v[j].y) + (v[j].z * v[j].z + v[j].w * v[j].w); }
    GAS u32x2* o8 = (GAS u32x2*)orow + lane;
#pragma unroll
    for (int j = 0; j < 8; ++j) { u32x2 w; w.x = cvt_pk_bf16(v[j].x, v[j].y); w.y = cvt_pk_bf16(v[j].z, v[j].w); o8[64 * j] = w; }
    return wave_sum(s);
}
__device__ __forceinline__ void rms_row_out(const bf16_t* xrow, float* orow, const float* g, float rstd, int lane) {
    const GAS u32x2* xr = (const GAS u32x2*)xrow + lane; GAS f32x4* o = (GAS f32x4*)orow + lane; const GAS f32x4* gr = (const GAS f32x4*)g + lane;
#pragma unroll
    for (int j = 0; j < 8; ++j) { const u32x2 w = xr[64 * j]; const f32x4 gg = gr[64 * j]; f32x4 v = {bflo(w.x), bfhi(w.x), bflo(w.y), bfhi(w.y)}; o[64 * j] = v * rstd * gg; }
}

__device__ __forceinline__ void qknorm_rows(bf16_t* qkv, const float* ropec, const float* ropes, const float* qg, const float* kg, int row_base, int tid) {
    const int lane = tid & 63, wave = tid >> 6;
    const int head = lane >> 3, q8 = lane & 7, hf = q8 >> 2, a = q8 & 3;
    const float* gp = (head < 6) ? qg : kg;
    const float osc = (head < 6) ? 0.088388347648318440f * 1.4426950408889634f : 1.0f;
    float g1[8], g2[8];
#pragma unroll
    for (int e = 0; e < 8; ++e) { g1[e] = gp[hf * 64 + 8 * a + e]; g2[e] = gp[hf * 64 + 32 + 8 * a + e]; }
    for (int t0 = 0; t0 < 32; t0 += 4) {
        u32x4 w1[4], w2[4]; f32x4 cs[4][4];
#pragma unroll
        for (int i = 0; i < 4; ++i) { const int m = row_base + wave + 8 * (t0 + i);
            const int s = (m < NPROMPT) ? (m & (SEQ_P - 1)) : ((m - NPROMPT) & (SEQ_S - 1)); const int n = hf ? (s & 63) : (s >> 6);
            const bf16_t* p1 = qkv + (size_t)m * PROJ + head * HD + hf * 64 + 8 * a;
            w1[i] = *(const GAS u32x4*)p1; w2[i] = *(const GAS u32x4*)(p1 + 32);
            cs[i][0] = *(const GAS f32x4*)(ropec + n * 32 + 8 * a); cs[i][1] = *(const GAS f32x4*)(ropec + n * 32 + 8 * a + 4);
            cs[i][2] = *(const GAS f32x4*)(ropes + n * 32 + 8 * a); cs[i][3] = *(const GAS f32x4*)(ropes + n * 32 + 8 * a + 4); }
#pragma unroll
        for (int i = 0; i < 4; ++i) { const int m = row_base + wave + 8 * (t0 + i);
            bf16_t* p1 = qkv + (size_t)m * PROJ + head * HD + hf * 64 + 8 * a;
            float x1[8], x2[8];
#pragma unroll
            for (int e = 0; e < 4; ++e) { x1[2 * e] = bflo(w1[i][e]); x1[2 * e + 1] = bfhi(w1[i][e]); x2[2 * e] = bflo(w2[i][e]); x2[2 * e + 1] = bfhi(w2[i][e]); }
            float ss = 0.f;
#pragma unroll
            for (int e = 0; e < 8; ++e) ss += x1[e] * x1[e] + x2[e] * x2[e];
            ss += __shfl_xor(ss, 1); ss += __shfl_xor(ss, 2); ss += __shfl_xor(ss, 4);
            const float rstd = 1.0f / sqrtf(ss * (1.f / HD) + RMS_EPS);
            float o1[8], o2[8];
#pragma unroll
            for (int e = 0; e < 8; ++e) { const float cc = e < 4 ? cs[i][0][e & 3] : cs[i][1][e & 3], sn = e < 4 ? cs[i][2][e & 3] : cs[i][3][e & 3];
                const float y1 = x1[e] * rstd * g1[e], y2 = x2[e] * rstd * g2[e]; o1[e] = (y1 * cc - y2 * sn) * osc; o2[e] = (y1 * sn + y2 * cc) * osc; }
            u32x4 r1, r2;
#pragma unroll
            for (int e = 0; e < 4; ++e) { r1[e] = cvt_pk_bf16(o1[2 * e], o1[2 * e + 1]); r2[e] = cvt_pk_bf16(o2[2 * e], o2[2 * e + 1]); }
            *(GAS u32x4*)p1 = r1; *(GAS u32x4*)(p1 + 32) = r2; }
    }
}
__device__ __forceinline__ void crescale_rows(bf16_t* mix, const float* lsebuf, int row_base, int tid) {
    const int lane = tid & 63, wave = tid >> 6;
    for (int t0 = 0; t0 < 32; t0 += 4) {
        float ls[4][6]; u32x2 w[4][3];
#pragma unroll
        for (int i = 0; i < 4; ++i) { const int m = row_base + wave + 8 * (t0 + i);
#pragma unroll
            for (int k = 0; k < 6; ++k) ls[i][k] = lsebuf[(size_t)m * 6 + k];
            const GAS u32x2* p = (const GAS u32x2*)(mix + (size_t)m * MIXW + 1280) + lane;
#pragma unroll
            for (int j = 0; j < 3; ++j) w[i][j] = p[64 * j]; }
#pragma unroll
        for (int i = 0; i < 4; ++i) { const int m = row_base + wave + 8 * (t0 + i);
            float al[6];
#pragma unroll
            for (int j = 0; j < 2; ++j) { const float mx = fmaxf(fmaxf(ls[i][j], ls[i][2 + j]), ls[i][4 + j]);
                const float e0 = __expf(ls[i][j] - mx), e1 = __expf(ls[i][2 + j] - mx), e2 = __expf(ls[i][4 + j] - mx); const float inv = 1.0f / (e0 + e1 + e2);
                al[j] = e0 * inv; al[2 + j] = e1 * inv; al[4 + j] = e2 * inv; }
            GAS u32x2* p = (GAS u32x2*)(mix + (size_t)m * MIXW + 1280) + lane;
#pragma unroll
            for (int j = 0; j < 3; ++j) { const int hc = (4 * lane + 256 * j) >> 7; const float a = (hc == 0) ? al[0] : (hc == 1) ? al[1] : (hc == 2) ? al[2] : (hc == 3) ? al[3] : (hc == 4) ? al[4] : al[5];
                u32x2 v = w[i][j]; v.x = cvt_pk_bf16(bflo(v.x) * a, bfhi(v.x) * a); v.y = cvt_pk_bf16(bflo(v.y) * a, bfhi(v.y) * a); p[64 * j] = v; } }
    }
}

__global__ void __launch_bounds__(NWAVES * 64, 2) fwd(Args args) {
    extern __shared__ __attribute__((aligned(16))) unsigned char lds[];
    LAS unsigned char* ldsl = (LAS unsigned char*)lds;
    volatile LAS unsigned* MISC = (volatile LAS unsigned*)(ldsl + MISC_OFF);
    const int G = gridDim.x;
    unsigned char* ws = args.ws;
    gu32* ctl = (gu32*)(ws + WS_CTL);
    { const int tid0 = threadIdx.x; for (int u = tid0; u < (LDS_BYTES - LDSCTL_OFF) / 4; u += NWAVES * 64) ((LAS unsigned*)(ldsl + LDSCTL_OFF))[u] = 0u; }
    __syncthreads();
    XcdBarrier bar; bar.bar = (unsigned*)ctl + CW_BAR; bar.x = 0; bar.st = nullptr;
    if (ONE_LAUNCH) bar = xcd_barrier_post((unsigned*)ctl + CW_BAR, MISC + 8);
    int bx = blockIdx.x;
    if (ONE_LAUNCH) {
        if (threadIdx.x == 0) { const unsigned xcc = xb_xcc_id(); const unsigned rk = __hip_atomic_fetch_add(ctl + CW_XRANK + 64 * (xcc & 15u), 1u, __ATOMIC_RELAXED, __HIP_MEMORY_SCOPE_AGENT); MISC[12] = rk * 8u + ((xcc + 3u) & 7u); }
        xcd_barrier(bar);
        if (threadIdx.x == 0) { bool ok = (G % 8 == 0);
            for (unsigned j = 0; j < 16; ++j) { const unsigned cnt = __hip_atomic_load(ctl + CW_XRANK + 64 * j, __ATOMIC_RELAXED, __HIP_MEMORY_SCOPE_AGENT); ok = ok && (cnt == (j < 8 ? (unsigned)G / 8u : 0u)); }
            if (!ok) MISC[12] = blockIdx.x; }
        __syncthreads();
        bx = __builtin_amdgcn_readfirstlane((int)MISC[12]);
    }
    const int lo = args.ph_lo, hi = args.ph_hi;
#ifndef PHMASK
#define PHMASK 0xffff
#endif
#define IN(k) (lo <= (k) && (k) < hi)
#define EN(b) ((PHMASK >> (b)) & 1)
#ifndef PROBE_DUP
#define PROBE_DUP 0
#endif
#define NREP(b) (1 + ((PROBE_DUP >> (b)) & 1))
#define REPSEAM(b) do { if (ONE_LAUNCH && NREP(b) > 1 && rep == 0) xcd_barrier(bar); } while (0)
#define SEAM(k) do { if (ONE_LAUNCH && IN(k) && IN((k) + 1)) xcd_barrier(bar); } while (0)
#define LANE_ID() const int tid = opaque_tid(), lane = tid & 63, wave = __builtin_amdgcn_readfirstlane(tid >> 6); const int vcu = (G % 8 == 0) ? (bx % 8) * (G / 8) + bx / 8 : bx; const int gw = vcu * NWAVES + wave, NGW = G * NWAVES; (void)lane; (void)gw; (void)NGW
#define ROPEC ((float*)(ws + WS_TAB))
#define ROPES (ROPEC + 128 * 32)
#define TABB (ROPES + 128 * 32)
#define TABC (TABB + 4 * 512)
#define LSEBUF ((float*)(ws + WS_LSE))
#define XB ((bf16_t*)(ws + WS_XB))
#define MB ((bf16_t*)(ws + WS_MB))
#define SSBUF ((pg8::ss_t*)(ws + WS_SS))
#define RSM ((pg8::ss_t*)(ws + WS_RSM))
#define QKV ((bf16_t*)(ws + WS_QKV))
#define MIX ((bf16_t*)(ws + WS_MIX))
#define HID ((bf16_t*)(ws + WS_HID))
#define QX ((bf16_t*)(ws + WS_QX))
#define OX ((bf16_t*)(ws + WS_OX))
#define KVX ((bf16_t*)(ws + WS_KVX))
    float* out = args.out;

    if (EN(13) && IN(0)) {
        LANE_ID();
        float* ropec = ROPEC; float* ropes = ROPES; float* tabB = TABB; float* tabC = TABC;
        LAS float* scr = (LAS float*)(ldsl + wave * 16384);
        constexpr int I_IN = 32 * 120, I_OUT = 32 * 64, I_CQ = 32 * 16, I_CKV = 32 * 32, I_CO = 8 * 64, I_FI = 32 * 352, I_FO = 88 * 64;
        constexpr int I_LAYER = I_IN + I_OUT + I_CQ + I_CKV + I_CO + I_FI + I_FO;
        for (int it = gw; it < DEPTH * I_LAYER; it += NGW) {
            const int l = it / I_LAYER; int r = it % I_LAYER;
            const float* W; bf16_t* WT; int K, N; const float* gain = nullptr;
            if (r < I_IN) { gain = args.in[4] + (size_t)l * DM; W = args.in[5] + (size_t)l * DM * PROJ; WT = (bf16_t*)(ws + WS_WIN) + (size_t)l * PROJ * DM; K = DM; N = PROJ; }
            else if ((r -= I_IN) < I_OUT) { W = args.in[10] + (size_t)l * MIXW * DM; WT = (bf16_t*)(ws + WS_WOUT) + (size_t)l * DM * MIXW; K = MIXW; N = DM; }
            else if ((r -= I_OUT) < I_CQ) { gain = args.in[11] + (size_t)l * DM; W = args.in[13] + (size_t)l * DM * XW; WT = (bf16_t*)(ws + WS_WCQ) + (size_t)l * XW * DM; K = DM; N = XW; }
            else if ((r -= I_CQ) < I_CKV) { gain = args.in[12] + (size_t)l * DM; W = args.in[14] + (size_t)l * DM * 2 * XW; WT = (bf16_t*)(ws + WS_WCKV) + (size_t)l * 2 * XW * DM; K = DM; N = 2 * XW; }
            else if ((r -= I_CKV) < I_CO) { W = args.in[15] + (size_t)l * XW * DM; WT = (bf16_t*)(ws + WS_WCO) + (size_t)l * DM * XW; K = XW; N = DM; }
            else if ((r -= I_CO) < I_FI) { gain = args.in[16] + (size_t)l * DM; W = args.in[17] + (size_t)l * DM * 2 * DFF; WT = (bf16_t*)(ws + WS_WFI) + (size_t)l * 2 * DFF * DM; K = DM; N = 2 * DFF; }
            else { r -= I_FI; W = args.in[18] + (size_t)l * DFF * DM; WT = (bf16_t*)(ws + WS_WFO) + (size_t)l * DM * DFF; K = DFF; N = DM; }
            const int nblk = N / 32, kb = r / nblk, nb = r % nblk, n0 = 32 * nb;
            int drow0 = n0;
            if (N == 2 * DFF) drow0 = (n0 < DFF) ? 256 * (n0 / 128) + (n0 % 128) : 256 * ((n0 - DFF) / 128) + 128 + ((n0 - DFF) % 128);
            transpose_item(W, gain, K, N, WT, 64 * kb, n0, drow0, scr, lane);
        }
        { bf16_t* xb = XB; pg8::ss_t* ss0 = SSBUF; bf16_t* mb = MB; pg8::ss_t* rsm = RSM;
          for (int m = gw; m < NTOK; m += NGW) { const float* xr = (m < NPROMPT) ? args.in[0] + (size_t)m * DM : args.in[1] + (size_t)(m - NPROMPT) * DM;
              const float q = row_to_bf16(xr, xb + (size_t)m * DM, lane); if (lane == 0) ss0[m] = (pg8::ss_t)(q * pg8::SS_SCALE); }
          for (int m = gw; m < MEMROWS; m += NGW) { const float* mr = (m < 2 * MEMLEN) ? args.in[2] + (size_t)m * DM : args.in[3] + (size_t)(m - 2 * MEMLEN) * DM;
              const float q = row_to_bf16(mr, mb + (size_t)m * DM, lane); if (lane == 0) rsm[m] = (pg8::ss_t)(q * pg8::SS_SCALE); } }
        const int gt = vcu * (NWAVES * 64) + tid, NGT = G * NWAVES * 64;
        const float* rel_bias = args.in[9];
        for (int e = gt; e < 4096 + 2048 + 3072; e += NGT) {
            if (e < 4096) { const int n = e >> 5, i = e & 31;
                double invd = 1.0; for (int q = 0; q < i; ++q) invd *= 0.7498942093324559;
                const float inv = (float)invd;
                const float ang = (float)n * inv; double s, c; sincos_d((double)ang, s, c); ropec[e] = (float)c; ropes[e] = (float)s; }
            else if (e < 4096 + 2048) { const int t = e - 4096, h = t >> 9, i = t & 511; const int rel = i - 96 - 128;
                float v = -INFINITY; if (rel >= -128 && rel <= 128) v = rel_bias[t5_bucket(rel) * 10 + h] * att::LOG2E;
                tabB[t] = v; }
            else { const int t = e - 6144, hc = t >> 9, i = t & 511; const int off = i - 96 - 64; const int d = (hc < 2) ? 1 : (hc < 4) ? 4 : 16;
                float v = -INFINITY; if (off >= -64 && off <= 64) v = rel_bias[t5_bucket(off * d) * 10 + 4 + hc] * att::LOG2E;
                tabC[t] = v; }
        }
    }
    SEAM(0);

    for (int l = 0; l < DEPTH; ++l) {
        const int pb = 1 + PPL * l;
#define XS0 ((l == 0) ? args.in[0] : (const float*)out)
#define XS1 ((l == 0) ? args.in[1] : (const float*)out + (size_t)NPROMPT * DM)
        if (EN(0) && IN(pb + 0)) for (int rep = 0; rep < NREP(0); ++rep) {
            { const bf16_t* Win = (const bf16_t*)(ws + WS_WIN) + (size_t)l * PROJ * DM; const bool tail = (G == 256) && l > 0;
              pg8::Gemm g{XB, Win, NTOK, PROJ, DM}; pg8::StaticOrder S; S.init(NTOK, PROJ, G, bx, 0, tail ? 11 : (1 << 30));
              pg8::EpiBf16 E{QKV, PROJ, SSBUF + (size_t)(3 * l) * NTOK};
              pg8::gemm_phase<pg8::EpiBf16, pg8::StaticOrder, true, true>(ldsl, g, S, E);
              if (tail) {
                  if (threadIdx.x == 0) MISC[13] = __hip_atomic_fetch_add(ctl + CW_TAIL + 64 * l, 1u, __ATOMIC_RELAXED, __HIP_MEMORY_SCOPE_AGENT);
                  __syncthreads(); const int slot = __builtin_amdgcn_readfirstlane((int)MISC[13]); __syncthreads();
                  pg8::TailHalfOrder T; T.init(NTOK, PROJ, G, slot, 11); pg8::EpiBf16H EH{QKV, PROJ, SSBUF + (size_t)(3 * l) * NTOK};
                  pg8::gemm_phase<pg8::EpiBf16H, pg8::TailHalfOrder, true, true, true>(ldsl, g, T, EH); } }
            if (l == 0) {
              pg8::Gemm g{MB, (const bf16_t*)(ws + WS_WCKV), MEMROWS, 4 * 2 * XW, DM}; pg8::StaticOrder S; S.init(MEMROWS, 4 * 2 * XW, G, (bx + G - 64) % G);
              pg8::EpiBf16 E{KVX, 4 * 2 * XW, RSM};
              pg8::gemm_phase<pg8::EpiBf16, pg8::StaticOrder, true, true>(ldsl, g, S, E); }
            REPSEAM(0);
        }
        SEAM(pb + 0);
        if (EN(1) && IN(pb + 1)) {
            const int tid = opaque_tid(); const float* tabC = TABC; float* lsebuf = LSEBUF;
            gu32* qhead = ctl + CW_QUEUE + 64 * (2 * l);
            volatile LAS unsigned* uidw = (volatile LAS unsigned*)(ldsl + att::OFF_UID);
            for (;;) {
                if (tid == 0) uidw[0] = __hip_atomic_fetch_add(qhead, 1u, __ATOMIC_RELAXED, __HIP_MEMORY_SCOPE_AGENT);
                __syncthreads();
                const int u = (int)uidw[0];
                __syncthreads();
                if (u >= 1344) break;
                if (u < 960 && u % 5 == 4) {
                    qknorm_rows(QKV, ROPEC, ROPES, args.in[6] + (size_t)l * HD, args.in[7] + (size_t)l * HD, (u / 5) * 256, tid);
                } else { const int v0 = (u < 960) ? u - u / 5 : u - 192;
                {
                    const int v = v0, gi = v % 3, idx = v / 3; const int d = (gi == 0) ? 1 : (gi == 1) ? 4 : 16;
                    long row0; int j, L;
                    if (idx < 128) { row0 = (long)(idx / 64) * SEQ_P; j = idx % 64; L = SEQ_P; } else { const int i2 = idx - 128; row0 = NPROMPT + (long)(i2 / 32) * SEQ_S; j = i2 % 32; L = SEQ_S; }
                    const int res = j % d, qbr = j / d, p0 = qbr * 128, Lr = L / d;
                    int tlo = p0 / 64 - 1, thi = p0 / 64 + 3; if (tlo < 0) tlo = 0; if (thi > Lr / 64) thi = Lr / 64;
                    const long rq = row0 + (long)p0 * d + res, rk = row0 + res; const int hc = 2 * gi;
                    att::attn_unit<true>(QKV + rq * PROJ + COL_QC + hc * HD, (long)d * PROJ, QKV + rk * PROJ + COL_KC + gi * HD, QKV + rk * PROJ + COL_VC + gi * HD, (long)d * PROJ,
                                         MIX + rq * MIXW + 1280 + hc * HD, (long)d * MIXW, tlo, thi, p0, 64, tabC + hc * 512, 321, -1e30f, -1e30f, 0.f, lsebuf + rq * 6 + hc, (long)d * 6, (char*)lds);
                } }
            }
        }
        SEAM(pb + 1);
        if (EN(2) && IN(pb + 2)) for (int rep = 0; rep < NREP(2); ++rep) {
            const int tid = opaque_tid(); const float* tabB = TABB;
            float mfix2;
            { const float* qg = args.in[6] + (size_t)l * HD; const float* kg = args.in[7] + (size_t)l * HD; const int ln = tid & 63;
              float a = fmaxf(fabsf(qg[ln]), fabsf(qg[ln + 64])), b = fmaxf(fabsf(kg[ln]), fabsf(kg[ln + 64]));
#pragma unroll
              for (int o = 1; o < 64; o <<= 1) { a = fmaxf(a, __shfl_xor(a, o)); b = fmaxf(b, __shfl_xor(b, o)); }
              mfix2 = __builtin_amdgcn_readfirstlane(128.f * a * b * 1.02f * att::C); if (!(mfix2 <= 40.f)) mfix2 = -1.f; }
            gu32* qhead = ctl + CW_QUEUE + 64 * (2 * l + 1 + 8 * rep);
            volatile LAS unsigned* uidw = (volatile LAS unsigned*)(ldsl + att::OFF_UID);
            const float* sink = args.in[8] + (size_t)l * 4;
            for (;;) {
                if (tid == 0) uidw[0] = __hip_atomic_fetch_add(qhead, 1u, __ATOMIC_RELAXED, __HIP_MEMORY_SCOPE_AGENT);
                __syncthreads();
                const int u = (int)uidw[0];
                __syncthreads();
                if (u >= 1152 + 192 + 768) break;
                if (u < 1152) {
                    int seq, kvh, qb, gi, L;
                    if (u < 384) { seq = u / 192; const int r = u % 192; kvh = r / 96; const int r2 = r % 96; qb = r2 / 3; gi = r2 % 3; L = SEQ_P; }
                    else { const int v = u - 384; seq = 2 + v / 96; const int r = v % 96; kvh = r / 48; const int r2 = r % 48; qb = r2 / 3; gi = r2 % 3; L = SEQ_S; }
                    const long row0 = (seq < 2) ? (long)seq * SEQ_P : (long)NPROMPT + (long)(seq - 2) * SEQ_S;
                    const int h = kvh * 3 + gi;
                    att::attn_unit_dense<true>(QKV + (row0 + qb * 256) * PROJ + COL_QA + h * HD, PROJ, QKV + row0 * PROJ + COL_KA + kvh * HD, QKV + row0 * PROJ + COL_VA + kvh * HD, PROJ,
                                         MIX + (row0 + qb * 256) * MIXW + h * HD, MIXW, L / 64, mfix2, (char*)lds);
                } else if (u < 1344) { if (rep == 0) crescale_rows(MIX, LSEBUF, (u - 1152) * 256, tid); }
                else {
                    const int v = u - 1344, qbg = v >> 1, kvh = v & 1; const long rowq = (long)qbg * 128;
                    long row0; int pos0, L;
                    if (rowq < NPROMPT) { row0 = (rowq / SEQ_P) * SEQ_P; pos0 = (int)(rowq % SEQ_P); L = SEQ_P; } else { const long rr = rowq - NPROMPT; row0 = NPROMPT + (rr / SEQ_S) * SEQ_S; pos0 = (int)(rr % SEQ_S); L = SEQ_S; }
                    int tlo = pos0 / 64 - 2, thi = pos0 / 64 + 4; if (tlo < 0) tlo = 0; if (thi > L / 64) thi = L / 64;
                    const int h = 2 * kvh;
                    att::attn_unit<true>(QKV + rowq * PROJ + COL_QB + h * HD, PROJ, QKV + row0 * PROJ + COL_KB + kvh * HD, QKV + row0 * PROJ + COL_VB + kvh * HD, PROJ,
                                         MIX + rowq * MIXW + 768 + h * HD, MIXW, tlo, thi, pos0, 128, tabB + h * 512, 449, sink[h] * att::LOG2E, sink[h + 1] * att::LOG2E, 1.0f, nullptr, 0, (char*)lds);
                }
            }
            REPSEAM(2);
        }
        SEAM(pb + 2);
        if (EN(3) && IN(pb + 3)) for (int rep = 0; rep < NREP(3); ++rep) {
            const bf16_t* Wout = (const bf16_t*)(ws + WS_WOUT) + (size_t)l * DM * MIXW;
            pg8::Gemm g{MIX, Wout, NTOK, DM, MIXW}; pg8::StaticOrder S; S.init(NTOK, DM, G, bx);
            pg8::EpiRes E{XB, SSBUF + (size_t)(rep ? NNORM : 3 * l + 1) * NTOK, rep ? 0.f : 1.f};
            pg8::gemm_phase<pg8::EpiRes, pg8::StaticOrder, true, true>(ldsl, g, S, E);
            REPSEAM(3);
        }
        SEAM(pb + 3);
        if (EN(4) && IN(pb + 4)) for (int rep = 0; rep < NREP(4); ++rep) {
            const bf16_t* Wcq = (const bf16_t*)(ws + WS_WCQ) + (size_t)l * XW * DM;
            const bool tail = (G == 256);
            pg8::Gemm g{XB, Wcq, NTOK, XW, DM}; pg8::StaticOrder S; S.init(NTOK, XW, G, bx, 0, tail ? 1 : (1 << 30)); pg8::EpiBf16 E{QX, XW, SSBUF + (size_t)(3 * l + 1) * NTOK};
            pg8::gemm_phase<pg8::EpiBf16, pg8::StaticOrder, true, true>(ldsl, g, S, E);
            if (tail) { pg8::TailHalfOrder T; T.init(NTOK, XW, G, bx, 1); pg8::EpiBf16H EH{QX, XW, SSBUF + (size_t)(3 * l + 1) * NTOK};
                pg8::gemm_phase<pg8::EpiBf16H, pg8::TailHalfOrder, true, true, true>(ldsl, g, T, EH); }
            REPSEAM(4);
        }
        SEAM(pb + 4);
        if (EN(5) && IN(pb + 5)) for (int rep = 0; rep < NREP(5); ++rep) {
            for (int u = bx; u < 768; u += G) {
                const int qbg = u >> 2, h = u & 3; const long rowq = (long)qbg * 256;
                const int seq = (rowq < NPROMPT) ? (int)(rowq / SEQ_P) : 2 + (int)((rowq - NPROMPT) / SEQ_S);
                const bf16_t* kb = KVX + (size_t)seq * MEMLEN * (4 * 2 * XW) + l * (2 * XW) + h * HD;
                att::attn_unit_dense<false>(QX + rowq * XW + h * HD, XW, kb, kb + XW, 4 * 2 * XW, OX + rowq * XW + h * HD, XW, MEMLEN / 64, -1.f, (char*)lds);
            }
            REPSEAM(5);
        }
        SEAM(pb + 5);
        if (EN(6) && IN(pb + 6)) for (int rep = 0; rep < NREP(6); ++rep) {
            const bf16_t* Wco = (const bf16_t*)(ws + WS_WCO) + (size_t)l * DM * XW;
            pg8::Gemm g{OX, Wco, NTOK, DM, XW}; pg8::StaticOrder S; S.init(NTOK, DM, G, bx);
            pg8::EpiRes E{XB, SSBUF + (size_t)(rep ? NNORM : 3 * l + 2) * NTOK, rep ? 0.f : 1.f};
            pg8::gemm_phase<pg8::EpiRes, pg8::StaticOrder, true, true>(ldsl, g, S, E);
            REPSEAM(6);
        }
        SEAM(pb + 6);
        if (EN(7) && IN(pb + 7)) for (int rep = 0; rep < NREP(7); ++rep) {
            const bf16_t* Wfi = (const bf16_t*)(ws + WS_WFI) + (size_t)l * 2 * DFF * DM;
            const bool dyn = (G == 256) && NREP(7) == 1;
            pg8::Gemm g{XB, Wfi, NTOK, 2 * DFF, DM}; pg8::StaticOrder S; S.init(NTOK, 2 * DFF, G, bx, 0, dyn ? 32 : (1 << 30));
            pg8::EpiSwiglu E{HID, DFF, SSBUF + (size_t)(3 * l + 2) * NTOK};
            pg8::gemm_phase<pg8::EpiSwiglu, pg8::StaticOrder, true, true>(ldsl, g, S, E);
            if (dyn) {
                if (threadIdx.x == 0) MISC[13] = __hip_atomic_fetch_add(ctl + CW_TAIL + 64 * (4 + l), 1u, __ATOMIC_RELAXED, __HIP_MEMORY_SCOPE_AGENT);
                __syncthreads(); const int slot1 = __builtin_amdgcn_readfirstlane((int)MISC[13]); __syncthreads();
                if (slot1 < G) { pg8::StaticOrder S1; S1.init(NTOK, 2 * DFF, G, slot1, 32, 33);
                    pg8::gemm_phase<pg8::EpiSwiglu, pg8::StaticOrder, true, true>(ldsl, g, S1, E);
                    if (threadIdx.x == 0) MISC[13] = __hip_atomic_fetch_add(ctl + CW_TAIL + 64 * (4 + l), 1u, __ATOMIC_RELAXED, __HIP_MEMORY_SCOPE_AGENT);
                    __syncthreads(); const int slot2 = __builtin_amdgcn_readfirstlane((int)MISC[13]); __syncthreads();
                    if (slot2 < G) { pg8::StaticOrder S2; S2.init(NTOK, 2 * DFF, G, slot2, 32, 33);
                        pg8::gemm_phase<pg8::EpiSwiglu, pg8::StaticOrder, true, true>(ldsl, g, S2, E); } } }
            REPSEAM(7);
        }
        SEAM(pb + 7);
        if (EN(8) && IN(pb + 8)) for (int rep = 0; rep < NREP(8); ++rep) {
            const bf16_t* Wfo = (const bf16_t*)(ws + WS_WFO) + (size_t)l * DM * DFF;
            pg8::Gemm g{HID, Wfo, NTOK, DM, DFF}; pg8::StaticOrder S; S.init(NTOK, DM, G, bx);
            pg8::EpiRes E{XB, SSBUF + (size_t)(rep ? NNORM : 3 * l + 3) * NTOK, rep ? 0.f : 1.f};
            pg8::gemm_phase<pg8::EpiRes, pg8::StaticOrder, true, true>(ldsl, g, S, E);
            REPSEAM(8);
        }
        SEAM(pb + 8);
    }
    if (EN(14) && IN(NPHASE - 1)) {
        LANE_ID();
        const float* g = args.in[19]; const pg8::ss_t* ssl = SSBUF + (size_t)(NNORM - 1) * NTOK;
        f32x4 gg[8];
#pragma unroll
        for (int j = 0; j < 8; ++j) gg[j] = ((const GAS f32x4*)g)[lane + 64 * j];
        for (int m = gw; m < NTOK; m += 4 * NGW) {
            u32x2 w[4][8]; float rstd[4];
#pragma unroll
            for (int i = 0; i < 4; ++i) { const int mi = m + i * NGW; const int mc = mi < NTOK ? mi : m;
                rstd[i] = __builtin_amdgcn_rsqf((float)ssl[mc] * pg8::SS_INV_MEAN + RMS_EPS);
#pragma unroll
                for (int j = 0; j < 8; ++j) w[i][j] = ((const GAS u32x2*)(XB + (size_t)mc * DM))[lane + 64 * j]; }
#pragma unroll
            for (int i = 0; i < 4; ++i) { const int mi = m + i * NGW; if (mi < NTOK) { GAS f32x4* o = (GAS f32x4*)(out + (size_t)mi * DM) + lane;
#pragma unroll
                for (int j = 0; j < 8; ++j) { const f32x4 v = {bflo(w[i][j].x), bfhi(w[i][j].x), bflo(w[i][j].y), bfhi(w[i][j].y)}; o[64 * j] = v * rstd[i] * gg[j]; } } }
        }
    }
#undef IN
#undef SEAM
}

extern "C" void kernel_launch(void* const* d_in, const int* in_sizes, int n_in, void* d_out, int out_size, void* d_ws, size_t ws_size, hipStream_t stream) {
    static int grid = 0;
    if (grid == 0) {
        if (n_in != 20 || out_size != NTOK * DM || ws_size < WS_END) { fprintf(stderr, "kernel_launch: unexpected shapes: n_in %d out %d ws %zu (need %zu)\n", n_in, out_size, ws_size, (size_t)WS_END); grid = -1; return; }
        int dev = 0, cus = 0, per_cu = 0;
        if (hipGetDevice(&dev) != hipSuccess || hipDeviceGetAttribute(&cus, hipDeviceAttributeMultiprocessorCount, dev) != hipSuccess) { grid = -1; return; }
        if (hipFuncSetAttribute((const void*)fwd, hipFuncAttributeMaxDynamicSharedMemorySize, LDS_BYTES) != hipSuccess) { fprintf(stderr, "kernel_launch: hipFuncSetAttribute failed\n"); grid = -1; return; }
        if (hipOccupancyMaxActiveBlocksPerMultiprocessor(&per_cu, (const void*)fwd, NWAVES * 64, LDS_BYTES) != hipSuccess || per_cu < 1) { fprintf(stderr, "kernel_launch: occupancy query says %d\n", per_cu); }
        (void)hipGetLastError();
        grid = cus;
    }
    if (grid < 0) return;
    (void)hipMemsetAsync((char*)d_ws + WS_CTL, 0, CTL_ZERO_BYTES, stream);
    Args a{};
    for (int i = 0; i < 20; ++i) a.in[i] = (const float*)d_in[i];
    a.out = (float*)d_out; a.ws = (unsigned char*)d_ws;
#if ONE_LAUNCH
    a.ph_lo = 0; a.ph_hi = NPHASE;
    hipLaunchKernelGGL(fwd, dim3(grid), dim3(NWAVES * 64), LDS_BYTES, stream, a);
#else
    for (int p = 0; p < NPHASE; ++p) { a.ph_lo = p; a.ph_hi = p + 1; hipLaunchKernelGGL(fwd, dim3(grid), dim3(NWAVES * 64), LDS_BYTES, stream, a); }
#endif
    const hipError_t le = hipPeekAtLastError();
    if (le != hipSuccess) fprintf(stderr, "kernel_launch: launch failed: %s\n", hipGetErrorName(le));
}
```

```cpp
#include <hip/hip_runtime.h>
#include <cstdio>
#include <cstdint>

#ifndef ONE_LAUNCH
#define ONE_LAUNCH 1
#endif

constexpr int DM = 2048, NTOK = 49152, NPROMPT = 16384, SEQ_P = 8192, SEQ_S = 4096, DEPTH = 4;
constexpr int PROJ = 3840, MIXW = 2048, XW = 512, DFF = 5632, MEMLEN = 256, MEMROWS = 2560, HD = 128;
constexpr int COL_QA = 0, COL_KA = 768, COL_VA = 1024, COL_QB = 1280, COL_KB = 1792, COL_VB = 2048, COL_QC = 2304, COL_KC = 3072, COL_VC = 3456;
constexpr float RMS_EPS = 1e-6f;
constexpr int PPL = 9;
constexpr int NPHASE = 2 + PPL * DEPTH;
constexpr int NNORM = 3 * DEPTH + 1;

constexpr size_t MiB = 1u << 20;
constexpr size_t WS_CTL = 0;
constexpr size_t WS_SS = 1 * MiB;
constexpr size_t CTL_ZERO_BYTES = 6 * MiB + 512 * 1024;
static_assert(WS_SS + (size_t)(NNORM + 1) * NTOK * 8 <= CTL_ZERO_BYTES, "ss inside the memset region");
constexpr size_t WS_TAB = 6 * MiB + 512 * 1024;
constexpr size_t WS_RSM = 7 * MiB;
constexpr size_t WS_LSE = 618 * MiB;
constexpr size_t WS_WIN = 8 * MiB, WS_WOUT = 68 * MiB, WS_WCQ = 100 * MiB, WS_WCKV = 108 * MiB, WS_WCO = 124 * MiB, WS_WFI = 132 * MiB, WS_WFO = 308 * MiB;
constexpr size_t WS_XB = 396 * MiB;
constexpr size_t WS_MB = 588 * MiB;
constexpr size_t WS_KVX = 598 * MiB;
constexpr size_t WS_QKV = 620 * MiB;
constexpr size_t WS_MIX = 980 * MiB;
constexpr size_t WS_HID = 620 * MiB;
constexpr size_t WS_QX = 620 * MiB, WS_OX = 668 * MiB;
constexpr size_t WS_END = 1172 * MiB;
constexpr int CW_BAR = 4096;
constexpr int CW_XRANK = 12288;
constexpr int CW_TAIL = 24576;
constexpr int CW_QUEUE = 16384;

#define GAS __attribute__((address_space(1)))
#define LAS __attribute__((address_space(3)))
typedef unsigned short bf16_t;
typedef short bf16x8 __attribute__((ext_vector_type(8)));
typedef short s16x4 __attribute__((ext_vector_type(4)));
typedef float f32x4 __attribute__((ext_vector_type(4)));
typedef float f32x16 __attribute__((ext_vector_type(16)));
typedef unsigned u32x4 __attribute__((ext_vector_type(4)));
typedef unsigned u32x2 __attribute__((ext_vector_type(2)));
typedef GAS unsigned gu32;

__device__ __forceinline__ int opaque_tid() { int t = threadIdx.x; asm volatile("" : "+v"(t)); return t; }
__device__ __forceinline__ unsigned cvt_pk_bf16(float lo, float hi) { unsigned r; asm volatile("v_cvt_pk_bf16_f32 %0, %1, %2" : "=v"(r) : "v"(lo), "v"(hi)); return r; }
__device__ __forceinline__ float bf2f(unsigned short b) { return __builtin_bit_cast(float, (unsigned)b << 16); }
__device__ __forceinline__ float bflo(unsigned w) { return __builtin_bit_cast(float, w << 16); }
__device__ __forceinline__ float bfhi(unsigned w) { return __builtin_bit_cast(float, w & 0xffff0000u); }

namespace pg8 {
#define PG8_LAS __attribute__((address_space(3)))
constexpr int BM = 256, BK = 64, HALF = 128, HTB = HALF * BK * 2, STAGE_BYTES = 8 * HTB, NXCD = 8, WGM = 4;
__host__ __device__ __forceinline__ int lds_byte(int r, int c) { const int st = (r >> 4) * 2 + (c >> 5), rr = r & 15, cc = c & 31, ob = rr * 64 + cc * 2; return st * 1024 + (ob ^ (((ob >> 9) & 1) << 5)); }
__host__ __device__ __forceinline__ void stage_rc(int b, int& R, int& C) { const int st = b / 1024, sb = b % 1024, swz = sb ^ (((sb >> 9) & 1) << 5); R = (st >> 1) * 16 + swz / 64; C = (st & 1) * 32 + (swz % 64) / 2; }
__host__ __device__ __forceinline__ int perm32(int rho) { const int n = rho >> 4, i = rho & 15; return 8 * (i >> 2) + 4 * n + (i & 3); }

struct Unit { int pm, pn; };
struct Gemm { const bf16_t* A; const bf16_t* Bt; int M, N, K; };

struct StaticOrder {
    int nM, nN, nwg, G, c, i_lo, i_hi, wgm = WGM;
    __host__ __device__ void init(int M, int N, int G_, int c_, int lo_ = 0, int hi_ = 1 << 30) { nM = M / BM; nN = N / BM; nwg = nM * nN; G = G_; c = c_; i_lo = lo_; i_hi = hi_; }
    __host__ __device__ bool next(int i, Unit& u) const {
        i += i_lo; if (i >= i_hi) return false;
        const long L = (long)i * G + c; if (L >= nwg) return false;
        int wgid = (int)L; { const int q = nwg / NXCD, r = nwg % NXCD, xcd = wgid % NXCD, off = wgid / NXCD; wgid = (xcd < r ? xcd * (q + 1) : r * (q + 1) + (xcd - r) * q) + off; }
        const int nig = wgm * nN, gid = wgid / nig, fm = gid * wgm, gsz = (nM - fm) < wgm ? (nM - fm) : wgm;
        u.pm = fm + ((wgid % nig) % gsz); u.pn = (wgid % nig) / gsz; return true;
    }
    __device__ __forceinline__ void a_ready(const Unit&) const {}
    __device__ __forceinline__ void done(const Unit&) const {}
};

struct TailHalfOrder {
    StaticOrder F; int c;
    __host__ __device__ void init(int M, int N, int G_, int c_, int round) { F.init(M, N, G_, c_ >> 1, round, round + 1); c = c_; }
    __host__ __device__ bool next(int i, Unit& u) const { if (i != 0) return false; Unit f; if (!F.next(0, f)) return false; u.pm = f.pm; u.pn = 2 * f.pn + (c & 1); return true; }
    __device__ __forceinline__ void a_ready(const Unit&) const {}
    __device__ __forceinline__ void done(const Unit&) const {}
};

typedef unsigned long long ss_t;
constexpr float SS_SCALE = 16777216.0f, SS_INV_MEAN = 1.0f / (16777216.0f * 2048.0f);
struct PreSS { ss_t v[2][4]; };
struct PreNone {};
__device__ __forceinline__ unsigned lane_perm(int src4, unsigned v) { return (unsigned)__builtin_amdgcn_ds_bpermute(src4, (int)v); }
__device__ __forceinline__ void ss_prefetch(PreSS& p, const ss_t* ss, int row0) {
#pragma unroll
    for (int ai = 0; ai < 2; ++ai)
#pragma unroll
        for (int m = 0; m < 4; ++m) p.v[ai][m] = ss[row0 + ai * HALF + m * 16];
}
__device__ __forceinline__ void row_rstd(const PreSS& p, float (&rs)[2][4]) {
#pragma unroll
    for (int ai = 0; ai < 2; ++ai)
#pragma unroll
        for (int m = 0; m < 4; ++m) {
            const ss_t v = p.v[ai][m]; const float f = (float)(unsigned)(v >> 32) * 4294967296.0f + (float)(unsigned)v;
            rs[ai][m] = __builtin_amdgcn_rsqf(f * SS_INV_MEAN + 1e-6f); }
}
template <int NBJ>
struct EpiBf16T {
    static constexpr bool PERM = true, AFTER_DRAIN = false;
    bf16_t* O; int ldc; const ss_t* ss;
    typedef PreSS Pre;
    __device__ __forceinline__ void prefetch(Pre& p, const Unit& u, int wr, int fr) const { ss_prefetch(p, ss, u.pm * BM + wr * 64 + fr); }
    __device__ __forceinline__ void operator()(const f32x4 (&acc)[2][2][4][2], const Unit& u, int wr, int wc, int fr, int fq, const Pre& pre) const {
        const int row0 = u.pm * BM + wr * 64 + fr; const int col0 = u.pn * (NBJ * HALF) + wc * 32 + 8 * fq;
        float rs[2][4]; row_rstd(pre, rs);
#pragma unroll
        for (int ai = 0; ai < 2; ++ai)
#pragma unroll
            for (int m = 0; m < 4; ++m) { bf16_t* rowp = O + (size_t)(row0 + ai * HALF + m * 16) * ldc + col0; const float r = rs[ai][m];
#pragma unroll
                for (int bj = 0; bj < NBJ; ++bj) { const f32x4 v0 = acc[ai][bj][m][0] * r, v1 = acc[ai][bj][m][1] * r;
                    u32x4 w; w.x = cvt_pk_bf16(v0[0], v0[1]); w.y = cvt_pk_bf16(v0[2], v0[3]); w.z = cvt_pk_bf16(v1[0], v1[1]); w.w = cvt_pk_bf16(v1[2], v1[3]);
                    *(u32x4*)(rowp + bj * HALF) = w; } }
    }
};
typedef EpiBf16T<2> EpiBf16; typedef EpiBf16T<1> EpiBf16H;
struct EpiRes {
    static constexpr bool PERM = true, AFTER_DRAIN = false;
    bf16_t* xb; ss_t* ssout; float scale;
    typedef PreNone Pre;
    __device__ __forceinline__ void prefetch(Pre&, const Unit&, int, int) const {}
    __device__ __forceinline__ void operator()(const f32x4 (&acc)[2][2][4][2], const Unit& u, int wr, int wc, int fr, int fq, const Pre&) const {
        const int row0 = u.pm * BM + wr * 64 + fr; const int col0 = u.pn * BM + wc * 32 + 8 * fq;
        bf16_t* xbase = xb + (size_t)row0 * DM + col0;
        const int pl = fq * 16 + fr, psrc = (4 * fr + fq) * 4;
        const bf16_t* xload = xb + (size_t)(u.pm * BM + wr * 64 + (pl >> 2)) * DM + u.pn * BM + wc * 32 + 8 * (pl & 3);
#pragma unroll
        for (int ai = 0; ai < 2; ++ai) { float sq[4];
            u32x4 xv[4][2];
#pragma unroll
            for (int m = 0; m < 4; ++m)
#pragma unroll
                for (int bj = 0; bj < 2; ++bj) xv[m][bj] = *(const u32x4*)(xload + (size_t)(ai * HALF + m * 16) * DM + bj * HALF);
#pragma unroll
            for (int m = 0; m < 4; ++m) { bf16_t* bp = xbase + (size_t)(ai * HALF + m * 16) * DM;
                float q = 0.f;
#pragma unroll
                for (int bj = 0; bj < 2; ++bj) { const u32x4 xq = xv[m][bj]; u32x4 xw; xw.x = lane_perm(psrc, xq.x); xw.y = lane_perm(psrc, xq.y); xw.z = lane_perm(psrc, xq.z); xw.w = lane_perm(psrc, xq.w);
                    const f32x4 d0 = acc[ai][bj][m][0] * scale, d1 = acc[ai][bj][m][1] * scale;
                    u32x4 w; w.x = cvt_pk_bf16(bflo(xw.x) + d0[0], bfhi(xw.x) + d0[1]); w.y = cvt_pk_bf16(bflo(xw.y) + d0[2], bfhi(xw.y) + d0[3]);
                    w.z = cvt_pk_bf16(bflo(xw.z) + d1[0], bfhi(xw.z) + d1[1]); w.w = cvt_pk_bf16(bflo(xw.w) + d1[2], bfhi(xw.w) + d1[3]);
                    *(u32x4*)(bp + bj * HALF) = w;
                    const float e0 = bflo(w.x), e1 = bfhi(w.x), e2 = bflo(w.y), e3 = bfhi(w.y), e4 = bflo(w.z), e5 = bfhi(w.z), e6 = bflo(w.w), e7 = bfhi(w.w);
                    q += (e0 * e0 + e1 * e1) + (e2 * e2 + e3 * e3) + (e4 * e4 + e5 * e5) + (e6 * e6 + e7 * e7); }
                sq[m] = q; }
            asm volatile("" ::: "memory");
            const bool b0 = fq & 1, b1 = fq & 2;
            const float w0 = (b0 ? sq[1] : sq[0]) + __shfl_xor(b0 ? sq[0] : sq[1], 16), w1 = (b0 ? sq[3] : sq[2]) + __shfl_xor(b0 ? sq[2] : sq[3], 16);
            const float tot = (b1 ? w1 : w0) + __shfl_xor(b1 ? w0 : w1, 32);
            __hip_atomic_fetch_add(ssout + u.pm * BM + ai * HALF + wr * 64 + fq * 16 + fr, (ss_t)(tot * SS_SCALE), __ATOMIC_RELAXED, __HIP_MEMORY_SCOPE_AGENT); }
    }
};
struct EpiSwiglu {
    static constexpr bool PERM = true, AFTER_DRAIN = false;
    bf16_t* O; int ldc; const ss_t* ss;
    typedef PreSS Pre;
    __device__ __forceinline__ void prefetch(Pre& p, const Unit& u, int wr, int fr) const { ss_prefetch(p, ss, u.pm * BM + wr * 64 + fr); }
    __device__ __forceinline__ void operator()(const f32x4 (&acc)[2][2][4][2], const Unit& u, int wr, int wc, int fr, int fq, const Pre& pre) const {
        const int row0 = u.pm * BM + wr * 64 + fr; const int col0 = u.pn * HALF + wc * 32 + 8 * fq;
        float rs[2][4]; row_rstd(pre, rs);
#pragma unroll
        for (int ai = 0; ai < 2; ++ai)
#pragma unroll
            for (int m = 0; m < 4; ++m) {
                const float r = rs[ai][m], c = -1.4426950408889634f * r, r2 = r * r;
                const f32x4 g0 = acc[ai][0][m][0], g1 = acc[ai][0][m][1], u0 = acc[ai][1][m][0], u1 = acc[ai][1][m][1];
                const f32x4 t0 = g0 * c, t1 = g1 * c;
                f32x4 e0, e1;
#pragma unroll
                for (int i = 0; i < 4; ++i) { e0[i] = __builtin_amdgcn_exp2f(t0[i]); e1[i] = __builtin_amdgcn_exp2f(t1[i]); }
                const f32x4 d0 = e0 + 1.0f, d1 = e1 + 1.0f;
                f32x4 q0, q1;
#pragma unroll
                for (int i = 0; i < 4; ++i) { q0[i] = __builtin_amdgcn_rcpf(d0[i]); q1[i] = __builtin_amdgcn_rcpf(d1[i]); }
                const f32x4 h0 = (g0 * u0) * (q0 * r2), h1 = (g1 * u1) * (q1 * r2);
                u32x4 w; w.x = cvt_pk_bf16(h0[0], h0[1]); w.y = cvt_pk_bf16(h0[2], h0[3]); w.z = cvt_pk_bf16(h1[0], h1[1]); w.w = cvt_pk_bf16(h1[2], h1[3]);
                *(u32x4*)(O + (size_t)(row0 + ai * HALF + m * 16) * ldc + col0) = w; }
    }
};

template <class Epi, class Sched, bool ALIGN_EPI = false, bool SP2 = false, bool HALFN = false>
__device__ __forceinline__ void gemm_phase(PG8_LAS unsigned char* lds, const Gemm g, const Sched& S, const Epi& E) {
    const int tid = opaque_tid(), wid = __builtin_amdgcn_readfirstlane(tid >> 6), lane = tid & 63, wr = wid >> 2, wc = wid & 3, fr = lane & 15, fq = lane >> 4;
    const int K = g.K, nt = K / BK;
    unsigned voffA[2], voffB[2];
#pragma unroll
    for (int i = 0; i < 2; ++i) { int R, C; stage_rc(tid * 16 + i * 8192, R, C); const int Rb = Epi::PERM ? ((R & ~31) + perm32(R & 31)) : R;
        voffA[i] = (unsigned)(R * K + C) * 2u; voffB[i] = (unsigned)(Rb * K + C) * 2u; }
    const size_t kstep = (size_t)(BK * 2);
    const size_t hstep = (size_t)HALF * K * 2;
    const size_t tstep = 2 * hstep;
    const size_t bstep = HALFN ? hstep : tstep;
    const unsigned ldsw = (unsigned)wid * 1024u;
    const int aoff = lds_byte(wr * 64 + fr, fq * 8), boff = lds_byte(wc * 32 + fr, fq * 8);
#define PG8_SA(b, h) (((b) * 2 + (h)) * HTB)
#define PG8_SB(b, h) ((4 + (b) * 2 + (h)) * HTB)
#define PG8_STAGE(bufoff, gbase, voff) do { _Pragma("unroll") for (int _i = 0; _i < 2; ++_i) \
        __builtin_amdgcn_global_load_lds((const unsigned*)((const char*)(gbase) + (voff)[_i]), (PG8_LAS unsigned*)(lds + (bufoff) + ldsw + _i * 8192), 16, 0, 0); } while (0)
#define PG8_LDA(dst, b, h) do { _Pragma("unroll") for (int m = 0; m < 4; ++m) _Pragma("unroll") for (int k = 0; k < 2; ++k) dst[m][k] = *(const PG8_LAS bf16x8*)(lds + PG8_SA(b, h) + aoff + m * 2048 + k * 1024); } while (0)
#define PG8_LDB(dst, b, h) do { _Pragma("unroll") for (int n = 0; n < 2; ++n) _Pragma("unroll") for (int k = 0; k < 2; ++k) dst[n][k] = *(const PG8_LAS bf16x8*)(lds + PG8_SB(b, h) + boff + n * 2048 + k * 1024); } while (0)
#define PG8_MMA(ai, bj, At, Bt) do { __builtin_amdgcn_s_setprio(1); _Pragma("unroll") for (int m = 0; m < 4; ++m) _Pragma("unroll") for (int n = 0; n < 2; ++n) _Pragma("unroll") for (int k = 0; k < 2; ++k) \
        acc[ai][bj][m][n] = __builtin_amdgcn_mfma_f32_16x16x32_bf16(Bt[n][k], At[m][k], acc[ai][bj][m][n], 0, 0, 0); __builtin_amdgcn_s_setprio(0); } while (0)
#define PG8_WAIT_V(n) asm volatile("s_waitcnt vmcnt(" #n ")" ::: "memory")
#define PG8_WAIT_L(n) asm volatile("s_waitcnt lgkmcnt(" #n ")" ::: "memory")
#define PG8_BAR __builtin_amdgcn_s_barrier()
#define PG8_SCHED __builtin_amdgcn_sched_barrier(0)
    Unit cur, nxt; int ui = 0;
    if (!S.next(0, cur)) return;
    f32x4 acc[2][2][4][2];
#pragma unroll
    for (int a = 0; a < 2; ++a)
#pragma unroll
        for (int b = 0; b < 2; ++b)
#pragma unroll
            for (int m = 0; m < 4; ++m)
#pragma unroll
                for (int n = 0; n < 2; ++n) acc[a][b][m][n] = (f32x4){0.f, 0.f, 0.f, 0.f};
    bf16x8 At[4][2], B0[2][2], B1[2][2];
    typename Epi::Pre pre;
    const char* cA = (const char*)g.A + (size_t)cur.pm * tstep; const char* cB = (const char*)g.Bt + (size_t)cur.pn * bstep;
    S.a_ready(cur);
    if constexpr (SP2 && HALFN) {
        PG8_STAGE(PG8_SB(0, 0), cB, voffB); PG8_STAGE(PG8_SA(0, 0), cA, voffA); PG8_STAGE(PG8_SA(0, 1), cA + hstep, voffA);
        if (wr == 1) PG8_BAR;
        PG8_WAIT_V(2); PG8_BAR;
        PG8_STAGE(PG8_SB(1, 0), cB + kstep, voffB); PG8_STAGE(PG8_SA(1, 0), cA + kstep, voffA);
        PG8_WAIT_V(4); PG8_BAR;
    } else if constexpr (SP2) {
        PG8_STAGE(PG8_SB(0, 0), cB, voffB); PG8_STAGE(PG8_SB(0, 1), cB + hstep, voffB); PG8_STAGE(PG8_SA(0, 0), cA, voffA); PG8_STAGE(PG8_SA(0, 1), cA + hstep, voffA);
        if (wr == 1) PG8_BAR;
        PG8_WAIT_V(2); PG8_BAR;
        PG8_STAGE(PG8_SB(1, 0), cB + kstep, voffB); PG8_STAGE(PG8_SA(1, 0), cA + kstep, voffA); PG8_STAGE(PG8_SB(1, 1), cB + hstep + kstep, voffB);
        PG8_WAIT_V(6); PG8_BAR;
    } else {
        PG8_STAGE(PG8_SB(0, 0), cB, voffB); PG8_STAGE(PG8_SA(0, 0), cA, voffA); PG8_STAGE(PG8_SB(0, 1), cB + hstep, voffB); PG8_STAGE(PG8_SA(0, 1), cA + hstep, voffA);
        if (wr == 1) PG8_BAR;
        PG8_WAIT_V(4); PG8_BAR;
        PG8_STAGE(PG8_SB(1, 0), cB + kstep, voffB); PG8_STAGE(PG8_SA(1, 0), cA + kstep, voffA); PG8_STAGE(PG8_SB(1, 1), cB + hstep + kstep, voffB);
        PG8_WAIT_V(6); PG8_BAR;
    }
    for (;;) {
        const bool has_next = S.next(ui + 1, nxt);
        const char* nA = has_next ? (const char*)g.A + (size_t)nxt.pm * tstep : cA; const char* nB = has_next ? (const char*)g.Bt + (size_t)nxt.pn * bstep : cB;
        for (int t = 0; t < nt; t += 2) {
            const bool last = (t == nt - 2);
            const char* a1 = cA + (size_t)(t + 1) * kstep;
            const char* a2 = last ? nA : cA + (size_t)(t + 2) * kstep; const char* b2 = last ? nB : cB + (size_t)(t + 2) * kstep;
            const char* a3 = a2 + kstep; const char* b3 = b2 + kstep;
            if (last && has_next) S.a_ready(nxt);
            if (last) E.prefetch(pre, cur, wr, fr);
            if constexpr (SP2 && HALFN) {
            PG8_LDB(B0, 0, 0); PG8_SCHED; PG8_LDA(At, 0, 0); PG8_STAGE(PG8_SA(1, 1), a1 + hstep, voffA);
            PG8_WAIT_V(6); PG8_WAIT_L(0); PG8_BAR; PG8_MMA(0, 0, At, B0); PG8_BAR; PG8_SCHED;
            PG8_LDA(At, 0, 1); PG8_STAGE(PG8_SB(0, 0), b2, voffB); PG8_STAGE(PG8_SA(0, 0), a2, voffA);
            PG8_WAIT_V(6); PG8_WAIT_L(0); PG8_BAR; PG8_MMA(1, 0, At, B0); PG8_BAR; PG8_SCHED;
            PG8_LDB(B0, 1, 0); PG8_SCHED; PG8_LDA(At, 1, 0); PG8_STAGE(PG8_SA(0, 1), a2 + hstep, voffA);
            PG8_WAIT_V(6); PG8_WAIT_L(0); PG8_BAR; PG8_MMA(0, 0, At, B0); PG8_BAR; PG8_SCHED;
            PG8_LDA(At, 1, 1); PG8_STAGE(PG8_SB(1, 0), b3, voffB); PG8_STAGE(PG8_SA(1, 0), a3, voffA);
            PG8_WAIT_V(6); PG8_WAIT_L(0); PG8_BAR; PG8_MMA(1, 0, At, B0); PG8_BAR; PG8_SCHED;
            } else if constexpr (SP2) {
            PG8_LDB(B0, 0, 0); PG8_LDB(B1, 0, 1); PG8_SCHED; PG8_LDA(At, 0, 0); PG8_STAGE(PG8_SA(1, 1), a1 + hstep, voffA);
            PG8_WAIT_V(8); PG8_WAIT_L(0); PG8_BAR; PG8_MMA(0, 0, At, B0); PG8_MMA(0, 1, At, B1); PG8_BAR; PG8_SCHED;
            PG8_LDA(At, 0, 1); PG8_STAGE(PG8_SB(0, 0), b2, voffB); PG8_STAGE(PG8_SB(0, 1), b2 + hstep, voffB); PG8_STAGE(PG8_SA(0, 0), a2, voffA);
            PG8_WAIT_V(8); PG8_WAIT_L(0); PG8_BAR; PG8_MMA(1, 0, At, B0); PG8_MMA(1, 1, At, B1); PG8_BAR; PG8_SCHED;
            PG8_LDB(B0, 1, 0); PG8_LDB(B1, 1, 1); PG8_SCHED; PG8_LDA(At, 1, 0); PG8_STAGE(PG8_SA(0, 1), a2 + hstep, voffA);
            PG8_WAIT_V(8); PG8_WAIT_L(0); PG8_BAR; PG8_MMA(0, 0, At, B0); PG8_MMA(0, 1, At, B1); PG8_BAR; PG8_SCHED;
            PG8_LDA(At, 1, 1); PG8_STAGE(PG8_SB(1, 0), b3, voffB); PG8_STAGE(PG8_SB(1, 1), b3 + hstep, voffB); PG8_STAGE(PG8_SA(1, 0), a3, voffA);
            PG8_WAIT_V(8); PG8_WAIT_L(0); PG8_BAR; PG8_MMA(1, 0, At, B0); PG8_MMA(1, 1, At, B1); PG8_BAR; PG8_SCHED;
            } else {
            PG8_LDB(B0, 0, 0); PG8_SCHED; PG8_LDA(At, 0, 0); PG8_STAGE(PG8_SA(1, 1), a1 + hstep, voffA);
            PG8_WAIT_L(8); PG8_BAR; PG8_WAIT_L(0); PG8_MMA(0, 0, At, B0); PG8_BAR; PG8_SCHED;
            PG8_LDB(B1, 0, 1); PG8_STAGE(PG8_SB(0, 0), b2, voffB);
            PG8_BAR; PG8_WAIT_L(0); PG8_MMA(0, 1, At, B1); PG8_BAR;
            PG8_LDA(At, 0, 1); PG8_STAGE(PG8_SA(0, 0), a2, voffA);
            PG8_BAR; PG8_WAIT_L(0); PG8_MMA(1, 0, At, B0); PG8_BAR; PG8_SCHED;
            PG8_STAGE(PG8_SB(0, 1), b2 + hstep, voffB);
            PG8_WAIT_V(6); PG8_BAR; PG8_MMA(1, 1, At, B1); PG8_BAR;
            PG8_LDB(B0, 1, 0); PG8_SCHED; PG8_LDA(At, 1, 0); PG8_STAGE(PG8_SA(0, 1), a2 + hstep, voffA);
            PG8_WAIT_L(8); PG8_BAR; PG8_WAIT_L(0); PG8_MMA(0, 0, At, B0); PG8_BAR; PG8_SCHED;
            PG8_LDB(B1, 1, 1); PG8_STAGE(PG8_SB(1, 0), b3, voffB);
            PG8_BAR; PG8_WAIT_L(0); PG8_MMA(0, 1, At, B1); PG8_BAR;
            PG8_LDA(At, 1, 1); PG8_STAGE(PG8_SA(1, 0), a3, voffA);
            PG8_BAR; PG8_WAIT_L(0); PG8_MMA(1, 0, At, B0); PG8_BAR; PG8_SCHED;
            PG8_STAGE(PG8_SB(1, 1), b3 + hstep, voffB);
            PG8_WAIT_V(6); PG8_BAR; PG8_MMA(1, 1, At, B1); PG8_BAR;
            }
        }
        if constexpr (ALIGN_EPI) { if (wr == 0) PG8_BAR; }
        if constexpr (!Epi::AFTER_DRAIN) { E(acc, cur, wr, wc, fr, fq, pre); S.done(cur); }
        if (!has_next) break;
#pragma unroll
        for (int a = 0; a < 2; ++a)
#pragma unroll
            for (int b = 0; b < 2; ++b)
#pragma unroll
                for (int m = 0; m < 4; ++m)
#pragma unroll
                    for (int n = 0; n < 2; ++n) acc[a][b][m][n] = (f32x4){0.f, 0.f, 0.f, 0.f};
        cur = nxt; cA = nA; cB = nB; ++ui;
        if constexpr (ALIGN_EPI) { if (wr == 1) PG8_BAR; }
    }
    PG8_WAIT_V(0);
    if constexpr (!ALIGN_EPI) { if (wr == 0) PG8_BAR; }
    PG8_BAR;
#undef PG8_SA
#undef PG8_SB
#undef PG8_STAGE
#undef PG8_LDA
#undef PG8_LDB
#undef PG8_MMA
#undef PG8_WAIT_V
#undef PG8_WAIT_L
#undef PG8_BAR
#undef PG8_SCHED
}
}

namespace att {
constexpr int D = 128, NW = 8, QBLK = 32, KVBLK = 64;
constexpr float SCALE = 0.088388347648318440f, LOG2E = 1.4426950408889634f, LN2 = 0.6931471805599453f;
constexpr float C = SCALE * LOG2E;
constexpr float THR2 = 8.f * LOG2E;
constexpr int SHM_V = KVBLK * D * 2, SHM_K = KVBLK * D * 2;
constexpr int OFF_V = 0, OFF_K = 2 * SHM_V, BUF3 = SHM_V + SHM_K  , OFF_WS = 3 * BUF3, OFF_TAB = OFF_WS + NW * 64 * 4, TAB_FLOATS = 1024, OFF_UID = OFF_TAB + TAB_FLOATS * 4, LDS_BYTES = OFF_UID + 64;
#define KSWZ(row, colB) ((row) * 256 + ((colB) ^ (((row) & 7) << 4)))
#define SBAR() __builtin_amdgcn_sched_barrier(0)
__device__ __forceinline__ int crow(int r, int hi) { return (r & 3) + 8 * (r >> 2) + 4 * hi; }
__device__ __forceinline__ void qkt(f32x16& p0, f32x16& p1, const char* Ks, const bf16x8* qr, int r32, int hi) {
  p0 = f32x16{}; p1 = f32x16{};
#pragma unroll
  for (int d0 = 0; d0 < 8; ++d0) { const int cb = (d0 * 16 + hi * 8) * 2;
    const bf16x8 b0 = *reinterpret_cast<const bf16x8*>(Ks + KSWZ(r32, cb));
    const bf16x8 b1 = *reinterpret_cast<const bf16x8*>(Ks + KSWZ(32 + r32, cb));
    p0 = __builtin_amdgcn_mfma_f32_32x32x16_bf16(b0, qr[d0], p0, 0, 0, 0);
    p1 = __builtin_amdgcn_mfma_f32_32x32x16_bf16(b1, qr[d0], p1, 0, 0, 0); }
}
__device__ __forceinline__ int v_st(int k, int c) { const int kk = (k & ~0xC) | ((k & 4) << 1) | ((k & 8) >> 1); return ((kk >> 3) * 4 + (c >> 5)) * 512 + ((kk & 7) * 32 + (c & 31)) * 2; }
__device__ __forceinline__ int v_rd_base(int lane) { return ((lane & 3) << 3) | (((lane >> 2) & 3) << 6) | (((lane >> 4) & 1) << 5) | (((lane >> 5) & 1) << 8); }
constexpr int v_rd_off(int d0, int ks, int half) { return d0 * 512 + ks * 4096 + half * 2048; }
template <int OFF> __device__ __forceinline__ s16x4 tr_read(int vb) {
  s16x4 r; asm volatile("ds_read_b64_tr_b16 %0, %1 offset:%2" : "=&v"(r) : "v"(vb), "i"(OFF) : "memory"); return r;
}
template <int D0> __device__ __forceinline__ void pv_one(f32x16& od, int vb, bf16x8 pa0, bf16x8 pa1, bf16x8 pa2, bf16x8 pa3) {
  const s16x4 l0 = tr_read<v_rd_off(D0, 0, 0)>(vb), h0 = tr_read<v_rd_off(D0, 0, 1)>(vb), l1 = tr_read<v_rd_off(D0, 1, 0)>(vb), h1 = tr_read<v_rd_off(D0, 1, 1)>(vb);
  const s16x4 l2 = tr_read<v_rd_off(D0, 2, 0)>(vb), h2 = tr_read<v_rd_off(D0, 2, 1)>(vb), l3 = tr_read<v_rd_off(D0, 3, 0)>(vb), h3 = tr_read<v_rd_off(D0, 3, 1)>(vb);
  asm volatile("s_waitcnt lgkmcnt(0)" ::: "memory"); SBAR();
#define PK(L, H) (bf16x8){L[0], L[1], L[2], L[3], H[0], H[1], H[2], H[3]}
  od = __builtin_amdgcn_mfma_f32_32x32x16_bf16(pa0, PK(l0, h0), od, 0, 0, 0);
  od = __builtin_amdgcn_mfma_f32_32x32x16_bf16(pa1, PK(l1, h1), od, 0, 0, 0);
  od = __builtin_amdgcn_mfma_f32_32x32x16_bf16(pa2, PK(l2, h2), od, 0, 0, 0);
  od = __builtin_amdgcn_mfma_f32_32x32x16_bf16(pa3, PK(l3, h3), od, 0, 0, 0);
#undef PK
}
__device__ __forceinline__ void pv_d0(f32x16* o, int vb, bf16x8 pa0, bf16x8 pa1, bf16x8 pa2, bf16x8 pa3) {
  pv_one<0>(o[0], vb, pa0, pa1, pa2, pa3); pv_one<1>(o[1], vb, pa0, pa1, pa2, pa3); pv_one<2>(o[2], vb, pa0, pa1, pa2, pa3); pv_one<3>(o[3], vb, pa0, pa1, pa2, pa3);
}

template <bool TAB>
__device__ __forceinline__ void attn_unit(const bf16_t* __restrict__ Qb, long ldq, const bf16_t* __restrict__ Kh, const bf16_t* __restrict__ Vh, long ldk,
                                          bf16_t* __restrict__ Ob, long ldo, int t_lo, int t_hi, int qpos0, int W, const float* __restrict__ tabg, int tablen,
                                          float m_init0, float m_init1, float l_init, float* __restrict__ lse, long ldlse, char* lds) {
  const int tid = opaque_tid(), lane = tid & 63, r32 = lane & 31, hi = lane >> 5; const int wid = __builtin_amdgcn_readfirstlane(tid >> 6);
  const int hw = wid >> 2, wq = wid & 3;
  char* V_lds = lds + OFF_V; char* K_lds = lds + OFF_K;
  float* ws = (float*)(lds + OFF_WS) + wid * 64; float* li_l = ws; float* al_l = ws + 32;
  float* tab = (float*)(lds + OFF_TAB);
  bf16x8 qr[8];
  { const bf16_t* Qw = Qb + hw * D + (long)(wq * QBLK + r32) * ldq + hi * 8;
#pragma unroll
    for (int d0 = 0; d0 < 8; ++d0) qr[d0] = *reinterpret_cast<const bf16x8*>(Qw + d0 * 16); }
  if (TAB) { for (int i = tid; i < 2 * 512; i += NW * 64) tab[i] = ((i & 511) < tablen) ? tabg[i] : 0.f; }
  const int sr = tid >> 4, sc = (tid & 15) * 8, vst0 = v_st(sr, sc), vst1 = v_st(32 + sr, sc);
  const int vb0 = (int)(uintptr_t)V_lds + v_rd_base(lane);
  bf16x8 vs0, vs1, ks0, ks1;
#define SLOAD(k0) do { vs0 = *reinterpret_cast<const bf16x8*>(&Vh[(long)((k0) + sr) * ldk + sc]); vs1 = *reinterpret_cast<const bf16x8*>(&Vh[(long)((k0) + 32 + sr) * ldk + sc]); \
    ks0 = *reinterpret_cast<const bf16x8*>(&Kh[(long)((k0) + sr) * ldk + sc]); ks1 = *reinterpret_cast<const bf16x8*>(&Kh[(long)((k0) + 32 + sr) * ldk + sc]); } while (0)
#define SWRITE(b) do { *(bf16x8*)(V_lds + (b) * SHM_V + vst0) = vs0; *(bf16x8*)(V_lds + (b) * SHM_V + vst1) = vs1; const int kc = sc * 2; \
    *(bf16x8*)(K_lds + (b) * SHM_K + KSWZ(sr, kc)) = ks0; *(bf16x8*)(K_lds + (b) * SHM_K + KSWZ(32 + sr, kc)) = ks1; } while (0)
  float m_reg = hw ? m_init1 : m_init0, l_reg = l_init; f32x16 o[4] = {};
  const int qw0 = qpos0 + wq * QBLK;
  SLOAD(t_lo * KVBLK); SWRITE(0); __syncthreads();
  for (int t = t_lo; t < t_hi; ++t) {
    const int b = (t - t_lo) & 1; const bool more = (t + 1 < t_hi);
    if (more) SLOAD((t + 1) * KVBLK);
    const bool active = !TAB || (KVBLK * t + KVBLK - 1 >= qw0 - W && KVBLK * t <= qw0 + QBLK - 1 + W);
    if (active) {
      f32x16 p0, p1; qkt(p0, p1, K_lds + b * SHM_K, qr, r32, hi);
      if (TAB) { const float* tl = tab + hw * 512 + (KVBLK * t - qw0 - r32 + 4 * hi + W + 96);
#pragma unroll
        for (int r = 0; r < 16; ++r) { const int ix = (r & 3) + 8 * (r >> 2); p0[r] = fmaf(p0[r], C, tl[ix]); p1[r] = fmaf(p1[r], C, tl[ix + 32]); } }
      else {
#pragma unroll
        for (int r = 0; r < 16; ++r) { p0[r] *= C; p1[r] *= C; } }
      float pmax = p0[0];
#pragma unroll
      for (int r = 1; r < 16; ++r) pmax = fmaxf(pmax, p0[r]);
#pragma unroll
      for (int r = 0; r < 16; ++r) pmax = fmaxf(pmax, p1[r]);
      { auto rr = __builtin_amdgcn_permlane32_swap(__float_as_uint(pmax), __float_as_uint(pmax), false, false);
        pmax = fmaxf(__uint_as_float(rr[0]), __uint_as_float(rr[1])); }
      if (!__all(pmax - m_reg <= THR2)) {
        const float mn = fmaxf(m_reg, pmax); const float alpha = __builtin_amdgcn_exp2f(m_reg - mn); m_reg = mn; l_reg *= alpha;
        if (hi == 0) al_l[r32] = alpha; asm volatile("s_waitcnt lgkmcnt(0)" ::: "memory");
#pragma unroll
        for (int d = 0; d < 4; ++d)
#pragma unroll
          for (int r = 0; r < 16; ++r) o[d][r] *= al_l[crow(r, hi)];
      }
#pragma unroll
      for (int r = 0; r < 16; ++r) { p0[r] = __builtin_amdgcn_exp2f(p0[r] - m_reg); p1[r] = __builtin_amdgcn_exp2f(p1[r] - m_reg); }
      float ps = 0.f;
#pragma unroll
      for (int r = 0; r < 16; ++r) ps += p0[r];
#pragma unroll
      for (int r = 0; r < 16; ++r) ps += p1[r];
      { auto rr = __builtin_amdgcn_permlane32_swap(__float_as_uint(ps), __float_as_uint(ps), false, false);
        ps = __uint_as_float(rr[0]) + __uint_as_float(rr[1]); }
      l_reg += ps;
      bf16x8 pa0, pa1, pa2, pa3;
#define PK4(P, BASE, OUT) do { unsigned a0 = cvt_pk_bf16(P[BASE + 0], P[BASE + 1]), a1 = cvt_pk_bf16(P[BASE + 2], P[BASE + 3]);   \
    unsigned b0 = cvt_pk_bf16(P[BASE + 4], P[BASE + 5]), b1 = cvt_pk_bf16(P[BASE + 6], P[BASE + 7]);                              \
    auto r0 = __builtin_amdgcn_permlane32_swap(a0, b0, false, false); auto r1 = __builtin_amdgcn_permlane32_swap(a1, b1, false, false); \
    u32x4 w = {r0[0], r1[0], r0[1], r1[1]}; OUT = *reinterpret_cast<bf16x8*>(&w); } while (0)
      PK4(p0, 0, pa0); PK4(p0, 8, pa1); PK4(p1, 0, pa2); PK4(p1, 8, pa3);
#undef PK4
      SBAR();
      pv_d0(o, vb0 + b * SHM_V, pa0, pa1, pa2, pa3);
    }
    if (more) SWRITE(b ^ 1);
    __syncthreads();
  }
  if (hi == 0) li_l[r32] = l_reg; asm volatile("s_waitcnt lgkmcnt(0)" ::: "memory");
  float rli[16];
#pragma unroll
  for (int r = 0; r < 16; ++r) rli[r] = __builtin_amdgcn_rcpf(li_l[crow(r, hi)]);
  bf16_t* stg = (bf16_t*)(lds + wid * 8192);
#pragma unroll
  for (int r = 0; r < 16; ++r) { const int orow = crow(r, hi);
#pragma unroll
    for (int d0 = 0; d0 < 4; ++d0) { const unsigned w = cvt_pk_bf16(o[d0][r] * rli[r], 0.f); stg[orow * 128 + d0 * 32 + r32] = (bf16_t)(w & 0xffffu); } }
  asm volatile("s_waitcnt lgkmcnt(0)" ::: "memory");
#pragma unroll
  for (int i = 0; i < 8; ++i) { const int row = i * 4 + (lane >> 4), ch = lane & 15; const u32x4 v = *(const u32x4*)(stg + row * 128 + ch * 8);
    *(u32x4*)(Ob + hw * D + (long)(wq * QBLK + row) * ldo + ch * 8) = v; }
  if (lse != nullptr && hi == 0) lse[hw + (long)(wq * QBLK + r32) * ldlse] = (m_reg + __builtin_amdgcn_logf(l_reg)) * LN2;
  __syncthreads();
#undef SLOAD
#undef SWRITE
}
template <bool PRE>
__device__ __forceinline__ void partialSM(f32x16& p0, f32x16& p1, float& m_reg, float& mn, float& alpha) {
  constexpr float cs = PRE ? 1.0f : C;
  float pmax = p0[0];
#pragma unroll
  for (int r = 1; r < 16; ++r) pmax = fmaxf(pmax, p0[r]);
#pragma unroll
  for (int r = 0; r < 16; ++r) pmax = fmaxf(pmax, p1[r]);
  { auto rr = __builtin_amdgcn_permlane32_swap(__float_as_uint(pmax), __float_as_uint(pmax), false, false);
    pmax = fmaxf(__uint_as_float(rr[0]), __uint_as_float(rr[1])); }
  if (__builtin_expect(__all((pmax - m_reg) * cs <= THR2), 1)) { mn = m_reg; alpha = 1.f; }
  else { mn = fmaxf(m_reg, pmax); alpha = __builtin_amdgcn_exp2f((m_reg - mn) * cs); m_reg = mn; }
  const float mnC = -mn * cs;
#pragma unroll
  for (int r = 0; r < 16; ++r) p0[r] = fmaf(p0[r], cs, mnC);
#pragma unroll
  for (int r = 0; r < 16; ++r) p1[r] = fmaf(p1[r], cs, mnC);
#pragma unroll
  for (int r = 0; r < 16; ++r) p0[r] = __builtin_amdgcn_exp2f(p0[r]);
}
__device__ __forceinline__ void partialSM_fixed(f32x16& p0) {
#pragma unroll
  for (int r = 0; r < 16; ++r) p0[r] = __builtin_amdgcn_exp2f(p0[r]);
}
__device__ __forceinline__ void finishSM(f32x16& p0, f32x16& p1, float alpha, float& l_reg, bf16x8& pa0, bf16x8& pa1, bf16x8& pa2, bf16x8& pa3) {
#pragma unroll
  for (int r = 0; r < 16; ++r) p1[r] = __builtin_amdgcn_exp2f(p1[r]);
  float ps = 0;
#pragma unroll
  for (int r = 0; r < 16; ++r) ps += p0[r];
#pragma unroll
  for (int r = 0; r < 16; ++r) ps += p1[r];
  { auto rr = __builtin_amdgcn_permlane32_swap(__float_as_uint(ps), __float_as_uint(ps), false, false);
    ps = __uint_as_float(rr[0]) + __uint_as_float(rr[1]); }
  l_reg = l_reg * alpha + ps;
#define PK4(P, BASE, OUT) do { unsigned a0 = cvt_pk_bf16(P[BASE + 0], P[BASE + 1]), a1 = cvt_pk_bf16(P[BASE + 2], P[BASE + 3]);   \
    unsigned b0 = cvt_pk_bf16(P[BASE + 4], P[BASE + 5]), b1 = cvt_pk_bf16(P[BASE + 6], P[BASE + 7]);                              \
    auto r0 = __builtin_amdgcn_permlane32_swap(a0, b0, false, false); auto r1 = __builtin_amdgcn_permlane32_swap(a1, b1, false, false); \
    u32x4 w = {r0[0], r1[0], r0[1], r1[1]}; OUT = *reinterpret_cast<bf16x8*>(&w); } while (0)
  PK4(p0, 0, pa0); PK4(p0, 8, pa1); PK4(p1, 0, pa2); PK4(p1, 8, pa3);
#undef PK4
}
template <bool PRE, int FIXM = -1>
__device__ __forceinline__ void attn_unit_dense(const bf16_t* __restrict__ Qb, long ldq, const bf16_t* __restrict__ Kh, const bf16_t* __restrict__ Vh, long ldk,
                                                bf16_t* __restrict__ Ob, long ldo, int ntile, float mfix2, char* lds) {
  const int tid = opaque_tid(), lane = tid & 63, r32 = lane & 31, hi = lane >> 5; const int wid = __builtin_amdgcn_readfirstlane(tid >> 6);
  float* ws = (float*)(lds + OFF_WS) + wid * 64; float* li_l = ws; float* al_l = ws + 32;
  const bool fixm = FIXM < 0 ? (PRE && mfix2 >= 0.f) : (FIXM != 0);
  float m_reg = -1e30f, l_reg = 0; f32x16 o[4] = {}; bf16x8 qr[8];
  { const bf16_t* Qw = Qb + (long)(wid * QBLK + r32) * ldq + hi * 8;
#pragma unroll
    for (int d0 = 0; d0 < 8; ++d0) qr[d0] = *reinterpret_cast<const bf16x8*>(Qw + d0 * 16); }
  const int sr = tid >> 4, sc = (tid & 15) * 8, vst0 = v_st(sr, sc), vst1 = v_st(32 + sr, sc);
  const int vb0 = (int)(uintptr_t)lds + v_rd_base(lane);
  bf16x8 vsE0, vsE1, ksE0, ksE1, vsO0, vsO1, ksO0, ksO1;
#define SLOAD_E(k0) do { vsE0 = *reinterpret_cast<const bf16x8*>(&Vh[(long)((k0) + sr) * ldk + sc]); vsE1 = *reinterpret_cast<const bf16x8*>(&Vh[(long)((k0) + 32 + sr) * ldk + sc]); \
    ksE0 = *reinterpret_cast<const bf16x8*>(&Kh[(long)((k0) + sr) * ldk + sc]); ksE1 = *reinterpret_cast<const bf16x8*>(&Kh[(long)((k0) + 32 + sr) * ldk + sc]); } while (0)
#define SLOAD_O(k0) do { vsO0 = *reinterpret_cast<const bf16x8*>(&Vh[(long)((k0) + sr) * ldk + sc]); vsO1 = *reinterpret_cast<const bf16x8*>(&Vh[(long)((k0) + 32 + sr) * ldk + sc]); \
    ksO0 = *reinterpret_cast<const bf16x8*>(&Kh[(long)((k0) + sr) * ldk + sc]); ksO1 = *reinterpret_cast<const bf16x8*>(&Kh[(long)((k0) + 32 + sr) * ldk + sc]); } while (0)
#define SWRITE_E(bo) do { char* B_ = lds + (bo); *(bf16x8*)(B_ + vst0) = vsE0; *(bf16x8*)(B_ + vst1) = vsE1; const int kc = sc * 2; \
    *(bf16x8*)(B_ + SHM_V + KSWZ(sr, kc)) = ksE0; *(bf16x8*)(B_ + SHM_V + KSWZ(32 + sr, kc)) = ksE1; } while (0)
#define SWRITE_O(bo) do { char* B_ = lds + (bo); *(bf16x8*)(B_ + vst0) = vsO0; *(bf16x8*)(B_ + vst1) = vsO1; const int kc = sc * 2; \
    *(bf16x8*)(B_ + SHM_V + KSWZ(sr, kc)) = ksO0; *(bf16x8*)(B_ + SHM_V + KSWZ(32 + sr, kc)) = ksO1; } while (0)
#define SWAIT() asm volatile("s_waitcnt vmcnt(4)" ::: "memory")
#define PSM(P0, P1, MN, AL) do { if (fixm) { partialSM_fixed(P0); AL = 1.f; MN = 0.f; } else partialSM<PRE>(P0, P1, m_reg, MN, AL); } while (0)
#define RESC(a) do { if (!fixm) if (__any((a) < 1.f)) { if (hi == 0) al_l[r32] = (a); asm volatile("s_waitcnt lgkmcnt(0)" ::: "memory"); \
    _Pragma("unroll") for (int d = 0; d < 4; ++d) _Pragma("unroll") for (int r = 0; r < 16; ++r) o[d][r] *= al_l[crow(r, hi)]; } } while (0)
#define ROT3() do { const int t_ = bV; bV = bK; bK = bW; bW = t_; } while (0)
  f32x16 pA0, pA1, pB0, pB1; float mnA, mnB, alA, alB; bf16x8 pa0, pa1, pa2, pa3; const int NT = ntile;
  int bV = 0, bK = 0, bW = BUF3;
  SLOAD_E(0); SLOAD_O(KVBLK); asm volatile("s_waitcnt vmcnt(4)" ::: "memory"); SWRITE_E(0); SLOAD_E(2 * KVBLK);
  __syncthreads();
  SWAIT(); SWRITE_O(bW);
  qkt(pA0, pA1, lds + bK + SHM_V, qr, r32, hi); PSM(pA0, pA1, mnA, alA);
  if (3 < NT) SLOAD_O(3 * KVBLK);
  bV = 0; bK = BUF3; bW = 2 * BUF3;
  for (int j = 1; j + 1 < NT; j += 2) {
    __syncthreads(); SWAIT(); SWRITE_E(bW);
    SBAR(); qkt(pB0, pB1, lds + bK + SHM_V, qr, r32, hi);
    finishSM(pA0, pA1, alA, l_reg, pa0, pa1, pa2, pa3); SBAR();
    if (j + 3 < NT) SLOAD_E((j + 3) * KVBLK); SBAR();
    pv_d0(o, vb0 + bV, pa0, pa1, pa2, pa3); PSM(pB0, pB1, mnB, alB);
    RESC(alB); ROT3();
    __syncthreads(); SWAIT(); SWRITE_O(bW);
    SBAR(); qkt(pA0, pA1, lds + bK + SHM_V, qr, r32, hi);
    finishSM(pB0, pB1, alB, l_reg, pa0, pa1, pa2, pa3); SBAR();
    if (j + 4 < NT) SLOAD_O((j + 4) * KVBLK); SBAR();
    pv_d0(o, vb0 + bV, pa0, pa1, pa2, pa3); PSM(pA0, pA1, mnA, alA);
    RESC(alA); ROT3();
  }
  __syncthreads();
  SBAR(); qkt(pB0, pB1, lds + bK + SHM_V, qr, r32, hi);
  finishSM(pA0, pA1, alA, l_reg, pa0, pa1, pa2, pa3); SBAR();
  pv_d0(o, vb0 + bV, pa0, pa1, pa2, pa3); PSM(pB0, pB1, mnB, alB);
  RESC(alB); ROT3();
  finishSM(pB0, pB1, alB, l_reg, pa0, pa1, pa2, pa3); SBAR();
  pv_d0(o, vb0 + bV, pa0, pa1, pa2, pa3);
#undef ROT3
  if (hi == 0) li_l[r32] = l_reg; asm volatile("s_waitcnt lgkmcnt(0)" ::: "memory");
  float rli[16];
#pragma unroll
  for (int r = 0; r < 16; ++r) rli[r] = __builtin_amdgcn_rcpf(li_l[crow(r, hi)]);
  __syncthreads();
  bf16_t* stg = (bf16_t*)(lds + wid * 8192);
#pragma unroll
  for (int r = 0; r < 16; ++r) { const int orow = crow(r, hi);
#pragma unroll
    for (int d0 = 0; d0 < 4; ++d0) { const unsigned w = cvt_pk_bf16(o[d0][r] * rli[r], 0.f); stg[orow * 128 + d0 * 32 + r32] = (bf16_t)(w & 0xffffu); } }
  asm volatile("s_waitcnt lgkmcnt(0)" ::: "memory");
#pragma unroll
  for (int i = 0; i < 8; ++i) { const int row = i * 4 + (lane >> 4), ch = lane & 15; const u32x4 v = *(const u32x4*)(stg + row * 128 + ch * 8);
    *(u32x4*)(Ob + (long)(wid * QBLK + row) * ldo + ch * 8) = v; }
  __syncthreads();
#undef PSM
#undef SLOAD_E
#undef SLOAD_O
#undef SWRITE_E
#undef SWRITE_O
#undef SWAIT
#undef RESC
}
#undef SBAR
}

#define XB_TMO      128
#define XB_XCNT(j)  (256  + 64 * (j))
#define XB_XSUB(j)  (1280 + 64 * (j))
#define XB_XGEN(j)  (2304 + 64 * (j))
#define XB_TOP      3328
#define XB_TOPGEN   3392
#define XCD_BAR_WORDS 3456
#define XB_SPIN_CAP (1u << 18)
__device__ __forceinline__ unsigned xb_ld(unsigned* p)              { return __hip_atomic_load(p, __ATOMIC_RELAXED, __HIP_MEMORY_SCOPE_AGENT); }
__device__ __forceinline__ unsigned xb_add(unsigned* p, unsigned v) { return __hip_atomic_fetch_add(p, v, __ATOMIC_RELAXED, __HIP_MEMORY_SCOPE_AGENT); }
__device__ __forceinline__ unsigned xb_xcc_id() { return (unsigned)__builtin_amdgcn_s_getreg((3 << 11) | 20) & 0xFu; }
#define XB_SPIN(cond, bar) do { unsigned _sp = 0; while (cond) { __builtin_amdgcn_s_sleep(1); \
    if ((++_sp & 255u) == 0u) { if (xb_ld(&(bar)[XB_TMO])) break; if (_sp > XB_SPIN_CAP) { atomicAdd(&(bar)[XB_TMO], 1u); break; } } } } while (0)
struct XcdBarrier { unsigned* bar; unsigned x; volatile LAS unsigned* st; };
__device__ __forceinline__ XcdBarrier xcd_barrier_post(unsigned* bar, volatile LAS unsigned* st) {
    XcdBarrier b; b.bar = bar; b.x = xb_xcc_id(); b.st = st;
    if (threadIdx.x == 0) (void)xb_add(&bar[XB_XCNT(b.x)], 1u);
    return b;
}
__device__ __forceinline__ void xcd_barrier_complete(unsigned* bar, unsigned x, unsigned& nloc, unsigned& nx) {
    const unsigned G = gridDim.x * gridDim.y * gridDim.z;
    unsigned sum, cnt, mine, sp = 0u;
    for (;;) {
        sum = 0u; cnt = 0u; mine = 0u;
#pragma unroll
        for (unsigned j = 0; j < 16; ++j) { const unsigned c = xb_ld(&bar[XB_XCNT(j)]); sum += c; cnt += (c > 0u) ? 1u : 0u; mine = (j == x) ? c : mine; }
        if (sum == G) break;
        __builtin_amdgcn_s_sleep(1);
        if ((++sp & 255u) == 0u) { if (xb_ld(&bar[XB_TMO])) break; if (sp > XB_SPIN_CAP) { atomicAdd(&bar[XB_TMO], 1u); break; } }
    }
    nloc = mine > 0u ? mine : 1u; nx = cnt > 0u ? cnt : 1u;
}
__device__ __forceinline__ void xcd_barrier(const XcdBarrier& b) {
    asm volatile("s_waitcnt vmcnt(0)" ::: "memory");
    __syncthreads();
    if (threadIdx.x == 0) {
        unsigned* bar = b.bar;
        __builtin_amdgcn_s_waitcnt(0);
        unsigned nloc = b.st[0], nx = b.st[1];
        if (nloc == 0u) { xcd_barrier_complete(bar, b.x, nloc, nx); b.st[0] = nloc; b.st[1] = nx; }
        const unsigned old = xb_add(&bar[XB_XSUB(b.x)], 1u);
        const unsigned gen = old / nloc;
        if (old + 1u == (gen + 1u) * nloc) {
            __builtin_amdgcn_fence(__ATOMIC_RELEASE, "agent");
            asm volatile("s_waitcnt vmcnt(0)" ::: "memory");
            const unsigned og = xb_add(&bar[XB_TOP], 1u);
            const unsigned tg = og / nx;
            if (og + 1u == (tg + 1u) * nx) xb_add(&bar[XB_TOPGEN], 1u);
            else XB_SPIN(xb_ld(&bar[XB_TOPGEN]) == tg, bar);
            __builtin_amdgcn_fence(__ATOMIC_ACQUIRE, "agent");
            xb_add(&bar[XB_XGEN(b.x)], 1u);
            asm volatile("s_waitcnt vmcnt(0)" ::: "memory");
        } else {
            XB_SPIN(xb_ld(&bar[XB_XGEN(b.x)]) == gen, bar);
            __builtin_amdgcn_fence(__ATOMIC_ACQUIRE, "agent");
            asm volatile("s_waitcnt vmcnt(0)" ::: "memory");
        }
    }
    __syncthreads();
}

constexpr int NWAVES = 8;
constexpr int RING_BYTES = 131072, LDSCTL_OFF = RING_BYTES, MISC_OFF = LDSCTL_OFF + 320, LDS_BYTES = 147456;
static_assert(att::LDS_BYTES <= RING_BYTES, "attention scratch inside the ring region");

struct Args {
    const float* in[20]; float* out; unsigned char* ws; int ph_lo, ph_hi;
};

__device__ __forceinline__ float wave_sum(float v) {
#pragma unroll
    for (int o = 1; o < 64; o <<= 1) v += __shfl_xor(v, o);
    return v;
}
__device__ __forceinline__ unsigned f2bf(float f) { unsigned u = __builtin_bit_cast(unsigned, f); return (u + 0x7fffu + ((u >> 16) & 1u)) >> 16; }
__device__ __forceinline__ unsigned pk2(float lo, float hi) { return f2bf(lo) | (f2bf(hi) << 16); }

__device__ __forceinline__ void transpose_item(const float* W, const float* gain, int K, int N, bf16_t* WT, int k0, int n0, int drow0, LAS float* scr, int lane) {
    const int kr = lane >> 3, nq = lane & 7;
    f32x4 v[8]; float gk[8];
#pragma unroll
    for (int i = 0; i < 8; ++i) { v[i] = *(const GAS f32x4*)(W + (size_t)(k0 + kr + 8 * i) * N + n0 + 4 * nq); gk[i] = gain ? gain[k0 + kr + 8 * i] : 1.0f; }
#pragma unroll
    for (int i = 0; i < 8; ++i) { LAS float* d = scr + (kr + 8 * i) * 33 + 4 * nq; d[0] = v[i].x * gk[i]; d[1] = v[i].y * gk[i]; d[2] = v[i].z * gk[i]; d[3] = v[i].w * gk[i]; }
    asm volatile("s_waitcnt lgkmcnt(0)" ::: "memory");
    const int c = lane & 7;
#pragma unroll
    for (int j = 0; j < 4; ++j) { const int n = (lane >> 3) + 8 * j; const LAS float* s = scr + (8 * c) * 33 + n;
        u32x4 o; o.x = pk2(s[0 * 33], s[1 * 33]); o.y = pk2(s[2 * 33], s[3 * 33]); o.z = pk2(s[4 * 33], s[5 * 33]); o.w = pk2(s[6 * 33], s[7 * 33]);
        *(GAS u32x4*)(WT + (size_t)(drow0 + n) * K + k0 + 8 * c) = o; }
    asm volatile("s_waitcnt lgkmcnt(0)" ::: "memory");
}

__device__ __forceinline__ int t5_bucket(int rel) {
    const int n = rel < 0 ? -rel : rel; int b;
    if (n < 8) b = n; else { b = 8 + (n >= 15) + (n >= 27) + (n >= 50) + (n >= 91) + (n >= 166) + (n >= 305) + (n >= 559); if (b > 15) b = 15; }
    return b + (rel > 0 ? 16 : 0);
}
__device__ __forceinline__ void sincos_d(double a, double& s, double& c) {
    const double k = __builtin_rint(a * 0.63661977236758134308);
    const double r = (a - k * 1.57079632679489655800) - k * 6.12323399573676603587e-17;
    const double r2 = r * r;
    double ps = 1.0 / 6227020800.0;
    ps = ps * r2 - 1.0 / 39916800.0; ps = ps * r2 + 1.0 / 362880.0; ps = ps * r2 - 1.0 / 5040.0; ps = ps * r2 + 1.0 / 120.0; ps = ps * r2 - 1.0 / 6.0; ps = ps * r2 + 1.0;
    const double sr = r * ps;
    double pc = -1.0 / 87178291200.0;
    pc = pc * r2 + 1.0 / 479001600.0; pc = pc * r2 - 1.0 / 3628800.0; pc = pc * r2 + 1.0 / 40320.0; pc = pc * r2 - 1.0 / 720.0; pc = pc * r2 + 1.0 / 24.0; pc = pc * r2 - 0.5; pc = pc * r2 + 1.0;
    const int q = ((int)k) & 3;
    s = (q == 0) ? sr : (q == 1) ? pc : (q == 2) ? -sr : -pc;
    c = (q == 0) ? pc : (q == 1) ? -sr : (q == 2) ? -pc : sr;
}

__device__ __forceinline__ float row_to_bf16(const float* xrow, bf16_t* orow, int lane) {
    const GAS f32x4* xr = (const GAS f32x4*)xrow + lane;
    f32x4 v[8]; float s = 0.f;
#pragma unroll
    for (int j = 0; j < 8; ++j) { v[j] = xr[64 * j]; s += (v[j].x * v[j].x + v[j].y * v[j].y) + (v[j].z * v[j].z + v[j].w * v[j].w); }
    GAS u32x2* o8 = (GAS u32x2*)orow + lane;
#pragma unroll
    for (int j = 0; j < 8; ++j) { u32x2 w; w.x = cvt_pk_bf16(v[j].x, v[j].y); w.y = cvt_pk_bf16(v[j].z, v[j].w); o8[64 * j] = w; }
    return wave_sum(s);
}
__device__ __forceinline__ void rms_row_out(const bf16_t* xrow, float* orow, const float* g, float rstd, int lane) {
    const GAS u32x2* xr = (const GAS u32x2*)xrow + lane; GAS f32x4* o = (GAS f32x4*)orow + lane; const GAS f32x4* gr = (const GAS f32x4*)g + lane;
#pragma unroll
    for (int j = 0; j < 8; ++j) { const u32x2 w = xr[64 * j]; const f32x4 gg = gr[64 * j]; f32x4 v = {bflo(w.x), bfhi(w.x), bflo(w.y), bfhi(w.y)}; o[64 * j] = v * rstd * gg; }
}

__device__ __forceinline__ void qknorm_rows(bf16_t* qkv, const float* ropec, const float* ropes, const float* qg, const float* kg, int row_base, int tid) {
    const int lane = tid & 63, wave = tid >> 6;
    const int head = lane >> 3, q8 = lane & 7, hf = q8 >> 2, a = q8 & 3;
    const float* gp = (head < 6) ? qg : kg;
    const float osc = (head < 6) ? 0.088388347648318440f * 1.4426950408889634f : 1.0f;
    float g1[8], g2[8];
#pragma unroll
    for (int e = 0; e < 8; ++e) { g1[e] = gp[hf * 64 + 8 * a + e]; g2[e] = gp[hf * 64 + 32 + 8 * a + e]; }
    for (int t0 = 0; t0 < 32; t0 += 4) {
        u32x4 w1[4], w2[4]; f32x4 cs[4][4];
#pragma unroll
        for (int i = 0; i < 4; ++i) { const int m = row_base + wave + 8 * (t0 + i);
            const int s = (m < NPROMPT) ? (m & (SEQ_P - 1)) : ((m - NPROMPT) & (SEQ_S - 1)); const int n = hf ? (s & 63) : (s >> 6);
            const bf16_t* p1 = qkv + (size_t)m * PROJ + head * HD + hf * 64 + 8 * a;
            w1[i] = *(const GAS u32x4*)p1; w2[i] = *(const GAS u32x4*)(p1 + 32);
            cs[i][0] = *(const GAS f32x4*)(ropec + n * 32 + 8 * a); cs[i][1] = *(const GAS f32x4*)(ropec + n * 32 + 8 * a + 4);
            cs[i][2] = *(const GAS f32x4*)(ropes + n * 32 + 8 * a); cs[i][3] = *(const GAS f32x4*)(ropes + n * 32 + 8 * a + 4); }
#pragma unroll
        for (int i = 0; i < 4; ++i) { const int m = row_base + wave + 8 * (t0 + i);
            bf16_t* p1 = qkv + (size_t)m * PROJ + head * HD + hf * 64 + 8 * a;
            float x1[8], x2[8];
#pragma unroll
            for (int e = 0; e < 4; ++e) { x1[2 * e] = bflo(w1[i][e]); x1[2 * e + 1] = bfhi(w1[i][e]); x2[2 * e] = bflo(w2[i][e]); x2[2 * e + 1] = bfhi(w2[i][e]); }
            float ss = 0.f;
#pragma unroll
            for (int e = 0; e < 8; ++e) ss += x1[e] * x1[e] + x2[e] * x2[e];
            ss += __shfl_xor(ss, 1); ss += __shfl_xor(ss, 2); ss += __shfl_xor(ss, 4);
            const float rstd = 1.0f / sqrtf(ss * (1.f / HD) + RMS_EPS);
            float o1[8], o2[8];
#pragma unroll
            for (int e = 0; e < 8; ++e) { const float cc = e < 4 ? cs[i][0][e & 3] : cs[i][1][e & 3], sn = e < 4 ? cs[i][2][e & 3] : cs[i][3][e & 3];
                const float y1 = x1[e] * rstd * g1[e], y2 = x2[e] * rstd * g2[e]; o1[e] = (y1 * cc - y2 * sn) * osc; o2[e] = (y1 * sn + y2 * cc) * osc; }
            u32x4 r1, r2;
#pragma unroll
            for (int e = 0; e < 4; ++e) { r1[e] = cvt_pk_bf16(o1[2 * e], o1[2 * e + 1]); r2[e] = cvt_pk_bf16(o2[2 * e], o2[2 * e + 1]); }
            *(GAS u32x4*)p1 = r1; *(GAS u32x4*)(p1 + 32) = r2; }
    }
}
__device__ __forceinline__ void crescale_rows(bf16_t* mix, const float* lsebuf, int row_base, int tid) {
    const int lane = tid & 63, wave = tid >> 6;
    for (int t0 = 0; t0 < 32; t0 += 4) {
        float ls[4][6]; u32x2 w[4][3];
#pragma unroll
        for (int i = 0; i < 4; ++i) { const int m = row_base + wave + 8 * (t0 + i);
#pragma unroll
            for (int k = 0; k < 6; ++k) ls[i][k] = lsebuf[(size_t)m * 6 + k];
            const GAS u32x2* p = (const GAS u32x2*)(mix + (size_t)m * MIXW + 1280) + lane;
#pragma unroll
            for (int j = 0; j < 3; ++j) w[i][j] = p[64 * j]; }
#pragma unroll
        for (int i = 0; i < 4; ++i) { const int m = row_base + wave + 8 * (t0 + i);
            float al[6];
#pragma unroll
            for (int j = 0; j < 2; ++j) { const float mx = fmaxf(fmaxf(ls[i][j], ls[i][2 + j]), ls[i][4 + j]);
                const float e0 = __expf(ls[i][j] - mx), e1 = __expf(ls[i][2 + j] - mx), e2 = __expf(ls[i][4 + j] - mx); const float inv = 1.0f / (e0 + e1 + e2);
                al[j] = e0 * inv; al[2 + j] = e1 * inv; al[4 + j] = e2 * inv; }
            GAS u32x2* p = (GAS u32x2*)(mix + (size_t)m * MIXW + 1280) + lane;
#pragma unroll
            for (int j = 0; j < 3; ++j) { const int hc = (4 * lane + 256 * j) >> 7; const float a = (hc == 0) ? al[0] : (hc == 1) ? al[1] : (hc == 2) ? al[2] : (hc == 3) ? al[3] : (hc == 4) ? al[4] : al[5];
                u32x2 v = w[i][j]; v.x = cvt_pk_bf16(bflo(v.x) * a, bfhi(v.x) * a); v.y = cvt_pk_bf16(bflo(v.y) * a, bfhi(v.y) * a); p[64 * j] = v; } }
    }
}

__global__ void __launch_bounds__(NWAVES * 64, 2) fwd(Args args) {
    extern __shared__ __attribute__((aligned(16))) unsigned char lds[];
    LAS unsigned char* ldsl = (LAS unsigned char*)lds;
    volatile LAS unsigned* MISC = (volatile LAS unsigned*)(ldsl + MISC_OFF);
    const int G = gridDim.x;
    unsigned char* ws = args.ws;
    gu32* ctl = (gu32*)(ws + WS_CTL);
    { const int tid0 = threadIdx.x; for (int u = tid0; u < (LDS_BYTES - LDSCTL_OFF) / 4; u += NWAVES * 64) ((LAS unsigned*)(ldsl + LDSCTL_OFF))[u] = 0u; }
    __syncthreads();
    XcdBarrier bar; bar.bar = (unsigned*)ctl + CW_BAR; bar.x = 0; bar.st = nullptr;
    if (ONE_LAUNCH) bar = xcd_barrier_post((unsigned*)ctl + CW_BAR, MISC + 8);
    int bx = blockIdx.x;
    if (ONE_LAUNCH) {
        if (threadIdx.x == 0) { const unsigned xcc = xb_xcc_id(); const unsigned rk = __hip_atomic_fetch_add(ctl + CW_XRANK + 64 * (xcc & 15u), 1u, __ATOMIC_RELAXED, __HIP_MEMORY_SCOPE_AGENT); MISC[12] = rk * 8u + ((xcc + 3u) & 7u); }
        xcd_barrier(bar);
        if (threadIdx.x == 0) { bool ok = (G % 8 == 0);
            for (unsigned j = 0; j < 16; ++j) { const unsigned cnt = __hip_atomic_load(ctl + CW_XRANK + 64 * j, __ATOMIC_RELAXED, __HIP_MEMORY_SCOPE_AGENT); ok = ok && (cnt == (j < 8 ? (unsigned)G / 8u : 0u)); }
            if (!ok) MISC[12] = blockIdx.x; }
        __syncthreads();
        bx = __builtin_amdgcn_readfirstlane((int)MISC[12]);
    }
    const int lo = args.ph_lo, hi = args.ph_hi;
#ifndef PHMASK
#define PHMASK 0xffff
#endif
#define IN(k) (lo <= (k) && (k) < hi)
#define EN(b) ((PHMASK >> (b)) & 1)
#ifndef PROBE_DUP
#define PROBE_DUP 0
#endif
#define NREP(b) (1 + ((PROBE_DUP >> (b)) & 1))
#define REPSEAM(b) do { if (ONE_LAUNCH && NREP(b) > 1 && rep == 0) xcd_barrier(bar); } while (0)
#define SEAM(k) do { if (ONE_LAUNCH && IN(k) && IN((k) + 1)) xcd_barrier(bar); } while (0)
#define LANE_ID() const int tid = opaque_tid(), lane = tid & 63, wave = __builtin_amdgcn_readfirstlane(tid >> 6); const int vcu = (G % 8 == 0) ? (bx % 8) * (G / 8) + bx / 8 : bx; const int gw = vcu * NWAVES + wave, NGW = G * NWAVES; (void)lane; (void)gw; (void)NGW
#define ROPEC ((float*)(ws + WS_TAB))
#define ROPES (ROPEC + 128 * 32)
#define TABB (ROPES + 128 * 32)
#define TABC (TABB + 4 * 512)
#define LSEBUF ((float*)(ws + WS_LSE))
#define XB ((bf16_t*)(ws + WS_XB))
#define MB ((bf16_t*)(ws + WS_MB))
#define SSBUF ((pg8::ss_t*)(ws + WS_SS))
#define RSM ((pg8::ss_t*)(ws + WS_RSM))
#define QKV ((bf16_t*)(ws + WS_QKV))
#define MIX ((bf16_t*)(ws + WS_MIX))
#define HID ((bf16_t*)(ws + WS_HID))
#define QX ((bf16_t*)(ws + WS_QX))
#define OX ((bf16_t*)(ws + WS_OX))
#define KVX ((bf16_t*)(ws + WS_KVX))
    float* out = args.out;

    if (EN(13) && IN(0)) {
        LANE_ID();
        float* ropec = ROPEC; float* ropes = ROPES; float* tabB = TABB; float* tabC = TABC;
        LAS float* scr = (LAS float*)(ldsl + wave * 16384);
        constexpr int I_IN = 32 * 120, I_OUT = 32 * 64, I_CQ = 32 * 16, I_CKV = 32 * 32, I_CO = 8 * 64, I_FI = 32 * 352, I_FO = 88 * 64;
        constexpr int I_LAYER = I_IN + I_OUT + I_CQ + I_CKV + I_CO + I_FI + I_FO;
        for (int it = gw; it < DEPTH * I_LAYER; it += NGW) {
            const int l = it / I_LAYER; int r = it % I_LAYER;
            const float* W; bf16_t* WT; int K, N; const float* gain = nullptr;
            if (r < I_IN) { gain = args.in[4] + (size_t)l * DM; W = args.in[5] + (size_t)l * DM * PROJ; WT = (bf16_t*)(ws + WS_WIN) + (size_t)l * PROJ * DM; K = DM; N = PROJ; }
            else if ((r -= I_IN) < I_OUT) { W = args.in[10] + (size_t)l * MIXW * DM; WT = (bf16_t*)(ws + WS_WOUT) + (size_t)l * DM * MIXW; K = MIXW; N = DM; }
            else if ((r -= I_OUT) < I_CQ) { gain = args.in[11] + (size_t)l * DM; W = args.in[13] + (size_t)l * DM * XW; WT = (bf16_t*)(ws + WS_WCQ) + (size_t)l * XW * DM; K = DM; N = XW; }
            else if ((r -= I_CQ) < I_CKV) { gain = args.in[12] + (size_t)l * DM; W = args.in[14] + (size_t)l * DM * 2 * XW; WT = (bf16_t*)(ws + WS_WCKV) + (size_t)l * 2 * XW * DM; K = DM; N = 2 * XW; }
            else if ((r -= I_CKV) < I_CO) { W = args.in[15] + (size_t)l * XW * DM; WT = (bf16_t*)(ws + WS_WCO) + (size_t)l * DM * XW; K = XW; N = DM; }
            else if ((r -= I_CO) < I_FI) { gain = args.in[16] + (size_t)l * DM; W = args.in[17] + (size_t)l * DM * 2 * DFF; WT = (bf16_t*)(ws + WS_WFI) + (size_t)l * 2 * DFF * DM; K = DM; N = 2 * DFF; }
            else { r -= I_FI; W = args.in[18] + (size_t)l * DFF * DM; WT = (bf16_t*)(ws + WS_WFO) + (size_t)l * DM * DFF; K = DFF; N = DM; }
            const int nblk = N / 32, kb = r / nblk, nb = r % nblk, n0 = 32 * nb;
            int drow0 = n0;
            if (N == 2 * DFF) drow0 = (n0 < DFF) ? 256 * (n0 / 128) + (n0 % 128) : 256 * ((n0 - DFF) / 128) + 128 + ((n0 - DFF) % 128);
            transpose_item(W, gain, K, N, WT, 64 * kb, n0, drow0, scr, lane);
        }
        { bf16_t* xb = XB; pg8::ss_t* ss0 = SSBUF; bf16_t* mb = MB; pg8::ss_t* rsm = RSM;
          for (int m = gw; m < NTOK; m += NGW) { const float* xr = (m < NPROMPT) ? args.in[0] + (size_t)m * DM : args.in[1] + (size_t)(m - NPROMPT) * DM;
              const float q = row_to_bf16(xr, xb + (size_t)m * DM, lane); if (lane == 0) ss0[m] = (pg8::ss_t)(q * pg8::SS_SCALE); }
          for (int m = gw; m < MEMROWS; m += NGW) { const float* mr = (m < 2 * MEMLEN) ? args.in[2] + (size_t)m * DM : args.in[3] + (size_t)(m - 2 * MEMLEN) * DM;
              const float q = row_to_bf16(mr, mb + (size_t)m * DM, lane); if (lane == 0) rsm[m] = (pg8::ss_t)(q * pg8::SS_SCALE); } }
        const int gt = vcu * (NWAVES * 64) + tid, NGT = G * NWAVES * 64;
        const float* rel_bias = args.in[9];
        for (int e = gt; e < 4096 + 2048 + 3072; e += NGT) {
            if (e < 4096) { const int n = e >> 5, i = e & 31;
                double invd = 1.0; for (int q = 0; q < i; ++q) invd *= 0.7498942093324559;
                const float inv = (float)invd;
                const float ang = (float)n * inv; double s, c; sincos_d((double)ang, s, c); ropec[e] = (float)c; ropes[e] = (float)s; }
            else if (e < 4096 + 2048) { const int t = e - 4096, h = t >> 9, i = t & 511; const int rel = i - 96 - 128;
                float v = -INFINITY; if (rel >= -128 && rel <= 128) v = rel_bias[t5_bucket(rel) * 10 + h] * att::LOG2E;
                tabB[t] = v; }
            else { const int t = e - 6144, hc = t >> 9, i = t & 511; const int off = i - 96 - 64; const int d = (hc < 2) ? 1 : (hc < 4) ? 4 : 16;
                float v = -INFINITY; if (off >= -64 && off <= 64) v = rel_bias[t5_bucket(off * d) * 10 + 4 + hc] * att::LOG2E;
                tabC[t] = v; }
        }
    }
    SEAM(0);

    for (int l = 0; l < DEPTH; ++l) {
        const int pb = 1 + PPL * l;
#define XS0 ((l == 0) ? args.in[0] : (const float*)out)
#define XS1 ((l == 0) ? args.in[1] : (const float*)out + (size_t)NPROMPT * DM)
        if (EN(0) && IN(pb + 0)) for (int rep = 0; rep < NREP(0); ++rep) {
            { const bf16_t* Win = (const bf16_t*)(ws + WS_WIN) + (size_t)l * PROJ * DM; const bool tail = (G == 256) && l > 0;
              pg8::Gemm g{XB, Win, NTOK, PROJ, DM}; pg8::StaticOrder S; S.init(NTOK, PROJ, G, bx, 0, tail ? 11 : (1 << 30));
              pg8::EpiBf16 E{QKV, PROJ, SSBUF + (size_t)(3 * l) * NTOK};
              pg8::gemm_phase<pg8::EpiBf16, pg8::StaticOrder, true, true>(ldsl, g, S, E);
              if (tail) {
                  if (threadIdx.x == 0) MISC[13] = __hip_atomic_fetch_add(ctl + CW_TAIL + 64 * l, 1u, __ATOMIC_RELAXED, __HIP_MEMORY_SCOPE_AGENT);
                  __syncthreads(); const int slot = __builtin_amdgcn_readfirstlane((int)MISC[13]); __syncthreads();
                  pg8::TailHalfOrder T; T.init(NTOK, PROJ, G, slot, 11); pg8::EpiBf16H EH{QKV, PROJ, SSBUF + (size_t)(3 * l) * NTOK};
                  pg8::gemm_phase<pg8::EpiBf16H, pg8::TailHalfOrder, true, true, true>(ldsl, g, T, EH); } }
            if (l == 0) {
              pg8::Gemm g{MB, (const bf16_t*)(ws + WS_WCKV), MEMROWS, 4 * 2 * XW, DM}; pg8::StaticOrder S; S.init(MEMROWS, 4 * 2 * XW, G, (bx + G - 64) % G);
              pg8::EpiBf16 E{KVX, 4 * 2 * XW, RSM};
              pg8::gemm_phase<pg8::EpiBf16, pg8::StaticOrder, true, true>(ldsl, g, S, E); }
            REPSEAM(0);
        }
        SEAM(pb + 0);
        if (EN(1) && IN(pb + 1)) {
            const int tid = opaque_tid(); const float* tabC = TABC; float* lsebuf = LSEBUF;
            gu32* qhead = ctl + CW_QUEUE + 64 * (2 * l);
            volatile LAS unsigned* uidw = (volatile LAS unsigned*)(ldsl + att::OFF_UID);
            for (;;) {
                if (tid == 0) uidw[0] = __hip_atomic_fetch_add(qhead, 1u, __ATOMIC_RELAXED, __HIP_MEMORY_SCOPE_AGENT);
                __syncthreads();
                const int u = (int)uidw[0];
                __syncthreads();
                if (u >= 1344) break;
                if (u < 960 && u % 5 == 4) {
                    qknorm_rows(QKV, ROPEC, ROPES, args.in[6] + (size_t)l * HD, args.in[7] + (size_t)l * HD, (u / 5) * 256, tid);
                } else { const int v0 = (u < 960) ? u - u / 5 : u - 192;
                {
                    const int v = v0, gi = v % 3, idx = v / 3; const int d = (gi == 0) ? 1 : (gi == 1) ? 4 : 16;
                    long row0; int j, L;
                    if (idx < 128) { row0 = (long)(idx / 64) * SEQ_P; j = idx % 64; L = SEQ_P; } else { const int i2 = idx - 128; row0 = NPROMPT + (long)(i2 / 32) * SEQ_S; j = i2 % 32; L = SEQ_S; }
                    const int res = j % d, qbr = j / d, p0 = qbr * 128, Lr = L / d;
                    int tlo = p0 / 64 - 1, thi = p0 / 64 + 3; if (tlo < 0) tlo = 0; if (thi > Lr / 64) thi = Lr / 64;
                    const long rq = row0 + (long)p0 * d + res, rk = row0 + res; const int hc = 2 * gi;
                    att::attn_unit<true>(QKV + rq * PROJ + COL_QC + hc * HD, (long)d * PROJ, QKV + rk * PROJ + COL_KC + gi * HD, QKV + rk * PROJ + COL_VC + gi * HD, (long)d * PROJ,
                                         MIX + rq * MIXW + 1280 + hc * HD, (long)d * MIXW, tlo, thi, p0, 64, tabC + hc * 512, 321, -1e30f, -1e30f, 0.f, lsebuf + rq * 6 + hc, (long)d * 6, (char*)lds);
                } }
            }
        }
        SEAM(pb + 1);
        if (EN(2) && IN(pb + 2)) for (int rep = 0; rep < NREP(2); ++rep) {
            const int tid = opaque_tid(); const float* tabB = TABB;
            float mfix2;
            { const float* qg = args.in[6] + (size_t)l * HD; const float* kg = args.in[7] + (size_t)l * HD; const int ln = tid & 63;
              float a = fmaxf(fabsf(qg[ln]), fabsf(qg[ln + 64])), b = fmaxf(fabsf(kg[ln]), fabsf(kg[ln + 64]));
#pragma unroll
              for (int o = 1; o < 64; o <<= 1) { a = fmaxf(a, __shfl_xor(a, o)); b = fmaxf(b, __shfl_xor(b, o)); }
              mfix2 = __builtin_amdgcn_readfirstlane(128.f * a * b * 1.02f * att::C); if (!(mfix2 <= 40.f)) mfix2 = -1.f; }
            gu32* qhead = ctl + CW_QUEUE + 64 * (2 * l + 1 + 8 * rep);
            volatile LAS unsigned* uidw = (volatile LAS unsigned*)(ldsl + att::OFF_UID);
            const float* sink = args.in[8] + (size_t)l * 4;
            for (;;) {
                if (tid == 0) uidw[0] = __hip_atomic_fetch_add(qhead, 1u, __ATOMIC_RELAXED, __HIP_MEMORY_SCOPE_AGENT);
                __syncthreads();
                const int u = (int)uidw[0];
                __syncthreads();
                if (u >= 1152 + 192 + 768) break;
                if (u < 1152) {
                    int seq, kvh, qb, gi, L;
                    if (u < 384) { seq = u / 192; const int r = u % 192; kvh = r / 96; const int r2 = r % 96; qb = r2 / 3; gi = r2 % 3; L = SEQ_P; }
                    else { const int v = u - 384; seq = 2 + v / 96; const int r = v % 96; kvh = r / 48; const int r2 = r % 48; qb = r2 / 3; gi = r2 % 3; L = SEQ_S; }
                    const long row0 = (seq < 2) ? (long)seq * SEQ_P : (long)NPROMPT + (long)(seq - 2) * SEQ_S;
                    const int h = kvh * 3 + gi;
                    if (mfix2 >= 0.f)
                    att::attn_unit_dense<true, 1>(QKV + (row0 + qb * 256) * PROJ + COL_QA + h * HD, PROJ, QKV + row0 * PROJ + COL_KA + kvh * HD, QKV + row0 * PROJ + COL_VA + kvh * HD, PROJ,
                                         MIX + (row0 + qb * 256) * MIXW + h * HD, MIXW, L / 64, mfix2, (char*)lds);
                    else
                    att::attn_unit_dense<true, 0>(QKV + (row0 + qb * 256) * PROJ + COL_QA + h * HD, PROJ, QKV + row0 * PROJ + COL_KA + kvh * HD, QKV + row0 * PROJ + COL_VA + kvh * HD, PROJ,
                                         MIX + (row0 + qb * 256) * MIXW + h * HD, MIXW, L / 64, mfix2, (char*)lds);
                } else if (u < 1344) { if (rep == 0) crescale_rows(MIX, LSEBUF, (u - 1152) * 256, tid); }
                else {
                    const int v = u - 1344, qbg = v >> 1, kvh = v & 1; const long rowq = (long)qbg * 128;
                    long row0; int pos0, L;
                    if (rowq < NPROMPT) { row0 = (rowq / SEQ_P) * SEQ_P; pos0 = (int)(rowq % SEQ_P); L = SEQ_P; } else { const long rr = rowq - NPROMPT; row0 = NPROMPT + (rr / SEQ_S) * SEQ_S; pos0 = (int)(rr % SEQ_S); L = SEQ_S; }
                    int tlo = pos0 / 64 - 2, thi = pos0 / 64 + 4; if (tlo < 0) tlo = 0; if (thi > L / 64) thi = L / 64;
                    const int h = 2 * kvh;
                    att::attn_unit<true>(QKV + rowq * PROJ + COL_QB + h * HD, PROJ, QKV + row0 * PROJ + COL_KB + kvh * HD, QKV + row0 * PROJ + COL_VB + kvh * HD, PROJ,
                                         MIX + rowq * MIXW + 768 + h * HD, MIXW, tlo, thi, pos0, 128, tabB + h * 512, 449, sink[h] * att::LOG2E, sink[h + 1] * att::LOG2E, 1.0f, nullptr, 0, (char*)lds);
                }
            }
            REPSEAM(2);
        }
        SEAM(pb + 2);
        if (EN(3) && IN(pb + 3)) for (int rep = 0; rep < NREP(3); ++rep) {
            const bf16_t* Wout = (const bf16_t*)(ws + WS_WOUT) + (size_t)l * DM * MIXW;
            pg8::Gemm g{MIX, Wout, NTOK, DM, MIXW}; pg8::StaticOrder S; S.init(NTOK, DM, G, bx);
            pg8::EpiRes E{XB, SSBUF + (size_t)(rep ? NNORM : 3 * l + 1) * NTOK, rep ? 0.f : 1.f};
            pg8::gemm_phase<pg8::EpiRes, pg8::StaticOrder, true, true>(ldsl, g, S, E);
            REPSEAM(3);
        }
        SEAM(pb + 3);
        if (EN(4) && IN(pb + 4)) for (int rep = 0; rep < NREP(4); ++rep) {
            const bf16_t* Wcq = (const bf16_t*)(ws + WS_WCQ) + (size_t)l * XW * DM;
            const bool tail = (G == 256);
            pg8::Gemm g{XB, Wcq, NTOK, XW, DM}; pg8::StaticOrder S; S.init(NTOK, XW, G, bx, 0, tail ? 1 : (1 << 30)); pg8::EpiBf16 E{QX, XW, SSBUF + (size_t)(3 * l + 1) * NTOK};
            pg8::gemm_phase<pg8::EpiBf16, pg8::StaticOrder, true, true>(ldsl, g, S, E);
            if (tail) { pg8::TailHalfOrder T; T.init(NTOK, XW, G, bx, 1); pg8::EpiBf16H EH{QX, XW, SSBUF + (size_t)(3 * l + 1) * NTOK};
                pg8::gemm_phase<pg8::EpiBf16H, pg8::TailHalfOrder, true, true, true>(ldsl, g, T, EH); }
            REPSEAM(4);
        }
        SEAM(pb + 4);
        if (EN(5) && IN(pb + 5)) for (int rep = 0; rep < NREP(5); ++rep) {
            for (int u = bx; u < 768; u += G) {
                const int qbg = u >> 2, h = u & 3; const long rowq = (long)qbg * 256;
                const int seq = (rowq < NPROMPT) ? (int)(rowq / SEQ_P) : 2 + (int)((rowq - NPROMPT) / SEQ_S);
                const bf16_t* kb = KVX + (size_t)seq * MEMLEN * (4 * 2 * XW) + l * (2 * XW) + h * HD;
                att::attn_unit_dense<false>(QX + rowq * XW + h * HD, XW, kb, kb + XW, 4 * 2 * XW, OX + rowq * XW + h * HD, XW, MEMLEN / 64, -1.f, (char*)lds);
            }
            REPSEAM(5);
        }
        SEAM(pb + 5);
        if (EN(6) && IN(pb + 6)) for (int rep = 0; rep < NREP(6); ++rep) {
            const bf16_t* Wco = (const bf16_t*)(ws + WS_WCO) + (size_t)l * DM * XW;
            pg8::Gemm g{OX, Wco, NTOK, DM, XW}; pg8::StaticOrder S; S.init(NTOK, DM, G, bx);
            pg8::EpiRes E{XB, SSBUF + (size_t)(rep ? NNORM : 3 * l + 2) * NTOK, rep ? 0.f : 1.f};
            pg8::gemm_phase<pg8::EpiRes, pg8::StaticOrder, true, true>(ldsl, g, S, E);
            REPSEAM(6);
        }
        SEAM(pb + 6);
        if (EN(7) && IN(pb + 7)) for (int rep = 0; rep < NREP(7); ++rep) {
            const bf16_t* Wfi = (const bf16_t*)(ws + WS_WFI) + (size_t)l * 2 * DFF * DM;
            const bool dyn = (G == 256) && NREP(7) == 1;
            pg8::Gemm g{XB, Wfi, NTOK, 2 * DFF, DM}; pg8::StaticOrder S; S.init(NTOK, 2 * DFF, G, bx, 0, dyn ? 32 : (1 << 30));
            pg8::EpiSwiglu E{HID, DFF, SSBUF + (size_t)(3 * l + 2) * NTOK};
            pg8::gemm_phase<pg8::EpiSwiglu, pg8::StaticOrder, true, true>(ldsl, g, S, E);
            if (dyn) {
                if (threadIdx.x == 0) MISC[13] = __hip_atomic_fetch_add(ctl + CW_TAIL + 64 * (4 + l), 1u, __ATOMIC_RELAXED, __HIP_MEMORY_SCOPE_AGENT);
                __syncthreads(); const int slot1 = __builtin_amdgcn_readfirstlane((int)MISC[13]); __syncthreads();
                if (slot1 < G) { pg8::StaticOrder S1; S1.init(NTOK, 2 * DFF, G, slot1, 32, 33);
                    pg8::gemm_phase<pg8::EpiSwiglu, pg8::StaticOrder, true, true>(ldsl, g, S1, E);
                    if (threadIdx.x == 0) MISC[13] = __hip_atomic_fetch_add(ctl + CW_TAIL + 64 * (4 + l), 1u, __ATOMIC_RELAXED, __HIP_MEMORY_SCOPE_AGENT);
                    __syncthreads(); const int slot2 = __builtin_amdgcn_readfirstlane((int)MISC[13]); __syncthreads();
                    if (slot2 < G) { pg8::StaticOrder S2; S2.init(NTOK, 2 * DFF, G, slot2, 32, 33);
                        pg8::gemm_phase<pg8::EpiSwiglu, pg8::StaticOrder, true, true>(ldsl, g, S2, E); } } }
            REPSEAM(7);
        }
        SEAM(pb + 7);
        if (EN(8) && IN(pb + 8)) for (int rep = 0; rep < NREP(8); ++rep) {
            const bf16_t* Wfo = (const bf16_t*)(ws + WS_WFO) + (size_t)l * DM * DFF;
            pg8::Gemm g{HID, Wfo, NTOK, DM, DFF}; pg8::StaticOrder S; S.init(NTOK, DM, G, bx);
            pg8::EpiRes E{XB, SSBUF + (size_t)(rep ? NNORM : 3 * l + 3) * NTOK, rep ? 0.f : 1.f};
            pg8::gemm_phase<pg8::EpiRes, pg8::StaticOrder, true, true>(ldsl, g, S, E);
            REPSEAM(8);
        }
        SEAM(pb + 8);
    }
    if (EN(14) && IN(NPHASE - 1)) {
        LANE_ID();
        const float* g = args.in[19]; const pg8::ss_t* ssl = SSBUF + (size_t)(NNORM - 1) * NTOK;
        f32x4 gg[8];
#pragma unroll
        for (int j = 0; j < 8; ++j) gg[j] = ((const GAS f32x4*)g)[lane + 64 * j];
        for (int m = gw; m < NTOK; m += 4 * NGW) {
            u32x2 w[4][8]; float rstd[4];
#pragma unroll
            for (int i = 0; i < 4; ++i) { const int mi = m + i * NGW; const int mc = mi < NTOK ? mi : m;
                rstd[i] = __builtin_amdgcn_rsqf((float)ssl[mc] * pg8::SS_INV_MEAN + RMS_EPS);
#pragma unroll
                for (int j = 0; j < 8; ++j) w[i][j] = ((const GAS u32x2*)(XB + (size_t)mc * DM))[lane + 64 * j]; }
#pragma unroll
            for (int i = 0; i < 4; ++i) { const int mi = m + i * NGW; if (mi < NTOK) { GAS f32x4* o = (GAS f32x4*)(out + (size_t)mi * DM) + lane;
#pragma unroll
                for (int j = 0; j < 8; ++j) { const f32x4 v = {bflo(w[i][j].x), bfhi(w[i][j].x), bflo(w[i][j].y), bfhi(w[i][j].y)}; o[64 * j] = v * rstd[i] * gg[j]; } } }
        }
    }
#undef IN
#undef SEAM
}

extern "C" void kernel_launch(void* const* d_in, const int* in_sizes, int n_in, void* d_out, int out_size, void* d_ws, size_t ws_size, hipStream_t stream) {
    static int grid = 0;
    if (grid == 0) {
        if (n_in != 20 || out_size != NTOK * DM || ws_size < WS_END) { fprintf(stderr, "kernel_launch: unexpected shapes: n_in %d out %d ws %zu (need %zu)\n", n_in, out_size, ws_size, (size_t)WS_END); grid = -1; return; }
        int dev = 0, cus = 0, per_cu = 0;
        if (hipGetDevice(&dev) != hipSuccess || hipDeviceGetAttribute(&cus, hipDeviceAttributeMultiprocessorCount, dev) != hipSuccess) { grid = -1; return; }
        if (hipFuncSetAttribute((const void*)fwd, hipFuncAttributeMaxDynamicSharedMemorySize, LDS_BYTES) != hipSuccess) { fprintf(stderr, "kernel_launch: hipFuncSetAttribute failed\n"); grid = -1; return; }
        if (hipOccupancyMaxActiveBlocksPerMultiprocessor(&per_cu, (const void*)fwd, NWAVES * 64, LDS_BYTES) != hipSuccess || per_cu < 1) { fprintf(stderr, "kernel_launch: occupancy query says %d\n", per_cu); }
        (void)hipGetLastError();
        grid = cus;
    }
    if (grid < 0) return;
    (void)hipMemsetAsync((char*)d_ws + WS_CTL, 0, CTL_ZERO_BYTES, stream);
    Args a{};
    for (int i = 0; i < 20; ++i) a.in[i] = (const float*)d_in[i];
    a.out = (float*)d_out; a.ws = (unsigned char*)d_ws;
#if ONE_LAUNCH
    a.ph_lo = 0; a.ph_hi = NPHASE;
    hipLaunchKernelGGL(fwd, dim3(grid), dim3(NWAVES * 64), LDS_BYTES, stream, a);
#else
    for (int p = 0; p < NPHASE; ++p) { a.ph_lo = p; a.ph_hi = p + 1; hipLaunchKernelGGL(fwd, dim3(grid), dim3(NWAVES * 64), LDS_BYTES, stream, a); }
#endif
    const hipError_t le = hipPeekAtLastError();
    if (le != hipSuccess) fprintf(stderr, "kernel_launch: launch failed: %s\n", hipGetErrorName(le));
}
```
